# Optimizing an MI355X kernel written in HIP

```python
import jax, jax.numpy as jnp
from jax import lax
import numpy as np

D_MODEL = 1024
BATCH = 8
SEQ = 4096
DEPTH = 2

N_MIXERS = 2
RWKV_HEAD_SIZE = 64
RWKV_HEADS = D_MODEL // RWKV_HEAD_SIZE
DECAY_LORA = 64
AAA_LORA = 64
GATE_LORA = 160
GN_EPS = 64e-5
N_SHIFT_BRANCHES = 6
POOL_WINDOWS = (2, 4, 8, 16)
POOL_GROUPS = 4
POOL_GROUP_WIDTH = D_MODEL // POOL_GROUPS
PEER_HEADS = 8
N_KEYS = 128
N_EXPERTS = N_KEYS * N_KEYS
PEER_TOPK = 16
PEER_DK = 256
PEER_DK_HALF = PEER_DK // 2
PEER_BLOCK = 128
ALPHA = (2 * DEPTH) ** 0.25
BETA = (8 * DEPTH) ** -0.25
LN_EPS = 1e-5
N_MOD = 6

kernel_name = 'hybrid_rwkv7_pool_peer_deepnorm_adaln'


def layer_norm(x, g, b):
    xf = x.astype(jnp.float32)
    mu = jnp.mean(xf, axis=-1, keepdims=True)
    var = jnp.mean(jnp.square(xf - mu), axis=-1, keepdims=True)
    return ((xf - mu) * lax.rsqrt(var + LN_EPS)).astype(x.dtype) * g + b


def wkv7_scan(r, decay, k, v, a_vec, b_vec):
    B, S, H, N = r.shape

    def step(state, inp):
        r_t, w_t, k_t, v_t, a_t, b_t = inp
        sa = jnp.einsum('bhvk,bhk->bhv', state, a_t)
        state = (state * w_t[:, :, None, :] + sa[..., None] * b_t[:, :, None, :]
                 + v_t[..., None] * k_t[:, :, None, :])
        y = jnp.einsum('bhvk,bhk->bhv', state, r_t)
        return state, y

    xs = tuple(jnp.moveaxis(t, 1, 0) for t in (r, decay, k, v, a_vec, b_vec))
    s0 = jnp.zeros((B, H, N, N), jnp.float32)
    _, ys = lax.scan(step, s0, xs)
    return jnp.moveaxis(ys, 0, 1)


def rwkv7_time_mix(h, mu, w_rkv, w0, w1, w2, a0, a1, a2, g1, g2, k_k, k_a, r_k, lnx_g, lnx_b, w_o):
    B, S, D = h.shape
    H, N = RWKV_HEADS, RWKV_HEAD_SIZE
    f32 = jnp.float32
    xx = jnp.pad(h, ((0, 0), (1, 0), (0, 0)))[:, :-1] - h
    xs = h[None] + xx[None] * mu[:, None, None, :]
    r, k, v = jnp.einsum('nbsd,nde->nbse', xs[:3], w_rkv)
    w = -jax.nn.softplus(-(w0 + jnp.tanh(xs[3] @ w1) @ w2).astype(f32)) - 0.5
    decay = jnp.exp(-jnp.exp(w))
    a = jax.nn.sigmoid(a0 + (xs[4] @ a1) @ a2)
    g = jax.nn.sigmoid(xs[5] @ g1) @ g2
    kk = (k * k_k).astype(f32).reshape(B, S, H, N)
    kk = kk * lax.rsqrt(jnp.maximum(jnp.sum(kk * kk, axis=-1, keepdims=True), 1e-24))
    k = k * (1 + (a - 1) * k_a)
    rh, kh, vh, ah = (t.astype(f32).reshape(B, S, H, N) for t in (r, k, v, a))
    y = wkv7_scan(rh, decay.reshape(B, S, H, N), kh, vh, -kk, kk * ah)
    ym = jnp.mean(y, axis=-1, keepdims=True)
    yv = jnp.mean(jnp.square(y - ym), axis=-1, keepdims=True)
    y = ((y - ym) * lax.rsqrt(yv + GN_EPS)).reshape(B, S, D) * lnx_g + lnx_b
    bonus = jnp.sum(rh * kh * r_k, axis=-1, keepdims=True) * vh
    y = (y + bonus.reshape(B, S, D)).astype(h.dtype)
    return (y * g) @ w_o


def multiscale_pool_mix(h, w_in, w_grp, scale, w_out):
    B, S, D = h.shape
    z = (h @ w_in).astype(jnp.float32).reshape(B, S, POOL_GROUPS, POOL_GROUP_WIDTH)
    cs = jnp.cumsum(z, axis=1)
    t = jnp.arange(S)
    pooled = []
    for gi, win in enumerate(POOL_WINDOWS):
        cg = cs[:, :, gi]
        lag = jnp.pad(cg, ((0, 0), (win, 0), (0, 0)))[:, :S]
        cnt = jnp.minimum(t + 1, win).astype(jnp.float32)[None, :, None]
        pooled.append((cg - lag) / cnt)
    p = (jnp.stack(pooled, axis=2) - z).astype(h.dtype)
    y = jnp.einsum('bsgc,gce->bsge', p, w_grp).reshape(B, S, D) * scale
    return y @ w_out


def peer_ffn(h, w_q, keys, u_tab, v_tab):
    B, S, D = h.shape
    K = PEER_TOPK
    q = (h @ w_q).reshape(B, S, PEER_HEADS, 2, PEER_DK_HALF)
    s = jnp.einsum('bshpd,hpkd->bshpk', q, keys).astype(jnp.float32)
    s_top, i_top = lax.top_k(s, K)
    cand = (s_top[..., 0, :, None] + s_top[..., 1, None, :]).reshape(B, S, PEER_HEADS, K * K)
    cand_idx = (i_top[..., 0, :, None] * N_KEYS + i_top[..., 1, None, :]).reshape(B, S, PEER_HEADS, K * K)
    best, pos = lax.top_k(cand, K)
    idx = jnp.take_along_axis(cand_idx, pos, axis=-1)
    gate = jax.nn.softmax(best, axis=-1).astype(h.dtype)
    nb = B * (S // PEER_BLOCK)
    hb = h.reshape(nb, PEER_BLOCK, D)
    ib = idx.reshape(nb, PEER_BLOCK, PEER_HEADS, K)
    gb = gate.reshape(nb, PEER_BLOCK, PEER_HEADS, K)

    def block(args):
        hx, ix, gx = args
        u_sel = jnp.take(u_tab, ix, axis=0)
        act = jax.nn.gelu(jnp.einsum('thkd,td->thk', u_sel, hx), approximate=False)
        v_sel = jnp.take(v_tab, ix, axis=0)
        return jnp.einsum('thk,thkd->td', gx * act, v_sel)

    return lax.map(block, (hb, ib, gb)).reshape(B, S, D)


def _normal(key, shape, scale):
    return jax.random.normal(key, shape, jnp.float32) * scale


def setup_inputs(seed: int = 0) -> dict:
    key = jax.random.key(seed)
    ks = list(jax.random.split(key, 32))
    D = D_MODEL
    n_rwkv = (DEPTH + 1) // 2
    n_pool = DEPTH // 2
    H, N = RWKV_HEADS, RWKV_HEAD_SIZE
    return {
        'x': _normal(ks[0], (BATCH, SEQ, D), 1.0),
        'c': _normal(ks[1], (BATCH, D), 1.0),
        'ada_w': _normal(ks[2], (DEPTH, D, N_MOD * D), D ** -0.5),
        'ada_b': _normal(ks[3], (DEPTH, N_MOD * D), 0.02),
        'ln_g': 1.0 + _normal(ks[4], (DEPTH, 2, D), 0.05),
        'ln_b': _normal(ks[5], (DEPTH, 2, D), 0.02),
        'rw_mu': jax.random.uniform(ks[6], (n_rwkv, N_SHIFT_BRANCHES, D), jnp.float32),
        'rw_w_rkv': _normal(ks[7], (n_rwkv, 3, D, D), D ** -0.5),
        'rw_w0': jax.random.uniform(ks[8], (n_rwkv, D), jnp.float32, -6.0, -1.0),
        'rw_w1': _normal(ks[9], (n_rwkv, D, DECAY_LORA), 0.5 * D ** -0.5),
        'rw_w2': _normal(ks[10], (n_rwkv, DECAY_LORA, D), 0.5 * DECAY_LORA ** -0.5),
        'rw_a0': _normal(ks[11], (n_rwkv, D), 0.1),
        'rw_a1': _normal(ks[12], (n_rwkv, D, AAA_LORA), D ** -0.5),
        'rw_a2': _normal(ks[13], (n_rwkv, AAA_LORA, D), AAA_LORA ** -0.5),
        'rw_g1': _normal(ks[14], (n_rwkv, D, GATE_LORA), D ** -0.5),
        'rw_g2': _normal(ks[15], (n_rwkv, GATE_LORA, D), GATE_LORA ** -0.5),
        'rw_k_k': 0.85 + _normal(ks[16], (n_rwkv, D), 0.05),
        'rw_k_a': 1.0 + _normal(ks[17], (n_rwkv, D), 0.05),
        'rw_r_k': _normal(ks[18], (n_rwkv, H, N), 0.1),
        'rw_lnx_g': 1.0 + _normal(ks[19], (n_rwkv, D), 0.05),
        'rw_lnx_b': _normal(ks[20], (n_rwkv, D), 0.02),
        'rw_w_o': _normal(ks[21], (n_rwkv, D, D), BETA * D ** -0.5),
        'pl_w_in': _normal(ks[22], (n_pool, D, D), D ** -0.5),
        'pl_w_grp': _normal(ks[23], (n_pool, POOL_GROUPS, POOL_GROUP_WIDTH, POOL_GROUP_WIDTH), POOL_GROUP_WIDTH ** -0.5),
        'pl_scale': 1.0 + _normal(ks[24], (n_pool, D), 0.1),
        'pl_w_out': _normal(ks[25], (n_pool, D, D), BETA * D ** -0.5),
        'pe_w_q': _normal(ks[26], (DEPTH, D, PEER_HEADS * PEER_DK), D ** -0.5),
        'pe_keys': _normal(ks[27], (DEPTH, PEER_HEADS, 2, N_KEYS, PEER_DK_HALF), PEER_DK_HALF ** -0.5),
        'pe_u': _normal(ks[28], (DEPTH, N_EXPERTS, D), D ** -0.5),
        'pe_v': _normal(ks[29], (DEPTH, N_EXPERTS, D), BETA),
    }


def reference(x, c, ada_w, ada_b, ln_g, ln_b, rw_mu, rw_w_rkv, rw_w0, rw_w1, rw_w2, rw_a0, rw_a1, rw_a2,
              rw_g1, rw_g2, rw_k_k, rw_k_a, rw_r_k, rw_lnx_g, rw_lnx_b, rw_w_o,
              pl_w_in, pl_w_grp, pl_scale, pl_w_out, pe_w_q, pe_keys, pe_u, pe_v):
    B = x.shape[0]
    cond = jax.nn.silu(c)
    for i in range(DEPTH):
        mod = (cond @ ada_w[i] + ada_b[i]).reshape(B, N_MOD, D_MODEL)[:, :, None, :]
        shift1, scale1, gate1, shift2, scale2, gate2 = (mod[:, n] for n in range(N_MOD))
        j = i // N_MIXERS
        h = x * (1 + scale1) + shift1
        if i % N_MIXERS == 0:
            y = rwkv7_time_mix(h, rw_mu[j], rw_w_rkv[j], rw_w0[j], rw_w1[j], rw_w2[j], rw_a0[j], rw_a1[j],
                               rw_a2[j], rw_g1[j], rw_g2[j], rw_k_k[j], rw_k_a[j], rw_r_k[j],
                               rw_lnx_g[j], rw_lnx_b[j], rw_w_o[j])
        else:
            y = multiscale_pool_mix(h, pl_w_in[j], pl_w_grp[j], pl_scale[j], pl_w_out[j])
        x = layer_norm(ALPHA * x + gate1 * y, ln_g[i, 0], ln_b[i, 0])
        h = x * (1 + scale2) + shift2
        y = peer_ffn(h, pe_w_q[i], pe_keys[i], pe_u[i], pe_v[i])
        x = layer_norm(ALPHA * x + gate2 * y, ln_g[i, 1], ln_b[i, 1])
    return x
```

```cpp
#include <hip/hip_runtime.h>
#include <stdint.h>
#include <stddef.h>

typedef unsigned short bf16_t;
typedef short bf16x8 __attribute__((ext_vector_type(8)));
typedef float f32x4 __attribute__((ext_vector_type(4)));
typedef float f32x2 __attribute__((ext_vector_type(2)));
typedef unsigned u32x4 __attribute__((ext_vector_type(4)));
typedef unsigned u32x2 __attribute__((ext_vector_type(2)));
#define DI __device__ __forceinline__

constexpr int D = 1024, NB = 8, SEQ = 4096, T = NB * SEQ;
constexpr int NH = 16, HS = 64;
constexpr int NEXP = 16384;
constexpr float ALPHA = 1.4142135623730951f;
constexpr float LN_EPS = 1e-5f, GN_EPS = 64e-5f;

DI unsigned cvt_pk_bf16(float lo, float hi) { unsigned r; asm volatile("v_cvt_pk_bf16_f32 %0, %1, %2" : "=v"(r) : "v"(lo), "v"(hi)); return r; }
DI float bf_lo(unsigned u) { return __uint_as_float(u << 16); }
DI float bf_hi(unsigned u) { return __uint_as_float(u & 0xffff0000u); }
DI float bf2f(bf16_t b) { return __uint_as_float(((unsigned)b) << 16); }
DI bf16_t f2bf(float f) { unsigned u = __float_as_uint(f); u += 0x7fffu + ((u >> 16) & 1u); return (bf16_t)(u >> 16); }
DI float sigmoidf_(float x) { return 1.f / (1.f + __expf(-x)); }
DI float wave_sum(float v) {
#pragma unroll
  for (int o = 32; o >= 1; o >>= 1) v += __shfl_xor(v, o);
  return v;
}
DI float gelu_exact(float v) { return 0.5f * v * (1.f + erff(v * 0.70710678118654752f)); }

struct Params {
  const float *x, *c, *ada_w, *ada_b, *ln_g, *ln_b, *rw_mu, *rw_w_rkv, *rw_w0, *rw_w1, *rw_w2, *rw_a0, *rw_a1, *rw_a2, *rw_g1, *rw_g2,
      *rw_k_k, *rw_k_a, *rw_r_k, *rw_lnx_g, *rw_lnx_b, *rw_w_o, *pl_w_in, *pl_w_grp, *pl_scale, *pl_w_out, *pe_w_q, *pe_keys, *pe_u, *pe_v;
  float* out;
  float* mod;
  bf16_t *WT_rkv, *W1T, *A1T, *G1T, *W2T, *A2T, *G2T, *WoT, *PinT, *PoutT, *WgrpT, *WqT, *KeysB;
  unsigned char* slot[7];
};

__global__ void __launch_bounds__(256) k_mod(Params p) {
  __shared__ float cond[NB * D];
  __shared__ float red[8][NB][32];
  const int tid = threadIdx.x;
  for (int i = tid; i < NB * D; i += 256) { float v = p.c[i]; cond[i] = v / (1.f + __expf(-v)); }
  __syncthreads();
  const int l = blockIdx.x / 192, cb = blockIdx.x % 192;
  const int col = cb * 32 + (tid & 31), kg = tid >> 5;
  const float* w = p.ada_w + (size_t)l * D * 6144 + col;
  float acc[NB];
#pragma unroll
  for (int b = 0; b < NB; ++b) acc[b] = 0.f;
  for (int k = kg * 128; k < kg * 128 + 128; ++k) {
    const float wv = w[(size_t)k * 6144];
#pragma unroll
    for (int b = 0; b < NB; ++b) acc[b] += cond[b * D + k] * wv;
  }
#pragma unroll
  for (int b = 0; b < NB; ++b) red[kg][b][tid & 31] = acc[b];
  __syncthreads();
  {
    const int b = tid >> 5, cc = tid & 31;
    float s = 0.f;
#pragma unroll
    for (int g = 0; g < 8; ++g) s += red[g][b][cc];
    const int n = cb * 32 + cc;
    p.mod[((size_t)l * NB + b) * 6144 + n] = s + p.ada_b[l * 6144 + n];
  }
}

__global__ void __launch_bounds__(256) k_transpose_cvt(const float* __restrict__ src, bf16_t* __restrict__ dst, int K, int N, int Kpad, int Npad,
                                                       size_t src_bstride, size_t dst_bstride) {
  __shared__ float tile[32][33];
  const int nb_n = Npad / 32, nb_k = Kpad / 32;
  const int per = nb_n * nb_k;
  const int bz = blockIdx.x / per, r = blockIdx.x % per;
  const int bk = r / nb_n, bn = r % nb_n;
  src += bz * src_bstride; dst += bz * dst_bstride;
  const int tx = threadIdx.x & 31, ty = threadIdx.x >> 5;
#pragma unroll
  for (int i = 0; i < 4; ++i) {
    const int k = bk * 32 + ty + i * 8, n = bn * 32 + tx;
    tile[ty + i * 8][tx] = (k < K && n < N) ? src[(size_t)k * N + n] : 0.f;
  }
  __syncthreads();
#pragma unroll
  for (int i = 0; i < 4; ++i) {
    const int n = bn * 32 + ty + i * 8, k = bk * 32 + tx;
    dst[(size_t)n * Kpad + k] = f2bf(tile[tx][ty + i * 8]);
  }
}
__global__ void __launch_bounds__(256) k_cvt(const float* __restrict__ src, bf16_t* __restrict__ dst, size_t n8) {
  for (size_t i = (size_t)blockIdx.x * 256 + threadIdx.x; i < n8; i += (size_t)gridDim.x * 256) {
    const f32x4 a = *(const f32x4*)(src + i * 8), b = *(const f32x4*)(src + i * 8 + 4);
    u32x4 o; o.x = cvt_pk_bf16(a[0], a[1]); o.y = cvt_pk_bf16(a[2], a[3]); o.z = cvt_pk_bf16(b[0], b[1]); o.w = cvt_pk_bf16(b[2], b[3]);
    *(u32x4*)(dst + i * 8) = o;
  }
}

__global__ void __launch_bounds__(256) k_modulate(const float* __restrict__ x, const float* __restrict__ mod_l, int shift_idx, int scale_idx, bf16_t* __restrict__ h) {
  const size_t n8 = (size_t)T * D / 8;
  for (size_t i = (size_t)blockIdx.x * 256 + threadIdx.x; i < n8; i += (size_t)gridDim.x * 256) {
    const size_t e = i * 8; const int t = (int)(e / D), d = (int)(e % D), b = t / SEQ;
    const float* sh = mod_l + (size_t)b * 6144 + shift_idx * D + d; const float* sc = mod_l + (size_t)b * 6144 + scale_idx * D + d;
    const f32x4 a0 = *(const f32x4*)(x + e), a1 = *(const f32x4*)(x + e + 4);
    const f32x4 s0 = *(const f32x4*)sh, s1 = *(const f32x4*)(sh + 4), c0 = *(const f32x4*)sc, c1 = *(const f32x4*)(sc + 4);
    const f32x4 r0 = a0 * (c0 + 1.f) + s0, r1 = a1 * (c1 + 1.f) + s1;
    u32x4 o; o.x = cvt_pk_bf16(r0[0], r0[1]); o.y = cvt_pk_bf16(r0[2], r0[3]); o.z = cvt_pk_bf16(r1[0], r1[1]); o.w = cvt_pk_bf16(r1[2], r1[3]);
    *(u32x4*)(h + e) = o;
  }
}

struct GemmArgs {
  const bf16_t* A; int lda;
  const bf16_t* Bt; int ldb;
  int M, N, K;
  const float* mu;
  void* out; int ldc;
  const float* v0; const float* v1; const float* v2;
};
enum { EPI_BF16 = 0, EPI_TANH, EPI_SIGMOID, EPI_LW, EPI_ASIG, EPI_Z, EPI_SCALE, EPI_TOPK };
enum { AL_PLAIN = 0, AL_LERP = 1 };

DI int lds_off(int row, int chunk) { return row * 128 + ((chunk ^ (row & 7)) << 4); }

template <int ALOAD> DI void gemm_load_a(const GemmArgs& g, int m0, int k0, int tid, u32x4 (&ra)[4]) {
#pragma unroll
  for (int i = 0; i < 4; ++i) {
    const int row = (tid >> 3) + i * 32, ch = tid & 7;
    const int m = m0 + row;
    const bf16_t* src = g.A + (size_t)m * g.lda + k0 + ch * 8;
    u32x4 v = *(const u32x4*)src;
    if (ALOAD == AL_LERP) {
      u32x4 pv = {0u, 0u, 0u, 0u};
      if ((m % SEQ) != 0) pv = *(const u32x4*)(src - g.lda);
      const f32x4 m0v = *(const f32x4*)(g.mu + k0 + ch * 8), m1v = *(const f32x4*)(g.mu + k0 + ch * 8 + 4);
      float hv[8], pvv[8];
      hv[0] = bf_lo(v.x); hv[1] = bf_hi(v.x); hv[2] = bf_lo(v.y); hv[3] = bf_hi(v.y); hv[4] = bf_lo(v.z); hv[5] = bf_hi(v.z); hv[6] = bf_lo(v.w); hv[7] = bf_hi(v.w);
      pvv[0] = bf_lo(pv.x); pvv[1] = bf_hi(pv.x); pvv[2] = bf_lo(pv.y); pvv[3] = bf_hi(pv.y); pvv[4] = bf_lo(pv.z); pvv[5] = bf_hi(pv.z); pvv[6] = bf_lo(pv.w); pvv[7] = bf_hi(pv.w);
      float o[8];
#pragma unroll
      for (int j = 0; j < 8; ++j) { const float mu = j < 4 ? m0v[j] : m1v[j - 4]; o[j] = hv[j] + (pvv[j] - hv[j]) * mu; }
      v.x = cvt_pk_bf16(o[0], o[1]); v.y = cvt_pk_bf16(o[2], o[3]); v.z = cvt_pk_bf16(o[4], o[5]); v.w = cvt_pk_bf16(o[6], o[7]);
    }
    ra[i] = v;
  }
}
DI void gemm_load_b(const GemmArgs& g, int n0, int k0, int tid, u32x4 (&rb)[4]) {
#pragma unroll
  for (int i = 0; i < 4; ++i) {
    const int row = (tid >> 3) + i * 32, ch = tid & 7;
    rb[i] = *(const u32x4*)(g.Bt + (size_t)(n0 + row) * g.ldb + k0 + ch * 8);
  }
}
DI void gemm_store_lds(unsigned char* buf, int tid, const u32x4 (&r)[4]) {
#pragma unroll
  for (int i = 0; i < 4; ++i) {
    const int row = (tid >> 3) + i * 32, ch = tid & 7;
    *(u32x4*)(buf + lds_off(row, ch)) = r[i];
  }
}

DI unsigned f2key(float f) { unsigned u = __float_as_uint(f); return u ^ ((u >> 31) ? 0xffffffffu : 0x80000000u); }
DI float key2f(unsigned k) { unsigned u = (k >> 31) ? (k ^ 0x80000000u) : ~k; return __uint_as_float(u); }
#define CE_DESC(a, b) { const unsigned _mx = max(a, b), _mn = min(a, b); a = _mx; b = _mn; }
DI void sort16_desc(unsigned (&x)[16]) {
#pragma unroll
  for (int k = 2; k <= 16; k <<= 1) {
#pragma unroll
    for (int j = k >> 1; j > 0; j >>= 1) {
#pragma unroll
      for (int i = 0; i < 16; ++i) {
        const int l = i ^ j;
        if (l > i) {
          if ((i & k) == 0) { CE_DESC(x[i], x[l]); } else { CE_DESC(x[l], x[i]); }
        }
      }
    }
  }
}
DI void merge16_desc(unsigned (&x)[16]) {
#pragma unroll
  for (int j = 8; j > 0; j >>= 1) {
#pragma unroll
    for (int i = 0; i < 16; ++i) { const int l = i ^ j; if (l > i) { CE_DESC(x[i], x[l]); } }
  }
}

template <int EPI, int ALOAD, int WM>
__global__ void __launch_bounds__(256) k_gemm(GemmArgs g) {
  __shared__ __attribute__((aligned(16))) unsigned char lds[65536];
  constexpr int WN = 4 / WM, TM = 128 / WM, TN = 128 / WN, MI = TM / 16, NI = TN / 16;
  const int tid = threadIdx.x, lane = tid & 63, wid = tid >> 6;
  const int wm = wid / WN, wn = wid % WN;
  const int ntn = (g.N + 127) / 128;
  const int tile = blockIdx.x;
  const int m0 = (tile / ntn) * 128, n0 = (tile % ntn) * 128;
  const int nk = g.K / 64;
  f32x4 acc[MI][NI];
#pragma unroll
  for (int i = 0; i < MI; ++i)
#pragma unroll
    for (int j = 0; j < NI; ++j) acc[i][j] = (f32x4){0.f, 0.f, 0.f, 0.f};
  u32x4 ra[4], rb[4];
  gemm_load_a<ALOAD>(g, m0, 0, tid, ra); gemm_load_b(g, n0, 0, tid, rb);
  gemm_store_lds(lds, tid, ra); gemm_store_lds(lds + 16384, tid, rb);
  __syncthreads();
  const int fr = lane & 15, fq = lane >> 4;
  for (int kt = 0; kt < nk; ++kt) {
    unsigned char* cur = lds + (kt & 1) * 32768;
    if (kt + 1 < nk) { gemm_load_a<ALOAD>(g, m0, (kt + 1) * 64, tid, ra); gemm_load_b(g, n0, (kt + 1) * 64, tid, rb); }
#pragma unroll
    for (int ks = 0; ks < 2; ++ks) {
      bf16x8 af[MI], bfr[NI];
#pragma unroll
      for (int i = 0; i < MI; ++i) af[i] = *(const bf16x8*)(cur + lds_off(wm * TM + i * 16 + fr, ks * 4 + fq));
#pragma unroll
      for (int j = 0; j < NI; ++j) bfr[j] = *(const bf16x8*)(cur + 16384 + lds_off(wn * TN + j * 16 + fr, ks * 4 + fq));
#pragma unroll
      for (int i = 0; i < MI; ++i)
#pragma unroll
        for (int j = 0; j < NI; ++j) acc[i][j] = __builtin_amdgcn_mfma_f32_16x16x32_bf16(bfr[j], af[i], acc[i][j], 0, 0, 0);
    }
    if (kt + 1 < nk) { unsigned char* nxt = lds + ((kt + 1) & 1) * 32768; gemm_store_lds(nxt, tid, ra); gemm_store_lds(nxt + 16384, tid, rb); }
    __syncthreads();
  }
  if (EPI == EPI_TOPK) {
    unsigned* lists = (unsigned*)g.out;
    const int grp = tile % ntn;
#pragma unroll
    for (int i = 0; i < MI; ++i) {
      unsigned a[16], b[16];
#pragma unroll
      for (int j = 0; j < 4; ++j)
#pragma unroll
        for (int q = 0; q < 4; ++q) {
          const int n = j * 16 + fq * 4 + q; a[j * 4 + q] = (f2key(acc[i][j][q]) & ~127u) | (unsigned)(127 - n);
          const int n2 = (j + 4) * 16 + fq * 4 + q; b[j * 4 + q] = (f2key(acc[i][j + 4][q]) & ~127u) | (unsigned)(127 - n2);
        }
      sort16_desc(a); sort16_desc(b);
#pragma unroll
      for (int e = 0; e < 16; ++e) a[e] = max(a[e], b[15 - e]);
      merge16_desc(a);
#pragma unroll
      for (int rnd = 0; rnd < 2; ++rnd) {
        const int xo = rnd ? 32 : 16;
#pragma unroll
        for (int e = 0; e < 16; ++e) b[e] = (unsigned)__shfl_xor((int)a[e], xo);
#pragma unroll
        for (int e = 0; e < 16; ++e) a[e] = max(a[e], b[15 - e]);
        merge16_desc(a);
      }
      if (fq == 0) {
        const int m = m0 + wm * TM + i * 16 + fr;
        u32x4* dst = (u32x4*)(lists + ((size_t)m * 16 + grp) * 16);
        dst[0] = (u32x4){a[0], a[1], a[2], a[3]}; dst[1] = (u32x4){a[4], a[5], a[6], a[7]};
        dst[2] = (u32x4){a[8], a[9], a[10], a[11]}; dst[3] = (u32x4){a[12], a[13], a[14], a[15]};
      }
    }
    return;
  }
#pragma unroll
  for (int i = 0; i < MI; ++i) {
    const int m = m0 + wm * TM + i * 16 + fr;
#pragma unroll
    for (int j = 0; j < NI; ++j) {
      const int n = n0 + wn * TN + j * 16 + fq * 4;
      if (n >= g.N) continue;
      f32x4 v = acc[i][j];
      if (EPI == EPI_BF16) {
        *(u32x2*)((bf16_t*)g.out + (size_t)m * g.ldc + n) = (u32x2){cvt_pk_bf16(v[0], v[1]), cvt_pk_bf16(v[2], v[3])};
      } else if (EPI == EPI_TANH) {
        *(u32x2*)((bf16_t*)g.out + (size_t)m * g.ldc + n) = (u32x2){cvt_pk_bf16(tanhf(v[0]), tanhf(v[1])), cvt_pk_bf16(tanhf(v[2]), tanhf(v[3]))};
      } else if (EPI == EPI_SIGMOID) {
        *(u32x2*)((bf16_t*)g.out + (size_t)m * g.ldc + n) = (u32x2){cvt_pk_bf16(sigmoidf_(v[0]), sigmoidf_(v[1])), cvt_pk_bf16(sigmoidf_(v[2]), sigmoidf_(v[3]))};
      } else if (EPI == EPI_LW) {
        const f32x4 w0 = *(const f32x4*)(g.v0 + n); float o[4];
#pragma unroll
        for (int q = 0; q < 4; ++q) { const float xx = -(w0[q] + v[q]); const float sp = fmaxf(xx, 0.f) + log1pf(__expf(-fabsf(xx))); o[q] = -__expf(-sp - 0.5f); }
        *(u32x2*)((bf16_t*)g.out + (size_t)m * g.ldc + n) = (u32x2){cvt_pk_bf16(o[0], o[1]), cvt_pk_bf16(o[2], o[3])};
      } else if (EPI == EPI_ASIG) {
        const f32x4 a0 = *(const f32x4*)(g.v0 + n);
        *(u32x2*)((bf16_t*)g.out + (size_t)m * g.ldc + n) = (u32x2){cvt_pk_bf16(sigmoidf_(a0[0] + v[0]), sigmoidf_(a0[1] + v[1])), cvt_pk_bf16(sigmoidf_(a0[2] + v[2]), sigmoidf_(a0[3] + v[3]))};
      } else if (EPI == EPI_Z) {
        const int b = m / SEQ;
        const f32x4 xv = *(const f32x4*)(g.v0 + (size_t)m * D + n), gt = *(const f32x4*)(g.v1 + (size_t)b * 6144 + n);
        *(f32x4*)((float*)g.out + (size_t)m * g.ldc + n) = xv * ALPHA + gt * v;
      } else if (EPI == EPI_SCALE) {
        const f32x4 sc = *(const f32x4*)(g.v0 + n);
        *(u32x2*)((bf16_t*)g.out + (size_t)m * g.ldc + n) = (u32x2){cvt_pk_bf16(v[0] * sc[0], v[1] * sc[1]), cvt_pk_bf16(v[2] * sc[2], v[3] * sc[3])};
      }
    }
  }
}

struct ScanArgs {
  const bf16_t *r, *k, *v, *lw, *a, *g;
  const float *k_k, *k_a, *r_k, *lnx_g, *lnx_b;
  bf16_t* yg;
};
__global__ void __launch_bounds__(256) k_scan_seq(ScanArgs s) {
  constexpr int TC = 32;
  __shared__ float sr[TC][64], sw[TC][64], sk[TC][64], sv[TC][64], sa[TC][64], sb[TC][64], sy[TC][64], sbonus[TC];
  const int tid = threadIdx.x, b = blockIdx.x / NH, h = blockIdx.x % NH;
  const int vrow = tid >> 2, kq = tid & 3;
  float S[16];
#pragma unroll
  for (int i = 0; i < 16; ++i) S[i] = 0.f;
  const size_t base = (size_t)b * SEQ * D + h * HS;
  for (int t0 = 0; t0 < SEQ; t0 += TC) {
    {
      const int tt = tid >> 3, c0 = (tid & 7) * 8;
      const size_t off = base + (size_t)(t0 + tt) * D + c0;
      const u32x4 vr = *(const u32x4*)(s.r + off), vk = *(const u32x4*)(s.k + off), vv = *(const u32x4*)(s.v + off), vw = *(const u32x4*)(s.lw + off), va = *(const u32x4*)(s.a + off);
      float fr_[8], fk[8], fv[8], fw[8], fa[8];
      const unsigned ur[4] = {vr.x, vr.y, vr.z, vr.w}, uk[4] = {vk.x, vk.y, vk.z, vk.w}, uv[4] = {vv.x, vv.y, vv.z, vv.w}, uw[4] = {vw.x, vw.y, vw.z, vw.w}, ua[4] = {va.x, va.y, va.z, va.w};
#pragma unroll
      for (int j = 0; j < 4; ++j) {
        fr_[2 * j] = bf_lo(ur[j]); fr_[2 * j + 1] = bf_hi(ur[j]); fk[2 * j] = bf_lo(uk[j]); fk[2 * j + 1] = bf_hi(uk[j]);
        fv[2 * j] = bf_lo(uv[j]); fv[2 * j + 1] = bf_hi(uv[j]); fw[2 * j] = bf_lo(uw[j]); fw[2 * j + 1] = bf_hi(uw[j]);
        fa[2 * j] = bf_lo(ua[j]); fa[2 * j + 1] = bf_hi(ua[j]);
      }
      float kkr[8], nrm = 0.f, bon = 0.f, kp[8];
#pragma unroll
      for (int j = 0; j < 8; ++j) {
        const int ch = h * HS + c0 + j;
        kkr[j] = fk[j] * s.k_k[ch]; nrm += kkr[j] * kkr[j];
        kp[j] = fk[j] * (1.f + (fa[j] - 1.f) * s.k_a[ch]);
        bon += fr_[j] * kp[j] * s.r_k[ch];
      }
      nrm += __shfl_xor(nrm, 1); nrm += __shfl_xor(nrm, 2); nrm += __shfl_xor(nrm, 4);
      bon += __shfl_xor(bon, 1); bon += __shfl_xor(bon, 2); bon += __shfl_xor(bon, 4);
      const float inv = rsqrtf(fmaxf(nrm, 1e-24f));
#pragma unroll
      for (int j = 0; j < 8; ++j) {
        const float kk = kkr[j] * inv;
        sr[tt][c0 + j] = fr_[j]; sw[tt][c0 + j] = __expf(fw[j]); sk[tt][c0 + j] = kp[j]; sv[tt][c0 + j] = fv[j];
        sa[tt][c0 + j] = -kk; sb[tt][c0 + j] = kk * fa[j];
      }
      if ((tid & 7) == 0) sbonus[tt] = bon;
    }
    __syncthreads();
    for (int tt = 0; tt < TC; ++tt) {
      float av[16], bv[16], wv[16], kv[16], rv[16];
#pragma unroll
      for (int q = 0; q < 4; ++q) {
        const f32x4 a4 = *(const f32x4*)&sa[tt][kq * 16 + q * 4], b4 = *(const f32x4*)&sb[tt][kq * 16 + q * 4], w4 = *(const f32x4*)&sw[tt][kq * 16 + q * 4],
                    k4 = *(const f32x4*)&sk[tt][kq * 16 + q * 4], r4 = *(const f32x4*)&sr[tt][kq * 16 + q * 4];
#pragma unroll
        for (int j = 0; j < 4; ++j) { av[q * 4 + j] = a4[j]; bv[q * 4 + j] = b4[j]; wv[q * 4 + j] = w4[j]; kv[q * 4 + j] = k4[j]; rv[q * 4 + j] = r4[j]; }
      }
      const float vt = sv[tt][vrow];
      float sap = 0.f;
#pragma unroll
      for (int i = 0; i < 16; ++i) sap += S[i] * av[i];
      sap += __shfl_xor(sap, 1); sap += __shfl_xor(sap, 2);
      float yp = 0.f;
#pragma unroll
      for (int i = 0; i < 16; ++i) { S[i] = S[i] * wv[i] + sap * bv[i] + vt * kv[i]; yp += S[i] * rv[i]; }
      yp += __shfl_xor(yp, 1); yp += __shfl_xor(yp, 2);
      if (kq == 0) sy[tt][vrow] = yp;
    }
    __syncthreads();
    {
      const int tt = tid >> 3, c0 = (tid & 7) * 8;
      float yv[8], sum = 0.f;
#pragma unroll
      for (int j = 0; j < 8; ++j) { yv[j] = sy[tt][c0 + j]; sum += yv[j]; }
      sum += __shfl_xor(sum, 1); sum += __shfl_xor(sum, 2); sum += __shfl_xor(sum, 4);
      const float mean = sum * (1.f / 64.f);
      float var = 0.f;
#pragma unroll
      for (int j = 0; j < 8; ++j) { const float d = yv[j] - mean; var += d * d; }
      var += __shfl_xor(var, 1); var += __shfl_xor(var, 2); var += __shfl_xor(var, 4);
      const float rstd = rsqrtf(var * (1.f / 64.f) + GN_EPS);
      const float bon = sbonus[tt];
      const size_t off = base + (size_t)(t0 + tt) * D + c0;
      const u32x4 vg = *(const u32x4*)(s.g + off);
      const unsigned ug[4] = {vg.x, vg.y, vg.z, vg.w};
      float o[8];
#pragma unroll
      for (int j = 0; j < 8; ++j) {
        const int ch = h * HS + c0 + j;
        const float gq = (j & 1) ? bf_hi(ug[j >> 1]) : bf_lo(ug[j >> 1]);
        o[j] = ((yv[j] - mean) * rstd * s.lnx_g[ch] + s.lnx_b[ch] + bon * sv[tt][c0 + j]) * gq;
      }
      *(u32x4*)(s.yg + off) = (u32x4){cvt_pk_bf16(o[0], o[1]), cvt_pk_bf16(o[2], o[3]), cvt_pk_bf16(o[4], o[5]), cvt_pk_bf16(o[6], o[7])};
    }
    __syncthreads();
  }
}

__global__ void __launch_bounds__(256) k_ln(const float* __restrict__ z, const float* __restrict__ lg, const float* __restrict__ lb, float* __restrict__ xo,
                                            const float* __restrict__ mod_l, int shift_idx, int scale_idx, bf16_t* __restrict__ ho) {
  const int lane = threadIdx.x & 63, wv = threadIdx.x >> 6;
  for (int row = blockIdx.x * 4 + wv; row < T; row += gridDim.x * 4) {
    const float* zr = z + (size_t)row * D;
    f32x4 v[4]; float s = 0.f;
#pragma unroll
    for (int i = 0; i < 4; ++i) { v[i] = *(const f32x4*)(zr + i * 256 + lane * 4); s += (v[i][0] + v[i][1]) + (v[i][2] + v[i][3]); }
    const float mean = wave_sum(s) * (1.f / D);
    float q = 0.f;
#pragma unroll
    for (int i = 0; i < 4; ++i) { const f32x4 d = v[i] - mean; q += (d[0] * d[0] + d[1] * d[1]) + (d[2] * d[2] + d[3] * d[3]); }
    const float rstd = rsqrtf(wave_sum(q) * (1.f / D) + LN_EPS);
    const int b = row / SEQ;
#pragma unroll
    for (int i = 0; i < 4; ++i) {
      const int d = i * 256 + lane * 4;
      const f32x4 o = (v[i] - mean) * rstd * *(const f32x4*)(lg + d) + *(const f32x4*)(lb + d);
      if (xo) *(f32x4*)(xo + (size_t)row * D + d) = o;
      if (ho) {
        const f32x4 sh = *(const f32x4*)(mod_l + (size_t)b * 6144 + shift_idx * D + d), sc = *(const f32x4*)(mod_l + (size_t)b * 6144 + scale_idx * D + d);
        const f32x4 hh = o * (sc + 1.f) + sh;
        *(u32x2*)(ho + (size_t)row * D + d) = (u32x2){cvt_pk_bf16(hh[0], hh[1]), cvt_pk_bf16(hh[2], hh[3])};
      }
    }
  }
}

__global__ void __launch_bounds__(256) k_combine(const unsigned* __restrict__ lists, int* __restrict__ eidx, float* __restrict__ gate) {
  const int gid = blockIdx.x * 256 + threadIdx.x;
  if (gid >= T * 8) return;
  const unsigned* la = lists + (size_t)gid * 32;
  const unsigned* lb = la + 16;
  float s1[16], s2[16];
#pragma unroll
  for (int i = 0; i < 4; ++i) {
    const u32x4 a = *(const u32x4*)(la + i * 4), b = *(const u32x4*)(lb + i * 4);
    s1[i * 4] = key2f(a.x & ~127u); s1[i * 4 + 1] = key2f(a.y & ~127u); s1[i * 4 + 2] = key2f(a.z & ~127u); s1[i * 4 + 3] = key2f(a.w & ~127u);
    s2[i * 4] = key2f(b.x & ~127u); s2[i * 4 + 1] = key2f(b.y & ~127u); s2[i * 4 + 2] = key2f(b.z & ~127u); s2[i * 4 + 3] = key2f(b.w & ~127u);
  }
  unsigned c[4][16];
  {
    int n = 0;
#pragma unroll
    for (int a = 0; a < 16; ++a)
#pragma unroll
      for (int b = 0; b < 16; ++b)
        if ((a + 1) * (b + 1) <= 16) { c[n >> 4][n & 15] = (f2key(s1[a] + s2[b]) & ~255u) | (unsigned)(255 - (a * 16 + b)); ++n; }
#pragma unroll
    for (int q = 50; q < 64; ++q) c[q >> 4][q & 15] = 0u;
  }
  sort16_desc(c[0]); sort16_desc(c[1]); sort16_desc(c[2]); sort16_desc(c[3]);
#pragma unroll
  for (int e = 0; e < 16; ++e) { c[0][e] = max(c[0][e], c[1][15 - e]); c[2][e] = max(c[2][e], c[3][15 - e]); }
  merge16_desc(c[0]); merge16_desc(c[2]);
#pragma unroll
  for (int e = 0; e < 16; ++e) c[0][e] = max(c[0][e], c[2][15 - e]);
  merge16_desc(c[0]);
  float best[16], den = 0.f;
  const float mx = key2f(c[0][0] & ~255u);
#pragma unroll
  for (int e = 0; e < 16; ++e) { best[e] = __expf(key2f(c[0][e] & ~255u) - mx); den += best[e]; }
  const float inv = 1.f / den;
#pragma unroll
  for (int e = 0; e < 16; ++e) {
    const int pos = 255 - (int)(c[0][e] & 255u), a = pos >> 4, b = pos & 15;
    const int i1 = 127 - (int)(la[a] & 127u), i2 = 127 - (int)(lb[b] & 127u);
    eidx[(size_t)gid * 16 + e] = i1 * 128 + i2;
    gate[(size_t)gid * 16 + e] = best[e] * inv;
  }
}

struct PeerArgs {
  const bf16_t* h2;
  const bf16_t *ub, *vb;
  const int* eidx; const float* gate;
  const float* xres;
  const float* gate2;
  const float *lg, *lb;
  float* xo;
  const float* mod_next; bf16_t* ho;
};
__global__ void __launch_bounds__(256) k_peer_gather(PeerArgs a) {
  const int lane = threadIdx.x & 63, wv = threadIdx.x >> 6;
  for (int t = blockIdx.x * 4 + wv; t < T; t += gridDim.x * 4) {
    const u32x4 h0 = *(const u32x4*)(a.h2 + (size_t)t * D + lane * 8), h1 = *(const u32x4*)(a.h2 + (size_t)t * D + 512 + lane * 8);
    float hf[16];
    { const unsigned u[8] = {h0.x, h0.y, h0.z, h0.w, h1.x, h1.y, h1.z, h1.w};
#pragma unroll
      for (int j = 0; j < 8; ++j) { hf[2 * j] = bf_lo(u[j]); hf[2 * j + 1] = bf_hi(u[j]); } }
    const int e0 = a.eidx[(size_t)t * 128 + lane], e1 = a.eidx[(size_t)t * 128 + 64 + lane];
    const float g0 = a.gate[(size_t)t * 128 + lane], g1 = a.gate[(size_t)t * 128 + 64 + lane];
    float c0 = 0.f, c1 = 0.f;
    for (int half = 0; half < 2; ++half) {
      const int ev = half ? e1 : e0;
      float cacc = 0.f;
      for (int j0 = 0; j0 < 64; j0 += 4) {
        u32x4 r0[4], r1[4];
#pragma unroll
        for (int jj = 0; jj < 4; ++jj) {
          const int e = __shfl(ev, j0 + jj);
          const bf16_t* row = a.ub + (size_t)e * D;
          r0[jj] = *(const u32x4*)(row + lane * 8); r1[jj] = *(const u32x4*)(row + 512 + lane * 8);
        }
#pragma unroll
        for (int jj = 0; jj < 4; ++jj) {
          const unsigned u[8] = {r0[jj].x, r0[jj].y, r0[jj].z, r0[jj].w, r1[jj].x, r1[jj].y, r1[jj].z, r1[jj].w};
          float d = 0.f;
#pragma unroll
          for (int q = 0; q < 8; ++q) d += bf_lo(u[q]) * hf[2 * q] + bf_hi(u[q]) * hf[2 * q + 1];
          d = wave_sum(d);
          if (lane == j0 + jj) cacc = d;
        }
      }
      const float act = gelu_exact(cacc);
      if (half) c1 = g1 * act; else c0 = g0 * act;
    }
    float o[16];
#pragma unroll
    for (int i = 0; i < 16; ++i) o[i] = 0.f;
    for (int half = 0; half < 2; ++half) {
      const int ev = half ? e1 : e0; const float cv = half ? c1 : c0;
      for (int j0 = 0; j0 < 64; j0 += 4) {
        u32x4 r0[4], r1[4]; float cf[4];
#pragma unroll
        for (int jj = 0; jj < 4; ++jj) {
          const int e = __shfl(ev, j0 + jj); cf[jj] = __shfl(cv, j0 + jj);
          const bf16_t* row = a.vb + (size_t)e * D;
          r0[jj] = *(const u32x4*)(row + lane * 8); r1[jj] = *(const u32x4*)(row + 512 + lane * 8);
        }
#pragma unroll
        for (int jj = 0; jj < 4; ++jj) {
          const unsigned u[8] = {r0[jj].x, r0[jj].y, r0[jj].z, r0[jj].w, r1[jj].x, r1[jj].y, r1[jj].z, r1[jj].w};
#pragma unroll
          for (int q = 0; q < 8; ++q) { o[2 * q] += cf[jj] * bf_lo(u[q]); o[2 * q + 1] += cf[jj] * bf_hi(u[q]); }
        }
      }
    }
    const int b = t / SEQ;
    float zv[16], s = 0.f;
#pragma unroll
    for (int hh = 0; hh < 2; ++hh) {
      const int d0 = hh * 512 + lane * 8;
      const f32x4 x0 = *(const f32x4*)(a.xres + (size_t)t * D + d0), x1 = *(const f32x4*)(a.xres + (size_t)t * D + d0 + 4);
      const f32x4 q0 = *(const f32x4*)(a.gate2 + (size_t)b * 6144 + d0), q1 = *(const f32x4*)(a.gate2 + (size_t)b * 6144 + d0 + 4);
#pragma unroll
      for (int j = 0; j < 4; ++j) { zv[hh * 8 + j] = ALPHA * x0[j] + q0[j] * o[hh * 8 + j]; zv[hh * 8 + 4 + j] = ALPHA * x1[j] + q1[j] * o[hh * 8 + 4 + j]; }
    }
#pragma unroll
    for (int j = 0; j < 16; ++j) s += zv[j];
    const float mean = wave_sum(s) * (1.f / D);
    float q = 0.f;
#pragma unroll
    for (int j = 0; j < 16; ++j) { const float d = zv[j] - mean; q += d * d; }
    const float rstd = rsqrtf(wave_sum(q) * (1.f / D) + LN_EPS);
#pragma unroll
    for (int hh = 0; hh < 2; ++hh) {
      const int d0 = hh * 512 + lane * 8;
      float r[8];
#pragma unroll
      for (int j = 0; j < 8; ++j) r[j] = (zv[hh * 8 + j] - mean) * rstd * a.lg[d0 + j] + a.lb[d0 + j];
      *(f32x4*)(a.xo + (size_t)t * D + d0) = (f32x4){r[0], r[1], r[2], r[3]};
      *(f32x4*)(a.xo + (size_t)t * D + d0 + 4) = (f32x4){r[4], r[5], r[6], r[7]};
      if (a.ho) {
        float hq[8];
#pragma unroll
        for (int j = 0; j < 8; ++j) hq[j] = r[j] * (1.f + a.mod_next[(size_t)b * 6144 + 1 * D + d0 + j]) + a.mod_next[(size_t)b * 6144 + 0 * D + d0 + j];
        *(u32x4*)(a.ho + (size_t)t * D + d0) = (u32x4){cvt_pk_bf16(hq[0], hq[1]), cvt_pk_bf16(hq[2], hq[3]), cvt_pk_bf16(hq[4], hq[5]), cvt_pk_bf16(hq[6], hq[7])};
      }
    }
  }
}

__global__ void __launch_bounds__(256) k_pool(const bf16_t* __restrict__ zin, bf16_t* __restrict__ pout) {
  const size_t n8 = (size_t)T * D / 8;
  for (size_t i = (size_t)blockIdx.x * 256 + threadIdx.x; i < n8; i += (size_t)gridDim.x * 256) {
    const size_t e = i * 8; const int t = (int)(e / D), d = (int)(e % D), tp = t % SEQ;
    const int win = 2 << (d / 256);
    const int cnt = min(tp + 1, win);
    float s[8];
#pragma unroll
    for (int j = 0; j < 8; ++j) s[j] = 0.f;
    float z0[8];
    for (int w = 0; w < cnt; ++w) {
      const u32x4 v = *(const u32x4*)(zin + e - (size_t)w * D);
      const unsigned u[4] = {v.x, v.y, v.z, v.w};
#pragma unroll
      for (int j = 0; j < 4; ++j) { const float lo = bf_lo(u[j]), hi = bf_hi(u[j]); s[2 * j] += lo; s[2 * j + 1] += hi; if (w == 0) { z0[2 * j] = lo; z0[2 * j + 1] = hi; } }
    }
    const float ic = 1.f / (float)cnt;
    float o[8];
#pragma unroll
    for (int j = 0; j < 8; ++j) o[j] = s[j] * ic - z0[j];
    *(u32x4*)(pout + e) = (u32x4){cvt_pk_bf16(o[0], o[1]), cvt_pk_bf16(o[2], o[3]), cvt_pk_bf16(o[4], o[5]), cvt_pk_bf16(o[6], o[7])};
  }
}

template <int EPI, int ALOAD, int WM>
static void launch_gemm(const GemmArgs& g, hipStream_t st) {
  const int tiles = (g.M / 128) * ((g.N + 127) / 128);
  hipLaunchKernelGGL((k_gemm<EPI, ALOAD, WM>), dim3(tiles), dim3(256), 0, st, g);
}
static GemmArgs mk(const bf16_t* A, int lda, const bf16_t* Bt, int ldb, int M, int N, int K, void* out, int ldc,
                   const float* mu = nullptr, const float* v0 = nullptr, const float* v1 = nullptr, const float* v2 = nullptr) {
  GemmArgs g{}; g.A = A; g.lda = lda; g.Bt = Bt; g.ldb = ldb; g.M = M; g.N = N; g.K = K; g.mu = mu; g.out = out; g.ldc = ldc; g.v0 = v0; g.v1 = v1; g.v2 = v2; return g;
}
static void transpose_cvt(const float* src, bf16_t* dst, int K, int N, int Kpad, int Npad, int batch, size_t sbs, size_t dbs, hipStream_t st) {
  hipLaunchKernelGGL(k_transpose_cvt, dim3((Kpad / 32) * (Npad / 32) * batch), dim3(256), 0, st, src, dst, K, N, Kpad, Npad, sbs, dbs);
}

extern "C" void kernel_launch(void* const* d_in, const int* in_sizes, int n_in, void* d_out, int out_size, void* d_ws, size_t ws_size, hipStream_t stream) {
  Params p{};
  const float** ip = (const float**)&p.x;
  for (int i = 0; i < 30; ++i) ip[i] = (const float*)d_in[i];
  p.out = (float*)d_out;
  unsigned char* w = (unsigned char*)d_ws; size_t off = 0;
  auto take = [&](size_t bytes) { unsigned char* r = w + off; off += (bytes + 255) & ~(size_t)255; return r; };
  p.mod = (float*)take((size_t)2 * NB * 6144 * 4);
  p.WT_rkv = (bf16_t*)take((size_t)3 * D * D * 2);
  p.W1T = (bf16_t*)take((size_t)128 * D * 2); p.A1T = (bf16_t*)take((size_t)128 * D * 2); p.G1T = (bf16_t*)take((size_t)256 * D * 2);
  p.W2T = (bf16_t*)take((size_t)D * 64 * 2); p.A2T = (bf16_t*)take((size_t)D * 64 * 2); p.G2T = (bf16_t*)take((size_t)D * 192 * 2);
  p.WoT = (bf16_t*)take((size_t)D * D * 2); p.PinT = (bf16_t*)take((size_t)D * D * 2); p.PoutT = (bf16_t*)take((size_t)D * D * 2);
  p.WgrpT = (bf16_t*)take((size_t)4 * 256 * 256 * 2); p.WqT = (bf16_t*)take((size_t)2 * 2048 * D * 2); p.KeysB = (bf16_t*)take((size_t)2 * 16 * 128 * 128 * 2);
  for (int i = 0; i < 7; ++i) p.slot[i] = take((size_t)64 << 20);
  if (off > ws_size) return;
  hipStream_t st = stream;

  hipLaunchKernelGGL(k_mod, dim3(384), dim3(256), 0, st, p);
  transpose_cvt(p.rw_w_rkv, p.WT_rkv, D, D, D, D, 3, (size_t)D * D, (size_t)D * D, st);
  transpose_cvt(p.rw_w1, p.W1T, D, 64, D, 128, 1, 0, 0, st);
  transpose_cvt(p.rw_a1, p.A1T, D, 64, D, 128, 1, 0, 0, st);
  transpose_cvt(p.rw_g1, p.G1T, D, 160, D, 256, 1, 0, 0, st);
  transpose_cvt(p.rw_w2, p.W2T, 64, D, 64, D, 1, 0, 0, st);
  transpose_cvt(p.rw_a2, p.A2T, 64, D, 64, D, 1, 0, 0, st);
  transpose_cvt(p.rw_g2, p.G2T, 160, D, 192, D, 1, 0, 0, st);
  transpose_cvt(p.rw_w_o, p.WoT, D, D, D, D, 1, 0, 0, st);
  transpose_cvt(p.pl_w_in, p.PinT, D, D, D, D, 1, 0, 0, st);
  transpose_cvt(p.pl_w_out, p.PoutT, D, D, D, D, 1, 0, 0, st);
  transpose_cvt(p.pl_w_grp, p.WgrpT, 256, 256, 256, 256, 4, (size_t)256 * 256, (size_t)256 * 256, st);
  transpose_cvt(p.pe_w_q, p.WqT, D, 2048, D, 2048, 2, (size_t)D * 2048, (size_t)D * 2048, st);
  hipLaunchKernelGGL(k_cvt, dim3(256), dim3(256), 0, st, p.pe_keys, p.KeysB, (size_t)2 * 16 * 128 * 128 / 8);

  const float* mod0 = p.mod; const float* mod1 = p.mod + (size_t)NB * 6144;
  bf16_t* S[7]; for (int i = 0; i < 7; ++i) S[i] = (bf16_t*)p.slot[i];

  bf16_t *h = S[0], *r = S[1], *k = S[2], *v = S[3], *lw = S[4], *av = S[5], *gv = S[6];
  hipLaunchKernelGGL(k_modulate, dim3(2048), dim3(256), 0, st, p.x, mod0, 0, 1, h);
  launch_gemm<EPI_BF16, AL_LERP, 2>(mk(h, D, p.WT_rkv, D, T, D, D, r, D, p.rw_mu + 0 * D), st);
  launch_gemm<EPI_BF16, AL_LERP, 2>(mk(h, D, p.WT_rkv + (size_t)D * D, D, T, D, D, k, D, p.rw_mu + 1 * D), st);
  launch_gemm<EPI_BF16, AL_LERP, 2>(mk(h, D, p.WT_rkv + (size_t)2 * D * D, D, T, D, D, v, D, p.rw_mu + 2 * D), st);
  bf16_t* tw = (bf16_t*)(p.slot[6]) ;
  tw = (bf16_t*)p.out; bf16_t* ta = tw + (size_t)T * 64; bf16_t* tg = ta + (size_t)T * 64;
  launch_gemm<EPI_TANH, AL_LERP, 2>(mk(h, D, p.W1T, D, T, 64, D, tw, 64, p.rw_mu + 3 * D), st);
  launch_gemm<EPI_BF16, AL_LERP, 2>(mk(h, D, p.A1T, D, T, 64, D, ta, 64, p.rw_mu + 4 * D), st);
  launch_gemm<EPI_SIGMOID, AL_LERP, 2>(mk(h, D, p.G1T, D, T, 192, D, tg, 192, p.rw_mu + 5 * D), st);
  launch_gemm<EPI_LW, AL_PLAIN, 2>(mk(tw, 64, p.W2T, 64, T, D, 64, lw, D, nullptr, p.rw_w0), st);
  launch_gemm<EPI_ASIG, AL_PLAIN, 2>(mk(ta, 64, p.A2T, 64, T, D, 64, av, D, nullptr, p.rw_a0), st);
  launch_gemm<EPI_BF16, AL_PLAIN, 2>(mk(tg, 192, p.G2T, 192, T, D, 192, gv, D), st);
  {
    ScanArgs s{}; s.r = r; s.k = k; s.v = v; s.lw = lw; s.a = av; s.g = gv; s.k_k = p.rw_k_k; s.k_a = p.rw_k_a; s.r_k = p.rw_r_k; s.lnx_g = p.rw_lnx_g; s.lnx_b = p.rw_lnx_b; s.yg = h;
    hipLaunchKernelGGL(k_scan_seq, dim3(NB * NH), dim3(256), 0, st, s);
  }
  float* z = (float*)p.slot[1];
  launch_gemm<EPI_Z, AL_PLAIN, 2>(mk(h, D, p.WoT, D, T, D, D, z, D, nullptr, p.x, mod0 + 2 * D), st);
  float* x1 = (float*)p.slot[3];
  bf16_t* h2 = S[5];
  hipLaunchKernelGGL(k_ln, dim3(2048), dim3(256), 0, st, (const float*)z, p.ln_g + 0 * D, p.ln_b + 0 * D, x1, mod0, 3, 4, h2);
  bf16_t* ub = S[6]; bf16_t* vb = S[6] + (size_t)NEXP * D;
  hipLaunchKernelGGL(k_cvt, dim3(4096), dim3(256), 0, st, p.pe_u, ub, (size_t)NEXP * D / 8);
  hipLaunchKernelGGL(k_cvt, dim3(4096), dim3(256), 0, st, p.pe_v, vb, (size_t)NEXP * D / 8);
  bf16_t* q = (bf16_t*)p.slot[1];
  launch_gemm<EPI_BF16, AL_PLAIN, 2>(mk(h2, D, p.WqT, D, T, 2048, D, q, 2048), st);
  unsigned* lists = (unsigned*)p.slot[0]; int* eidx = (int*)(p.slot[0] + ((size_t)32 << 20)); float* gate = (float*)(p.slot[0] + ((size_t)48 << 20));
  for (int grp = 0; grp < 16; ++grp) {
    GemmArgs g = mk(q + grp * 128, 2048, p.KeysB + (size_t)grp * 128 * 128, 128, T, 128, 128, lists + grp * 16, 0);
    hipLaunchKernelGGL((k_gemm<EPI_TOPK, AL_PLAIN, 4>), dim3(T / 128), dim3(256), 0, st, g);
  }
  hipLaunchKernelGGL(k_combine, dim3(T * 8 / 256), dim3(256), 0, st, (const unsigned*)lists, eidx, gate);
  float* x2 = (float*)p.slot[1];
  {
    PeerArgs a{}; a.h2 = h2; a.ub = ub; a.vb = vb; a.eidx = eidx; a.gate = gate; a.xres = x1; a.gate2 = mod0 + 5 * D; a.lg = p.ln_g + 1 * D; a.lb = p.ln_b + 1 * D; a.xo = x2;
    a.mod_next = mod1; a.ho = h2;
    hipLaunchKernelGGL(k_peer_gather, dim3(2048), dim3(256), 0, st, a);
  }
  bf16_t* hB = h2;
  bf16_t *zin = S[3], *pp = S[4], *yp = S[3];
  launch_gemm<EPI_BF16, AL_PLAIN, 2>(mk(hB, D, p.PinT, D, T, D, D, zin, D), st);
  hipLaunchKernelGGL(k_pool, dim3(2048), dim3(256), 0, st, (const bf16_t*)zin, pp);
  for (int gi = 0; gi < 4; ++gi)
    launch_gemm<EPI_SCALE, AL_PLAIN, 2>(mk(pp + gi * 256, D, p.WgrpT + (size_t)gi * 256 * 256, 256, T, 256, 256, yp + gi * 256, D, nullptr, p.pl_scale + gi * 256), st);
  float* z1 = (float*)p.slot[4];
  launch_gemm<EPI_Z, AL_PLAIN, 2>(mk(yp, D, p.PoutT, D, T, D, D, z1, D, nullptr, x2, mod1 + 2 * D), st);
  float* x3 = (float*)p.slot[1];
  bf16_t* h3 = S[0];
  hipLaunchKernelGGL(k_ln, dim3(2048), dim3(256), 0, st, (const float*)z1, p.ln_g + 2 * D, p.ln_b + 2 * D, x3, mod1, 3, 4, h3);
  hipLaunchKernelGGL(k_cvt, dim3(4096), dim3(256), 0, st, p.pe_u + (size_t)NEXP * D, ub, (size_t)NEXP * D / 8);
  hipLaunchKernelGGL(k_cvt, dim3(4096), dim3(256), 0, st, p.pe_v + (size_t)NEXP * D, vb, (size_t)NEXP * D / 8);
  bf16_t* q1 = (bf16_t*)p.slot[4];
  launch_gemm<EPI_BF16, AL_PLAIN, 2>(mk(h3, D, p.WqT + (size_t)2048 * D, D, T, 2048, D, q1, 2048), st);
  unsigned* lists1 = (unsigned*)p.slot[3]; int* eidx1 = (int*)(p.slot[3] + ((size_t)32 << 20)); float* gate1 = (float*)(p.slot[3] + ((size_t)48 << 20));
  for (int grp = 0; grp < 16; ++grp) {
    GemmArgs g = mk(q1 + grp * 128, 2048, p.KeysB + (size_t)(16 + grp) * 128 * 128, 128, T, 128, 128, lists1 + grp * 16, 0);
    hipLaunchKernelGGL((k_gemm<EPI_TOPK, AL_PLAIN, 4>), dim3(T / 128), dim3(256), 0, st, g);
  }
  hipLaunchKernelGGL(k_combine, dim3(T * 8 / 256), dim3(256), 0, st, (const unsigned*)lists1, eidx1, gate1);
  {
    PeerArgs a{}; a.h2 = h3; a.ub = ub; a.vb = vb; a.eidx = eidx1; a.gate = gate1; a.xres = x3; a.gate2 = mod1 + 5 * D; a.lg = p.ln_g + 3 * D; a.lb = p.ln_b + 3 * D; a.xo = p.out;
    a.mod_next = nullptr; a.ho = nullptr;
    hipLaunchKernelGGL(k_peer_gather, dim3(2048), dim3(256), 0, st, a);
  }
}
```

```cpp
#include <hip/hip_runtime.h>
#include <hip/hip_cooperative_groups.h>
#include <stdint.h>
#include <stddef.h>
namespace cg = cooperative_groups;

typedef unsigned short bf16_t;
typedef short bf16x8 __attribute__((ext_vector_type(8)));
typedef float f32x4 __attribute__((ext_vector_type(4)));
typedef float f32x2 __attribute__((ext_vector_type(2)));
typedef unsigned u32x4 __attribute__((ext_vector_type(4)));
typedef unsigned u32x2 __attribute__((ext_vector_type(2)));
#define DI __device__ __forceinline__

constexpr int D = 1024, NB = 8, SEQ = 4096, T = NB * SEQ;
constexpr int NH = 16, HS = 64;
constexpr int NEXP = 16384;
constexpr float ALPHA = 1.4142135623730951f;
constexpr float LN_EPS = 1e-5f, GN_EPS = 64e-5f;
constexpr int LDS_BYTES = 128 * 528;

DI unsigned cvt_pk_bf16(float lo, float hi) { unsigned r; asm volatile("v_cvt_pk_bf16_f32 %0, %1, %2" : "=v"(r) : "v"(lo), "v"(hi)); return r; }
DI float bf_lo(unsigned u) { return __uint_as_float(u << 16); }
DI float bf_hi(unsigned u) { return __uint_as_float(u & 0xffff0000u); }
DI bf16_t f2bf(float f) { unsigned u = __float_as_uint(f); u += 0x7fffu + ((u >> 16) & 1u); return (bf16_t)(u >> 16); }
DI float sigmoidf_(float x) { return 1.f / (1.f + __expf(-x)); }
DI float wave_sum(float v) {
#pragma unroll
  for (int o = 32; o >= 1; o >>= 1) v += __shfl_xor(v, o);
  return v;
}
DI int opaque_v(int x) { asm volatile("" : "+v"(x)); return x; }
DI float gelu_exact(float v) { return 0.5f * v * (1.f + erff(v * 0.70710678118654752f)); }

struct Params {
  const float *x, *c, *ada_w, *ada_b, *ln_g, *ln_b, *rw_mu, *rw_w_rkv, *rw_w0, *rw_w1, *rw_w2, *rw_a0, *rw_a1, *rw_a2, *rw_g1, *rw_g2,
      *rw_k_k, *rw_k_a, *rw_r_k, *rw_lnx_g, *rw_lnx_b, *rw_w_o, *pl_w_in, *pl_w_grp, *pl_scale, *pl_w_out, *pe_w_q, *pe_keys, *pe_u, *pe_v;
  float* out;
  float* mod;
  bf16_t *WT_rkv, *W1T, *A1T, *G1T, *W2T, *A2T, *G2T, *WoT, *PinT, *PoutT, *WgrpT, *WqT, *KeysB;
  unsigned char* slot[7];
  unsigned* bar;
};

DI void mod_item(const Params& p, int item, unsigned char* lds) {
  float* cond = (float*)lds;
  float (*red)[NB][32] = (float (*)[NB][32])(lds + 32768);
  const int tid = opaque_v(threadIdx.x);
  for (int i = tid; i < NB * D; i += 256) { float v = p.c[i]; cond[i] = v / (1.f + __expf(-v)); }
  __syncthreads();
  const int l = item / 192, cb = item % 192;
  const int col = cb * 32 + (tid & 31), kg = tid >> 5;
  const float* w = p.ada_w + (size_t)l * D * 6144 + col;
  float acc[NB];
#pragma unroll
  for (int b = 0; b < NB; ++b) acc[b] = 0.f;
  for (int k = kg * 128; k < kg * 128 + 128; ++k) {
    const float wv = w[(size_t)k * 6144];
#pragma unroll
    for (int b = 0; b < NB; ++b) acc[b] += cond[b * D + k] * wv;
  }
#pragma unroll
  for (int b = 0; b < NB; ++b) red[kg][b][tid & 31] = acc[b];
  __syncthreads();
  {
    const int b = tid >> 5, cc = tid & 31;
    float s = 0.f;
#pragma unroll
    for (int g = 0; g < 8; ++g) s += red[g][b][cc];
    const int n = cb * 32 + cc;
    p.mod[((size_t)l * NB + b) * 6144 + n] = s + p.ada_b[l * 6144 + n];
  }
  __syncthreads();
}

DI void transpose_item(const float* __restrict__ src, bf16_t* __restrict__ dst, int K, int N, int Kpad, int Npad, size_t sbs, size_t dbs, int item, unsigned char* lds) {
  float (*tile)[33] = (float (*)[33])lds;
  const int nb_n = Npad / 32, nb_k = Kpad / 32;
  const int per = nb_n * nb_k;
  const int bz = item / per, r = item % per;
  const int bk = r / nb_n, bn = r % nb_n;
  src += bz * sbs; dst += bz * dbs;
  const int tq = opaque_v(threadIdx.x); const int tx = tq & 31, ty = tq >> 5;
#pragma unroll
  for (int i = 0; i < 4; ++i) {
    const int k = bk * 32 + ty + i * 8, n = bn * 32 + tx;
    tile[ty + i * 8][tx] = (k < K && n < N) ? src[(size_t)k * N + n] : 0.f;
  }
  __syncthreads();
#pragma unroll
  for (int i = 0; i < 4; ++i) {
    const int n = bn * 32 + ty + i * 8, k = bk * 32 + tx;
    dst[(size_t)n * Kpad + k] = f2bf(tile[tx][ty + i * 8]);
  }
  __syncthreads();
}
DI void cvt_range(const float* __restrict__ src, bf16_t* __restrict__ dst, size_t n8, int bid, int nblk) {
  const int tq = opaque_v(threadIdx.x);
  for (size_t i = (size_t)bid * 256 + tq; i < n8; i += (size_t)nblk * 256) {
    const f32x4 a = *(const f32x4*)(src + i * 8), b = *(const f32x4*)(src + i * 8 + 4);
    u32x4 o; o.x = cvt_pk_bf16(a[0], a[1]); o.y = cvt_pk_bf16(a[2], a[3]); o.z = cvt_pk_bf16(b[0], b[1]); o.w = cvt_pk_bf16(b[2], b[3]);
    *(u32x4*)(dst + i * 8) = o;
  }
}
DI void prologue_phase(const Params& p, unsigned char* lds, int bid, int nblk) {
  constexpr int total = 384 + 3072 + 128 + 128 + 256 + 64 + 64 + 192 + 1024 + 1024 + 1024 + 256 + 4096;
  for (int it = bid; it < total; it += nblk) {
    int r = it;
    if (r < 384) { mod_item(p, r, lds); continue; } r -= 384;
    if (r < 3072) { transpose_item(p.rw_w_rkv, p.WT_rkv, D, D, D, D, (size_t)D * D, (size_t)D * D, r, lds); continue; } r -= 3072;
    if (r < 128) { transpose_item(p.rw_w1, p.W1T, D, 64, D, 128, 0, 0, r, lds); continue; } r -= 128;
    if (r < 128) { transpose_item(p.rw_a1, p.A1T, D, 64, D, 128, 0, 0, r, lds); continue; } r -= 128;
    if (r < 256) { transpose_item(p.rw_g1, p.G1T, D, 160, D, 256, 0, 0, r, lds); continue; } r -= 256;
    if (r < 64) { transpose_item(p.rw_w2, p.W2T, 64, D, 64, D, 0, 0, r, lds); continue; } r -= 64;
    if (r < 64) { transpose_item(p.rw_a2, p.A2T, 64, D, 64, D, 0, 0, r, lds); continue; } r -= 64;
    if (r < 192) { transpose_item(p.rw_g2, p.G2T, 160, D, 192, D, 0, 0, r, lds); continue; } r -= 192;
    if (r < 1024) { transpose_item(p.rw_w_o, p.WoT, D, D, D, D, 0, 0, r, lds); continue; } r -= 1024;
    if (r < 1024) { transpose_item(p.pl_w_in, p.PinT, D, D, D, D, 0, 0, r, lds); continue; } r -= 1024;
    if (r < 1024) { transpose_item(p.pl_w_out, p.PoutT, D, D, D, D, 0, 0, r, lds); continue; } r -= 1024;
    if (r < 256) { transpose_item(p.pl_w_grp, p.WgrpT, 256, 256, 256, 256, (size_t)256 * 256, (size_t)256 * 256, r, lds); continue; } r -= 256;
    transpose_item(p.pe_w_q, p.WqT, D, 2048, D, 2048, (size_t)D * 2048, (size_t)D * 2048, r, lds);
  }
  cvt_range(p.pe_keys, p.KeysB, (size_t)2 * 16 * 128 * 128 / 8, bid, nblk);
}

DI void modulate_phase(const float* __restrict__ x, const float* __restrict__ mod_l, int shift_idx, int scale_idx, bf16_t* __restrict__ h, int bid, int nblk) {
  const size_t n8 = (size_t)T * D / 8; const int tq = opaque_v(threadIdx.x);
  for (size_t i = (size_t)bid * 256 + tq; i < n8; i += (size_t)nblk * 256) {
    const size_t e = i * 8; const int t = (int)(e / D), d = (int)(e % D), b = t / SEQ;
    const float* sh = mod_l + (size_t)b * 6144 + shift_idx * D + d; const float* sc = mod_l + (size_t)b * 6144 + scale_idx * D + d;
    const f32x4 a0 = *(const f32x4*)(x + e), a1 = *(const f32x4*)(x + e + 4);
    const f32x4 s0 = *(const f32x4*)sh, s1 = *(const f32x4*)(sh + 4), c0 = *(const f32x4*)sc, c1 = *(const f32x4*)(sc + 4);
    const f32x4 r0 = a0 * (c0 + 1.f) + s0, r1 = a1 * (c1 + 1.f) + s1;
    u32x4 o; o.x = cvt_pk_bf16(r0[0], r0[1]); o.y = cvt_pk_bf16(r0[2], r0[3]); o.z = cvt_pk_bf16(r1[0], r1[1]); o.w = cvt_pk_bf16(r1[2], r1[3]);
    *(u32x4*)(h + e) = o;
  }
}

enum { EPI_BF16 = 0, EPI_TANH, EPI_SIGMOID, EPI_LW, EPI_ASIG, EPI_Z, EPI_SCALE, EPI_TOPK };
struct GemmArgs {
  const bf16_t* A; int lda;
  const bf16_t* Bt; int ldb;
  int N, K;
  const float* mu;
  int epi; void* out; int ldc;
  const float* v0; const float* v1;
};

DI int lds_off(int row, int chunk) { return row * 128 + ((chunk ^ (row & 7)) << 4); }

DI void gemm_load_a(const GemmArgs& g, int m0, int k0, int tid, u32x4 (&ra)[4]) {
#pragma unroll
  for (int i = 0; i < 4; ++i) {
    const int row = (tid >> 3) + i * 32, ch = tid & 7;
    const int m = m0 + row;
    const bf16_t* src = g.A + (size_t)m * g.lda + k0 + ch * 8;
    u32x4 v = *(const u32x4*)src;
    if (g.mu) {
      u32x4 pv = {0u, 0u, 0u, 0u};
      if ((m % SEQ) != 0) pv = *(const u32x4*)(src - g.lda);
      const f32x4 m0v = *(const f32x4*)(g.mu + k0 + ch * 8), m1v = *(const f32x4*)(g.mu + k0 + ch * 8 + 4);
      const unsigned hu[4] = {v.x, v.y, v.z, v.w}, pu[4] = {pv.x, pv.y, pv.z, pv.w};
      float o[8];
#pragma unroll
      for (int j = 0; j < 4; ++j) {
        const float h0 = bf_lo(hu[j]), h1 = bf_hi(hu[j]), p0 = bf_lo(pu[j]), p1 = bf_hi(pu[j]);
        const float mu0 = (2 * j < 4) ? m0v[(2 * j) & 3] : m1v[(2 * j) & 3], mu1 = (2 * j + 1 < 4) ? m0v[(2 * j + 1) & 3] : m1v[(2 * j + 1) & 3];
        o[2 * j] = h0 + (p0 - h0) * mu0; o[2 * j + 1] = h1 + (p1 - h1) * mu1;
      }
      v.x = cvt_pk_bf16(o[0], o[1]); v.y = cvt_pk_bf16(o[2], o[3]); v.z = cvt_pk_bf16(o[4], o[5]); v.w = cvt_pk_bf16(o[6], o[7]);
    }
    ra[i] = v;
  }
}
DI void gemm_load_b(const GemmArgs& g, int n0, int k0, int tid, u32x4 (&rb)[4]) {
#pragma unroll
  for (int i = 0; i < 4; ++i) {
    const int row = (tid >> 3) + i * 32, ch = tid & 7;
    rb[i] = *(const u32x4*)(g.Bt + (size_t)(n0 + row) * g.ldb + k0 + ch * 8);
  }
}
DI void gemm_store_lds(unsigned char* buf, int tid, const u32x4 (&r)[4]) {
#pragma unroll
  for (int i = 0; i < 4; ++i) {
    const int row = (tid >> 3) + i * 32, ch = tid & 7;
    *(u32x4*)(buf + lds_off(row, ch)) = r[i];
  }
}

DI unsigned f2key(float f) { unsigned u = __float_as_uint(f); return u ^ ((u >> 31) ? 0xffffffffu : 0x80000000u); }
DI float key2f(unsigned k) { unsigned u = (k >> 31) ? (k ^ 0x80000000u) : ~k; return __uint_as_float(u); }
#define CE_DESC(a, b) { const unsigned _mx = max(a, b), _mn = min(a, b); a = _mx; b = _mn; }
DI void sort16_desc(unsigned (&x)[16]) {
#pragma unroll
  for (int k = 2; k <= 16; k <<= 1) {
#pragma unroll
    for (int j = k >> 1; j > 0; j >>= 1) {
#pragma unroll
      for (int i = 0; i < 16; ++i) {
        const int l = i ^ j;
        if (l > i) {
          if ((i & k) == 0) { CE_DESC(x[i], x[l]); } else { CE_DESC(x[l], x[i]); }
        }
      }
    }
  }
}
DI void merge16_desc(unsigned (&x)[16]) {
#pragma unroll
  for (int j = 8; j > 0; j >>= 1) {
#pragma unroll
    for (int i = 0; i < 16; ++i) { const int l = i ^ j; if (l > i) { CE_DESC(x[i], x[l]); } }
  }
}

DI void gemm_tile(const GemmArgs& g, int m0, int n0, unsigned char* lds) {
  constexpr int WM = 2, WN = 4 / WM, TM = 128 / WM, TN = 128 / WN, MI = TM / 16, NI = TN / 16;
  const int tid = opaque_v(threadIdx.x), lane = tid & 63, wid = tid >> 6;
  const int wm = wid / WN, wn = wid % WN;
  const int nk = g.K / 64;
  f32x4 acc[MI][NI];
#pragma unroll
  for (int i = 0; i < MI; ++i)
#pragma unroll
    for (int j = 0; j < NI; ++j) acc[i][j] = (f32x4){0.f, 0.f, 0.f, 0.f};
  u32x4 ra[4], rb[4];
  gemm_load_a(g, m0, 0, tid, ra); gemm_load_b(g, n0, 0, tid, rb);
  gemm_store_lds(lds, tid, ra); gemm_store_lds(lds + 16384, tid, rb);
  __syncthreads();
  const int fr = lane & 15, fq = lane >> 4;
  for (int kt = 0; kt < nk; ++kt) {
    unsigned char* cur = lds + (kt & 1) * 32768;
    if (kt + 1 < nk) { gemm_load_a(g, m0, (kt + 1) * 64, tid, ra); gemm_load_b(g, n0, (kt + 1) * 64, tid, rb); }
#pragma unroll
    for (int ks = 0; ks < 2; ++ks) {
      bf16x8 af[MI], bfr[NI];
#pragma unroll
      for (int i = 0; i < MI; ++i) af[i] = *(const bf16x8*)(cur + lds_off(wm * TM + i * 16 + fr, ks * 4 + fq));
#pragma unroll
      for (int j = 0; j < NI; ++j) bfr[j] = *(const bf16x8*)(cur + 16384 + lds_off(wn * TN + j * 16 + fr, ks * 4 + fq));
#pragma unroll
      for (int i = 0; i < MI; ++i)
#pragma unroll
        for (int j = 0; j < NI; ++j) acc[i][j] = __builtin_amdgcn_mfma_f32_16x16x32_bf16(bfr[j], af[i], acc[i][j], 0, 0, 0);
    }
    if (kt + 1 < nk) { unsigned char* nxt = lds + ((kt + 1) & 1) * 32768; gemm_store_lds(nxt, tid, ra); gemm_store_lds(nxt + 16384, tid, rb); }
    __syncthreads();
  }
#pragma unroll
  for (int i = 0; i < MI; ++i) {
    const int m = m0 + wm * TM + i * 16 + fr;
#pragma unroll
    for (int j = 0; j < NI; ++j) {
      const int n = n0 + wn * TN + j * 16 + fq * 4;
      if (n >= g.N) continue;
      const f32x4 v = acc[i][j];
      bf16_t* ob = (bf16_t*)g.out + (size_t)m * g.ldc + n;
      switch (g.epi) {
        case EPI_BF16: *(u32x2*)ob = (u32x2){cvt_pk_bf16(v[0], v[1]), cvt_pk_bf16(v[2], v[3])}; break;
        case EPI_TANH: *(u32x2*)ob = (u32x2){cvt_pk_bf16(tanhf(v[0]), tanhf(v[1])), cvt_pk_bf16(tanhf(v[2]), tanhf(v[3]))}; break;
        case EPI_SIGMOID: *(u32x2*)ob = (u32x2){cvt_pk_bf16(sigmoidf_(v[0]), sigmoidf_(v[1])), cvt_pk_bf16(sigmoidf_(v[2]), sigmoidf_(v[3]))}; break;
        case EPI_LW: {
          const f32x4 w0 = *(const f32x4*)(g.v0 + n); float o[4];
#pragma unroll
          for (int q = 0; q < 4; ++q) { const float xx = -(w0[q] + v[q]); const float sp = fmaxf(xx, 0.f) + log1pf(__expf(-fabsf(xx))); o[q] = -__expf(-sp - 0.5f); }
          *(u32x2*)ob = (u32x2){cvt_pk_bf16(o[0], o[1]), cvt_pk_bf16(o[2], o[3])};
        } break;
        case EPI_ASIG: {
          const f32x4 a0 = *(const f32x4*)(g.v0 + n);
          *(u32x2*)ob = (u32x2){cvt_pk_bf16(sigmoidf_(a0[0] + v[0]), sigmoidf_(a0[1] + v[1])), cvt_pk_bf16(sigmoidf_(a0[2] + v[2]), sigmoidf_(a0[3] + v[3]))};
        } break;
        case EPI_Z: {
          const int b = m / SEQ;
          const f32x4 xv = *(const f32x4*)(g.v0 + (size_t)m * D + n), gt = *(const f32x4*)(g.v1 + (size_t)b * 6144 + n);
          *(f32x4*)((float*)g.out + (size_t)m * g.ldc + n) = xv * ALPHA + gt * v;
        } break;
        default: {
          const f32x4 sc = *(const f32x4*)(g.v0 + n);
          *(u32x2*)ob = (u32x2){cvt_pk_bf16(v[0] * sc[0], v[1] * sc[1]), cvt_pk_bf16(v[2] * sc[2], v[3] * sc[3])};
        } break;
      }
    }
  }
}

DI void scores_topk_tile(const bf16_t* __restrict__ q, const bf16_t* __restrict__ keys, unsigned* __restrict__ lists, int m0, int grp, unsigned char* lds) {
  const int tid = opaque_v(threadIdx.x), lane = tid & 63, wm = tid >> 6, fr = lane & 15, fq = lane >> 4;
#pragma unroll
  for (int hk = 0; hk < 2; ++hk)
#pragma unroll
    for (int i = 0; i < 4; ++i) {
      const int row = (tid >> 3) + i * 32, ch = tid & 7;
      const u32x4 va = *(const u32x4*)(q + (size_t)(m0 + row) * 2048 + grp * 128 + hk * 64 + ch * 8);
      const u32x4 vb = *(const u32x4*)(keys + (size_t)grp * 128 * 128 + (size_t)row * 128 + hk * 64 + ch * 8);
      *(u32x4*)(lds + hk * 16384 + lds_off(row, ch)) = va;
      *(u32x4*)(lds + 32768 + hk * 16384 + lds_off(row, ch)) = vb;
    }
  __syncthreads();
  f32x4 acc[2][8];
#pragma unroll
  for (int i = 0; i < 2; ++i)
#pragma unroll
    for (int j = 0; j < 8; ++j) acc[i][j] = (f32x4){0.f, 0.f, 0.f, 0.f};
#pragma unroll
  for (int kk = 0; kk < 4; ++kk) {
    const int hk = kk >> 1, ks = kk & 1;
    bf16x8 af[2];
#pragma unroll
    for (int i = 0; i < 2; ++i) af[i] = *(const bf16x8*)(lds + hk * 16384 + lds_off(wm * 32 + i * 16 + fr, ks * 4 + fq));
#pragma unroll
    for (int j = 0; j < 8; ++j) {
      const bf16x8 bfr = *(const bf16x8*)(lds + 32768 + hk * 16384 + lds_off(j * 16 + fr, ks * 4 + fq));
#pragma unroll
      for (int i = 0; i < 2; ++i) acc[i][j] = __builtin_amdgcn_mfma_f32_16x16x32_bf16(bfr, af[i], acc[i][j], 0, 0, 0);
    }
  }
  __syncthreads();
  constexpr int MI = 2, NI = 8, TM = 32;
  {
#pragma unroll
    for (int i = 0; i < MI; ++i)
#pragma unroll
      for (int j = 0; j < NI; ++j) {
        const int ml = wm * TM + i * 16 + fr, c = j * 4 + fq;
        u32x4 kv;
        kv.x = (f2key(acc[i][j][0]) & ~127u) | (unsigned)(127 - (c * 4 + 0)); kv.y = (f2key(acc[i][j][1]) & ~127u) | (unsigned)(127 - (c * 4 + 1));
        kv.z = (f2key(acc[i][j][2]) & ~127u) | (unsigned)(127 - (c * 4 + 2)); kv.w = (f2key(acc[i][j][3]) & ~127u) | (unsigned)(127 - (c * 4 + 3));
        *(u32x4*)(lds + ml * 528 + (c << 4)) = kv;
      }
    __syncthreads();
    {
      const int ml = wm * 32 + (lane & 31), hf = lane >> 5;
      unsigned a[16], b[16];
#pragma unroll
      for (int ch = 0; ch < 4; ++ch) {
#pragma unroll
        for (int cc = 0; cc < 4; ++cc) {
          const int c = hf * 16 + ch * 4 + cc;
          const u32x4 kv = *(const u32x4*)(lds + ml * 528 + (c << 4));
          b[cc * 4] = kv.x; b[cc * 4 + 1] = kv.y; b[cc * 4 + 2] = kv.z; b[cc * 4 + 3] = kv.w;
        }
        sort16_desc(b);
        if (ch == 0) {
#pragma unroll
          for (int e = 0; e < 16; ++e) a[e] = b[e];
        } else {
#pragma unroll
          for (int e = 0; e < 16; ++e) a[e] = max(a[e], b[15 - e]);
          merge16_desc(a);
        }
      }
#pragma unroll
      for (int e = 0; e < 16; ++e) b[e] = (unsigned)__shfl_xor((int)a[e], 32);
#pragma unroll
      for (int e = 0; e < 16; ++e) a[e] = max(a[e], b[15 - e]);
      merge16_desc(a);
      if (hf == 0) {
        const int m = m0 + ml;
        u32x4* dst = (u32x4*)(lists + ((size_t)m * 16 + grp) * 16);
        dst[0] = (u32x4){a[0], a[1], a[2], a[3]}; dst[1] = (u32x4){a[4], a[5], a[6], a[7]};
        dst[2] = (u32x4){a[8], a[9], a[10], a[11]}; dst[3] = (u32x4){a[12], a[13], a[14], a[15]};
      }
    }
    __syncthreads();
  }
}

DI GemmArgs mk(const bf16_t* A, int lda, const bf16_t* Bt, int ldb, int N, int K, int epi, void* out, int ldc,
               const float* mu = nullptr, const float* v0 = nullptr, const float* v1 = nullptr) {
  GemmArgs g; g.A = A; g.lda = lda; g.Bt = Bt; g.ldb = ldb; g.N = N; g.K = K; g.mu = mu; g.epi = epi; g.out = out; g.ldc = ldc; g.v0 = v0; g.v1 = v1; return g;
}
DI void item_mn(int item, int ntn, int& mt, int& nt) { const int grp = item / (8 * ntn), w = item % (8 * ntn); mt = grp * 8 + (w & 7); nt = w >> 3; }

struct ScanArgs {
  const bf16_t *r, *k, *v, *lw, *a, *g;
  const float *k_k, *k_a, *r_k, *lnx_g, *lnx_b;
  bf16_t* yg;
};
DI void scan_seq_item(const ScanArgs& s, int item, unsigned char* lds) {
  constexpr int TC = 32;
  float (*sr)[64] = (float (*)[64])(lds), (*sw)[64] = (float (*)[64])(lds + 8192), (*sk)[64] = (float (*)[64])(lds + 16384), (*sv)[64] = (float (*)[64])(lds + 24576),
        (*sa)[64] = (float (*)[64])(lds + 32768), (*sb)[64] = (float (*)[64])(lds + 40960), (*sy)[64] = (float (*)[64])(lds + 49152);
  float* sbonus = (float*)(lds + 57344);
  const int tid = opaque_v(threadIdx.x), b = item / NH, h = item % NH;
  const int vrow = tid >> 2, kq = tid & 3;
  float S[16];
#pragma unroll
  for (int i = 0; i < 16; ++i) S[i] = 0.f;
  const size_t base = (size_t)b * SEQ * D + h * HS;
  for (int t0 = 0; t0 < SEQ; t0 += TC) {
    {
      const int tt = tid >> 3, c0 = (tid & 7) * 8;
      const size_t off = base + (size_t)(t0 + tt) * D + c0;
      const u32x4 vr = *(const u32x4*)(s.r + off), vk = *(const u32x4*)(s.k + off), vv = *(const u32x4*)(s.v + off), vw = *(const u32x4*)(s.lw + off), va = *(const u32x4*)(s.a + off);
      float fr_[8], fk[8], fv[8], fw[8], fa[8];
      const unsigned ur[4] = {vr.x, vr.y, vr.z, vr.w}, uk[4] = {vk.x, vk.y, vk.z, vk.w}, uv[4] = {vv.x, vv.y, vv.z, vv.w}, uw[4] = {vw.x, vw.y, vw.z, vw.w}, ua[4] = {va.x, va.y, va.z, va.w};
#pragma unroll
      for (int j = 0; j < 4; ++j) {
        fr_[2 * j] = bf_lo(ur[j]); fr_[2 * j + 1] = bf_hi(ur[j]); fk[2 * j] = bf_lo(uk[j]); fk[2 * j + 1] = bf_hi(uk[j]);
        fv[2 * j] = bf_lo(uv[j]); fv[2 * j + 1] = bf_hi(uv[j]); fw[2 * j] = bf_lo(uw[j]); fw[2 * j + 1] = bf_hi(uw[j]);
        fa[2 * j] = bf_lo(ua[j]); fa[2 * j + 1] = bf_hi(ua[j]);
      }
      float kkr[8], nrm = 0.f, bon = 0.f, kp[8];
#pragma unroll
      for (int j = 0; j < 8; ++j) {
        const int ch = h * HS + c0 + j;
        kkr[j] = fk[j] * s.k_k[ch]; nrm += kkr[j] * kkr[j];
        kp[j] = fk[j] * (1.f + (fa[j] - 1.f) * s.k_a[ch]);
        bon += fr_[j] * kp[j] * s.r_k[ch];
      }
      nrm += __shfl_xor(nrm, 1); nrm += __shfl_xor(nrm, 2); nrm += __shfl_xor(nrm, 4);
      bon += __shfl_xor(bon, 1); bon += __shfl_xor(bon, 2); bon += __shfl_xor(bon, 4);
      const float inv = rsqrtf(fmaxf(nrm, 1e-24f));
#pragma unroll
      for (int j = 0; j < 8; ++j) {
        const float kk = kkr[j] * inv;
        sr[tt][c0 + j] = fr_[j]; sw[tt][c0 + j] = __expf(fw[j]); sk[tt][c0 + j] = kp[j]; sv[tt][c0 + j] = fv[j];
        sa[tt][c0 + j] = -kk; sb[tt][c0 + j] = kk * fa[j];
      }
      if ((tid & 7) == 0) sbonus[tt] = bon;
    }
    __syncthreads();
    for (int tt = 0; tt < TC; ++tt) {
      float av[16], bv[16], wv[16], kv[16], rv[16];
#pragma unroll
      for (int q = 0; q < 4; ++q) {
        const f32x4 a4 = *(const f32x4*)&sa[tt][kq * 16 + q * 4], b4 = *(const f32x4*)&sb[tt][kq * 16 + q * 4], w4 = *(const f32x4*)&sw[tt][kq * 16 + q * 4],
                    k4 = *(const f32x4*)&sk[tt][kq * 16 + q * 4], r4 = *(const f32x4*)&sr[tt][kq * 16 + q * 4];
#pragma unroll
        for (int j = 0; j < 4; ++j) { av[q * 4 + j] = a4[j]; bv[q * 4 + j] = b4[j]; wv[q * 4 + j] = w4[j]; kv[q * 4 + j] = k4[j]; rv[q * 4 + j] = r4[j]; }
      }
      const float vt = sv[tt][vrow];
      float sap = 0.f;
#pragma unroll
      for (int i = 0; i < 16; ++i) sap += S[i] * av[i];
      sap += __shfl_xor(sap, 1); sap += __shfl_xor(sap, 2);
      float yp = 0.f;
#pragma unroll
      for (int i = 0; i < 16; ++i) { S[i] = S[i] * wv[i] + sap * bv[i] + vt * kv[i]; yp += S[i] * rv[i]; }
      yp += __shfl_xor(yp, 1); yp += __shfl_xor(yp, 2);
      if (kq == 0) sy[tt][vrow] = yp;
    }
    __syncthreads();
    {
      const int tt = tid >> 3, c0 = (tid & 7) * 8;
      float yv[8], sum = 0.f;
#pragma unroll
      for (int j = 0; j < 8; ++j) { yv[j] = sy[tt][c0 + j]; sum += yv[j]; }
      sum += __shfl_xor(sum, 1); sum += __shfl_xor(sum, 2); sum += __shfl_xor(sum, 4);
      const float mean = sum * (1.f / 64.f);
      float var = 0.f;
#pragma unroll
      for (int j = 0; j < 8; ++j) { const float d = yv[j] - mean; var += d * d; }
      var += __shfl_xor(var, 1); var += __shfl_xor(var, 2); var += __shfl_xor(var, 4);
      const float rstd = rsqrtf(var * (1.f / 64.f) + GN_EPS);
      const float bon = sbonus[tt];
      const size_t off = base + (size_t)(t0 + tt) * D + c0;
      const u32x4 vg = *(const u32x4*)(s.g + off);
      const unsigned ug[4] = {vg.x, vg.y, vg.z, vg.w};
      float o[8];
#pragma unroll
      for (int j = 0; j < 8; ++j) {
        const int ch = h * HS + c0 + j;
        const float gq = (j & 1) ? bf_hi(ug[j >> 1]) : bf_lo(ug[j >> 1]);
        o[j] = ((yv[j] - mean) * rstd * s.lnx_g[ch] + s.lnx_b[ch] + bon * sv[tt][c0 + j]) * gq;
      }
      *(u32x4*)(s.yg + off) = (u32x4){cvt_pk_bf16(o[0], o[1]), cvt_pk_bf16(o[2], o[3]), cvt_pk_bf16(o[4], o[5]), cvt_pk_bf16(o[6], o[7])};
    }
    __syncthreads();
  }
}

DI void ln_phase(const float* __restrict__ z, const float* __restrict__ lg, const float* __restrict__ lb, float* __restrict__ xo,
                 const float* __restrict__ mod_l, int shift_idx, int scale_idx, bf16_t* __restrict__ ho, int bid, int nblk) {
  const int tq = opaque_v(threadIdx.x); const int lane = tq & 63, wv = tq >> 6;
  for (int row = bid * 4 + wv; row < T; row += nblk * 4) {
    const float* zr = z + (size_t)row * D;
    f32x4 v[4]; float s = 0.f;
#pragma unroll
    for (int i = 0; i < 4; ++i) { v[i] = *(const f32x4*)(zr + i * 256 + lane * 4); s += (v[i][0] + v[i][1]) + (v[i][2] + v[i][3]); }
    const float mean = wave_sum(s) * (1.f / D);
    float q = 0.f;
#pragma unroll
    for (int i = 0; i < 4; ++i) { const f32x4 d = v[i] - mean; q += (d[0] * d[0] + d[1] * d[1]) + (d[2] * d[2] + d[3] * d[3]); }
    const float rstd = rsqrtf(wave_sum(q) * (1.f / D) + LN_EPS);
    const int b = row / SEQ;
#pragma unroll
    for (int i = 0; i < 4; ++i) {
      const int d = i * 256 + lane * 4;
      const f32x4 o = (v[i] - mean) * rstd * *(const f32x4*)(lg + d) + *(const f32x4*)(lb + d);
      *(f32x4*)(xo + (size_t)row * D + d) = o;
      const f32x4 sh = *(const f32x4*)(mod_l + (size_t)b * 6144 + shift_idx * D + d), sc = *(const f32x4*)(mod_l + (size_t)b * 6144 + scale_idx * D + d);
      const f32x4 hh = o * (sc + 1.f) + sh;
      *(u32x2*)(ho + (size_t)row * D + d) = (u32x2){cvt_pk_bf16(hh[0], hh[1]), cvt_pk_bf16(hh[2], hh[3])};
    }
  }
}

DI void combine_phase(const unsigned* __restrict__ lists, int* __restrict__ eidx, float* __restrict__ gate, int bid, int nblk) {
  const int tq = opaque_v(threadIdx.x);
  for (int gid = bid * 256 + tq; gid < T * 8; gid += nblk * 256) {
    const unsigned* la = lists + (size_t)gid * 32;
    const unsigned* lb = la + 16;
    float s1[16], s2[16];
#pragma unroll
    for (int i = 0; i < 4; ++i) {
      const u32x4 a = *(const u32x4*)(la + i * 4), b = *(const u32x4*)(lb + i * 4);
      s1[i * 4] = key2f(a.x & ~127u); s1[i * 4 + 1] = key2f(a.y & ~127u); s1[i * 4 + 2] = key2f(a.z & ~127u); s1[i * 4 + 3] = key2f(a.w & ~127u);
      s2[i * 4] = key2f(b.x & ~127u); s2[i * 4 + 1] = key2f(b.y & ~127u); s2[i * 4 + 2] = key2f(b.z & ~127u); s2[i * 4 + 3] = key2f(b.w & ~127u);
    }
    unsigned c[4][16];
    {
      int n = 0;
#pragma unroll
      for (int a = 0; a < 16; ++a)
#pragma unroll
        for (int b = 0; b < 16; ++b)
          if ((a + 1) * (b + 1) <= 16) { c[n >> 4][n & 15] = (f2key(s1[a] + s2[b]) & ~255u) | (unsigned)(255 - (a * 16 + b)); ++n; }
#pragma unroll
      for (int q = 50; q < 64; ++q) c[q >> 4][q & 15] = 0u;
    }
    sort16_desc(c[0]); sort16_desc(c[1]); sort16_desc(c[2]); sort16_desc(c[3]);
#pragma unroll
    for (int e = 0; e < 16; ++e) { c[0][e] = max(c[0][e], c[1][15 - e]); c[2][e] = max(c[2][e], c[3][15 - e]); }
    merge16_desc(c[0]); merge16_desc(c[2]);
#pragma unroll
    for (int e = 0; e < 16; ++e) c[0][e] = max(c[0][e], c[2][15 - e]);
    merge16_desc(c[0]);
    float best[16], den = 0.f;
    const float mx = key2f(c[0][0] & ~255u);
#pragma unroll
    for (int e = 0; e < 16; ++e) { best[e] = __expf(key2f(c[0][e] & ~255u) - mx); den += best[e]; }
    const float inv = 1.f / den;
#pragma unroll
    for (int e = 0; e < 16; ++e) {
      const int pos = 255 - (int)(c[0][e] & 255u), a = pos >> 4, b = pos & 15;
      const int i1 = 127 - (int)(la[a] & 127u), i2 = 127 - (int)(lb[b] & 127u);
      eidx[(size_t)gid * 16 + e] = i1 * 128 + i2;
      gate[(size_t)gid * 16 + e] = best[e] * inv;
    }
  }
}

struct PeerArgs {
  const bf16_t* h2;
  const bf16_t *ub, *vb;
  const int* eidx; const float* gate;
  const float* xres;
  const float* gate2;
  const float *lg, *lb;
  float* xo;
  const float* mod_next; bf16_t* ho;
};
DI void peer_gather_phase(const PeerArgs& a, int bid, int nblk) {
  const int tq = opaque_v(threadIdx.x); const int lane = tq & 63, wv = tq >> 6;
  for (int t = bid * 4 + wv; t < T; t += nblk * 4) {
    const u32x4 h0 = *(const u32x4*)(a.h2 + (size_t)t * D + lane * 8), h1 = *(const u32x4*)(a.h2 + (size_t)t * D + 512 + lane * 8);
    float hf[16];
    { const unsigned u[8] = {h0.x, h0.y, h0.z, h0.w, h1.x, h1.y, h1.z, h1.w};
#pragma unroll
      for (int j = 0; j < 8; ++j) { hf[2 * j] = bf_lo(u[j]); hf[2 * j + 1] = bf_hi(u[j]); } }
    const int e0 = a.eidx[(size_t)t * 128 + lane], e1 = a.eidx[(size_t)t * 128 + 64 + lane];
    const float g0 = a.gate[(size_t)t * 128 + lane], g1 = a.gate[(size_t)t * 128 + 64 + lane];
    float c0 = 0.f, c1 = 0.f;
#pragma unroll 1
    for (int half = 0; half < 2; ++half) {
      const int ev = half ? e1 : e0;
      float cacc = 0.f;
#pragma unroll 1
      for (int j0 = 0; j0 < 64; j0 += 4) {
        u32x4 r0[4], r1[4];
#pragma unroll
        for (int jj = 0; jj < 4; ++jj) {
          const int e = __shfl(ev, j0 + jj);
          const bf16_t* row = a.ub + (size_t)e * D;
          r0[jj] = *(const u32x4*)(row + lane * 8); r1[jj] = *(const u32x4*)(row + 512 + lane * 8);
        }
#pragma unroll
        for (int jj = 0; jj < 4; ++jj) {
          const unsigned u[8] = {r0[jj].x, r0[jj].y, r0[jj].z, r0[jj].w, r1[jj].x, r1[jj].y, r1[jj].z, r1[jj].w};
          float d = 0.f;
#pragma unroll
          for (int q = 0; q < 8; ++q) d += bf_lo(u[q]) * hf[2 * q] + bf_hi(u[q]) * hf[2 * q + 1];
          d = wave_sum(d);
          if (lane == j0 + jj) cacc = d;
        }
      }
      const float act = gelu_exact(cacc);
      if (half) c1 = g1 * act; else c0 = g0 * act;
    }
    float o[16];
#pragma unroll
    for (int i = 0; i < 16; ++i) o[i] = 0.f;
#pragma unroll 1
    for (int half = 0; half < 2; ++half) {
      const int ev = half ? e1 : e0; const float cv = half ? c1 : c0;
#pragma unroll 1
      for (int j0 = 0; j0 < 64; j0 += 4) {
        u32x4 r0[4], r1[4]; float cf[4];
#pragma unroll
        for (int jj = 0; jj < 4; ++jj) {
          const int e = __shfl(ev, j0 + jj); cf[jj] = __shfl(cv, j0 + jj);
          const bf16_t* row = a.vb + (size_t)e * D;
          r0[jj] = *(const u32x4*)(row + lane * 8); r1[jj] = *(const u32x4*)(row + 512 + lane * 8);
        }
#pragma unroll
        for (int jj = 0; jj < 4; ++jj) {
          const unsigned u[8] = {r0[jj].x, r0[jj].y, r0[jj].z, r0[jj].w, r1[jj].x, r1[jj].y, r1[jj].z, r1[jj].w};
#pragma unroll
          for (int q = 0; q < 8; ++q) { o[2 * q] += cf[jj] * bf_lo(u[q]); o[2 * q + 1] += cf[jj] * bf_hi(u[q]); }
        }
      }
    }
    const int b = t / SEQ;
    float zv[16], s = 0.f;
#pragma unroll
    for (int hh = 0; hh < 2; ++hh) {
      const int d0 = hh * 512 + lane * 8;
      const f32x4 x0 = *(const f32x4*)(a.xres + (size_t)t * D + d0), x1 = *(const f32x4*)(a.xres + (size_t)t * D + d0 + 4);
      const f32x4 q0 = *(const f32x4*)(a.gate2 + (size_t)b * 6144 + d0), q1 = *(const f32x4*)(a.gate2 + (size_t)b * 6144 + d0 + 4);
#pragma unroll
      for (int j = 0; j < 4; ++j) { zv[hh * 8 + j] = ALPHA * x0[j] + q0[j] * o[hh * 8 + j]; zv[hh * 8 + 4 + j] = ALPHA * x1[j] + q1[j] * o[hh * 8 + 4 + j]; }
    }
#pragma unroll
    for (int j = 0; j < 16; ++j) s += zv[j];
    const float mean = wave_sum(s) * (1.f / D);
    float q = 0.f;
#pragma unroll
    for (int j = 0; j < 16; ++j) { const float d = zv[j] - mean; q += d * d; }
    const float rstd = rsqrtf(wave_sum(q) * (1.f / D) + LN_EPS);
#pragma unroll
    for (int hh = 0; hh < 2; ++hh) {
      const int d0 = hh * 512 + lane * 8;
      float r[8];
#pragma unroll
      for (int j = 0; j < 8; ++j) r[j] = (zv[hh * 8 + j] - mean) * rstd * a.lg[d0 + j] + a.lb[d0 + j];
      *(f32x4*)(a.xo + (size_t)t * D + d0) = (f32x4){r[0], r[1], r[2], r[3]};
      *(f32x4*)(a.xo + (size_t)t * D + d0 + 4) = (f32x4){r[4], r[5], r[6], r[7]};
      if (a.ho) {
        float hq[8];
#pragma unroll
        for (int j = 0; j < 8; ++j) hq[j] = r[j] * (1.f + a.mod_next[(size_t)b * 6144 + 1 * D + d0 + j]) + a.mod_next[(size_t)b * 6144 + 0 * D + d0 + j];
        *(u32x4*)(a.ho + (size_t)t * D + d0) = (u32x4){cvt_pk_bf16(hq[0], hq[1]), cvt_pk_bf16(hq[2], hq[3]), cvt_pk_bf16(hq[4], hq[5]), cvt_pk_bf16(hq[6], hq[7])};
      }
    }
  }
}

DI void pool_phase(const bf16_t* __restrict__ zin, bf16_t* __restrict__ pout, int bid, int nblk) {
  const size_t n8 = (size_t)T * D / 8; const int tq = opaque_v(threadIdx.x);
  for (size_t i = (size_t)bid * 256 + tq; i < n8; i += (size_t)nblk * 256) {
    const size_t e = i * 8; const int t = (int)(e / D), d = (int)(e % D), tp = t % SEQ;
    const int win = 2 << (d / 256);
    const int cnt = min(tp + 1, win);
    float s[8], z0[8];
#pragma unroll
    for (int j = 0; j < 8; ++j) { s[j] = 0.f; z0[j] = 0.f; }
    for (int w = 0; w < cnt; ++w) {
      const u32x4 v = *(const u32x4*)(zin + e - (size_t)w * D);
      const unsigned u[4] = {v.x, v.y, v.z, v.w};
#pragma unroll
      for (int j = 0; j < 4; ++j) { const float lo = bf_lo(u[j]), hi = bf_hi(u[j]); s[2 * j] += lo; s[2 * j + 1] += hi; if (w == 0) { z0[2 * j] = lo; z0[2 * j + 1] = hi; } }
    }
    const float ic = 1.f / (float)cnt;
    float o[8];
#pragma unroll
    for (int j = 0; j < 8; ++j) o[j] = s[j] * ic - z0[j];
    *(u32x4*)(pout + e) = (u32x4){cvt_pk_bf16(o[0], o[1]), cvt_pk_bf16(o[2], o[3]), cvt_pk_bf16(o[4], o[5]), cvt_pk_bf16(o[6], o[7])};
  }
}

struct PeerLayer {
  const bf16_t* h2; const bf16_t* WqT; const bf16_t* Keys; bf16_t* q; unsigned* lists; int* eidx; float* gate;
  PeerArgs ga;
};

#define GRID_SYNC() grid.sync()

__global__ void __launch_bounds__(256, 2) mega(Params p) {
  __shared__ __attribute__((aligned(16))) unsigned char lds[LDS_BYTES];
  cg::grid_group grid = cg::this_grid();
  const int bid = blockIdx.x, nblk = gridDim.x;
  const float* mod0 = p.mod; const float* mod1 = p.mod + (size_t)NB * 6144;
  bf16_t* S[7];
#pragma unroll
  for (int i = 0; i < 7; ++i) S[i] = (bf16_t*)p.slot[i];

  prologue_phase(p, lds, bid, nblk);
  GRID_SYNC();
  bf16_t *h = S[0], *r = S[1], *k = S[2], *v = S[3], *lw = S[4], *av = S[5], *gv = S[6];
  bf16_t* tw = (bf16_t*)p.out; bf16_t* ta = tw + (size_t)T * 64; bf16_t* tg = ta + (size_t)T * 64;
  modulate_phase(p.x, mod0, 0, 1, h, bid, nblk);
  GRID_SYNC();
  for (int it = bid; it < 256 * 28; it += nblk) {
    int mt, nt; item_mn(it, 28, mt, nt);
    GemmArgs g; int n0;
    if (nt < 24) { const int j = nt >> 3; n0 = (nt & 7) * 128; g = mk(h, D, p.WT_rkv + (size_t)j * D * D, D, D, D, EPI_BF16, j == 0 ? r : (j == 1 ? k : v), D, p.rw_mu + j * D); }
    else if (nt == 24) { n0 = 0; g = mk(h, D, p.W1T, D, 64, D, EPI_TANH, tw, 64, p.rw_mu + 3 * D); }
    else if (nt == 25) { n0 = 0; g = mk(h, D, p.A1T, D, 64, D, EPI_BF16, ta, 64, p.rw_mu + 4 * D); }
    else { n0 = (nt - 26) * 128; g = mk(h, D, p.G1T, D, 192, D, EPI_SIGMOID, tg, 192, p.rw_mu + 5 * D); }
    gemm_tile(g, mt * 128, n0, lds);
  }
  GRID_SYNC();
  for (int it = bid; it < 256 * 24; it += nblk) {
    int mt, nt; item_mn(it, 24, mt, nt);
    const int j = nt >> 3, n0 = (nt & 7) * 128;
    GemmArgs g;
    if (j == 0) g = mk(tw, 64, p.W2T, 64, D, 64, EPI_LW, lw, D, nullptr, p.rw_w0);
    else if (j == 1) g = mk(ta, 64, p.A2T, 64, D, 64, EPI_ASIG, av, D, nullptr, p.rw_a0);
    else g = mk(tg, 192, p.G2T, 192, D, 192, EPI_BF16, gv, D);
    gemm_tile(g, mt * 128, n0, lds);
  }
  GRID_SYNC();
  {
    ScanArgs s; s.r = r; s.k = k; s.v = v; s.lw = lw; s.a = av; s.g = gv; s.k_k = p.rw_k_k; s.k_a = p.rw_k_a; s.r_k = p.rw_r_k; s.lnx_g = p.rw_lnx_g; s.lnx_b = p.rw_lnx_b; s.yg = h;
    for (int it = bid; it < NB * NH; it += nblk) scan_seq_item(s, it, lds);
  }
  GRID_SYNC();
  float* z = (float*)p.slot[1];
  bf16_t* ub = S[6]; bf16_t* vb = S[6] + (size_t)NEXP * D;
  for (int it = bid; it < 256 * 8; it += nblk) {
    int mt, nt; item_mn(it, 8, mt, nt);
    gemm_tile(mk(h, D, p.WoT, D, D, D, EPI_Z, z, D, nullptr, p.x, mod0 + 2 * D), mt * 128, nt * 128, lds);
  }
  cvt_range(p.pe_u, ub, (size_t)NEXP * D / 8, bid, nblk);
  cvt_range(p.pe_v, vb, (size_t)NEXP * D / 8, bid, nblk);
  GRID_SYNC();
  float* x1 = (float*)p.slot[3]; bf16_t* h2 = S[5];
  ln_phase(z, p.ln_g + 0 * D, p.ln_b + 0 * D, x1, mod0, 3, 4, h2, bid, nblk);
  GRID_SYNC();

#pragma unroll
  for (int layer = 0; layer < 2; ++layer) {
    const bf16_t* hp = layer == 0 ? h2 : S[0];
    bf16_t* q = layer == 0 ? (bf16_t*)p.slot[1] : (bf16_t*)p.slot[4];
    unsigned char* ls = layer == 0 ? p.slot[0] : p.slot[3];
    unsigned* lists = (unsigned*)ls; int* eidx = (int*)(ls + ((size_t)32 << 20)); float* gate = (float*)(ls + ((size_t)48 << 20));
    const bf16_t* WqT = p.WqT + (size_t)layer * 2048 * D; const bf16_t* Keys = p.KeysB + (size_t)layer * 16 * 128 * 128;
    for (int it = bid; it < 256 * 16; it += nblk) {
      int mt, nt; item_mn(it, 16, mt, nt);
      gemm_tile(mk(hp, D, WqT, D, 2048, D, EPI_BF16, q, 2048), mt * 128, nt * 128, lds);
    }
    GRID_SYNC();
    for (int it = bid; it < 256 * 16; it += nblk) {
      int mt, grp; item_mn(it, 16, mt, grp);
      scores_topk_tile(q, Keys, lists, mt * 128, grp, lds);
    }
    GRID_SYNC();
    combine_phase(lists, eidx, gate, bid, nblk);
    GRID_SYNC();
    {
      PeerArgs a; a.h2 = hp; a.ub = ub; a.vb = vb; a.eidx = eidx; a.gate = gate;
      if (layer == 0) { a.xres = x1; a.gate2 = mod0 + 5 * D; a.lg = p.ln_g + 1 * D; a.lb = p.ln_b + 1 * D; a.xo = (float*)p.slot[1]; a.mod_next = mod1; a.ho = h2; }
      else { a.xres = (float*)p.slot[1]; a.gate2 = mod1 + 5 * D; a.lg = p.ln_g + 3 * D; a.lb = p.ln_b + 3 * D; a.xo = p.out; a.mod_next = nullptr; a.ho = nullptr; }
      peer_gather_phase(a, bid, nblk);
    }
    if (layer == 1) break;
    GRID_SYNC();
    float* x2 = (float*)p.slot[1];
    bf16_t* hB = h2;
    bf16_t *zin = S[3], *pp = S[4], *yp = S[3];
    for (int it = bid; it < 256 * 8; it += nblk) {
      int mt, nt; item_mn(it, 8, mt, nt);
      gemm_tile(mk(hB, D, p.PinT, D, D, D, EPI_BF16, zin, D), mt * 128, nt * 128, lds);
    }
    cvt_range(p.pe_u + (size_t)NEXP * D, ub, (size_t)NEXP * D / 8, bid, nblk);
    cvt_range(p.pe_v + (size_t)NEXP * D, vb, (size_t)NEXP * D / 8, bid, nblk);
    GRID_SYNC();
    pool_phase(zin, pp, bid, nblk);
    GRID_SYNC();
    for (int it = bid; it < 256 * 8; it += nblk) {
      int mt, nt; item_mn(it, 8, mt, nt);
      const int gi = nt >> 1, n0 = (nt & 1) * 128;
      gemm_tile(mk(pp + gi * 256, D, p.WgrpT + (size_t)gi * 256 * 256, 256, 256, 256, EPI_SCALE, yp + gi * 256, D, nullptr, p.pl_scale + gi * 256), mt * 128, n0, lds);
    }
    GRID_SYNC();
    float* z1 = (float*)p.slot[4];
    for (int it = bid; it < 256 * 8; it += nblk) {
      int mt, nt; item_mn(it, 8, mt, nt);
      gemm_tile(mk(yp, D, p.PoutT, D, D, D, EPI_Z, z1, D, nullptr, x2, mod1 + 2 * D), mt * 128, nt * 128, lds);
    }
    GRID_SYNC();
    ln_phase(z1, p.ln_g + 2 * D, p.ln_b + 2 * D, (float*)p.slot[1], mod1, 3, 4, S[0], bid, nblk);
    GRID_SYNC();
  }
}

extern "C" void kernel_launch(void* const* d_in, const int* in_sizes, int n_in, void* d_out, int out_size, void* d_ws, size_t ws_size, hipStream_t stream) {
  Params p{};
  const float** ip = (const float**)&p.x;
  for (int i = 0; i < 30; ++i) ip[i] = (const float*)d_in[i];
  p.out = (float*)d_out;
  unsigned char* w = (unsigned char*)d_ws; size_t off = 0;
  auto take = [&](size_t bytes) { unsigned char* r = w + off; off += (bytes + 255) & ~(size_t)255; return r; };
  p.bar = (unsigned*)take(16384);
  p.mod = (float*)take((size_t)2 * NB * 6144 * 4);
  p.WT_rkv = (bf16_t*)take((size_t)3 * D * D * 2);
  p.W1T = (bf16_t*)take((size_t)128 * D * 2); p.A1T = (bf16_t*)take((size_t)128 * D * 2); p.G1T = (bf16_t*)take((size_t)256 * D * 2);
  p.W2T = (bf16_t*)take((size_t)D * 64 * 2); p.A2T = (bf16_t*)take((size_t)D * 64 * 2); p.G2T = (bf16_t*)take((size_t)D * 192 * 2);
  p.WoT = (bf16_t*)take((size_t)D * D * 2); p.PinT = (bf16_t*)take((size_t)D * D * 2); p.PoutT = (bf16_t*)take((size_t)D * D * 2);
  p.WgrpT = (bf16_t*)take((size_t)4 * 256 * 256 * 2); p.WqT = (bf16_t*)take((size_t)2 * 2048 * D * 2); p.KeysB = (bf16_t*)take((size_t)2 * 16 * 128 * 128 * 2);
  for (int i = 0; i < 7; ++i) p.slot[i] = take((size_t)64 << 20);
  if (off > ws_size) return;

  static int grid_blocks = 0;
  if (!grid_blocks) {
    int dev = 0, cus = 0, per_cu = 0;
    hipGetDevice(&dev);
    hipDeviceGetAttribute(&cus, hipDeviceAttributeMultiprocessorCount, dev);
    hipOccupancyMaxActiveBlocksPerMultiprocessor(&per_cu, mega, 256, 0);
    if (per_cu > 2) per_cu = 2;
    if (per_cu < 1) per_cu = 1;
    grid_blocks = cus * per_cu;
  }
  hipMemsetAsync(p.bar, 0, 16384, stream);
  void* args[] = {&p};
  hipLaunchCooperativeKernel((void*)mega, dim3(grid_blocks), dim3(256), args, 0, stream);
}
```

```cpp
#include <hip/hip_runtime.h>
#include <hip/hip_cooperative_groups.h>
#include <stdint.h>
#include <stddef.h>
namespace cg = cooperative_groups;

typedef unsigned short bf16_t;
typedef short bf16x8 __attribute__((ext_vector_type(8)));
typedef float f32x4 __attribute__((ext_vector_type(4)));
typedef float f32x2 __attribute__((ext_vector_type(2)));
typedef unsigned u32x4 __attribute__((ext_vector_type(4)));
typedef unsigned u32x2 __attribute__((ext_vector_type(2)));
#define DI __device__ __forceinline__

constexpr int D = 1024, NB = 8, SEQ = 4096, T = NB * SEQ;
constexpr int NH = 16, HS = 64;
constexpr int NEXP = 16384;
constexpr float ALPHA = 1.4142135623730951f;
constexpr float LN_EPS = 1e-5f, GN_EPS = 64e-5f;
constexpr int LDS_BYTES = 128 * 528;

DI unsigned cvt_pk_bf16(float lo, float hi) { unsigned r; asm volatile("v_cvt_pk_bf16_f32 %0, %1, %2" : "=v"(r) : "v"(lo), "v"(hi)); return r; }
DI float bf_lo(unsigned u) { return __uint_as_float(u << 16); }
DI float bf_hi(unsigned u) { return __uint_as_float(u & 0xffff0000u); }
DI bf16_t f2bf(float f) { unsigned u = __float_as_uint(f); u += 0x7fffu + ((u >> 16) & 1u); return (bf16_t)(u >> 16); }
DI float sigmoidf_(float x) { return 1.f / (1.f + __expf(-x)); }
DI float wave_sum(float v) {
#pragma unroll
  for (int o = 32; o >= 1; o >>= 1) v += __shfl_xor(v, o);
  return v;
}
DI int opaque_v(int x) { asm volatile("" : "+v"(x)); return x; }
DI float gelu_exact(float v) { return 0.5f * v * (1.f + erff(v * 0.70710678118654752f)); }

#define XB_TMO      128
#define XB_XCNT(j)  (256  + 64 * (j))
#define XB_XSUB(j)  (1280 + 64 * (j))
#define XB_XGEN(j)  (2304 + 64 * (j))
#define XB_TOP      3328
#define XB_TOPGEN   3392
#define XCD_BAR_WORDS 3456
#define XB_SPIN_CAP (1u << 22)
#define LAS __attribute__((address_space(3)))
DI unsigned xb_ld(unsigned* p)              { return __hip_atomic_load(p, __ATOMIC_RELAXED, __HIP_MEMORY_SCOPE_AGENT); }
DI unsigned xb_add(unsigned* p, unsigned v) { return __hip_atomic_fetch_add(p, v, __ATOMIC_RELAXED, __HIP_MEMORY_SCOPE_AGENT); }
DI unsigned xb_xcc_id() { return (unsigned)__builtin_amdgcn_s_getreg((3 << 11) | 20) & 0xFu; }
#define XB_SPIN(cond, bar) do { unsigned _sp = 0; while (cond) { __builtin_amdgcn_s_sleep(1); \
    if ((++_sp & 255u) == 0u) { if (xb_ld(&(bar)[XB_TMO])) break; if (_sp > XB_SPIN_CAP) { atomicAdd(&(bar)[XB_TMO], 1u); break; } } } } while (0)
struct XcdBarrier { unsigned* bar; unsigned x; volatile LAS unsigned* st; };
DI XcdBarrier xcd_barrier_post(unsigned* bar, volatile LAS unsigned* st) {
  XcdBarrier b; b.bar = bar; b.x = xb_xcc_id(); b.st = st;
  if (threadIdx.x == 0) (void)xb_add(&bar[XB_XCNT(b.x)], 1u);
  return b;
}
DI void xcd_barrier_complete(unsigned* bar, unsigned x, unsigned& nloc, unsigned& nx) {
  const unsigned G = gridDim.x * gridDim.y * gridDim.z;
  unsigned sum, cnt, mine, sp = 0u;
  for (;;) {
    sum = 0u; cnt = 0u; mine = 0u;
#pragma unroll
    for (unsigned j = 0; j < 16; ++j) { const unsigned c = xb_ld(&bar[XB_XCNT(j)]); sum += c; cnt += (c > 0u) ? 1u : 0u; mine = (j == x) ? c : mine; }
    if (sum == G) break;
    __builtin_amdgcn_s_sleep(1);
    if ((++sp & 255u) == 0u) { if (xb_ld(&bar[XB_TMO])) break; if (sp > XB_SPIN_CAP) { atomicAdd(&bar[XB_TMO], 1u); break; } }
  }
  nloc = mine > 0u ? mine : 1u; nx = cnt > 0u ? cnt : 1u;
}
DI void xcd_barrier(const XcdBarrier& b) {
  asm volatile("s_waitcnt vmcnt(0)" ::: "memory");
  __syncthreads();
  if (threadIdx.x == 0) {
    unsigned* bar = b.bar;
    __builtin_amdgcn_s_waitcnt(0);
    unsigned nloc = b.st[0], nx = b.st[1];
    if (nloc == 0u) { xcd_barrier_complete(bar, b.x, nloc, nx); b.st[0] = nloc; b.st[1] = nx; }
    const unsigned old = xb_add(&bar[XB_XSUB(b.x)], 1u);
    const unsigned gen = old / nloc;
    if (old + 1u == (gen + 1u) * nloc) {
      __builtin_amdgcn_fence(__ATOMIC_RELEASE, "agent");
      asm volatile("s_waitcnt vmcnt(0)" ::: "memory");
      const unsigned og = xb_add(&bar[XB_TOP], 1u);
      const unsigned tg = og / nx;
      if (og + 1u == (tg + 1u) * nx) xb_add(&bar[XB_TOPGEN], 1u);
      else XB_SPIN(xb_ld(&bar[XB_TOPGEN]) == tg, bar);
      __builtin_amdgcn_fence(__ATOMIC_ACQUIRE, "agent");
      xb_add(&bar[XB_XGEN(b.x)], 1u);
      asm volatile("s_waitcnt vmcnt(0)" ::: "memory");
    } else {
      XB_SPIN(xb_ld(&bar[XB_XGEN(b.x)]) == gen, bar);
      __builtin_amdgcn_fence(__ATOMIC_ACQUIRE, "agent");
      asm volatile("s_waitcnt vmcnt(0)" ::: "memory");
    }
  }
  __syncthreads();
}

struct Params {
  const float *x, *c, *ada_w, *ada_b, *ln_g, *ln_b, *rw_mu, *rw_w_rkv, *rw_w0, *rw_w1, *rw_w2, *rw_a0, *rw_a1, *rw_a2, *rw_g1, *rw_g2,
      *rw_k_k, *rw_k_a, *rw_r_k, *rw_lnx_g, *rw_lnx_b, *rw_w_o, *pl_w_in, *pl_w_grp, *pl_scale, *pl_w_out, *pe_w_q, *pe_keys, *pe_u, *pe_v;
  float* out;
  float* mod;
  bf16_t *WT_rkv, *W1T, *A1T, *G1T, *W2T, *A2T, *G2T, *WoT, *PinT, *PoutT, *WgrpT, *WqT, *KeysB;
  unsigned char* slot[7];
  unsigned* bar;
};

DI void mod_item(const Params& p, int item, unsigned char* lds) {
  float* cond = (float*)lds;
  float (*red)[NB][32] = (float (*)[NB][32])(lds + 32768);
  const int tid = opaque_v(threadIdx.x);
  for (int i = tid; i < NB * D; i += 256) { float v = p.c[i]; cond[i] = v / (1.f + __expf(-v)); }
  __syncthreads();
  const int l = item / 192, cb = item % 192;
  const int col = cb * 32 + (tid & 31), kg = tid >> 5;
  const float* w = p.ada_w + (size_t)l * D * 6144 + col;
  float acc[NB];
#pragma unroll
  for (int b = 0; b < NB; ++b) acc[b] = 0.f;
  for (int k = kg * 128; k < kg * 128 + 128; ++k) {
    const float wv = w[(size_t)k * 6144];
#pragma unroll
    for (int b = 0; b < NB; ++b) acc[b] += cond[b * D + k] * wv;
  }
#pragma unroll
  for (int b = 0; b < NB; ++b) red[kg][b][tid & 31] = acc[b];
  __syncthreads();
  {
    const int b = tid >> 5, cc = tid & 31;
    float s = 0.f;
#pragma unroll
    for (int g = 0; g < 8; ++g) s += red[g][b][cc];
    const int n = cb * 32 + cc;
    p.mod[((size_t)l * NB + b) * 6144 + n] = s + p.ada_b[l * 6144 + n];
  }
  __syncthreads();
}

DI void transpose_item(const float* __restrict__ src, bf16_t* __restrict__ dst, int K, int N, int Kpad, int Npad, size_t sbs, size_t dbs, int item, unsigned char* lds) {
  float (*tile)[33] = (float (*)[33])lds;
  const int nb_n = Npad / 32, nb_k = Kpad / 32;
  const int per = nb_n * nb_k;
  const int bz = item / per, r = item % per;
  const int bk = r / nb_n, bn = r % nb_n;
  src += bz * sbs; dst += bz * dbs;
  const int tq = opaque_v(threadIdx.x); const int tx = tq & 31, ty = tq >> 5;
#pragma unroll
  for (int i = 0; i < 4; ++i) {
    const int k = bk * 32 + ty + i * 8, n = bn * 32 + tx;
    tile[ty + i * 8][tx] = (k < K && n < N) ? src[(size_t)k * N + n] : 0.f;
  }
  __syncthreads();
#pragma unroll
  for (int i = 0; i < 4; ++i) {
    const int n = bn * 32 + ty + i * 8, k = bk * 32 + tx;
    dst[(size_t)n * Kpad + k] = f2bf(tile[tx][ty + i * 8]);
  }
  __syncthreads();
}
DI void cvt_range(const float* __restrict__ src, bf16_t* __restrict__ dst, size_t n8, int bid, int nblk) {
  const int tq = opaque_v(threadIdx.x);
  for (size_t i = (size_t)bid * 256 + tq; i < n8; i += (size_t)nblk * 256) {
    const f32x4 a = *(const f32x4*)(src + i * 8), b = *(const f32x4*)(src + i * 8 + 4);
    u32x4 o; o.x = cvt_pk_bf16(a[0], a[1]); o.y = cvt_pk_bf16(a[2], a[3]); o.z = cvt_pk_bf16(b[0], b[1]); o.w = cvt_pk_bf16(b[2], b[3]);
    *(u32x4*)(dst + i * 8) = o;
  }
}
DI void prologue_phase(const Params& p, unsigned char* lds, int bid, int nblk) {
  constexpr int total = 384 + 3072 + 128 + 128 + 256 + 64 + 64 + 192 + 1024 + 1024 + 1024 + 256 + 4096;
  for (int it = bid; it < total; it += nblk) {
    int r = it;
    if (r < 384) { mod_item(p, r, lds); continue; } r -= 384;
    if (r < 3072) { transpose_item(p.rw_w_rkv, p.WT_rkv, D, D, D, D, (size_t)D * D, (size_t)D * D, r, lds); continue; } r -= 3072;
    if (r < 128) { transpose_item(p.rw_w1, p.W1T, D, 64, D, 128, 0, 0, r, lds); continue; } r -= 128;
    if (r < 128) { transpose_item(p.rw_a1, p.A1T, D, 64, D, 128, 0, 0, r, lds); continue; } r -= 128;
    if (r < 256) { transpose_item(p.rw_g1, p.G1T, D, 160, D, 256, 0, 0, r, lds); continue; } r -= 256;
    if (r < 64) { transpose_item(p.rw_w2, p.W2T, 64, D, 64, D, 0, 0, r, lds); continue; } r -= 64;
    if (r < 64) { transpose_item(p.rw_a2, p.A2T, 64, D, 64, D, 0, 0, r, lds); continue; } r -= 64;
    if (r < 192) { transpose_item(p.rw_g2, p.G2T, 160, D, 192, D, 0, 0, r, lds); continue; } r -= 192;
    if (r < 1024) { transpose_item(p.rw_w_o, p.WoT, D, D, D, D, 0, 0, r, lds); continue; } r -= 1024;
    if (r < 1024) { transpose_item(p.pl_w_in, p.PinT, D, D, D, D, 0, 0, r, lds); continue; } r -= 1024;
    if (r < 1024) { transpose_item(p.pl_w_out, p.PoutT, D, D, D, D, 0, 0, r, lds); continue; } r -= 1024;
    if (r < 256) { transpose_item(p.pl_w_grp, p.WgrpT, 256, 256, 256, 256, (size_t)256 * 256, (size_t)256 * 256, r, lds); continue; } r -= 256;
    transpose_item(p.pe_w_q, p.WqT, D, 2048, D, 2048, (size_t)D * 2048, (size_t)D * 2048, r, lds);
  }
  cvt_range(p.pe_keys, p.KeysB, (size_t)2 * 16 * 128 * 128 / 8, bid, nblk);
}

DI void modulate_phase(const float* __restrict__ x, const float* __restrict__ mod_l, int shift_idx, int scale_idx, bf16_t* __restrict__ h, int bid, int nblk) {
  const size_t n8 = (size_t)T * D / 8; const int tq = opaque_v(threadIdx.x);
  for (size_t i = (size_t)bid * 256 + tq; i < n8; i += (size_t)nblk * 256) {
    const size_t e = i * 8; const int t = (int)(e / D), d = (int)(e % D), b = t / SEQ;
    const float* sh = mod_l + (size_t)b * 6144 + shift_idx * D + d; const float* sc = mod_l + (size_t)b * 6144 + scale_idx * D + d;
    const f32x4 a0 = *(const f32x4*)(x + e), a1 = *(const f32x4*)(x + e + 4);
    const f32x4 s0 = *(const f32x4*)sh, s1 = *(const f32x4*)(sh + 4), c0 = *(const f32x4*)sc, c1 = *(const f32x4*)(sc + 4);
    const f32x4 r0 = a0 * (c0 + 1.f) + s0, r1 = a1 * (c1 + 1.f) + s1;
    u32x4 o; o.x = cvt_pk_bf16(r0[0], r0[1]); o.y = cvt_pk_bf16(r0[2], r0[3]); o.z = cvt_pk_bf16(r1[0], r1[1]); o.w = cvt_pk_bf16(r1[2], r1[3]);
    *(u32x4*)(h + e) = o;
  }
}

enum { EPI_BF16 = 0, EPI_TANH, EPI_SIGMOID, EPI_LW, EPI_ASIG, EPI_Z, EPI_SCALE, EPI_TOPK };
struct GemmArgs {
  const bf16_t* A; int lda;
  const bf16_t* Bt; int ldb;
  int N, K;
  const float* mu;
  int epi; void* out; int ldc;
  const float* v0; const float* v1;
};

DI int lds_off(int row, int chunk) { return row * 128 + ((chunk ^ (row & 7)) << 4); }

DI void gemm_load_a(const GemmArgs& g, int m0, int k0, int tid, u32x4 (&ra)[4]) {
#pragma unroll
  for (int i = 0; i < 4; ++i) {
    const int row = (tid >> 3) + i * 32, ch = tid & 7;
    const int m = m0 + row;
    const bf16_t* src = g.A + (size_t)m * g.lda + k0 + ch * 8;
    u32x4 v = *(const u32x4*)src;
    if (g.mu) {
      u32x4 pv = {0u, 0u, 0u, 0u};
      if ((m % SEQ) != 0) pv = *(const u32x4*)(src - g.lda);
      const f32x4 m0v = *(const f32x4*)(g.mu + k0 + ch * 8), m1v = *(const f32x4*)(g.mu + k0 + ch * 8 + 4);
      const unsigned hu[4] = {v.x, v.y, v.z, v.w}, pu[4] = {pv.x, pv.y, pv.z, pv.w};
      float o[8];
#pragma unroll
      for (int j = 0; j < 4; ++j) {
        const float h0 = bf_lo(hu[j]), h1 = bf_hi(hu[j]), p0 = bf_lo(pu[j]), p1 = bf_hi(pu[j]);
        const float mu0 = (2 * j < 4) ? m0v[(2 * j) & 3] : m1v[(2 * j) & 3], mu1 = (2 * j + 1 < 4) ? m0v[(2 * j + 1) & 3] : m1v[(2 * j + 1) & 3];
        o[2 * j] = h0 + (p0 - h0) * mu0; o[2 * j + 1] = h1 + (p1 - h1) * mu1;
      }
      v.x = cvt_pk_bf16(o[0], o[1]); v.y = cvt_pk_bf16(o[2], o[3]); v.z = cvt_pk_bf16(o[4], o[5]); v.w = cvt_pk_bf16(o[6], o[7]);
    }
    ra[i] = v;
  }
}
DI void gemm_load_b(const GemmArgs& g, int n0, int k0, int tid, u32x4 (&rb)[4]) {
#pragma unroll
  for (int i = 0; i < 4; ++i) {
    const int row = (tid >> 3) + i * 32, ch = tid & 7;
    rb[i] = *(const u32x4*)(g.Bt + (size_t)(n0 + row) * g.ldb + k0 + ch * 8);
  }
}
DI void gemm_store_lds(unsigned char* buf, int tid, const u32x4 (&r)[4]) {
#pragma unroll
  for (int i = 0; i < 4; ++i) {
    const int row = (tid >> 3) + i * 32, ch = tid & 7;
    *(u32x4*)(buf + lds_off(row, ch)) = r[i];
  }
}

DI unsigned f2key(float f) { unsigned u = __float_as_uint(f); return u ^ ((u >> 31) ? 0xffffffffu : 0x80000000u); }
DI float key2f(unsigned k) { unsigned u = (k >> 31) ? (k ^ 0x80000000u) : ~k; return __uint_as_float(u); }
#define CE_DESC(a, b) { const unsigned _mx = max(a, b), _mn = min(a, b); a = _mx; b = _mn; }
DI void sort16_desc(unsigned (&x)[16]) {
#pragma unroll
  for (int k = 2; k <= 16; k <<= 1) {
#pragma unroll
    for (int j = k >> 1; j > 0; j >>= 1) {
#pragma unroll
      for (int i = 0; i < 16; ++i) {
        const int l = i ^ j;
        if (l > i) {
          if ((i & k) == 0) { CE_DESC(x[i], x[l]); } else { CE_DESC(x[l], x[i]); }
        }
      }
    }
  }
}
DI void merge16_desc(unsigned (&x)[16]) {
#pragma unroll
  for (int j = 8; j > 0; j >>= 1) {
#pragma unroll
    for (int i = 0; i < 16; ++i) { const int l = i ^ j; if (l > i) { CE_DESC(x[i], x[l]); } }
  }
}

DI void gemm_tile(const GemmArgs& g, int m0, int n0, unsigned char* lds) {
  constexpr int WM = 2, WN = 4 / WM, TM = 128 / WM, TN = 128 / WN, MI = TM / 16, NI = TN / 16;
  const int tid = opaque_v(threadIdx.x), lane = tid & 63, wid = tid >> 6;
  const int wm = wid / WN, wn = wid % WN;
  const int nk = g.K / 64;
  f32x4 acc[MI][NI];
#pragma unroll
  for (int i = 0; i < MI; ++i)
#pragma unroll
    for (int j = 0; j < NI; ++j) acc[i][j] = (f32x4){0.f, 0.f, 0.f, 0.f};
  u32x4 ra[4], rb[4];
  gemm_load_a(g, m0, 0, tid, ra); gemm_load_b(g, n0, 0, tid, rb);
  gemm_store_lds(lds, tid, ra); gemm_store_lds(lds + 16384, tid, rb);
  __syncthreads();
  const int fr = lane & 15, fq = lane >> 4;
  for (int kt = 0; kt < nk; ++kt) {
    unsigned char* cur = lds + (kt & 1) * 32768;
    if (kt + 1 < nk) { gemm_load_a(g, m0, (kt + 1) * 64, tid, ra); gemm_load_b(g, n0, (kt + 1) * 64, tid, rb); }
#pragma unroll
    for (int ks = 0; ks < 2; ++ks) {
      bf16x8 af[MI], bfr[NI];
#pragma unroll
      for (int i = 0; i < MI; ++i) af[i] = *(const bf16x8*)(cur + lds_off(wm * TM + i * 16 + fr, ks * 4 + fq));
#pragma unroll
      for (int j = 0; j < NI; ++j) bfr[j] = *(const bf16x8*)(cur + 16384 + lds_off(wn * TN + j * 16 + fr, ks * 4 + fq));
#pragma unroll
      for (int i = 0; i < MI; ++i)
#pragma unroll
        for (int j = 0; j < NI; ++j) acc[i][j] = __builtin_amdgcn_mfma_f32_16x16x32_bf16(bfr[j], af[i], acc[i][j], 0, 0, 0);
    }
    if (kt + 1 < nk) { unsigned char* nxt = lds + ((kt + 1) & 1) * 32768; gemm_store_lds(nxt, tid, ra); gemm_store_lds(nxt + 16384, tid, rb); }
    __syncthreads();
  }
#pragma unroll
  for (int i = 0; i < MI; ++i) {
    const int m = m0 + wm * TM + i * 16 + fr;
#pragma unroll
    for (int j = 0; j < NI; ++j) {
      const int n = n0 + wn * TN + j * 16 + fq * 4;
      if (n >= g.N) continue;
      const f32x4 v = acc[i][j];
      bf16_t* ob = (bf16_t*)g.out + (size_t)m * g.ldc + n;
      switch (g.epi) {
        case EPI_BF16: *(u32x2*)ob = (u32x2){cvt_pk_bf16(v[0], v[1]), cvt_pk_bf16(v[2], v[3])}; break;
        case EPI_TANH: *(u32x2*)ob = (u32x2){cvt_pk_bf16(tanhf(v[0]), tanhf(v[1])), cvt_pk_bf16(tanhf(v[2]), tanhf(v[3]))}; break;
        case EPI_SIGMOID: *(u32x2*)ob = (u32x2){cvt_pk_bf16(sigmoidf_(v[0]), sigmoidf_(v[1])), cvt_pk_bf16(sigmoidf_(v[2]), sigmoidf_(v[3]))}; break;
        case EPI_LW: {
          const f32x4 w0 = *(const f32x4*)(g.v0 + n); float o[4];
#pragma unroll
          for (int q = 0; q < 4; ++q) { const float xx = -(w0[q] + v[q]); const float sp = fmaxf(xx, 0.f) + log1pf(__expf(-fabsf(xx))); o[q] = -__expf(-sp - 0.5f); }
          *(u32x2*)ob = (u32x2){cvt_pk_bf16(o[0], o[1]), cvt_pk_bf16(o[2], o[3])};
        } break;
        case EPI_ASIG: {
          const f32x4 a0 = *(const f32x4*)(g.v0 + n);
          *(u32x2*)ob = (u32x2){cvt_pk_bf16(sigmoidf_(a0[0] + v[0]), sigmoidf_(a0[1] + v[1])), cvt_pk_bf16(sigmoidf_(a0[2] + v[2]), sigmoidf_(a0[3] + v[3]))};
        } break;
        case EPI_Z: {
          const int b = m / SEQ;
          const f32x4 xv = *(const f32x4*)(g.v0 + (size_t)m * D + n), gt = *(const f32x4*)(g.v1 + (size_t)b * 6144 + n);
          *(f32x4*)((float*)g.out + (size_t)m * g.ldc + n) = xv * ALPHA + gt * v;
        } break;
        default: {
          const f32x4 sc = *(const f32x4*)(g.v0 + n);
          *(u32x2*)ob = (u32x2){cvt_pk_bf16(v[0] * sc[0], v[1] * sc[1]), cvt_pk_bf16(v[2] * sc[2], v[3] * sc[3])};
        } break;
      }
    }
  }
}

DI void scores_topk_tile(const bf16_t* __restrict__ q, const bf16_t* __restrict__ keys, unsigned* __restrict__ lists, int m0, int grp, unsigned char* lds) {
  const int tid = opaque_v(threadIdx.x), lane = tid & 63, wm = tid >> 6, fr = lane & 15, fq = lane >> 4;
#pragma unroll
  for (int hk = 0; hk < 2; ++hk)
#pragma unroll
    for (int i = 0; i < 4; ++i) {
      const int row = (tid >> 3) + i * 32, ch = tid & 7;
      const u32x4 va = *(const u32x4*)(q + (size_t)(m0 + row) * 2048 + grp * 128 + hk * 64 + ch * 8);
      const u32x4 vb = *(const u32x4*)(keys + (size_t)grp * 128 * 128 + (size_t)row * 128 + hk * 64 + ch * 8);
      *(u32x4*)(lds + hk * 16384 + lds_off(row, ch)) = va;
      *(u32x4*)(lds + 32768 + hk * 16384 + lds_off(row, ch)) = vb;
    }
  __syncthreads();
  f32x4 acc[2][8];
#pragma unroll
  for (int i = 0; i < 2; ++i)
#pragma unroll
    for (int j = 0; j < 8; ++j) acc[i][j] = (f32x4){0.f, 0.f, 0.f, 0.f};
#pragma unroll
  for (int kk = 0; kk < 4; ++kk) {
    const int hk = kk >> 1, ks = kk & 1;
    bf16x8 af[2];
#pragma unroll
    for (int i = 0; i < 2; ++i) af[i] = *(const bf16x8*)(lds + hk * 16384 + lds_off(wm * 32 + i * 16 + fr, ks * 4 + fq));
#pragma unroll
    for (int j = 0; j < 8; ++j) {
      const bf16x8 bfr = *(const bf16x8*)(lds + 32768 + hk * 16384 + lds_off(j * 16 + fr, ks * 4 + fq));
#pragma unroll
      for (int i = 0; i < 2; ++i) acc[i][j] = __builtin_amdgcn_mfma_f32_16x16x32_bf16(bfr, af[i], acc[i][j], 0, 0, 0);
    }
  }
  __syncthreads();
  constexpr int MI = 2, NI = 8, TM = 32;
  {
#pragma unroll
    for (int i = 0; i < MI; ++i)
#pragma unroll
      for (int j = 0; j < NI; ++j) {
        const int ml = wm * TM + i * 16 + fr, c = j * 4 + fq;
        u32x4 kv;
        kv.x = (f2key(acc[i][j][0]) & ~127u) | (unsigned)(127 - (c * 4 + 0)); kv.y = (f2key(acc[i][j][1]) & ~127u) | (unsigned)(127 - (c * 4 + 1));
        kv.z = (f2key(acc[i][j][2]) & ~127u) | (unsigned)(127 - (c * 4 + 2)); kv.w = (f2key(acc[i][j][3]) & ~127u) | (unsigned)(127 - (c * 4 + 3));
        *(u32x4*)(lds + ml * 528 + (c << 4)) = kv;
      }
    __syncthreads();
    {
      const int ml = wm * 32 + (lane & 31), hf = lane >> 5;
      unsigned a[16], b[16];
#pragma unroll
      for (int ch = 0; ch < 4; ++ch) {
#pragma unroll
        for (int cc = 0; cc < 4; ++cc) {
          const int c = hf * 16 + ch * 4 + cc;
          const u32x4 kv = *(const u32x4*)(lds + ml * 528 + (c << 4));
          b[cc * 4] = kv.x; b[cc * 4 + 1] = kv.y; b[cc * 4 + 2] = kv.z; b[cc * 4 + 3] = kv.w;
        }
        sort16_desc(b);
        if (ch == 0) {
#pragma unroll
          for (int e = 0; e < 16; ++e) a[e] = b[e];
        } else {
#pragma unroll
          for (int e = 0; e < 16; ++e) a[e] = max(a[e], b[15 - e]);
          merge16_desc(a);
        }
      }
#pragma unroll
      for (int e = 0; e < 16; ++e) b[e] = (unsigned)__shfl_xor((int)a[e], 32);
#pragma unroll
      for (int e = 0; e < 16; ++e) a[e] = max(a[e], b[15 - e]);
      merge16_desc(a);
      if (hf == 0) {
        const int m = m0 + ml;
        u32x4* dst = (u32x4*)(lists + ((size_t)m * 16 + grp) * 16);
        dst[0] = (u32x4){a[0], a[1], a[2], a[3]}; dst[1] = (u32x4){a[4], a[5], a[6], a[7]};
        dst[2] = (u32x4){a[8], a[9], a[10], a[11]}; dst[3] = (u32x4){a[12], a[13], a[14], a[15]};
      }
    }
    __syncthreads();
  }
}

DI GemmArgs mk(const bf16_t* A, int lda, const bf16_t* Bt, int ldb, int N, int K, int epi, void* out, int ldc,
               const float* mu = nullptr, const float* v0 = nullptr, const float* v1 = nullptr) {
  GemmArgs g; g.A = A; g.lda = lda; g.Bt = Bt; g.ldb = ldb; g.N = N; g.K = K; g.mu = mu; g.epi = epi; g.out = out; g.ldc = ldc; g.v0 = v0; g.v1 = v1; return g;
}
DI void item_mn(int item, int ntn, int& mt, int& nt) { const int grp = item / (8 * ntn), w = item % (8 * ntn); mt = grp * 8 + (w & 7); nt = w >> 3; }

struct ScanArgs {
  const bf16_t *r, *k, *v, *lw, *a, *g;
  const float *k_k, *k_a, *r_k, *lnx_g, *lnx_b;
  bf16_t* yg;
};
DI void scan_seq_item(const ScanArgs& s, int item, unsigned char* lds) {
  constexpr int TC = 32;
  float (*sr)[64] = (float (*)[64])(lds), (*sw)[64] = (float (*)[64])(lds + 8192), (*sk)[64] = (float (*)[64])(lds + 16384), (*sv)[64] = (float (*)[64])(lds + 24576),
        (*sa)[64] = (float (*)[64])(lds + 32768), (*sb)[64] = (float (*)[64])(lds + 40960), (*sy)[64] = (float (*)[64])(lds + 49152);
  float* sbonus = (float*)(lds + 57344);
  const int tid = opaque_v(threadIdx.x), b = item / NH, h = item % NH;
  const int vrow = tid >> 2, kq = tid & 3;
  float S[16];
#pragma unroll
  for (int i = 0; i < 16; ++i) S[i] = 0.f;
  const size_t base = (size_t)b * SEQ * D + h * HS;
  for (int t0 = 0; t0 < SEQ; t0 += TC) {
    {
      const int tt = tid >> 3, c0 = (tid & 7) * 8;
      const size_t off = base + (size_t)(t0 + tt) * D + c0;
      const u32x4 vr = *(const u32x4*)(s.r + off), vk = *(const u32x4*)(s.k + off), vv = *(const u32x4*)(s.v + off), vw = *(const u32x4*)(s.lw + off), va = *(const u32x4*)(s.a + off);
      float fr_[8], fk[8], fv[8], fw[8], fa[8];
      const unsigned ur[4] = {vr.x, vr.y, vr.z, vr.w}, uk[4] = {vk.x, vk.y, vk.z, vk.w}, uv[4] = {vv.x, vv.y, vv.z, vv.w}, uw[4] = {vw.x, vw.y, vw.z, vw.w}, ua[4] = {va.x, va.y, va.z, va.w};
#pragma unroll
      for (int j = 0; j < 4; ++j) {
        fr_[2 * j] = bf_lo(ur[j]); fr_[2 * j + 1] = bf_hi(ur[j]); fk[2 * j] = bf_lo(uk[j]); fk[2 * j + 1] = bf_hi(uk[j]);
        fv[2 * j] = bf_lo(uv[j]); fv[2 * j + 1] = bf_hi(uv[j]); fw[2 * j] = bf_lo(uw[j]); fw[2 * j + 1] = bf_hi(uw[j]);
        fa[2 * j] = bf_lo(ua[j]); fa[2 * j + 1] = bf_hi(ua[j]);
      }
      float kkr[8], nrm = 0.f, bon = 0.f, kp[8];
#pragma unroll
      for (int j = 0; j < 8; ++j) {
        const int ch = h * HS + c0 + j;
        kkr[j] = fk[j] * s.k_k[ch]; nrm += kkr[j] * kkr[j];
        kp[j] = fk[j] * (1.f + (fa[j] - 1.f) * s.k_a[ch]);
        bon += fr_[j] * kp[j] * s.r_k[ch];
      }
      nrm += __shfl_xor(nrm, 1); nrm += __shfl_xor(nrm, 2); nrm += __shfl_xor(nrm, 4);
      bon += __shfl_xor(bon, 1); bon += __shfl_xor(bon, 2); bon += __shfl_xor(bon, 4);
      const float inv = rsqrtf(fmaxf(nrm, 1e-24f));
#pragma unroll
      for (int j = 0; j < 8; ++j) {
        const float kk = kkr[j] * inv;
        sr[tt][c0 + j] = fr_[j]; sw[tt][c0 + j] = __expf(fw[j]); sk[tt][c0 + j] = kp[j]; sv[tt][c0 + j] = fv[j];
        sa[tt][c0 + j] = -kk; sb[tt][c0 + j] = kk * fa[j];
      }
      if ((tid & 7) == 0) sbonus[tt] = bon;
    }
    __syncthreads();
    for (int tt = 0; tt < TC; ++tt) {
      float av[16], bv[16], wv[16], kv[16], rv[16];
#pragma unroll
      for (int q = 0; q < 4; ++q) {
        const f32x4 a4 = *(const f32x4*)&sa[tt][kq * 16 + q * 4], b4 = *(const f32x4*)&sb[tt][kq * 16 + q * 4], w4 = *(const f32x4*)&sw[tt][kq * 16 + q * 4],
                    k4 = *(const f32x4*)&sk[tt][kq * 16 + q * 4], r4 = *(const f32x4*)&sr[tt][kq * 16 + q * 4];
#pragma unroll
        for (int j = 0; j < 4; ++j) { av[q * 4 + j] = a4[j]; bv[q * 4 + j] = b4[j]; wv[q * 4 + j] = w4[j]; kv[q * 4 + j] = k4[j]; rv[q * 4 + j] = r4[j]; }
      }
      const float vt = sv[tt][vrow];
      float sap = 0.f;
#pragma unroll
      for (int i = 0; i < 16; ++i) sap += S[i] * av[i];
      sap += __shfl_xor(sap, 1); sap += __shfl_xor(sap, 2);
      float yp = 0.f;
#pragma unroll
      for (int i = 0; i < 16; ++i) { S[i] = S[i] * wv[i] + sap * bv[i] + vt * kv[i]; yp += S[i] * rv[i]; }
      yp += __shfl_xor(yp, 1); yp += __shfl_xor(yp, 2);
      if (kq == 0) sy[tt][vrow] = yp;
    }
    __syncthreads();
    {
      const int tt = tid >> 3, c0 = (tid & 7) * 8;
      float yv[8], sum = 0.f;
#pragma unroll
      for (int j = 0; j < 8; ++j) { yv[j] = sy[tt][c0 + j]; sum += yv[j]; }
      sum += __shfl_xor(sum, 1); sum += __shfl_xor(sum, 2); sum += __shfl_xor(sum, 4);
      const float mean = sum * (1.f / 64.f);
      float var = 0.f;
#pragma unroll
      for (int j = 0; j < 8; ++j) { const float d = yv[j] - mean; var += d * d; }
      var += __shfl_xor(var, 1); var += __shfl_xor(var, 2); var += __shfl_xor(var, 4);
      const float rstd = rsqrtf(var * (1.f / 64.f) + GN_EPS);
      const float bon = sbonus[tt];
      const size_t off = base + (size_t)(t0 + tt) * D + c0;
      const u32x4 vg = *(const u32x4*)(s.g + off);
      const unsigned ug[4] = {vg.x, vg.y, vg.z, vg.w};
      float o[8];
#pragma unroll
      for (int j = 0; j < 8; ++j) {
        const int ch = h * HS + c0 + j;
        const float gq = (j & 1) ? bf_hi(ug[j >> 1]) : bf_lo(ug[j >> 1]);
        o[j] = ((yv[j] - mean) * rstd * s.lnx_g[ch] + s.lnx_b[ch] + bon * sv[tt][c0 + j]) * gq;
      }
      *(u32x4*)(s.yg + off) = (u32x4){cvt_pk_bf16(o[0], o[1]), cvt_pk_bf16(o[2], o[3]), cvt_pk_bf16(o[4], o[5]), cvt_pk_bf16(o[6], o[7])};
    }
    __syncthreads();
  }
}

DI void ln_phase(const float* __restrict__ z, const float* __restrict__ lg, const float* __restrict__ lb, float* __restrict__ xo,
                 const float* __restrict__ mod_l, int shift_idx, int scale_idx, bf16_t* __restrict__ ho, int bid, int nblk) {
  const int tq = opaque_v(threadIdx.x); const int lane = tq & 63, wv = tq >> 6;
  for (int row = bid * 4 + wv; row < T; row += nblk * 4) {
    const float* zr = z + (size_t)row * D;
    f32x4 v[4]; float s = 0.f;
#pragma unroll
    for (int i = 0; i < 4; ++i) { v[i] = *(const f32x4*)(zr + i * 256 + lane * 4); s += (v[i][0] + v[i][1]) + (v[i][2] + v[i][3]); }
    const float mean = wave_sum(s) * (1.f / D);
    float q = 0.f;
#pragma unroll
    for (int i = 0; i < 4; ++i) { const f32x4 d = v[i] - mean; q += (d[0] * d[0] + d[1] * d[1]) + (d[2] * d[2] + d[3] * d[3]); }
    const float rstd = rsqrtf(wave_sum(q) * (1.f / D) + LN_EPS);
    const int b = row / SEQ;
#pragma unroll
    for (int i = 0; i < 4; ++i) {
      const int d = i * 256 + lane * 4;
      const f32x4 o = (v[i] - mean) * rstd * *(const f32x4*)(lg + d) + *(const f32x4*)(lb + d);
      *(f32x4*)(xo + (size_t)row * D + d) = o;
      const f32x4 sh = *(const f32x4*)(mod_l + (size_t)b * 6144 + shift_idx * D + d), sc = *(const f32x4*)(mod_l + (size_t)b * 6144 + scale_idx * D + d);
      const f32x4 hh = o * (sc + 1.f) + sh;
      *(u32x2*)(ho + (size_t)row * D + d) = (u32x2){cvt_pk_bf16(hh[0], hh[1]), cvt_pk_bf16(hh[2], hh[3])};
    }
  }
}

DI void combine_phase(const unsigned* __restrict__ lists, int* __restrict__ eidx, float* __restrict__ gate, int bid, int nblk) {
  const int tq = opaque_v(threadIdx.x);
  for (int gid = bid * 256 + tq; gid < T * 8; gid += nblk * 256) {
    const unsigned* la = lists + (size_t)gid * 32;
    const unsigned* lb = la + 16;
    float s1[16], s2[16];
#pragma unroll
    for (int i = 0; i < 4; ++i) {
      const u32x4 a = *(const u32x4*)(la + i * 4), b = *(const u32x4*)(lb + i * 4);
      s1[i * 4] = key2f(a.x & ~127u); s1[i * 4 + 1] = key2f(a.y & ~127u); s1[i * 4 + 2] = key2f(a.z & ~127u); s1[i * 4 + 3] = key2f(a.w & ~127u);
      s2[i * 4] = key2f(b.x & ~127u); s2[i * 4 + 1] = key2f(b.y & ~127u); s2[i * 4 + 2] = key2f(b.z & ~127u); s2[i * 4 + 3] = key2f(b.w & ~127u);
    }
    unsigned c[4][16];
    {
      int n = 0;
#pragma unroll
      for (int a = 0; a < 16; ++a)
#pragma unroll
        for (int b = 0; b < 16; ++b)
          if ((a + 1) * (b + 1) <= 16) { c[n >> 4][n & 15] = (f2key(s1[a] + s2[b]) & ~255u) | (unsigned)(255 - (a * 16 + b)); ++n; }
#pragma unroll
      for (int q = 50; q < 64; ++q) c[q >> 4][q & 15] = 0u;
    }
    sort16_desc(c[0]); sort16_desc(c[1]); sort16_desc(c[2]); sort16_desc(c[3]);
#pragma unroll
    for (int e = 0; e < 16; ++e) { c[0][e] = max(c[0][e], c[1][15 - e]); c[2][e] = max(c[2][e], c[3][15 - e]); }
    merge16_desc(c[0]); merge16_desc(c[2]);
#pragma unroll
    for (int e = 0; e < 16; ++e) c[0][e] = max(c[0][e], c[2][15 - e]);
    merge16_desc(c[0]);
    float best[16], den = 0.f;
    const float mx = key2f(c[0][0] & ~255u);
#pragma unroll
    for (int e = 0; e < 16; ++e) { best[e] = __expf(key2f(c[0][e] & ~255u) - mx); den += best[e]; }
    const float inv = 1.f / den;
#pragma unroll
    for (int e = 0; e < 16; ++e) {
      const int pos = 255 - (int)(c[0][e] & 255u), a = pos >> 4, b = pos & 15;
      const int i1 = 127 - (int)(la[a] & 127u), i2 = 127 - (int)(lb[b] & 127u);
      eidx[(size_t)gid * 16 + e] = i1 * 128 + i2;
      gate[(size_t)gid * 16 + e] = best[e] * inv;
    }
  }
}

struct PeerArgs {
  const bf16_t* h2;
  const bf16_t *ub, *vb;
  const int* eidx; const float* gate;
  const float* xres;
  const float* gate2;
  const float *lg, *lb;
  float* xo;
  const float* mod_next; bf16_t* ho;
};
DI void peer_gather_phase(const PeerArgs& a, int bid, int nblk) {
  const int tq = opaque_v(threadIdx.x); const int lane = tq & 63, wv = tq >> 6;
  for (int t = bid * 4 + wv; t < T; t += nblk * 4) {
    const u32x4 h0 = *(const u32x4*)(a.h2 + (size_t)t * D + lane * 8), h1 = *(const u32x4*)(a.h2 + (size_t)t * D + 512 + lane * 8);
    float hf[16];
    { const unsigned u[8] = {h0.x, h0.y, h0.z, h0.w, h1.x, h1.y, h1.z, h1.w};
#pragma unroll
      for (int j = 0; j < 8; ++j) { hf[2 * j] = bf_lo(u[j]); hf[2 * j + 1] = bf_hi(u[j]); } }
    const int e0 = a.eidx[(size_t)t * 128 + lane], e1 = a.eidx[(size_t)t * 128 + 64 + lane];
    const float g0 = a.gate[(size_t)t * 128 + lane], g1 = a.gate[(size_t)t * 128 + 64 + lane];
    float c0 = 0.f, c1 = 0.f;
#pragma unroll 1
    for (int half = 0; half < 2; ++half) {
      const int ev = half ? e1 : e0;
      float cacc = 0.f;
#pragma unroll 1
      for (int j0 = 0; j0 < 64; j0 += 4) {
        u32x4 r0[4], r1[4];
#pragma unroll
        for (int jj = 0; jj < 4; ++jj) {
          const int e = __shfl(ev, j0 + jj);
          const bf16_t* row = a.ub + (size_t)e * D;
          r0[jj] = *(const u32x4*)(row + lane * 8); r1[jj] = *(const u32x4*)(row + 512 + lane * 8);
        }
#pragma unroll
        for (int jj = 0; jj < 4; ++jj) {
          const unsigned u[8] = {r0[jj].x, r0[jj].y, r0[jj].z, r0[jj].w, r1[jj].x, r1[jj].y, r1[jj].z, r1[jj].w};
          float d = 0.f;
#pragma unroll
          for (int q = 0; q < 8; ++q) d += bf_lo(u[q]) * hf[2 * q] + bf_hi(u[q]) * hf[2 * q + 1];
          d = wave_sum(d);
          if (lane == j0 + jj) cacc = d;
        }
      }
      const float act = gelu_exact(cacc);
      if (half) c1 = g1 * act; else c0 = g0 * act;
    }
    float o[16];
#pragma unroll
    for (int i = 0; i < 16; ++i) o[i] = 0.f;
#pragma unroll 1
    for (int half = 0; half < 2; ++half) {
      const int ev = half ? e1 : e0; const float cv = half ? c1 : c0;
#pragma unroll 1
      for (int j0 = 0; j0 < 64; j0 += 4) {
        u32x4 r0[4], r1[4]; float cf[4];
#pragma unroll
        for (int jj = 0; jj < 4; ++jj) {
          const int e = __shfl(ev, j0 + jj); cf[jj] = __shfl(cv, j0 + jj);
          const bf16_t* row = a.vb + (size_t)e * D;
          r0[jj] = *(const u32x4*)(row + lane * 8); r1[jj] = *(const u32x4*)(row + 512 + lane * 8);
        }
#pragma unroll
        for (int jj = 0; jj < 4; ++jj) {
          const unsigned u[8] = {r0[jj].x, r0[jj].y, r0[jj].z, r0[jj].w, r1[jj].x, r1[jj].y, r1[jj].z, r1[jj].w};
#pragma unroll
          for (int q = 0; q < 8; ++q) { o[2 * q] += cf[jj] * bf_lo(u[q]); o[2 * q + 1] += cf[jj] * bf_hi(u[q]); }
        }
      }
    }
    const int b = t / SEQ;
    float zv[16], s = 0.f;
#pragma unroll
    for (int hh = 0; hh < 2; ++hh) {
      const int d0 = hh * 512 + lane * 8;
      const f32x4 x0 = *(const f32x4*)(a.xres + (size_t)t * D + d0), x1 = *(const f32x4*)(a.xres + (size_t)t * D + d0 + 4);
      const f32x4 q0 = *(const f32x4*)(a.gate2 + (size_t)b * 6144 + d0), q1 = *(const f32x4*)(a.gate2 + (size_t)b * 6144 + d0 + 4);
#pragma unroll
      for (int j = 0; j < 4; ++j) { zv[hh * 8 + j] = ALPHA * x0[j] + q0[j] * o[hh * 8 + j]; zv[hh * 8 + 4 + j] = ALPHA * x1[j] + q1[j] * o[hh * 8 + 4 + j]; }
    }
#pragma unroll
    for (int j = 0; j < 16; ++j) s += zv[j];
    const float mean = wave_sum(s) * (1.f / D);
    float q = 0.f;
#pragma unroll
    for (int j = 0; j < 16; ++j) { const float d = zv[j] - mean; q += d * d; }
    const float rstd = rsqrtf(wave_sum(q) * (1.f / D) + LN_EPS);
#pragma unroll
    for (int hh = 0; hh < 2; ++hh) {
      const int d0 = hh * 512 + lane * 8;
      float r[8];
#pragma unroll
      for (int j = 0; j < 8; ++j) r[j] = (zv[hh * 8 + j] - mean) * rstd * a.lg[d0 + j] + a.lb[d0 + j];
      *(f32x4*)(a.xo + (size_t)t * D + d0) = (f32x4){r[0], r[1], r[2], r[3]};
      *(f32x4*)(a.xo + (size_t)t * D + d0 + 4) = (f32x4){r[4], r[5], r[6], r[7]};
      if (a.ho) {
        float hq[8];
#pragma unroll
        for (int j = 0; j < 8; ++j) hq[j] = r[j] * (1.f + a.mod_next[(size_t)b * 6144 + 1 * D + d0 + j]) + a.mod_next[(size_t)b * 6144 + 0 * D + d0 + j];
        *(u32x4*)(a.ho + (size_t)t * D + d0) = (u32x4){cvt_pk_bf16(hq[0], hq[1]), cvt_pk_bf16(hq[2], hq[3]), cvt_pk_bf16(hq[4], hq[5]), cvt_pk_bf16(hq[6], hq[7])};
      }
    }
  }
}

DI void pool_phase(const bf16_t* __restrict__ zin, bf16_t* __restrict__ pout, int bid, int nblk) {
  const size_t n8 = (size_t)T * D / 8; const int tq = opaque_v(threadIdx.x);
  for (size_t i = (size_t)bid * 256 + tq; i < n8; i += (size_t)nblk * 256) {
    const size_t e = i * 8; const int t = (int)(e / D), d = (int)(e % D), tp = t % SEQ;
    const int win = 2 << (d / 256);
    const int cnt = min(tp + 1, win);
    float s[8], z0[8];
#pragma unroll
    for (int j = 0; j < 8; ++j) { s[j] = 0.f; z0[j] = 0.f; }
    for (int w = 0; w < cnt; ++w) {
      const u32x4 v = *(const u32x4*)(zin + e - (size_t)w * D);
      const unsigned u[4] = {v.x, v.y, v.z, v.w};
#pragma unroll
      for (int j = 0; j < 4; ++j) { const float lo = bf_lo(u[j]), hi = bf_hi(u[j]); s[2 * j] += lo; s[2 * j + 1] += hi; if (w == 0) { z0[2 * j] = lo; z0[2 * j + 1] = hi; } }
    }
    const float ic = 1.f / (float)cnt;
    float o[8];
#pragma unroll
    for (int j = 0; j < 8; ++j) o[j] = s[j] * ic - z0[j];
    *(u32x4*)(pout + e) = (u32x4){cvt_pk_bf16(o[0], o[1]), cvt_pk_bf16(o[2], o[3]), cvt_pk_bf16(o[4], o[5]), cvt_pk_bf16(o[6], o[7])};
  }
}

struct PeerLayer {
  const bf16_t* h2; const bf16_t* WqT; const bf16_t* Keys; bf16_t* q; unsigned* lists; int* eidx; float* gate;
  PeerArgs ga;
};

#define GRID_SYNC() xcd_barrier(xb)

__global__ void __launch_bounds__(256, 2) mega(Params p) {
  __shared__ __attribute__((aligned(16))) unsigned char lds[LDS_BYTES + 16];
  cg::grid_group grid = cg::this_grid();
  const int bid = blockIdx.x, nblk = gridDim.x;
  if (threadIdx.x == 0) { *(volatile LAS unsigned*)(lds + LDS_BYTES) = 0u; *(volatile LAS unsigned*)(lds + LDS_BYTES + 4) = 0u; }
  __syncthreads();
  const XcdBarrier xb = xcd_barrier_post(p.bar, (volatile LAS unsigned*)(lds + LDS_BYTES));
  const float* mod0 = p.mod; const float* mod1 = p.mod + (size_t)NB * 6144;
  bf16_t* S[7];
#pragma unroll
  for (int i = 0; i < 7; ++i) S[i] = (bf16_t*)p.slot[i];

  prologue_phase(p, lds, bid, nblk);
  grid.sync();
  bf16_t *h = S[0], *r = S[1], *k = S[2], *v = S[3], *lw = S[4], *av = S[5], *gv = S[6];
  bf16_t* tw = (bf16_t*)p.out; bf16_t* ta = tw + (size_t)T * 64; bf16_t* tg = ta + (size_t)T * 64;
  modulate_phase(p.x, mod0, 0, 1, h, bid, nblk);
  GRID_SYNC();
  for (int it = bid; it < 256 * 28; it += nblk) {
    int mt, nt; item_mn(it, 28, mt, nt);
    GemmArgs g; int n0;
    if (nt < 24) { const int j = nt >> 3; n0 = (nt & 7) * 128; g = mk(h, D, p.WT_rkv + (size_t)j * D * D, D, D, D, EPI_BF16, j == 0 ? r : (j == 1 ? k : v), D, p.rw_mu + j * D); }
    else if (nt == 24) { n0 = 0; g = mk(h, D, p.W1T, D, 64, D, EPI_TANH, tw, 64, p.rw_mu + 3 * D); }
    else if (nt == 25) { n0 = 0; g = mk(h, D, p.A1T, D, 64, D, EPI_BF16, ta, 64, p.rw_mu + 4 * D); }
    else { n0 = (nt - 26) * 128; g = mk(h, D, p.G1T, D, 192, D, EPI_SIGMOID, tg, 192, p.rw_mu + 5 * D); }
    gemm_tile(g, mt * 128, n0, lds);
  }
  GRID_SYNC();
  for (int it = bid; it < 256 * 24; it += nblk) {
    int mt, nt; item_mn(it, 24, mt, nt);
    const int j = nt >> 3, n0 = (nt & 7) * 128;
    GemmArgs g;
    if (j == 0) g = mk(tw, 64, p.W2T, 64, D, 64, EPI_LW, lw, D, nullptr, p.rw_w0);
    else if (j == 1) g = mk(ta, 64, p.A2T, 64, D, 64, EPI_ASIG, av, D, nullptr, p.rw_a0);
    else g = mk(tg, 192, p.G2T, 192, D, 192, EPI_BF16, gv, D);
    gemm_tile(g, mt * 128, n0, lds);
  }
  GRID_SYNC();
  {
    ScanArgs s; s.r = r; s.k = k; s.v = v; s.lw = lw; s.a = av; s.g = gv; s.k_k = p.rw_k_k; s.k_a = p.rw_k_a; s.r_k = p.rw_r_k; s.lnx_g = p.rw_lnx_g; s.lnx_b = p.rw_lnx_b; s.yg = h;
    for (int it = bid; it < NB * NH; it += nblk) scan_seq_item(s, it, lds);
  }
  GRID_SYNC();
  float* z = (float*)p.slot[1];
  bf16_t* ub = S[6]; bf16_t* vb = S[6] + (size_t)NEXP * D;
  for (int it = bid; it < 256 * 8; it += nblk) {
    int mt, nt; item_mn(it, 8, mt, nt);
    gemm_tile(mk(h, D, p.WoT, D, D, D, EPI_Z, z, D, nullptr, p.x, mod0 + 2 * D), mt * 128, nt * 128, lds);
  }
  cvt_range(p.pe_u, ub, (size_t)NEXP * D / 8, bid, nblk);
  cvt_range(p.pe_v, vb, (size_t)NEXP * D / 8, bid, nblk);
  GRID_SYNC();
  float* x1 = (float*)p.slot[3]; bf16_t* h2 = S[5];
  ln_phase(z, p.ln_g + 0 * D, p.ln_b + 0 * D, x1, mod0, 3, 4, h2, bid, nblk);
  GRID_SYNC();

#pragma unroll
  for (int layer = 0; layer < 2; ++layer) {
    const bf16_t* hp = layer == 0 ? h2 : S[0];
    bf16_t* q = layer == 0 ? (bf16_t*)p.slot[1] : (bf16_t*)p.slot[4];
    unsigned char* ls = layer == 0 ? p.slot[0] : p.slot[3];
    unsigned* lists = (unsigned*)ls; int* eidx = (int*)(ls + ((size_t)32 << 20)); float* gate = (float*)(ls + ((size_t)48 << 20));
    const bf16_t* WqT = p.WqT + (size_t)layer * 2048 * D; const bf16_t* Keys = p.KeysB + (size_t)layer * 16 * 128 * 128;
    for (int it = bid; it < 256 * 16; it += nblk) {
      int mt, nt; item_mn(it, 16, mt, nt);
      gemm_tile(mk(hp, D, WqT, D, 2048, D, EPI_BF16, q, 2048), mt * 128, nt * 128, lds);
    }
    GRID_SYNC();
    for (int it = bid; it < 256 * 16; it += nblk) {
      int mt, grp; item_mn(it, 16, mt, grp);
      scores_topk_tile(q, Keys, lists, mt * 128, grp, lds);
    }
    GRID_SYNC();
    combine_phase(lists, eidx, gate, bid, nblk);
    GRID_SYNC();
    {
      PeerArgs a; a.h2 = hp; a.ub = ub; a.vb = vb; a.eidx = eidx; a.gate = gate;
      if (layer == 0) { a.xres = x1; a.gate2 = mod0 + 5 * D; a.lg = p.ln_g + 1 * D; a.lb = p.ln_b + 1 * D; a.xo = (float*)p.slot[1]; a.mod_next = mod1; a.ho = h2; }
      else { a.xres = (float*)p.slot[1]; a.gate2 = mod1 + 5 * D; a.lg = p.ln_g + 3 * D; a.lb = p.ln_b + 3 * D; a.xo = p.out; a.mod_next = nullptr; a.ho = nullptr; }
      peer_gather_phase(a, bid, nblk);
    }
    if (layer == 1) break;
    GRID_SYNC();
    float* x2 = (float*)p.slot[1];
    bf16_t* hB = h2;
    bf16_t *zin = S[3], *pp = S[4], *yp = S[3];
    for (int it = bid; it < 256 * 8; it += nblk) {
      int mt, nt; item_mn(it, 8, mt, nt);
      gemm_tile(mk(hB, D, p.PinT, D, D, D, EPI_BF16, zin, D), mt * 128, nt * 128, lds);
    }
    cvt_range(p.pe_u + (size_t)NEXP * D, ub, (size_t)NEXP * D / 8, bid, nblk);
    cvt_range(p.pe_v + (size_t)NEXP * D, vb, (size_t)NEXP * D / 8, bid, nblk);
    GRID_SYNC();
    pool_phase(zin, pp, bid, nblk);
    GRID_SYNC();
    for (int it = bid; it < 256 * 8; it += nblk) {
      int mt, nt; item_mn(it, 8, mt, nt);
      const int gi = nt >> 1, n0 = (nt & 1) * 128;
      gemm_tile(mk(pp + gi * 256, D, p.WgrpT + (size_t)gi * 256 * 256, 256, 256, 256, EPI_SCALE, yp + gi * 256, D, nullptr, p.pl_scale + gi * 256), mt * 128, n0, lds);
    }
    GRID_SYNC();
    float* z1 = (float*)p.slot[4];
    for (int it = bid; it < 256 * 8; it += nblk) {
      int mt, nt; item_mn(it, 8, mt, nt);
      gemm_tile(mk(yp, D, p.PoutT, D, D, D, EPI_Z, z1, D, nullptr, x2, mod1 + 2 * D), mt * 128, nt * 128, lds);
    }
    GRID_SYNC();
    ln_phase(z1, p.ln_g + 2 * D, p.ln_b + 2 * D, (float*)p.slot[1], mod1, 3, 4, S[0], bid, nblk);
    GRID_SYNC();
  }
}

extern "C" void kernel_launch(void* const* d_in, const int* in_sizes, int n_in, void* d_out, int out_size, void* d_ws, size_t ws_size, hipStream_t stream) {
  Params p{};
  const float** ip = (const float**)&p.x;
  for (int i = 0; i < 30; ++i) ip[i] = (const float*)d_in[i];
  p.out = (float*)d_out;
  unsigned char* w = (unsigned char*)d_ws; size_t off = 0;
  auto take = [&](size_t bytes) { unsigned char* r = w + off; off += (bytes + 255) & ~(size_t)255; return r; };
  p.bar = (unsigned*)take(16384);
  p.mod = (float*)take((size_t)2 * NB * 6144 * 4);
  p.WT_rkv = (bf16_t*)take((size_t)3 * D * D * 2);
  p.W1T = (bf16_t*)take((size_t)128 * D * 2); p.A1T = (bf16_t*)take((size_t)128 * D * 2); p.G1T = (bf16_t*)take((size_t)256 * D * 2);
  p.W2T = (bf16_t*)take((size_t)D * 64 * 2); p.A2T = (bf16_t*)take((size_t)D * 64 * 2); p.G2T = (bf16_t*)take((size_t)D * 192 * 2);
  p.WoT = (bf16_t*)take((size_t)D * D * 2); p.PinT = (bf16_t*)take((size_t)D * D * 2); p.PoutT = (bf16_t*)take((size_t)D * D * 2);
  p.WgrpT = (bf16_t*)take((size_t)4 * 256 * 256 * 2); p.WqT = (bf16_t*)take((size_t)2 * 2048 * D * 2); p.KeysB = (bf16_t*)take((size_t)2 * 16 * 128 * 128 * 2);
  for (int i = 0; i < 7; ++i) p.slot[i] = take((size_t)64 << 20);
  if (off > ws_size) return;

  static int grid_blocks = 0;
  if (!grid_blocks) {
    int dev = 0, cus = 0, per_cu = 0;
    hipGetDevice(&dev);
    hipDeviceGetAttribute(&cus, hipDeviceAttributeMultiprocessorCount, dev);
    hipOccupancyMaxActiveBlocksPerMultiprocessor(&per_cu, mega, 256, 0);
    if (per_cu > 2) per_cu = 2;
    if (per_cu < 1) per_cu = 1;
    grid_blocks = cus * per_cu;
  }
  hipMemsetAsync(p.bar, 0, 16384, stream);
  void* args[] = {&p};
  hipLaunchCooperativeKernel((void*)mega, dim3(grid_blocks), dim3(256), args, 0, stream);
}
```

```cpp
#include <hip/hip_runtime.h>
#include <hip/hip_cooperative_groups.h>
#include <stdint.h>
#include <stddef.h>
namespace cg = cooperative_groups;

typedef unsigned short bf16_t;
typedef short bf16x8 __attribute__((ext_vector_type(8)));
typedef float f32x4 __attribute__((ext_vector_type(4)));
typedef float f32x2 __attribute__((ext_vector_type(2)));
typedef unsigned u32x4 __attribute__((ext_vector_type(4)));
typedef unsigned u32x2 __attribute__((ext_vector_type(2)));
#define DI __device__ __forceinline__

constexpr int D = 1024, NB = 8, SEQ = 4096, T = NB * SEQ;
constexpr int NH = 16, HS = 64;
constexpr int NEXP = 16384;
constexpr float ALPHA = 1.4142135623730951f;
constexpr float LN_EPS = 1e-5f, GN_EPS = 64e-5f;
constexpr int LDS_BYTES = 128 * 528;

DI unsigned cvt_pk_bf16(float lo, float hi) { unsigned r; asm volatile("v_cvt_pk_bf16_f32 %0, %1, %2" : "=v"(r) : "v"(lo), "v"(hi)); return r; }
DI float bf_lo(unsigned u) { return __uint_as_float(u << 16); }
DI float bf_hi(unsigned u) { return __uint_as_float(u & 0xffff0000u); }
DI bf16_t f2bf(float f) { unsigned u = __float_as_uint(f); u += 0x7fffu + ((u >> 16) & 1u); return (bf16_t)(u >> 16); }
DI float sigmoidf_(float x) { return 1.f / (1.f + __expf(-x)); }
DI float wave_sum(float v) {
#pragma unroll
  for (int o = 32; o >= 1; o >>= 1) v += __shfl_xor(v, o);
  return v;
}
DI int opaque_v(int x) { asm volatile("" : "+v"(x)); return x; }
DI float gelu_exact(float v) { return 0.5f * v * (1.f + erff(v * 0.70710678118654752f)); }

#define XB_TMO      128
#define XB_XCNT(j)  (256  + 64 * (j))
#define XB_XSUB(j)  (1280 + 64 * (j))
#define XB_XGEN(j)  (2304 + 64 * (j))
#define XB_TOP      3328
#define XB_TOPGEN   3392
#define XCD_BAR_WORDS 3456
#define XB_SPIN_CAP (1u << 22)
#define LAS __attribute__((address_space(3)))
DI unsigned xb_ld(unsigned* p)              { return __hip_atomic_load(p, __ATOMIC_RELAXED, __HIP_MEMORY_SCOPE_AGENT); }
DI unsigned xb_add(unsigned* p, unsigned v) { return __hip_atomic_fetch_add(p, v, __ATOMIC_RELAXED, __HIP_MEMORY_SCOPE_AGENT); }
DI unsigned xb_xcc_id() { return (unsigned)__builtin_amdgcn_s_getreg((3 << 11) | 20) & 0xFu; }
#define XB_SPIN(cond, bar) do { unsigned _sp = 0; while (cond) { __builtin_amdgcn_s_sleep(1); \
    if ((++_sp & 255u) == 0u) { if (xb_ld(&(bar)[XB_TMO])) break; if (_sp > XB_SPIN_CAP) { atomicAdd(&(bar)[XB_TMO], 1u); break; } } } } while (0)
struct XcdBarrier { unsigned* bar; unsigned x; volatile LAS unsigned* st; };
DI XcdBarrier xcd_barrier_post(unsigned* bar, volatile LAS unsigned* st) {
  XcdBarrier b; b.bar = bar; b.x = xb_xcc_id(); b.st = st;
  if (threadIdx.x == 0) (void)xb_add(&bar[XB_XCNT(b.x)], 1u);
  return b;
}
DI void xcd_barrier_complete(unsigned* bar, unsigned x, unsigned& nloc, unsigned& nx) {
  const unsigned G = gridDim.x * gridDim.y * gridDim.z;
  unsigned sum, cnt, mine, sp = 0u;
  for (;;) {
    sum = 0u; cnt = 0u; mine = 0u;
#pragma unroll
    for (unsigned j = 0; j < 16; ++j) { const unsigned c = xb_ld(&bar[XB_XCNT(j)]); sum += c; cnt += (c > 0u) ? 1u : 0u; mine = (j == x) ? c : mine; }
    if (sum == G) break;
    __builtin_amdgcn_s_sleep(1);
    if ((++sp & 255u) == 0u) { if (xb_ld(&bar[XB_TMO])) break; if (sp > XB_SPIN_CAP) { atomicAdd(&bar[XB_TMO], 1u); break; } }
  }
  nloc = mine > 0u ? mine : 1u; nx = cnt > 0u ? cnt : 1u;
}
DI void xcd_barrier(const XcdBarrier& b) {
  asm volatile("s_waitcnt vmcnt(0)" ::: "memory");
  __syncthreads();
  if (threadIdx.x == 0) {
    unsigned* bar = b.bar;
    __builtin_amdgcn_s_waitcnt(0);
    unsigned nloc = b.st[0], nx = b.st[1];
    if (nloc == 0u) { xcd_barrier_complete(bar, b.x, nloc, nx); b.st[0] = nloc; b.st[1] = nx; }
    const unsigned old = xb_add(&bar[XB_XSUB(b.x)], 1u);
    const unsigned gen = old / nloc;
    if (old + 1u == (gen + 1u) * nloc) {
      __builtin_amdgcn_fence(__ATOMIC_RELEASE, "agent");
      asm volatile("s_waitcnt vmcnt(0)" ::: "memory");
      const unsigned og = xb_add(&bar[XB_TOP], 1u);
      const unsigned tg = og / nx;
      if (og + 1u == (tg + 1u) * nx) xb_add(&bar[XB_TOPGEN], 1u);
      else XB_SPIN(xb_ld(&bar[XB_TOPGEN]) == tg, bar);
      __builtin_amdgcn_fence(__ATOMIC_ACQUIRE, "agent");
      xb_add(&bar[XB_XGEN(b.x)], 1u);
      asm volatile("s_waitcnt vmcnt(0)" ::: "memory");
    } else {
      XB_SPIN(xb_ld(&bar[XB_XGEN(b.x)]) == gen, bar);
      __builtin_amdgcn_fence(__ATOMIC_ACQUIRE, "agent");
      asm volatile("s_waitcnt vmcnt(0)" ::: "memory");
    }
  }
  __syncthreads();
}

struct Params {
  const float *x, *c, *ada_w, *ada_b, *ln_g, *ln_b, *rw_mu, *rw_w_rkv, *rw_w0, *rw_w1, *rw_w2, *rw_a0, *rw_a1, *rw_a2, *rw_g1, *rw_g2,
      *rw_k_k, *rw_k_a, *rw_r_k, *rw_lnx_g, *rw_lnx_b, *rw_w_o, *pl_w_in, *pl_w_grp, *pl_scale, *pl_w_out, *pe_w_q, *pe_keys, *pe_u, *pe_v;
  float* out;
  float* mod;
  bf16_t *WT_rkv, *W1T, *A1T, *G1T, *W2T, *A2T, *G2T, *WoT, *PinT, *PoutT, *WgrpT, *WqT, *KeysB;
  unsigned char* slot[7];
  float* tinv;
  unsigned* bar;
};

DI void mod_item(const Params& p, int item, unsigned char* lds) {
  float* cond = (float*)lds;
  float (*red)[NB][32] = (float (*)[NB][32])(lds + 32768);
  const int tid = opaque_v(threadIdx.x);
  for (int i = tid; i < NB * D; i += 256) { float v = p.c[i]; cond[i] = v / (1.f + __expf(-v)); }
  __syncthreads();
  const int l = item / 192, cb = item % 192;
  const int col = cb * 32 + (tid & 31), kg = tid >> 5;
  const float* w = p.ada_w + (size_t)l * D * 6144 + col;
  float acc[NB];
#pragma unroll
  for (int b = 0; b < NB; ++b) acc[b] = 0.f;
  for (int k = kg * 128; k < kg * 128 + 128; ++k) {
    const float wv = w[(size_t)k * 6144];
#pragma unroll
    for (int b = 0; b < NB; ++b) acc[b] += cond[b * D + k] * wv;
  }
#pragma unroll
  for (int b = 0; b < NB; ++b) red[kg][b][tid & 31] = acc[b];
  __syncthreads();
  {
    const int b = tid >> 5, cc = tid & 31;
    float s = 0.f;
#pragma unroll
    for (int g = 0; g < 8; ++g) s += red[g][b][cc];
    const int n = cb * 32 + cc;
    p.mod[((size_t)l * NB + b) * 6144 + n] = s + p.ada_b[l * 6144 + n];
  }
  __syncthreads();
}

DI void transpose_item(const float* __restrict__ src, bf16_t* __restrict__ dst, int K, int N, int Kpad, int Npad, size_t sbs, size_t dbs, int item, unsigned char* lds) {
  float (*tile)[33] = (float (*)[33])lds;
  const int nb_n = Npad / 32, nb_k = Kpad / 32;
  const int per = nb_n * nb_k;
  const int bz = item / per, r = item % per;
  const int bk = r / nb_n, bn = r % nb_n;
  src += bz * sbs; dst += bz * dbs;
  const int tq = opaque_v(threadIdx.x); const int tx = tq & 31, ty = tq >> 5;
#pragma unroll
  for (int i = 0; i < 4; ++i) {
    const int k = bk * 32 + ty + i * 8, n = bn * 32 + tx;
    tile[ty + i * 8][tx] = (k < K && n < N) ? src[(size_t)k * N + n] : 0.f;
  }
  __syncthreads();
#pragma unroll
  for (int i = 0; i < 4; ++i) {
    const int n = bn * 32 + ty + i * 8, k = bk * 32 + tx;
    dst[(size_t)n * Kpad + k] = f2bf(tile[tx][ty + i * 8]);
  }
  __syncthreads();
}
DI void cvt_range(const float* __restrict__ src, bf16_t* __restrict__ dst, size_t n8, int bid, int nblk) {
  const int tq = opaque_v(threadIdx.x);
  for (size_t i = (size_t)bid * 256 + tq; i < n8; i += (size_t)nblk * 256) {
    const f32x4 a = *(const f32x4*)(src + i * 8), b = *(const f32x4*)(src + i * 8 + 4);
    u32x4 o; o.x = cvt_pk_bf16(a[0], a[1]); o.y = cvt_pk_bf16(a[2], a[3]); o.z = cvt_pk_bf16(b[0], b[1]); o.w = cvt_pk_bf16(b[2], b[3]);
    *(u32x4*)(dst + i * 8) = o;
  }
}
DI void prologue_phase(const Params& p, unsigned char* lds, int bid, int nblk) {
  constexpr int total = 384 + 3072 + 128 + 128 + 256 + 64 + 64 + 192 + 1024 + 1024 + 1024 + 256 + 4096;
  for (int it = bid; it < total; it += nblk) {
    int r = it;
    if (r < 384) { mod_item(p, r, lds); continue; } r -= 384;
    if (r < 3072) { transpose_item(p.rw_w_rkv, p.WT_rkv, D, D, D, D, (size_t)D * D, (size_t)D * D, r, lds); continue; } r -= 3072;
    if (r < 128) { transpose_item(p.rw_w1, p.W1T, D, 64, D, 128, 0, 0, r, lds); continue; } r -= 128;
    if (r < 128) { transpose_item(p.rw_a1, p.A1T, D, 64, D, 128, 0, 0, r, lds); continue; } r -= 128;
    if (r < 256) { transpose_item(p.rw_g1, p.G1T, D, 160, D, 256, 0, 0, r, lds); continue; } r -= 256;
    if (r < 64) { transpose_item(p.rw_w2, p.W2T, 64, D, 64, D, 0, 0, r, lds); continue; } r -= 64;
    if (r < 64) { transpose_item(p.rw_a2, p.A2T, 64, D, 64, D, 0, 0, r, lds); continue; } r -= 64;
    if (r < 192) { transpose_item(p.rw_g2, p.G2T, 160, D, 192, D, 0, 0, r, lds); continue; } r -= 192;
    if (r < 1024) { transpose_item(p.rw_w_o, p.WoT, D, D, D, D, 0, 0, r, lds); continue; } r -= 1024;
    if (r < 1024) { transpose_item(p.pl_w_in, p.PinT, D, D, D, D, 0, 0, r, lds); continue; } r -= 1024;
    if (r < 1024) { transpose_item(p.pl_w_out, p.PoutT, D, D, D, D, 0, 0, r, lds); continue; } r -= 1024;
    if (r < 256) { transpose_item(p.pl_w_grp, p.WgrpT, 256, 256, 256, 256, (size_t)256 * 256, (size_t)256 * 256, r, lds); continue; } r -= 256;
    transpose_item(p.pe_w_q, p.WqT, D, 2048, D, 2048, (size_t)D * 2048, (size_t)D * 2048, r, lds);
  }
  cvt_range(p.pe_keys, p.KeysB, (size_t)2 * 16 * 128 * 128 / 8, bid, nblk);
}

DI void modulate_phase(const float* __restrict__ x, const float* __restrict__ mod_l, int shift_idx, int scale_idx, bf16_t* __restrict__ h, int bid, int nblk) {
  const size_t n8 = (size_t)T * D / 8; const int tq = opaque_v(threadIdx.x);
  for (size_t i = (size_t)bid * 256 + tq; i < n8; i += (size_t)nblk * 256) {
    const size_t e = i * 8; const int t = (int)(e / D), d = (int)(e % D), b = t / SEQ;
    const float* sh = mod_l + (size_t)b * 6144 + shift_idx * D + d; const float* sc = mod_l + (size_t)b * 6144 + scale_idx * D + d;
    const f32x4 a0 = *(const f32x4*)(x + e), a1 = *(const f32x4*)(x + e + 4);
    const f32x4 s0 = *(const f32x4*)sh, s1 = *(const f32x4*)(sh + 4), c0 = *(const f32x4*)sc, c1 = *(const f32x4*)(sc + 4);
    const f32x4 r0 = a0 * (c0 + 1.f) + s0, r1 = a1 * (c1 + 1.f) + s1;
    u32x4 o; o.x = cvt_pk_bf16(r0[0], r0[1]); o.y = cvt_pk_bf16(r0[2], r0[3]); o.z = cvt_pk_bf16(r1[0], r1[1]); o.w = cvt_pk_bf16(r1[2], r1[3]);
    *(u32x4*)(h + e) = o;
  }
}

enum { EPI_BF16 = 0, EPI_TANH, EPI_SIGMOID, EPI_LW, EPI_ASIG, EPI_Z, EPI_SCALE, EPI_TOPK };
struct GemmArgs {
  const bf16_t* A; int lda;
  const bf16_t* Bt; int ldb;
  int N, K;
  const float* mu;
  int epi; void* out; int ldc;
  const float* v0; const float* v1;
};

DI int lds_off(int row, int chunk) { return row * 128 + ((chunk ^ (row & 7)) << 4); }

DI void gemm_load_a(const GemmArgs& g, int m0, int k0, int tid, u32x4 (&ra)[4]) {
#pragma unroll
  for (int i = 0; i < 4; ++i) {
    const int row = (tid >> 3) + i * 32, ch = tid & 7;
    const int m = m0 + row;
    const bf16_t* src = g.A + (size_t)m * g.lda + k0 + ch * 8;
    u32x4 v = *(const u32x4*)src;
    if (g.mu) {
      u32x4 pv = {0u, 0u, 0u, 0u};
      if ((m % SEQ) != 0) pv = *(const u32x4*)(src - g.lda);
      const f32x4 m0v = *(const f32x4*)(g.mu + k0 + ch * 8), m1v = *(const f32x4*)(g.mu + k0 + ch * 8 + 4);
      const unsigned hu[4] = {v.x, v.y, v.z, v.w}, pu[4] = {pv.x, pv.y, pv.z, pv.w};
      float o[8];
#pragma unroll
      for (int j = 0; j < 4; ++j) {
        const float h0 = bf_lo(hu[j]), h1 = bf_hi(hu[j]), p0 = bf_lo(pu[j]), p1 = bf_hi(pu[j]);
        const float mu0 = (2 * j < 4) ? m0v[(2 * j) & 3] : m1v[(2 * j) & 3], mu1 = (2 * j + 1 < 4) ? m0v[(2 * j + 1) & 3] : m1v[(2 * j + 1) & 3];
        o[2 * j] = h0 + (p0 - h0) * mu0; o[2 * j + 1] = h1 + (p1 - h1) * mu1;
      }
      v.x = cvt_pk_bf16(o[0], o[1]); v.y = cvt_pk_bf16(o[2], o[3]); v.z = cvt_pk_bf16(o[4], o[5]); v.w = cvt_pk_bf16(o[6], o[7]);
    }
    ra[i] = v;
  }
}
DI void gemm_load_b(const GemmArgs& g, int n0, int k0, int tid, u32x4 (&rb)[4]) {
#pragma unroll
  for (int i = 0; i < 4; ++i) {
    const int row = (tid >> 3) + i * 32, ch = tid & 7;
    rb[i] = *(const u32x4*)(g.Bt + (size_t)(n0 + row) * g.ldb + k0 + ch * 8);
  }
}
DI void gemm_store_lds(unsigned char* buf, int tid, const u32x4 (&r)[4]) {
#pragma unroll
  for (int i = 0; i < 4; ++i) {
    const int row = (tid >> 3) + i * 32, ch = tid & 7;
    *(u32x4*)(buf + lds_off(row, ch)) = r[i];
  }
}

DI unsigned f2key(float f) { unsigned u = __float_as_uint(f); return u ^ ((u >> 31) ? 0xffffffffu : 0x80000000u); }
DI float key2f(unsigned k) { unsigned u = (k >> 31) ? (k ^ 0x80000000u) : ~k; return __uint_as_float(u); }
#define CE_DESC(a, b) { const unsigned _mx = max(a, b), _mn = min(a, b); a = _mx; b = _mn; }
DI void sort16_desc(unsigned (&x)[16]) {
#pragma unroll
  for (int k = 2; k <= 16; k <<= 1) {
#pragma unroll
    for (int j = k >> 1; j > 0; j >>= 1) {
#pragma unroll
      for (int i = 0; i < 16; ++i) {
        const int l = i ^ j;
        if (l > i) {
          if ((i & k) == 0) { CE_DESC(x[i], x[l]); } else { CE_DESC(x[l], x[i]); }
        }
      }
    }
  }
}
DI void merge16_desc(unsigned (&x)[16]) {
#pragma unroll
  for (int j = 8; j > 0; j >>= 1) {
#pragma unroll
    for (int i = 0; i < 16; ++i) { const int l = i ^ j; if (l > i) { CE_DESC(x[i], x[l]); } }
  }
}

DI void gemm_tile(const GemmArgs& g, int m0, int n0, unsigned char* lds) {
  constexpr int WM = 2, WN = 4 / WM, TM = 128 / WM, TN = 128 / WN, MI = TM / 16, NI = TN / 16;
  const int tid = opaque_v(threadIdx.x), lane = tid & 63, wid = tid >> 6;
  const int wm = wid / WN, wn = wid % WN;
  const int nk = g.K / 64;
  f32x4 acc[MI][NI];
#pragma unroll
  for (int i = 0; i < MI; ++i)
#pragma unroll
    for (int j = 0; j < NI; ++j) acc[i][j] = (f32x4){0.f, 0.f, 0.f, 0.f};
  u32x4 ra[4], rb[4];
  gemm_load_a(g, m0, 0, tid, ra); gemm_load_b(g, n0, 0, tid, rb);
  gemm_store_lds(lds, tid, ra); gemm_store_lds(lds + 16384, tid, rb);
  __syncthreads();
  const int fr = lane & 15, fq = lane >> 4;
  for (int kt = 0; kt < nk; ++kt) {
    unsigned char* cur = lds + (kt & 1) * 32768;
    if (kt + 1 < nk) { gemm_load_a(g, m0, (kt + 1) * 64, tid, ra); gemm_load_b(g, n0, (kt + 1) * 64, tid, rb); }
#pragma unroll
    for (int ks = 0; ks < 2; ++ks) {
      bf16x8 af[MI], bfr[NI];
#pragma unroll
      for (int i = 0; i < MI; ++i) af[i] = *(const bf16x8*)(cur + lds_off(wm * TM + i * 16 + fr, ks * 4 + fq));
#pragma unroll
      for (int j = 0; j < NI; ++j) bfr[j] = *(const bf16x8*)(cur + 16384 + lds_off(wn * TN + j * 16 + fr, ks * 4 + fq));
#pragma unroll
      for (int i = 0; i < MI; ++i)
#pragma unroll
        for (int j = 0; j < NI; ++j) acc[i][j] = __builtin_amdgcn_mfma_f32_16x16x32_bf16(bfr[j], af[i], acc[i][j], 0, 0, 0);
    }
    if (kt + 1 < nk) { unsigned char* nxt = lds + ((kt + 1) & 1) * 32768; gemm_store_lds(nxt, tid, ra); gemm_store_lds(nxt + 16384, tid, rb); }
    __syncthreads();
  }
#pragma unroll
  for (int i = 0; i < MI; ++i) {
    const int m = m0 + wm * TM + i * 16 + fr;
#pragma unroll
    for (int j = 0; j < NI; ++j) {
      const int n = n0 + wn * TN + j * 16 + fq * 4;
      if (n >= g.N) continue;
      const f32x4 v = acc[i][j];
      bf16_t* ob = (bf16_t*)g.out + (size_t)m * g.ldc + n;
      switch (g.epi) {
        case EPI_BF16: *(u32x2*)ob = (u32x2){cvt_pk_bf16(v[0], v[1]), cvt_pk_bf16(v[2], v[3])}; break;
        case EPI_TANH: *(u32x2*)ob = (u32x2){cvt_pk_bf16(tanhf(v[0]), tanhf(v[1])), cvt_pk_bf16(tanhf(v[2]), tanhf(v[3]))}; break;
        case EPI_SIGMOID: *(u32x2*)ob = (u32x2){cvt_pk_bf16(sigmoidf_(v[0]), sigmoidf_(v[1])), cvt_pk_bf16(sigmoidf_(v[2]), sigmoidf_(v[3]))}; break;
        case EPI_LW: {
          const f32x4 w0 = *(const f32x4*)(g.v0 + n); float o[4];
#pragma unroll
          for (int q = 0; q < 4; ++q) { const float xx = -(w0[q] + v[q]); const float sp = fmaxf(xx, 0.f) + log1pf(__expf(-fabsf(xx))); o[q] = -__expf(-sp - 0.5f); }
          *(u32x2*)ob = (u32x2){cvt_pk_bf16(o[0], o[1]), cvt_pk_bf16(o[2], o[3])};
        } break;
        case EPI_ASIG: {
          const f32x4 a0 = *(const f32x4*)(g.v0 + n);
          *(u32x2*)ob = (u32x2){cvt_pk_bf16(sigmoidf_(a0[0] + v[0]), sigmoidf_(a0[1] + v[1])), cvt_pk_bf16(sigmoidf_(a0[2] + v[2]), sigmoidf_(a0[3] + v[3]))};
        } break;
        case EPI_Z: {
          const int b = m / SEQ;
          const f32x4 xv = *(const f32x4*)(g.v0 + (size_t)m * D + n), gt = *(const f32x4*)(g.v1 + (size_t)b * 6144 + n);
          *(f32x4*)((float*)g.out + (size_t)m * g.ldc + n) = xv * ALPHA + gt * v;
        } break;
        default: {
          const f32x4 sc = *(const f32x4*)(g.v0 + n);
          *(u32x2*)ob = (u32x2){cvt_pk_bf16(v[0] * sc[0], v[1] * sc[1]), cvt_pk_bf16(v[2] * sc[2], v[3] * sc[3])};
        } break;
      }
    }
  }
}

DI void scores_topk_tile(const bf16_t* __restrict__ q, const bf16_t* __restrict__ keys, unsigned* __restrict__ lists, int m0, int grp, unsigned char* lds) {
  const int tid = opaque_v(threadIdx.x), lane = tid & 63, wm = tid >> 6, fr = lane & 15, fq = lane >> 4;
#pragma unroll
  for (int hk = 0; hk < 2; ++hk)
#pragma unroll
    for (int i = 0; i < 4; ++i) {
      const int row = (tid >> 3) + i * 32, ch = tid & 7;
      const u32x4 va = *(const u32x4*)(q + (size_t)(m0 + row) * 2048 + grp * 128 + hk * 64 + ch * 8);
      const u32x4 vb = *(const u32x4*)(keys + (size_t)grp * 128 * 128 + (size_t)row * 128 + hk * 64 + ch * 8);
      *(u32x4*)(lds + hk * 16384 + lds_off(row, ch)) = va;
      *(u32x4*)(lds + 32768 + hk * 16384 + lds_off(row, ch)) = vb;
    }
  __syncthreads();
  f32x4 acc[2][8];
#pragma unroll
  for (int i = 0; i < 2; ++i)
#pragma unroll
    for (int j = 0; j < 8; ++j) acc[i][j] = (f32x4){0.f, 0.f, 0.f, 0.f};
#pragma unroll
  for (int kk = 0; kk < 4; ++kk) {
    const int hk = kk >> 1, ks = kk & 1;
    bf16x8 af[2];
#pragma unroll
    for (int i = 0; i < 2; ++i) af[i] = *(const bf16x8*)(lds + hk * 16384 + lds_off(wm * 32 + i * 16 + fr, ks * 4 + fq));
#pragma unroll
    for (int j = 0; j < 8; ++j) {
      const bf16x8 bfr = *(const bf16x8*)(lds + 32768 + hk * 16384 + lds_off(j * 16 + fr, ks * 4 + fq));
#pragma unroll
      for (int i = 0; i < 2; ++i) acc[i][j] = __builtin_amdgcn_mfma_f32_16x16x32_bf16(bfr, af[i], acc[i][j], 0, 0, 0);
    }
  }
  __syncthreads();
  constexpr int MI = 2, NI = 8, TM = 32;
  {
#pragma unroll
    for (int i = 0; i < MI; ++i)
#pragma unroll
      for (int j = 0; j < NI; ++j) {
        const int ml = wm * TM + i * 16 + fr, c = j * 4 + fq;
        u32x4 kv;
        kv.x = (f2key(acc[i][j][0]) & ~127u) | (unsigned)(127 - (c * 4 + 0)); kv.y = (f2key(acc[i][j][1]) & ~127u) | (unsigned)(127 - (c * 4 + 1));
        kv.z = (f2key(acc[i][j][2]) & ~127u) | (unsigned)(127 - (c * 4 + 2)); kv.w = (f2key(acc[i][j][3]) & ~127u) | (unsigned)(127 - (c * 4 + 3));
        *(u32x4*)(lds + ml * 528 + (c << 4)) = kv;
      }
    __syncthreads();
    {
      const int ml = wm * 32 + (lane & 31), hf = lane >> 5;
      unsigned a[16], b[16];
#pragma unroll
      for (int ch = 0; ch < 4; ++ch) {
#pragma unroll
        for (int cc = 0; cc < 4; ++cc) {
          const int c = hf * 16 + ch * 4 + cc;
          const u32x4 kv = *(const u32x4*)(lds + ml * 528 + (c << 4));
          b[cc * 4] = kv.x; b[cc * 4 + 1] = kv.y; b[cc * 4 + 2] = kv.z; b[cc * 4 + 3] = kv.w;
        }
        sort16_desc(b);
        if (ch == 0) {
#pragma unroll
          for (int e = 0; e < 16; ++e) a[e] = b[e];
        } else {
#pragma unroll
          for (int e = 0; e < 16; ++e) a[e] = max(a[e], b[15 - e]);
          merge16_desc(a);
        }
      }
#pragma unroll
      for (int e = 0; e < 16; ++e) b[e] = (unsigned)__shfl_xor((int)a[e], 32);
#pragma unroll
      for (int e = 0; e < 16; ++e) a[e] = max(a[e], b[15 - e]);
      merge16_desc(a);
      if (hf == 0) {
        const int m = m0 + ml;
        u32x4* dst = (u32x4*)(lists + ((size_t)m * 16 + grp) * 16);
        dst[0] = (u32x4){a[0], a[1], a[2], a[3]}; dst[1] = (u32x4){a[4], a[5], a[6], a[7]};
        dst[2] = (u32x4){a[8], a[9], a[10], a[11]}; dst[3] = (u32x4){a[12], a[13], a[14], a[15]};
      }
    }
    __syncthreads();
  }
}

DI GemmArgs mk(const bf16_t* A, int lda, const bf16_t* Bt, int ldb, int N, int K, int epi, void* out, int ldc,
               const float* mu = nullptr, const float* v0 = nullptr, const float* v1 = nullptr) {
  GemmArgs g; g.A = A; g.lda = lda; g.Bt = Bt; g.ldb = ldb; g.N = N; g.K = K; g.mu = mu; g.epi = epi; g.out = out; g.ldc = ldc; g.v0 = v0; g.v1 = v1; return g;
}
DI void item_mn(int item, int ntn, int& mt, int& nt) { const int grp = item / (8 * ntn), w = item % (8 * ntn); mt = grp * 8 + (w & 7); nt = w >> 3; }

struct ScanArgs {
  const bf16_t *r, *k, *v, *lw, *a, *g;
  const float *k_k, *k_a, *r_k, *lnx_g, *lnx_b;
  bf16_t* yg;
};
DI void scan_seq_item(const ScanArgs& s, int item, unsigned char* lds) {
  constexpr int TC = 32;
  float (*sr)[64] = (float (*)[64])(lds), (*sw)[64] = (float (*)[64])(lds + 8192), (*sk)[64] = (float (*)[64])(lds + 16384), (*sv)[64] = (float (*)[64])(lds + 24576),
        (*sa)[64] = (float (*)[64])(lds + 32768), (*sb)[64] = (float (*)[64])(lds + 40960), (*sy)[64] = (float (*)[64])(lds + 49152);
  float* sbonus = (float*)(lds + 57344);
  const int tid = opaque_v(threadIdx.x), b = item / NH, h = item % NH;
  const int vrow = tid >> 2, kq = tid & 3;
  float S[16];
#pragma unroll
  for (int i = 0; i < 16; ++i) S[i] = 0.f;
  const size_t base = (size_t)b * SEQ * D + h * HS;
  for (int t0 = 0; t0 < SEQ; t0 += TC) {
    {
      const int tt = tid >> 3, c0 = (tid & 7) * 8;
      const size_t off = base + (size_t)(t0 + tt) * D + c0;
      const u32x4 vr = *(const u32x4*)(s.r + off), vk = *(const u32x4*)(s.k + off), vv = *(const u32x4*)(s.v + off), vw = *(const u32x4*)(s.lw + off), va = *(const u32x4*)(s.a + off);
      float fr_[8], fk[8], fv[8], fw[8], fa[8];
      const unsigned ur[4] = {vr.x, vr.y, vr.z, vr.w}, uk[4] = {vk.x, vk.y, vk.z, vk.w}, uv[4] = {vv.x, vv.y, vv.z, vv.w}, uw[4] = {vw.x, vw.y, vw.z, vw.w}, ua[4] = {va.x, va.y, va.z, va.w};
#pragma unroll
      for (int j = 0; j < 4; ++j) {
        fr_[2 * j] = bf_lo(ur[j]); fr_[2 * j + 1] = bf_hi(ur[j]); fk[2 * j] = bf_lo(uk[j]); fk[2 * j + 1] = bf_hi(uk[j]);
        fv[2 * j] = bf_lo(uv[j]); fv[2 * j + 1] = bf_hi(uv[j]); fw[2 * j] = bf_lo(uw[j]); fw[2 * j + 1] = bf_hi(uw[j]);
        fa[2 * j] = bf_lo(ua[j]); fa[2 * j + 1] = bf_hi(ua[j]);
      }
      float kkr[8], nrm = 0.f, bon = 0.f, kp[8];
#pragma unroll
      for (int j = 0; j < 8; ++j) {
        const int ch = h * HS + c0 + j;
        kkr[j] = fk[j] * s.k_k[ch]; nrm += kkr[j] * kkr[j];
        kp[j] = fk[j] * (1.f + (fa[j] - 1.f) * s.k_a[ch]);
        bon += fr_[j] * kp[j] * s.r_k[ch];
      }
      nrm += __shfl_xor(nrm, 1); nrm += __shfl_xor(nrm, 2); nrm += __shfl_xor(nrm, 4);
      bon += __shfl_xor(bon, 1); bon += __shfl_xor(bon, 2); bon += __shfl_xor(bon, 4);
      const float inv = rsqrtf(fmaxf(nrm, 1e-24f));
#pragma unroll
      for (int j = 0; j < 8; ++j) {
        const float kk = kkr[j] * inv;
        sr[tt][c0 + j] = fr_[j]; sw[tt][c0 + j] = __expf(fw[j]); sk[tt][c0 + j] = kp[j]; sv[tt][c0 + j] = fv[j];
        sa[tt][c0 + j] = -kk; sb[tt][c0 + j] = kk * fa[j];
      }
      if ((tid & 7) == 0) sbonus[tt] = bon;
    }
    __syncthreads();
    for (int tt = 0; tt < TC; ++tt) {
      float av[16], bv[16], wv[16], kv[16], rv[16];
#pragma unroll
      for (int q = 0; q < 4; ++q) {
        const f32x4 a4 = *(const f32x4*)&sa[tt][kq * 16 + q * 4], b4 = *(const f32x4*)&sb[tt][kq * 16 + q * 4], w4 = *(const f32x4*)&sw[tt][kq * 16 + q * 4],
                    k4 = *(const f32x4*)&sk[tt][kq * 16 + q * 4], r4 = *(const f32x4*)&sr[tt][kq * 16 + q * 4];
#pragma unroll
        for (int j = 0; j < 4; ++j) { av[q * 4 + j] = a4[j]; bv[q * 4 + j] = b4[j]; wv[q * 4 + j] = w4[j]; kv[q * 4 + j] = k4[j]; rv[q * 4 + j] = r4[j]; }
      }
      const float vt = sv[tt][vrow];
      float sap = 0.f;
#pragma unroll
      for (int i = 0; i < 16; ++i) sap += S[i] * av[i];
      sap += __shfl_xor(sap, 1); sap += __shfl_xor(sap, 2);
      float yp = 0.f;
#pragma unroll
      for (int i = 0; i < 16; ++i) { S[i] = S[i] * wv[i] + sap * bv[i] + vt * kv[i]; yp += S[i] * rv[i]; }
      yp += __shfl_xor(yp, 1); yp += __shfl_xor(yp, 2);
      if (kq == 0) sy[tt][vrow] = yp;
    }
    __syncthreads();
    {
      const int tt = tid >> 3, c0 = (tid & 7) * 8;
      float yv[8], sum = 0.f;
#pragma unroll
      for (int j = 0; j < 8; ++j) { yv[j] = sy[tt][c0 + j]; sum += yv[j]; }
      sum += __shfl_xor(sum, 1); sum += __shfl_xor(sum, 2); sum += __shfl_xor(sum, 4);
      const float mean = sum * (1.f / 64.f);
      float var = 0.f;
#pragma unroll
      for (int j = 0; j < 8; ++j) { const float d = yv[j] - mean; var += d * d; }
      var += __shfl_xor(var, 1); var += __shfl_xor(var, 2); var += __shfl_xor(var, 4);
      const float rstd = rsqrtf(var * (1.f / 64.f) + GN_EPS);
      const float bon = sbonus[tt];
      const size_t off = base + (size_t)(t0 + tt) * D + c0;
      const u32x4 vg = *(const u32x4*)(s.g + off);
      const unsigned ug[4] = {vg.x, vg.y, vg.z, vg.w};
      float o[8];
#pragma unroll
      for (int j = 0; j < 8; ++j) {
        const int ch = h * HS + c0 + j;
        const float gq = (j & 1) ? bf_hi(ug[j >> 1]) : bf_lo(ug[j >> 1]);
        o[j] = ((yv[j] - mean) * rstd * s.lnx_g[ch] + s.lnx_b[ch] + bon * sv[tt][c0 + j]) * gq;
      }
      *(u32x4*)(s.yg + off) = (u32x4){cvt_pk_bf16(o[0], o[1]), cvt_pk_bf16(o[2], o[3]), cvt_pk_bf16(o[4], o[5]), cvt_pk_bf16(o[6], o[7])};
    }
    __syncthreads();
  }
}

DI void ln_phase(const float* __restrict__ z, const float* __restrict__ lg, const float* __restrict__ lb, float* __restrict__ xo,
                 const float* __restrict__ mod_l, int shift_idx, int scale_idx, bf16_t* __restrict__ ho, int bid, int nblk) {
  const int tq = opaque_v(threadIdx.x); const int lane = tq & 63, wv = tq >> 6;
  for (int row = bid * 4 + wv; row < T; row += nblk * 4) {
    const float* zr = z + (size_t)row * D;
    f32x4 v[4]; float s = 0.f;
#pragma unroll
    for (int i = 0; i < 4; ++i) { v[i] = *(const f32x4*)(zr + i * 256 + lane * 4); s += (v[i][0] + v[i][1]) + (v[i][2] + v[i][3]); }
    const float mean = wave_sum(s) * (1.f / D);
    float q = 0.f;
#pragma unroll
    for (int i = 0; i < 4; ++i) { const f32x4 d = v[i] - mean; q += (d[0] * d[0] + d[1] * d[1]) + (d[2] * d[2] + d[3] * d[3]); }
    const float rstd = rsqrtf(wave_sum(q) * (1.f / D) + LN_EPS);
    const int b = row / SEQ;
#pragma unroll
    for (int i = 0; i < 4; ++i) {
      const int d = i * 256 + lane * 4;
      const f32x4 o = (v[i] - mean) * rstd * *(const f32x4*)(lg + d) + *(const f32x4*)(lb + d);
      *(f32x4*)(xo + (size_t)row * D + d) = o;
      if (!ho) continue;
      const f32x4 sh = *(const f32x4*)(mod_l + (size_t)b * 6144 + shift_idx * D + d), sc = *(const f32x4*)(mod_l + (size_t)b * 6144 + scale_idx * D + d);
      const f32x4 hh = o * (sc + 1.f) + sh;
      *(u32x2*)(ho + (size_t)row * D + d) = (u32x2){cvt_pk_bf16(hh[0], hh[1]), cvt_pk_bf16(hh[2], hh[3])};
    }
  }
}

DI void combine_phase(const unsigned* __restrict__ lists, unsigned short* __restrict__ epk, float* __restrict__ gate, int bid, int nblk) {
  const int tq = opaque_v(threadIdx.x);
  for (int gid = bid * 256 + tq; gid < T * 8; gid += nblk * 256) {
    const unsigned* la = lists + (size_t)gid * 32;
    const unsigned* lb = la + 16;
    float s1[16], s2[16];
#pragma unroll
    for (int i = 0; i < 4; ++i) {
      const u32x4 a = *(const u32x4*)(la + i * 4), b = *(const u32x4*)(lb + i * 4);
      s1[i * 4] = key2f(a.x & ~127u); s1[i * 4 + 1] = key2f(a.y & ~127u); s1[i * 4 + 2] = key2f(a.z & ~127u); s1[i * 4 + 3] = key2f(a.w & ~127u);
      s2[i * 4] = key2f(b.x & ~127u); s2[i * 4 + 1] = key2f(b.y & ~127u); s2[i * 4 + 2] = key2f(b.z & ~127u); s2[i * 4 + 3] = key2f(b.w & ~127u);
    }
    unsigned c[4][16];
    {
      int n = 0;
#pragma unroll
      for (int a = 0; a < 16; ++a)
#pragma unroll
        for (int b = 0; b < 16; ++b)
          if ((a + 1) * (b + 1) <= 16) { c[n >> 4][n & 15] = (f2key(s1[a] + s2[b]) & ~255u) | (unsigned)(255 - (a * 16 + b)); ++n; }
#pragma unroll
      for (int q = 50; q < 64; ++q) c[q >> 4][q & 15] = 0u;
    }
    sort16_desc(c[0]); sort16_desc(c[1]); sort16_desc(c[2]); sort16_desc(c[3]);
#pragma unroll
    for (int e = 0; e < 16; ++e) { c[0][e] = max(c[0][e], c[1][15 - e]); c[2][e] = max(c[2][e], c[3][15 - e]); }
    merge16_desc(c[0]); merge16_desc(c[2]);
#pragma unroll
    for (int e = 0; e < 16; ++e) c[0][e] = max(c[0][e], c[2][15 - e]);
    merge16_desc(c[0]);
    float best[16], den = 0.f;
    const float mx = key2f(c[0][0] & ~255u);
#pragma unroll
    for (int e = 0; e < 16; ++e) { best[e] = __expf(key2f(c[0][e] & ~255u) - mx); den += best[e]; }
    const float inv = 1.f / den;
#pragma unroll
    for (int e = 0; e < 16; ++e) {
      const int pos = 255 - (int)(c[0][e] & 255u), a = pos >> 4, b = pos & 15;
      const int i1 = 127 - (int)(la[a] & 127u), i2 = 127 - (int)(lb[b] & 127u);
      { const int jj = (gid & 7) * 16 + e; epk[(size_t)(gid >> 3) * 128 + (jj < 64 ? 2 * jj : 2 * (jj - 64) + 1)] = (unsigned short)(i1 * 128 + i2); }
      gate[(size_t)gid * 16 + e] = best[e] * inv;
    }
  }
}

DI void table_fp8_phase(const float* __restrict__ src, unsigned char* __restrict__ dst, float* __restrict__ inv, int rows, int bid, int nblk) {
  const int tq = opaque_v(threadIdx.x); const int lane = tq & 63, wv = tq >> 6;
  for (int r = bid * 4 + wv; r < rows; r += nblk * 4) {
    const float* sr = src + (size_t)r * D + lane * 16;
    f32x4 v[4]; float mx = 0.f;
#pragma unroll
    for (int i = 0; i < 4; ++i) { v[i] = __builtin_nontemporal_load((const f32x4*)(sr + i * 4)); mx = fmaxf(mx, fmaxf(fmaxf(fabsf(v[i][0]), fabsf(v[i][1])), fmaxf(fabsf(v[i][2]), fabsf(v[i][3])))); }
#pragma unroll
    for (int o = 32; o >= 1; o >>= 1) mx = fmaxf(mx, __shfl_xor(mx, o));
    const float sc = mx > 0.f ? exp2f(floorf(log2f(384.f / mx))) : 1.f;
    u32x4 o4; unsigned w[4];
#pragma unroll
    for (int i = 0; i < 4; ++i) {
      int pk = 0;
      pk = __builtin_amdgcn_cvt_pk_fp8_f32(v[i][0] * sc, v[i][1] * sc, pk, false);
      pk = __builtin_amdgcn_cvt_pk_fp8_f32(v[i][2] * sc, v[i][3] * sc, pk, true);
      w[i] = (unsigned)pk;
    }
    o4.x = w[0]; o4.y = w[1]; o4.z = w[2]; o4.w = w[3];
    *(u32x4*)(dst + (size_t)r * D + lane * 16) = o4;
    if (lane == 0) inv[r] = 1.f / sc;
  }
}

struct PeerArgs {
  const bf16_t* h2;
  const unsigned char *u8, *v8;
  const float *uinv, *vinv;
  const unsigned* epk; const float* gate;
  float* part;
  float* coef;
  const float* xres;
  const float* gate2;
  float* z;
  unsigned* ctr_u; unsigned* ctr_v;
};
constexpr int PCH = 64;
DI void cvt16_fp8(const u32x4& d, float (&f)[16]) {
  const unsigned w[4] = {d.x, d.y, d.z, d.w};
#pragma unroll
  for (int i = 0; i < 4; ++i) {
    const f32x2 lo = __builtin_amdgcn_cvt_pk_f32_fp8((int)w[i], false), hi = __builtin_amdgcn_cvt_pk_f32_fp8((int)w[i], true);
    f[i * 4] = lo.x; f[i * 4 + 1] = lo.y; f[i * 4 + 2] = hi.x; f[i * 4 + 3] = hi.y;
  }
}
template <bool VPHASE>
DI void peer_slice_phase(const PeerArgs& a, unsigned char* lds) {
  const int tq = opaque_v(threadIdx.x); const int lane = tq & 63, wv = tq >> 6, cc = lane & 7;
  volatile int* nxt = (volatile int*)lds;
  const unsigned xcc = xb_xcc_id() & 7u;
  unsigned* ctr = VPHASE ? a.ctr_v : a.ctr_u;
  for (int ks = 0; ks < 8; ++ks) {
    const int s = (int)((xcc + ks) & 7u);
    for (;;) {
      __syncthreads();
      if (tq == 0) *nxt = (int)atomicAdd(&ctr[s * 16], 1u);
      __syncthreads();
      const int chunk = *nxt;
      if (chunk >= T / PCH) break;
      for (int ti = 0; ti < PCH / 4; ++ti) {
        const int t = chunk * PCH + wv * (PCH / 4) + ti;
        const unsigned ep = a.epk[(size_t)t * 64 + lane];
        const unsigned char* tab = (VPHASE ? a.v8 : a.u8) + s * 128 + cc * 16;
        u32x4 data[16];
        float cv[16];
        float c_lo = 0.f, c_hi = 0.f;
        if (VPHASE) { c_lo = a.coef[(size_t)t * 128 + lane]; c_hi = a.coef[(size_t)t * 128 + 64 + lane]; }
#pragma unroll
        for (int i = 0; i < 16; ++i) {
          const int src = (lane & ~7) | (i & 7);
          const unsigned ev = (unsigned)__shfl((int)ep, src);
          const unsigned e = (i < 8) ? (ev & 0xffffu) : (ev >> 16);
          if (VPHASE) cv[i] = __shfl(i < 8 ? c_lo : c_hi, src);
          data[i] = *(const u32x4*)(tab + (size_t)e * D);
        }
        if (!VPHASE) {
          const u32x4 h0 = *(const u32x4*)(a.h2 + (size_t)t * D + s * 128 + cc * 16), h1 = *(const u32x4*)(a.h2 + (size_t)t * D + s * 128 + cc * 16 + 8);
          float hf[16];
          { const unsigned u[8] = {h0.x, h0.y, h0.z, h0.w, h1.x, h1.y, h1.z, h1.w};
#pragma unroll
            for (int q = 0; q < 8; ++q) { hf[2 * q] = bf_lo(u[q]); hf[2 * q + 1] = bf_hi(u[q]); } }
          float r_lo = 0.f, r_hi = 0.f;
#pragma unroll
          for (int i = 0; i < 16; ++i) {
            float f[16]; cvt16_fp8(data[i], f);
            float d = 0.f;
#pragma unroll
            for (int q = 0; q < 16; ++q) d += f[q] * hf[q];
            d += __shfl_xor(d, 1); d += __shfl_xor(d, 2); d += __shfl_xor(d, 4);
            if ((i & 7) == cc) { if (i < 8) r_lo = d; else r_hi = d; }
          }
          float* pp = a.part + ((size_t)s * T + t) * 128;
          pp[lane] = r_lo; pp[64 + lane] = r_hi;
        } else {
          float acc[16];
#pragma unroll
          for (int q = 0; q < 16; ++q) acc[q] = 0.f;
#pragma unroll
          for (int i = 0; i < 16; ++i) {
            float f[16]; cvt16_fp8(data[i], f);
#pragma unroll
            for (int q = 0; q < 16; ++q) acc[q] += cv[i] * f[q];
          }
          float r8[8], r4[4], r2[2];
          { const bool up = (lane & 8) != 0;
#pragma unroll
            for (int q = 0; q < 8; ++q) { const float keep = up ? acc[8 + q] : acc[q], send = up ? acc[q] : acc[8 + q]; r8[q] = keep + __shfl_xor(send, 8); } }
          { const bool up = (lane & 16) != 0;
#pragma unroll
            for (int q = 0; q < 4; ++q) { const float keep = up ? r8[4 + q] : r8[q], send = up ? r8[q] : r8[4 + q]; r4[q] = keep + __shfl_xor(send, 16); } }
          { const bool up = (lane & 32) != 0;
#pragma unroll
            for (int q = 0; q < 2; ++q) { const float keep = up ? r4[2 + q] : r4[q], send = up ? r4[q] : r4[2 + q]; r2[q] = keep + __shfl_xor(send, 32); } }
          const int col = s * 128 + cc * 16 + ((lane >> 3) & 1) * 8 + ((lane >> 4) & 1) * 4 + ((lane >> 5) & 1) * 2;
          const int b = t / SEQ;
          const f32x2 xv = *(const f32x2*)(a.xres + (size_t)t * D + col), gt = *(const f32x2*)(a.gate2 + (size_t)b * 6144 + col);
          *(f32x2*)(a.z + (size_t)t * D + col) = (f32x2){ALPHA * xv.x + gt.x * r2[0], ALPHA * xv.y + gt.y * r2[1]};
        }
      }
    }
  }
  __syncthreads();
}
DI void peer_coef_phase(const PeerArgs& a, int bid, int nblk) {
  const int tq = opaque_v(threadIdx.x);
  for (int gid = bid * 256 + tq; gid < T * 128; gid += nblk * 256) {
    const int t = gid >> 7, j = gid & 127;
    const unsigned ep = a.epk[(size_t)t * 64 + (j & 63)];
    const unsigned e = (j < 64) ? (ep & 0xffffu) : (ep >> 16);
    float sum = 0.f;
#pragma unroll
    for (int s8 = 0; s8 < 8; ++s8) sum += a.part[((size_t)s8 * T + t) * 128 + j];
    a.coef[gid] = a.gate[gid] * gelu_exact(sum * a.uinv[e]) * a.vinv[e];
  }
}

DI void pool_phase(const bf16_t* __restrict__ zin, bf16_t* __restrict__ pout, int bid, int nblk) {
  const size_t n8 = (size_t)T * D / 8; const int tq = opaque_v(threadIdx.x);
  for (size_t i = (size_t)bid * 256 + tq; i < n8; i += (size_t)nblk * 256) {
    const size_t e = i * 8; const int t = (int)(e / D), d = (int)(e % D), tp = t % SEQ;
    const int win = 2 << (d / 256);
    const int cnt = min(tp + 1, win);
    float s[8], z0[8];
#pragma unroll
    for (int j = 0; j < 8; ++j) { s[j] = 0.f; z0[j] = 0.f; }
    for (int w = 0; w < cnt; ++w) {
      const u32x4 v = *(const u32x4*)(zin + e - (size_t)w * D);
      const unsigned u[4] = {v.x, v.y, v.z, v.w};
#pragma unroll
      for (int j = 0; j < 4; ++j) { const float lo = bf_lo(u[j]), hi = bf_hi(u[j]); s[2 * j] += lo; s[2 * j + 1] += hi; if (w == 0) { z0[2 * j] = lo; z0[2 * j + 1] = hi; } }
    }
    const float ic = 1.f / (float)cnt;
    float o[8];
#pragma unroll
    for (int j = 0; j < 8; ++j) o[j] = s[j] * ic - z0[j];
    *(u32x4*)(pout + e) = (u32x4){cvt_pk_bf16(o[0], o[1]), cvt_pk_bf16(o[2], o[3]), cvt_pk_bf16(o[4], o[5]), cvt_pk_bf16(o[6], o[7])};
  }
}


#define GRID_SYNC() xcd_barrier(xb)

__global__ void __launch_bounds__(256, 2) mega(Params p) {
  __shared__ __attribute__((aligned(16))) unsigned char lds[LDS_BYTES + 16];
  cg::grid_group grid = cg::this_grid();
  const int bid = blockIdx.x, nblk = gridDim.x;
  if (threadIdx.x == 0) { *(volatile LAS unsigned*)(lds + LDS_BYTES) = 0u; *(volatile LAS unsigned*)(lds + LDS_BYTES + 4) = 0u; }
  __syncthreads();
  const XcdBarrier xb = xcd_barrier_post(p.bar, (volatile LAS unsigned*)(lds + LDS_BYTES));
  const float* mod0 = p.mod; const float* mod1 = p.mod + (size_t)NB * 6144;
  bf16_t* S[7];
#pragma unroll
  for (int i = 0; i < 7; ++i) S[i] = (bf16_t*)p.slot[i];

  prologue_phase(p, lds, bid, nblk);
  grid.sync();
  bf16_t *h = S[0], *r = S[1], *k = S[2], *v = S[3], *lw = S[4], *av = S[5], *gv = S[6];
  bf16_t* tw = (bf16_t*)p.out; bf16_t* ta = tw + (size_t)T * 64; bf16_t* tg = ta + (size_t)T * 64;
  modulate_phase(p.x, mod0, 0, 1, h, bid, nblk);
  GRID_SYNC();
  for (int it = bid; it < 256 * 28; it += nblk) {
    int mt, nt; item_mn(it, 28, mt, nt);
    GemmArgs g; int n0;
    if (nt < 24) { const int j = nt >> 3; n0 = (nt & 7) * 128; g = mk(h, D, p.WT_rkv + (size_t)j * D * D, D, D, D, EPI_BF16, j == 0 ? r : (j == 1 ? k : v), D, p.rw_mu + j * D); }
    else if (nt == 24) { n0 = 0; g = mk(h, D, p.W1T, D, 64, D, EPI_TANH, tw, 64, p.rw_mu + 3 * D); }
    else if (nt == 25) { n0 = 0; g = mk(h, D, p.A1T, D, 64, D, EPI_BF16, ta, 64, p.rw_mu + 4 * D); }
    else { n0 = (nt - 26) * 128; g = mk(h, D, p.G1T, D, 192, D, EPI_SIGMOID, tg, 192, p.rw_mu + 5 * D); }
    gemm_tile(g, mt * 128, n0, lds);
  }
  GRID_SYNC();
  for (int it = bid; it < 256 * 24; it += nblk) {
    int mt, nt; item_mn(it, 24, mt, nt);
    const int j = nt >> 3, n0 = (nt & 7) * 128;
    GemmArgs g;
    if (j == 0) g = mk(tw, 64, p.W2T, 64, D, 64, EPI_LW, lw, D, nullptr, p.rw_w0);
    else if (j == 1) g = mk(ta, 64, p.A2T, 64, D, 64, EPI_ASIG, av, D, nullptr, p.rw_a0);
    else g = mk(tg, 192, p.G2T, 192, D, 192, EPI_BF16, gv, D);
    gemm_tile(g, mt * 128, n0, lds);
  }
  GRID_SYNC();
  {
    ScanArgs s; s.r = r; s.k = k; s.v = v; s.lw = lw; s.a = av; s.g = gv; s.k_k = p.rw_k_k; s.k_a = p.rw_k_a; s.r_k = p.rw_r_k; s.lnx_g = p.rw_lnx_g; s.lnx_b = p.rw_lnx_b; s.yg = h;
    for (int it = bid; it < NB * NH; it += nblk) scan_seq_item(s, it, lds);
  }
  GRID_SYNC();
  float* z = (float*)p.slot[1];
  for (int it = bid; it < 256 * 8; it += nblk) {
    int mt, nt; item_mn(it, 8, mt, nt);
    gemm_tile(mk(h, D, p.WoT, D, D, D, EPI_Z, z, D, nullptr, p.x, mod0 + 2 * D), mt * 128, nt * 128, lds);
  }
  table_fp8_phase(p.pe_u, p.slot[6], p.tinv, NEXP, bid, nblk);
  table_fp8_phase(p.pe_v, p.slot[6] + ((size_t)16 << 20), p.tinv + NEXP, NEXP, bid, nblk);
  table_fp8_phase(p.pe_u + (size_t)NEXP * D, p.slot[6] + ((size_t)32 << 20), p.tinv + 2 * NEXP, NEXP, bid, nblk);
  table_fp8_phase(p.pe_v + (size_t)NEXP * D, p.slot[6] + ((size_t)48 << 20), p.tinv + 3 * NEXP, NEXP, bid, nblk);
  GRID_SYNC();
  ln_phase(z, p.ln_g + 0 * D, p.ln_b + 0 * D, (float*)p.slot[3], mod0, 3, 4, S[5], bid, nblk);
  GRID_SYNC();

#pragma unroll
  for (int layer = 0; layer < 2; ++layer) {
    const float* modl = layer == 0 ? mod0 : mod1;
    const bf16_t* hp = S[5];
    bf16_t* q = (bf16_t*)p.slot[1];
    unsigned* lists = (unsigned*)p.slot[0];
    unsigned* epk = (unsigned*)(p.slot[0] + ((size_t)32 << 20));
    float* gate = (float*)(p.slot[0] + ((size_t)40 << 20));
    const bf16_t* WqT = p.WqT + (size_t)layer * 2048 * D; const bf16_t* Keys = p.KeysB + (size_t)layer * 16 * 128 * 128;
    for (int it = bid; it < 256 * 16; it += nblk) {
      int mt, nt; item_mn(it, 16, mt, nt);
      gemm_tile(mk(hp, D, WqT, D, 2048, D, EPI_BF16, q, 2048), mt * 128, nt * 128, lds);
    }
    GRID_SYNC();
    for (int it = bid; it < 256 * 16; it += nblk) {
      int mt, grp; item_mn(it, 16, mt, grp);
      scores_topk_tile(q, Keys, lists, mt * 128, grp, lds);
    }
    GRID_SYNC();
    combine_phase(lists, (unsigned short*)epk, gate, bid, nblk);
    GRID_SYNC();
    PeerArgs a; a.h2 = hp;
    a.u8 = p.slot[6] + ((size_t)(layer * 32) << 20); a.v8 = a.u8 + ((size_t)16 << 20);
    a.uinv = p.tinv + (layer * 2) * NEXP; a.vinv = a.uinv + NEXP;
    a.epk = epk; a.gate = gate; a.part = (float*)p.slot[1]; a.coef = (float*)p.slot[0];
    a.xres = (const float*)p.slot[3]; a.gate2 = modl + 5 * D; a.z = (float*)p.slot[1];
    a.ctr_u = p.bar + XCD_BAR_WORDS + (layer * 2) * 128; a.ctr_v = a.ctr_u + 128;
    peer_slice_phase<false>(a, lds);
    GRID_SYNC();
    peer_coef_phase(a, bid, nblk);
    GRID_SYNC();
    peer_slice_phase<true>(a, lds);
    GRID_SYNC();
    if (layer == 1) { ln_phase(a.z, p.ln_g + 3 * D, p.ln_b + 3 * D, p.out, mod1, 0, 1, nullptr, bid, nblk); break; }
    ln_phase(a.z, p.ln_g + 1 * D, p.ln_b + 1 * D, (float*)p.slot[3], mod1, 0, 1, S[5], bid, nblk);
    GRID_SYNC();
    const float* x2 = (const float*)p.slot[3];
    bf16_t *hB = S[5], *zin = S[0], *pp = S[1], *yp = S[0];
    for (int it = bid; it < 256 * 8; it += nblk) {
      int mt, nt; item_mn(it, 8, mt, nt);
      gemm_tile(mk(hB, D, p.PinT, D, D, D, EPI_BF16, zin, D), mt * 128, nt * 128, lds);
    }
    GRID_SYNC();
    pool_phase(zin, pp, bid, nblk);
    GRID_SYNC();
    for (int it = bid; it < 256 * 8; it += nblk) {
      int mt, nt; item_mn(it, 8, mt, nt);
      const int gi = nt >> 1, n0 = (nt & 1) * 128;
      gemm_tile(mk(pp + gi * 256, D, p.WgrpT + (size_t)gi * 256 * 256, 256, 256, 256, EPI_SCALE, yp + gi * 256, D, nullptr, p.pl_scale + gi * 256), mt * 128, n0, lds);
    }
    GRID_SYNC();
    float* z1 = (float*)p.slot[1];
    for (int it = bid; it < 256 * 8; it += nblk) {
      int mt, nt; item_mn(it, 8, mt, nt);
      gemm_tile(mk(yp, D, p.PoutT, D, D, D, EPI_Z, z1, D, nullptr, x2, mod1 + 2 * D), mt * 128, nt * 128, lds);
    }
    GRID_SYNC();
    ln_phase(z1, p.ln_g + 2 * D, p.ln_b + 2 * D, (float*)p.slot[3], mod1, 3, 4, S[5], bid, nblk);
    GRID_SYNC();
  }
}

extern "C" void kernel_launch(void* const* d_in, const int* in_sizes, int n_in, void* d_out, int out_size, void* d_ws, size_t ws_size, hipStream_t stream) {
  Params p{};
  const float** ip = (const float**)&p.x;
  for (int i = 0; i < 30; ++i) ip[i] = (const float*)d_in[i];
  p.out = (float*)d_out;
  unsigned char* w = (unsigned char*)d_ws; size_t off = 0;
  auto take = [&](size_t bytes) { unsigned char* r = w + off; off += (bytes + 255) & ~(size_t)255; return r; };
  p.bar = (unsigned*)take(16384);
  p.mod = (float*)take((size_t)2 * NB * 6144 * 4);
  p.WT_rkv = (bf16_t*)take((size_t)3 * D * D * 2);
  p.W1T = (bf16_t*)take((size_t)128 * D * 2); p.A1T = (bf16_t*)take((size_t)128 * D * 2); p.G1T = (bf16_t*)take((size_t)256 * D * 2);
  p.W2T = (bf16_t*)take((size_t)D * 64 * 2); p.A2T = (bf16_t*)take((size_t)D * 64 * 2); p.G2T = (bf16_t*)take((size_t)D * 192 * 2);
  p.WoT = (bf16_t*)take((size_t)D * D * 2); p.PinT = (bf16_t*)take((size_t)D * D * 2); p.PoutT = (bf16_t*)take((size_t)D * D * 2);
  p.WgrpT = (bf16_t*)take((size_t)4 * 256 * 256 * 2); p.WqT = (bf16_t*)take((size_t)2 * 2048 * D * 2); p.KeysB = (bf16_t*)take((size_t)2 * 16 * 128 * 128 * 2);
  p.tinv = (float*)take((size_t)4 * NEXP * 4);
  for (int i = 0; i < 7; ++i) p.slot[i] = take((size_t)64 << 20);
  if (off > ws_size) return;

  static int grid_blocks = 0;
  if (!grid_blocks) {
    int dev = 0, cus = 0, per_cu = 0;
    hipGetDevice(&dev);
    hipDeviceGetAttribute(&cus, hipDeviceAttributeMultiprocessorCount, dev);
    hipOccupancyMaxActiveBlocksPerMultiprocessor(&per_cu, mega, 256, 0);
    if (per_cu > 2) per_cu = 2;
    if (per_cu < 1) per_cu = 1;
    grid_blocks = cus * per_cu;
  }
  hipMemsetAsync(p.bar, 0, 16384, stream);
  void* args[] = {&p};
  hipLaunchCooperativeKernel((void*)mega, dim3(grid_blocks), dim3(256), args, 0, stream);
}
```

```cpp
#include <hip/hip_runtime.h>
#include <hip/hip_cooperative_groups.h>
#include <stdint.h>
#include <stddef.h>
namespace cg = cooperative_groups;

typedef unsigned short bf16_t;
typedef short bf16x8 __attribute__((ext_vector_type(8)));
typedef float f32x4 __attribute__((ext_vector_type(4)));
typedef float f32x2 __attribute__((ext_vector_type(2)));
typedef unsigned u32x4 __attribute__((ext_vector_type(4)));
typedef unsigned u32x2 __attribute__((ext_vector_type(2)));
#define DI __device__ __forceinline__

constexpr int D = 1024, NB = 8, SEQ = 4096, T = NB * SEQ;
constexpr int NH = 16, HS = 64;
constexpr int NEXP = 16384;
constexpr float ALPHA = 1.4142135623730951f;
constexpr float LN_EPS = 1e-5f, GN_EPS = 64e-5f;
constexpr int LDS_BYTES = 72 * 1024;

typedef __bf16 bf16x2_t __attribute__((ext_vector_type(2)));
DI unsigned cvt_pk_bf16(float lo, float hi) { const f32x2 v = {lo, hi}; return __builtin_bit_cast(unsigned, __builtin_convertvector(v, bf16x2_t)); }
DI float bf_lo(unsigned u) { return __uint_as_float(u << 16); }
DI float bf_hi(unsigned u) { return __uint_as_float(u & 0xffff0000u); }
DI bf16_t f2bf(float f) { unsigned u = __float_as_uint(f); u += 0x7fffu + ((u >> 16) & 1u); return (bf16_t)(u >> 16); }
DI float sigmoidf_(float x) { return 1.f / (1.f + __expf(-x)); }
DI float wave_sum(float v) {
#pragma unroll
  for (int o = 32; o >= 1; o >>= 1) v += __shfl_xor(v, o);
  return v;
}
DI int opaque_v(int x) { asm volatile("" : "+v"(x)); return x; }
DI float gelu_exact(float v) { return 0.5f * v * (1.f + erff(v * 0.70710678118654752f)); }

#define XB_TMO      128
#define XB_XCNT(j)  (256  + 64 * (j))
#define XB_XSUB(j)  (1280 + 64 * (j))
#define XB_XGEN(j)  (2304 + 64 * (j))
#define XB_TOP      3328
#define XB_TOPGEN   3392
#define XCD_BAR_WORDS 3456
#define XB_SPIN_CAP (1u << 22)
#define LAS __attribute__((address_space(3)))
DI unsigned xb_ld(unsigned* p)              { return __hip_atomic_load(p, __ATOMIC_RELAXED, __HIP_MEMORY_SCOPE_AGENT); }
DI unsigned xb_add(unsigned* p, unsigned v) { return __hip_atomic_fetch_add(p, v, __ATOMIC_RELAXED, __HIP_MEMORY_SCOPE_AGENT); }
DI unsigned xb_xcc_id() { return (unsigned)__builtin_amdgcn_s_getreg((3 << 11) | 20) & 0xFu; }
#define XB_SPIN(cond, bar) do { unsigned _sp = 0; while (cond) { __builtin_amdgcn_s_sleep(1); \
    if ((++_sp & 255u) == 0u) { if (xb_ld(&(bar)[XB_TMO])) break; if (_sp > XB_SPIN_CAP) { atomicAdd(&(bar)[XB_TMO], 1u); break; } } } } while (0)
struct XcdBarrier { unsigned* bar; unsigned x; volatile LAS unsigned* st; };
DI XcdBarrier xcd_barrier_post(unsigned* bar, volatile LAS unsigned* st) {
  XcdBarrier b; b.bar = bar; b.x = xb_xcc_id(); b.st = st;
  if (threadIdx.x == 0) (void)xb_add(&bar[XB_XCNT(b.x)], 1u);
  return b;
}
DI void xcd_barrier_complete(unsigned* bar, unsigned x, unsigned& nloc, unsigned& nx) {
  const unsigned G = gridDim.x * gridDim.y * gridDim.z;
  unsigned sum, cnt, mine, sp = 0u;
  for (;;) {
    sum = 0u; cnt = 0u; mine = 0u;
#pragma unroll
    for (unsigned j = 0; j < 16; ++j) { const unsigned c = xb_ld(&bar[XB_XCNT(j)]); sum += c; cnt += (c > 0u) ? 1u : 0u; mine = (j == x) ? c : mine; }
    if (sum == G) break;
    __builtin_amdgcn_s_sleep(1);
    if ((++sp & 255u) == 0u) { if (xb_ld(&bar[XB_TMO])) break; if (sp > XB_SPIN_CAP) { atomicAdd(&bar[XB_TMO], 1u); break; } }
  }
  nloc = mine > 0u ? mine : 1u; nx = cnt > 0u ? cnt : 1u;
}
DI void xcd_barrier(const XcdBarrier& b) {
  asm volatile("s_waitcnt vmcnt(0)" ::: "memory");
  __syncthreads();
  if (threadIdx.x == 0) {
    unsigned* bar = b.bar;
    __builtin_amdgcn_s_waitcnt(0);
    unsigned nloc = b.st[0], nx = b.st[1];
    if (nloc == 0u) { xcd_barrier_complete(bar, b.x, nloc, nx); b.st[0] = nloc; b.st[1] = nx; }
    const unsigned old = xb_add(&bar[XB_XSUB(b.x)], 1u);
    const unsigned gen = old / nloc;
    if (old + 1u == (gen + 1u) * nloc) {
      __builtin_amdgcn_fence(__ATOMIC_RELEASE, "agent");
      asm volatile("s_waitcnt vmcnt(0)" ::: "memory");
      const unsigned og = xb_add(&bar[XB_TOP], 1u);
      const unsigned tg = og / nx;
      if (og + 1u == (tg + 1u) * nx) xb_add(&bar[XB_TOPGEN], 1u);
      else XB_SPIN(xb_ld(&bar[XB_TOPGEN]) == tg, bar);
      __builtin_amdgcn_fence(__ATOMIC_ACQUIRE, "agent");
      xb_add(&bar[XB_XGEN(b.x)], 1u);
      asm volatile("s_waitcnt vmcnt(0)" ::: "memory");
    } else {
      XB_SPIN(xb_ld(&bar[XB_XGEN(b.x)]) == gen, bar);
      __builtin_amdgcn_fence(__ATOMIC_ACQUIRE, "agent");
      asm volatile("s_waitcnt vmcnt(0)" ::: "memory");
    }
  }
  __syncthreads();
}

struct Params {
  const float *x, *c, *ada_w, *ada_b, *ln_g, *ln_b, *rw_mu, *rw_w_rkv, *rw_w0, *rw_w1, *rw_w2, *rw_a0, *rw_a1, *rw_a2, *rw_g1, *rw_g2,
      *rw_k_k, *rw_k_a, *rw_r_k, *rw_lnx_g, *rw_lnx_b, *rw_w_o, *pl_w_in, *pl_w_grp, *pl_scale, *pl_w_out, *pe_w_q, *pe_keys, *pe_u, *pe_v;
  float* out;
  float* mod;
  bf16_t *WT_rkv, *W1T, *A1T, *G1T, *W2T, *A2T, *G2T, *WoT, *PinT, *PoutT, *WgrpT, *WqT, *KeysB;
  unsigned char* slot[7];
  float* tinv;
  bf16_t* lora_tmp;
  float* Gg;
  unsigned* bar;
};

DI void mod_item(const Params& p, int item, unsigned char* lds) {
  float* cond = (float*)lds;
  float (*red)[NB][32] = (float (*)[NB][32])(lds + 32768);
  const int tid = opaque_v(threadIdx.x);
  for (int i = tid; i < NB * D; i += 256) { float v = p.c[i]; cond[i] = v / (1.f + __expf(-v)); }
  __syncthreads();
  const int l = item / 192, cb = item % 192;
  const int col = cb * 32 + (tid & 31), kg = tid >> 5;
  const float* w = p.ada_w + (size_t)l * D * 6144 + col;
  float acc[NB];
#pragma unroll
  for (int b = 0; b < NB; ++b) acc[b] = 0.f;
  for (int k = kg * 128; k < kg * 128 + 128; ++k) {
    const float wv = w[(size_t)k * 6144];
#pragma unroll
    for (int b = 0; b < NB; ++b) acc[b] += cond[b * D + k] * wv;
  }
#pragma unroll
  for (int b = 0; b < NB; ++b) red[kg][b][tid & 31] = acc[b];
  __syncthreads();
  {
    const int b = tid >> 5, cc = tid & 31;
    float s = 0.f;
#pragma unroll
    for (int g = 0; g < 8; ++g) s += red[g][b][cc];
    const int n = cb * 32 + cc;
    p.mod[((size_t)l * NB + b) * 6144 + n] = s + p.ada_b[l * 6144 + n];
  }
  __syncthreads();
}

DI void transpose_item(const float* __restrict__ src, bf16_t* __restrict__ dst, int K, int N, int Kpad, int Npad, size_t sbs, size_t dbs, int item, unsigned char* lds) {
  float (*tile)[33] = (float (*)[33])lds;
  const int nb_n = Npad / 32, nb_k = Kpad / 32;
  const int per = nb_n * nb_k;
  const int bz = item / per, r = item % per;
  const int bk = r / nb_n, bn = r % nb_n;
  src += bz * sbs; dst += bz * dbs;
  const int tq = opaque_v(threadIdx.x); const int tx = tq & 31, ty = tq >> 5;
#pragma unroll
  for (int i = 0; i < 4; ++i) {
    const int k = bk * 32 + ty + i * 8, n = bn * 32 + tx;
    tile[ty + i * 8][tx] = (k < K && n < N) ? src[(size_t)k * N + n] : 0.f;
  }
  __syncthreads();
#pragma unroll
  for (int i = 0; i < 4; ++i) {
    const int n = bn * 32 + ty + i * 8, k = bk * 32 + tx;
    dst[(size_t)n * Kpad + k] = f2bf(tile[tx][ty + i * 8]);
  }
  __syncthreads();
}
DI void cvt_range(const float* __restrict__ src, bf16_t* __restrict__ dst, size_t n8, int bid, int nblk) {
  const int tq = opaque_v(threadIdx.x);
  for (size_t i = (size_t)bid * 256 + tq; i < n8; i += (size_t)nblk * 256) {
    const f32x4 a = *(const f32x4*)(src + i * 8), b = *(const f32x4*)(src + i * 8 + 4);
    u32x4 o; o.x = cvt_pk_bf16(a[0], a[1]); o.y = cvt_pk_bf16(a[2], a[3]); o.z = cvt_pk_bf16(b[0], b[1]); o.w = cvt_pk_bf16(b[2], b[3]);
    *(u32x4*)(dst + i * 8) = o;
  }
}
DI void prologue_phase(const Params& p, unsigned char* lds, int bid, int nblk) {
  constexpr int total = 384 + 3072 + 128 + 128 + 256 + 64 + 64 + 192 + 1024 + 1024 + 1024 + 256 + 4096;
  for (int it = bid; it < total; it += nblk) {
    int r = it;
    if (r < 384) { mod_item(p, r, lds); continue; } r -= 384;
    if (r < 3072) { transpose_item(p.rw_w_rkv, p.WT_rkv, D, D, D, D, (size_t)D * D, (size_t)D * D, r, lds); continue; } r -= 3072;
    if (r < 128) { transpose_item(p.rw_w1, p.W1T, D, 64, D, 128, 0, 0, r, lds); continue; } r -= 128;
    if (r < 128) { transpose_item(p.rw_a1, p.A1T, D, 64, D, 128, 0, 0, r, lds); continue; } r -= 128;
    if (r < 256) { transpose_item(p.rw_g1, p.G1T, D, 160, D, 256, 0, 0, r, lds); continue; } r -= 256;
    if (r < 64) { transpose_item(p.rw_w2, p.W2T, 64, D, 64, D, 0, 0, r, lds); continue; } r -= 64;
    if (r < 64) { transpose_item(p.rw_a2, p.A2T, 64, D, 64, D, 0, 0, r, lds); continue; } r -= 64;
    if (r < 192) { transpose_item(p.rw_g2, p.G2T, 160, D, 192, D, 0, 0, r, lds); continue; } r -= 192;
    if (r < 1024) { transpose_item(p.rw_w_o, p.WoT, D, D, D, D, 0, 0, r, lds); continue; } r -= 1024;
    if (r < 1024) { transpose_item(p.pl_w_in, p.PinT, D, D, D, D, 0, 0, r, lds); continue; } r -= 1024;
    if (r < 1024) { transpose_item(p.pl_w_out, p.PoutT, D, D, D, D, 0, 0, r, lds); continue; } r -= 1024;
    if (r < 256) { transpose_item(p.pl_w_grp, p.WgrpT, 256, 256, 256, 256, (size_t)256 * 256, (size_t)256 * 256, r, lds); continue; } r -= 256;
    transpose_item(p.pe_w_q, p.WqT, D, 2048, D, 2048, (size_t)D * 2048, (size_t)D * 2048, r, lds);
  }
  cvt_range(p.pe_keys, p.KeysB, (size_t)2 * 16 * 128 * 128 / 8, bid, nblk);
}

DI void modulate_phase(const float* __restrict__ x, const float* __restrict__ mod_l, int shift_idx, int scale_idx, bf16_t* __restrict__ h, int bid, int nblk) {
  const size_t n8 = (size_t)T * D / 8; const int tq = opaque_v(threadIdx.x);
  for (size_t i = (size_t)bid * 256 + tq; i < n8; i += (size_t)nblk * 256) {
    const size_t e = i * 8; const int t = (int)(e / D), d = (int)(e % D), b = t / SEQ;
    const float* sh = mod_l + (size_t)b * 6144 + shift_idx * D + d; const float* sc = mod_l + (size_t)b * 6144 + scale_idx * D + d;
    const f32x4 a0 = *(const f32x4*)(x + e), a1 = *(const f32x4*)(x + e + 4);
    const f32x4 s0 = *(const f32x4*)sh, s1 = *(const f32x4*)(sh + 4), c0 = *(const f32x4*)sc, c1 = *(const f32x4*)(sc + 4);
    const f32x4 r0 = a0 * (c0 + 1.f) + s0, r1 = a1 * (c1 + 1.f) + s1;
    u32x4 o; o.x = cvt_pk_bf16(r0[0], r0[1]); o.y = cvt_pk_bf16(r0[2], r0[3]); o.z = cvt_pk_bf16(r1[0], r1[1]); o.w = cvt_pk_bf16(r1[2], r1[3]);
    *(u32x4*)(h + e) = o;
  }
}

enum { EPI_BF16 = 0, EPI_TANH, EPI_SIGMOID, EPI_LW, EPI_ASIG, EPI_Z, EPI_SCALE, EPI_GATE };
struct GemmArgs {
  const bf16_t* A; int lda;
  const bf16_t* Bt; int ldb;
  int N, K;
  const float* mu;
  int epi; void* out; int ldc;
  const float* v0; const float* v1;
};

DI int lds_off(int row, int chunk) { return row * 128 + ((chunk ^ (row & 7)) << 4); }

DI void gemm_load_a(const GemmArgs& g, int m0, int k0, int tid, u32x4 (&ra)[4]) {
#pragma unroll
  for (int i = 0; i < 4; ++i) {
    const int row = (tid >> 3) + i * 32, ch = tid & 7;
    const int m = m0 + row;
    const bf16_t* src = g.A + (size_t)m * g.lda + k0 + ch * 8;
    u32x4 v = *(const u32x4*)src;
    if (g.mu) {
      u32x4 pv = {0u, 0u, 0u, 0u};
      if ((m % SEQ) != 0) pv = *(const u32x4*)(src - g.lda);
      const f32x4 m0v = *(const f32x4*)(g.mu + k0 + ch * 8), m1v = *(const f32x4*)(g.mu + k0 + ch * 8 + 4);
      const unsigned hu[4] = {v.x, v.y, v.z, v.w}, pu[4] = {pv.x, pv.y, pv.z, pv.w};
      float o[8];
#pragma unroll
      for (int j = 0; j < 4; ++j) {
        const float h0 = bf_lo(hu[j]), h1 = bf_hi(hu[j]), p0 = bf_lo(pu[j]), p1 = bf_hi(pu[j]);
        const float mu0 = (2 * j < 4) ? m0v[(2 * j) & 3] : m1v[(2 * j) & 3], mu1 = (2 * j + 1 < 4) ? m0v[(2 * j + 1) & 3] : m1v[(2 * j + 1) & 3];
        o[2 * j] = h0 + (p0 - h0) * mu0; o[2 * j + 1] = h1 + (p1 - h1) * mu1;
      }
      v.x = cvt_pk_bf16(o[0], o[1]); v.y = cvt_pk_bf16(o[2], o[3]); v.z = cvt_pk_bf16(o[4], o[5]); v.w = cvt_pk_bf16(o[6], o[7]);
    }
    ra[i] = v;
  }
}
DI void gemm_load_b(const GemmArgs& g, int n0, int k0, int tid, u32x4 (&rb)[4]) {
#pragma unroll
  for (int i = 0; i < 4; ++i) {
    const int row = (tid >> 3) + i * 32, ch = tid & 7;
    rb[i] = *(const u32x4*)(g.Bt + (size_t)(n0 + row) * g.ldb + k0 + ch * 8);
  }
}
DI void gemm_store_lds(unsigned char* buf, int tid, const u32x4 (&r)[4]) {
#pragma unroll
  for (int i = 0; i < 4; ++i) {
    const int row = (tid >> 3) + i * 32, ch = tid & 7;
    *(u32x4*)(buf + lds_off(row, ch)) = r[i];
  }
}

DI unsigned f2key(float f) { unsigned u = __float_as_uint(f); return u ^ ((u >> 31) ? 0xffffffffu : 0x80000000u); }
DI float key2f(unsigned k) { unsigned u = (k >> 31) ? (k ^ 0x80000000u) : ~k; return __uint_as_float(u); }
#define CE_DESC(a, b) { const unsigned _mx = max(a, b), _mn = min(a, b); a = _mx; b = _mn; }
DI void sort16_desc(unsigned (&x)[16]) {
#pragma unroll
  for (int k = 2; k <= 16; k <<= 1) {
#pragma unroll
    for (int j = k >> 1; j > 0; j >>= 1) {
#pragma unroll
      for (int i = 0; i < 16; ++i) {
        const int l = i ^ j;
        if (l > i) {
          if ((i & k) == 0) { CE_DESC(x[i], x[l]); } else { CE_DESC(x[l], x[i]); }
        }
      }
    }
  }
}
DI void merge16_desc(unsigned (&x)[16]) {
#pragma unroll
  for (int j = 8; j > 0; j >>= 1) {
#pragma unroll
    for (int i = 0; i < 16; ++i) { const int l = i ^ j; if (l > i) { CE_DESC(x[i], x[l]); } }
  }
}

DI void gemm_tile(const GemmArgs& g, int m0, int n0, unsigned char* lds) {
  constexpr int WM = 2, WN = 4 / WM, TM = 128 / WM, TN = 128 / WN, MI = TM / 16, NI = TN / 16;
  const int tid = opaque_v(threadIdx.x), lane = tid & 63, wid = tid >> 6;
  const int wm = wid / WN, wn = wid % WN;
  const int nk = g.K / 64;
  f32x4 acc[MI][NI];
#pragma unroll
  for (int i = 0; i < MI; ++i)
#pragma unroll
    for (int j = 0; j < NI; ++j) acc[i][j] = (f32x4){0.f, 0.f, 0.f, 0.f};
  u32x4 ra[4], rb[4];
  gemm_load_a(g, m0, 0, tid, ra); gemm_load_b(g, n0, 0, tid, rb);
  gemm_store_lds(lds, tid, ra); gemm_store_lds(lds + 16384, tid, rb);
  __syncthreads();
  const int fr = lane & 15, fq = lane >> 4;
  for (int kt = 0; kt < nk; ++kt) {
    unsigned char* cur = lds + (kt & 1) * 32768;
    if (kt + 1 < nk) { gemm_load_a(g, m0, (kt + 1) * 64, tid, ra); gemm_load_b(g, n0, (kt + 1) * 64, tid, rb); }
#pragma unroll
    for (int ks = 0; ks < 2; ++ks) {
      bf16x8 af[MI], bfr[NI];
#pragma unroll
      for (int i = 0; i < MI; ++i) af[i] = *(const bf16x8*)(cur + lds_off(wm * TM + i * 16 + fr, ks * 4 + fq));
#pragma unroll
      for (int j = 0; j < NI; ++j) bfr[j] = *(const bf16x8*)(cur + 16384 + lds_off(wn * TN + j * 16 + fr, ks * 4 + fq));
#pragma unroll
      for (int i = 0; i < MI; ++i)
#pragma unroll
        for (int j = 0; j < NI; ++j) acc[i][j] = __builtin_amdgcn_mfma_f32_16x16x32_bf16(bfr[j], af[i], acc[i][j], 0, 0, 0);
    }
    if (kt + 1 < nk) { unsigned char* nxt = lds + ((kt + 1) & 1) * 32768; gemm_store_lds(nxt, tid, ra); gemm_store_lds(nxt + 16384, tid, rb); }
    __syncthreads();
  }
#pragma unroll
  for (int i = 0; i < MI; ++i) {
    const int m = m0 + wm * TM + i * 16 + fr;
#pragma unroll
    for (int j = 0; j < NI; ++j) {
      const int n = n0 + wn * TN + j * 16 + fq * 4;
      if (n >= g.N) continue;
      const f32x4 v = acc[i][j];
      bf16_t* ob = (bf16_t*)g.out + (size_t)m * g.ldc + n;
      switch (g.epi) {
        case EPI_BF16: *(u32x2*)ob = (u32x2){cvt_pk_bf16(v[0], v[1]), cvt_pk_bf16(v[2], v[3])}; break;
        case EPI_TANH: *(u32x2*)ob = (u32x2){cvt_pk_bf16(tanhf(v[0]), tanhf(v[1])), cvt_pk_bf16(tanhf(v[2]), tanhf(v[3]))}; break;
        case EPI_SIGMOID: *(u32x2*)ob = (u32x2){cvt_pk_bf16(sigmoidf_(v[0]), sigmoidf_(v[1])), cvt_pk_bf16(sigmoidf_(v[2]), sigmoidf_(v[3]))}; break;
        case EPI_LW: {
          const f32x4 w0 = *(const f32x4*)(g.v0 + n); float o[4];
#pragma unroll
          for (int q = 0; q < 4; ++q) { const float xx = -(w0[q] + v[q]); const float sp = fmaxf(xx, 0.f) + log1pf(__expf(-fabsf(xx))); o[q] = -__expf(-sp - 0.5f); }
          *(u32x2*)ob = (u32x2){cvt_pk_bf16(o[0], o[1]), cvt_pk_bf16(o[2], o[3])};
        } break;
        case EPI_ASIG: {
          const f32x4 a0 = *(const f32x4*)(g.v0 + n);
          *(u32x2*)ob = (u32x2){cvt_pk_bf16(sigmoidf_(a0[0] + v[0]), sigmoidf_(a0[1] + v[1])), cvt_pk_bf16(sigmoidf_(a0[2] + v[2]), sigmoidf_(a0[3] + v[3]))};
        } break;
        case EPI_Z: {
          const int b = m / SEQ;
          const f32x4 xv = *(const f32x4*)(g.v0 + (size_t)m * D + n), gt = *(const f32x4*)(g.v1 + (size_t)b * 6144 + n);
          *(f32x4*)((float*)g.out + (size_t)m * g.ldc + n) = xv * ALPHA + gt * v;
        } break;
        case EPI_GATE: {
          const u32x2 yv = *(const u32x2*)ob;
          *(u32x2*)ob = (u32x2){cvt_pk_bf16(bf_lo(yv.x) * v[0], bf_hi(yv.x) * v[1]), cvt_pk_bf16(bf_lo(yv.y) * v[2], bf_hi(yv.y) * v[3])};
        } break;
        default: {
          const f32x4 sc = *(const f32x4*)(g.v0 + n);
          *(u32x2*)ob = (u32x2){cvt_pk_bf16(v[0] * sc[0], v[1] * sc[1]), cvt_pk_bf16(v[2] * sc[2], v[3] * sc[3])};
        } break;
      }
    }
  }
}

DI void scores_topk_tile(const bf16_t* __restrict__ q, const bf16_t* __restrict__ keys, unsigned* __restrict__ lists, int m0, int grp, unsigned char* lds) {
  const int tid = opaque_v(threadIdx.x), lane = tid & 63, wm = tid >> 6, fr = lane & 15, fq = lane >> 4;
#pragma unroll
  for (int hk = 0; hk < 2; ++hk)
#pragma unroll
    for (int i = 0; i < 4; ++i) {
      const int row = (tid >> 3) + i * 32, ch = tid & 7;
      const u32x4 va = *(const u32x4*)(q + (size_t)(m0 + row) * 2048 + grp * 128 + hk * 64 + ch * 8);
      const u32x4 vb = *(const u32x4*)(keys + (size_t)grp * 128 * 128 + (size_t)row * 128 + hk * 64 + ch * 8);
      *(u32x4*)(lds + hk * 16384 + lds_off(row, ch)) = va;
      *(u32x4*)(lds + 32768 + hk * 16384 + lds_off(row, ch)) = vb;
    }
  __syncthreads();
  f32x4 acc[2][8];
#pragma unroll
  for (int i = 0; i < 2; ++i)
#pragma unroll
    for (int j = 0; j < 8; ++j) acc[i][j] = (f32x4){0.f, 0.f, 0.f, 0.f};
#pragma unroll
  for (int kk = 0; kk < 4; ++kk) {
    const int hk = kk >> 1, ks = kk & 1;
    bf16x8 af[2];
#pragma unroll
    for (int i = 0; i < 2; ++i) af[i] = *(const bf16x8*)(lds + hk * 16384 + lds_off(wm * 32 + i * 16 + fr, ks * 4 + fq));
#pragma unroll
    for (int j = 0; j < 8; ++j) {
      const bf16x8 bfr = *(const bf16x8*)(lds + 32768 + hk * 16384 + lds_off(j * 16 + fr, ks * 4 + fq));
#pragma unroll
      for (int i = 0; i < 2; ++i) acc[i][j] = __builtin_amdgcn_mfma_f32_16x16x32_bf16(bfr, af[i], acc[i][j], 0, 0, 0);
    }
  }
  __syncthreads();
  constexpr int MI = 2, NI = 8, TM = 32;
  {
#pragma unroll
    for (int i = 0; i < MI; ++i)
#pragma unroll
      for (int j = 0; j < NI; ++j) {
        const int ml = wm * TM + i * 16 + fr, c = j * 4 + fq;
        u32x4 kv;
        kv.x = (f2key(acc[i][j][0]) & ~127u) | (unsigned)(127 - (c * 4 + 0)); kv.y = (f2key(acc[i][j][1]) & ~127u) | (unsigned)(127 - (c * 4 + 1));
        kv.z = (f2key(acc[i][j][2]) & ~127u) | (unsigned)(127 - (c * 4 + 2)); kv.w = (f2key(acc[i][j][3]) & ~127u) | (unsigned)(127 - (c * 4 + 3));
        *(u32x4*)(lds + ml * 528 + (c << 4)) = kv;
      }
    __syncthreads();
    {
      const int ml = wm * 32 + (lane & 31), hf = lane >> 5;
      unsigned a[16], b[16];
#pragma unroll
      for (int ch = 0; ch < 4; ++ch) {
#pragma unroll
        for (int cc = 0; cc < 4; ++cc) {
          const int c = hf * 16 + ch * 4 + cc;
          const u32x4 kv = *(const u32x4*)(lds + ml * 528 + (c << 4));
          b[cc * 4] = kv.x; b[cc * 4 + 1] = kv.y; b[cc * 4 + 2] = kv.z; b[cc * 4 + 3] = kv.w;
        }
        sort16_desc(b);
        if (ch == 0) {
#pragma unroll
          for (int e = 0; e < 16; ++e) a[e] = b[e];
        } else {
#pragma unroll
          for (int e = 0; e < 16; ++e) a[e] = max(a[e], b[15 - e]);
          merge16_desc(a);
        }
      }
#pragma unroll
      for (int e = 0; e < 16; ++e) b[e] = (unsigned)__shfl_xor((int)a[e], 32);
#pragma unroll
      for (int e = 0; e < 16; ++e) a[e] = max(a[e], b[15 - e]);
      merge16_desc(a);
      if (hf == 0) {
        const int m = m0 + ml;
        u32x4* dst = (u32x4*)(lists + ((size_t)m * 16 + grp) * 16);
        dst[0] = (u32x4){a[0], a[1], a[2], a[3]}; dst[1] = (u32x4){a[4], a[5], a[6], a[7]};
        dst[2] = (u32x4){a[8], a[9], a[10], a[11]}; dst[3] = (u32x4){a[12], a[13], a[14], a[15]};
      }
    }
    __syncthreads();
  }
}

DI GemmArgs mk(const bf16_t* A, int lda, const bf16_t* Bt, int ldb, int N, int K, int epi, void* out, int ldc,
               const float* mu = nullptr, const float* v0 = nullptr, const float* v1 = nullptr) {
  GemmArgs g; g.A = A; g.lda = lda; g.Bt = Bt; g.ldb = ldb; g.N = N; g.K = K; g.mu = mu; g.epi = epi; g.out = out; g.ldc = ldc; g.v0 = v0; g.v1 = v1; return g;
}
DI void item_mn(int item, int ntn, int& mt, int& nt) { const int grp = item / (8 * ntn), w = item % (8 * ntn); mt = grp * 8 + (w & 7); nt = w >> 3; }

constexpr int CL = 32;
constexpr int NCH = SEQ / CL;
constexpr int SN = 144, ST = 80;
struct ScanArgs {
  bf16_t* r; const bf16_t *k, *v, *lw, *a;
  const float *k_k, *k_a, *r_k, *lnx_g, *lnx_b;
  bf16_t* Pg;
  bf16_t *Qz0, *Qz1;
  float* Gg;
};
DI f32x4 tile_mm(const unsigned char* P, int ps, const unsigned char* Q, int qs, int i0, int j0, int nks, f32x4 acc, int lane) {
  const int fr = lane & 15, fq = lane >> 4;
  for (int ks = 0; ks < nks; ++ks) {
    const bf16x8 pa = *(const bf16x8*)(P + (i0 + fr) * ps + ks * 64 + fq * 16);
    const bf16x8 qb = *(const bf16x8*)(Q + (j0 + fr) * qs + ks * 64 + fq * 16);
    acc = __builtin_amdgcn_mfma_f32_16x16x32_bf16(pa, qb, acc, 0, 0, 0);
  }
  return acc;
}
DI bf16_t* qz_ptr(const ScanArgs& s, int ch) { return ((ch >> 13) ? s.Qz1 : s.Qz0) + (size_t)(ch & 8191) * 4096; }
DI void st_bf16x4(unsigned char* p, const f32x4& v) { *(u32x2*)p = (u32x2){cvt_pk_bf16(v[0], v[1]), cvt_pk_bf16(v[2], v[3])}; }

template <bool PHASE_C>
DI void scan_load(const ScanArgs& s, size_t gbase, int h, unsigned char* lds, float* lwbuf, unsigned char* At, unsigned char* Bt, unsigned char* Kt, unsigned char* Rt,
                  unsigned char* AtT, unsigned char* BhT, unsigned char* KhT, unsigned char* VT, float& bonus, float (&vout)[8], float* Gout) {
  const int tid = opaque_v(threadIdx.x), tt = tid >> 3, c0 = (tid & 7) * 8;
  const size_t off = gbase + (size_t)tt * D + c0;
  const u32x4 vk = *(const u32x4*)(s.k + off), vv = *(const u32x4*)(s.v + off), vw = *(const u32x4*)(s.lw + off), va = *(const u32x4*)(s.a + off);
  u32x4 vr = {0u, 0u, 0u, 0u};
  if (PHASE_C) vr = *(const u32x4*)(s.r + off);
  float fr_[8], fk[8], fv[8], fw[8], fa[8];
  { const unsigned ur[4] = {vr.x, vr.y, vr.z, vr.w}, uk[4] = {vk.x, vk.y, vk.z, vk.w}, uv[4] = {vv.x, vv.y, vv.z, vv.w}, uw[4] = {vw.x, vw.y, vw.z, vw.w}, ua[4] = {va.x, va.y, va.z, va.w};
#pragma unroll
    for (int j = 0; j < 4; ++j) {
      fr_[2 * j] = bf_lo(ur[j]); fr_[2 * j + 1] = bf_hi(ur[j]); fk[2 * j] = bf_lo(uk[j]); fk[2 * j + 1] = bf_hi(uk[j]);
      fv[2 * j] = bf_lo(uv[j]); fv[2 * j + 1] = bf_hi(uv[j]); fw[2 * j] = bf_lo(uw[j]); fw[2 * j + 1] = bf_hi(uw[j]);
      fa[2 * j] = bf_lo(ua[j]); fa[2 * j + 1] = bf_hi(ua[j]);
    } }
#pragma unroll
  for (int j = 0; j < 8; ++j) lwbuf[tt * 64 + c0 + j] = fw[j];
  float kkr[8], nrm = 0.f, bon = 0.f, kp[8];
#pragma unroll
  for (int j = 0; j < 8; ++j) {
    const int ch = h * HS + c0 + j;
    kkr[j] = fk[j] * s.k_k[ch]; nrm += kkr[j] * kkr[j];
    kp[j] = fk[j] * (1.f + (fa[j] - 1.f) * s.k_a[ch]);
    if (PHASE_C) bon += fr_[j] * kp[j] * s.r_k[ch];
  }
  nrm += __shfl_xor(nrm, 1); nrm += __shfl_xor(nrm, 2); nrm += __shfl_xor(nrm, 4);
  if (PHASE_C) { bon += __shfl_xor(bon, 1); bon += __shfl_xor(bon, 2); bon += __shfl_xor(bon, 4); }
  bonus = bon;
  const float inv = rsqrtf(fmaxf(nrm, 1e-24f));
  __syncthreads();
  {
    const int c = tid & 63, sg = tid >> 6;
    float run = 0.f;
#pragma unroll
    for (int i = 0; i < 8; ++i) { run += lwbuf[(sg * 8 + i) * 64 + c]; lwbuf[(sg * 8 + i) * 64 + c] = run; }
  }
  __syncthreads();
  float cum[8], cl[8];
#pragma unroll
  for (int j = 0; j < 8; ++j) {
    const int c = c0 + j;
    const float s0 = lwbuf[7 * 64 + c], s1 = lwbuf[15 * 64 + c], s2 = lwbuf[23 * 64 + c], s3 = lwbuf[31 * 64 + c];
    const int sg = tt >> 3;
    const float pre = (sg > 0 ? s0 : 0.f) + (sg > 1 ? s1 : 0.f) + (sg > 2 ? s2 : 0.f);
    cum[j] = lwbuf[tt * 64 + c] + pre; cl[j] = s0 + s1 + s2 + s3;
  }
  float at[8], bt[8], kt[8], rt[8], bh[8], kh[8];
#pragma unroll
  for (int j = 0; j < 8; ++j) {
    const float kk = kkr[j] * inv, bb = kk * fa[j];
    const float ein = __expf(cum[j]), eneg = __expf(-cum[j]), eex = __expf(cum[j] - fw[j]), eend = __expf(cl[j] - cum[j]);
    at[j] = -kk * eex; bt[j] = bb * eneg; kt[j] = kp[j] * eneg; rt[j] = fr_[j] * ein; bh[j] = bb * eend; kh[j] = kp[j] * eend;
    vout[j] = fv[j];
  }
  *(u32x4*)(At + tt * SN + c0 * 2) = (u32x4){cvt_pk_bf16(at[0], at[1]), cvt_pk_bf16(at[2], at[3]), cvt_pk_bf16(at[4], at[5]), cvt_pk_bf16(at[6], at[7])};
  *(u32x4*)(Bt + tt * SN + c0 * 2) = (u32x4){cvt_pk_bf16(bt[0], bt[1]), cvt_pk_bf16(bt[2], bt[3]), cvt_pk_bf16(bt[4], bt[5]), cvt_pk_bf16(bt[6], bt[7])};
  *(u32x4*)(Kt + tt * SN + c0 * 2) = (u32x4){cvt_pk_bf16(kt[0], kt[1]), cvt_pk_bf16(kt[2], kt[3]), cvt_pk_bf16(kt[4], kt[5]), cvt_pk_bf16(kt[6], kt[7])};
  if (PHASE_C) *(u32x4*)(Rt + tt * SN + c0 * 2) = (u32x4){cvt_pk_bf16(rt[0], rt[1]), cvt_pk_bf16(rt[2], rt[3]), cvt_pk_bf16(rt[4], rt[5]), cvt_pk_bf16(rt[6], rt[7])};
#pragma unroll
  for (int j = 0; j < 8; ++j) {
    *(bf16_t*)(VT + (c0 + j) * ST + tt * 2) = f2bf(fv[j]);
    if (!PHASE_C) {
      *(bf16_t*)(AtT + (c0 + j) * ST + tt * 2) = f2bf(at[j]);
      *(bf16_t*)(BhT + (c0 + j) * ST + tt * 2) = f2bf(bh[j]);
      *(bf16_t*)(KhT + (c0 + j) * ST + tt * 2) = f2bf(kh[j]);
    }
  }
  if (!PHASE_C && tt == 0 && Gout) {
#pragma unroll
    for (int j = 0; j < 8; ++j) Gout[c0 + j] = __expf(cl[j]);
  }
}
DI void scan_tinv(const float* A32, unsigned char* Tm, int lane) {
  const int c = lane & 31;
  float Tc[32];
#pragma unroll
  for (int i = 0; i < 32; ++i) {
    float sacc = (i == c) ? 1.f : 0.f;
#pragma unroll
    for (int j4 = 0; j4 < (i + 3) / 4; ++j4) {
      const f32x4 a4 = *(const f32x4*)(A32 + i * 36 + j4 * 4);
#pragma unroll
      for (int q = 0; q < 4; ++q) if (j4 * 4 + q < i) sacc += a4[q] * Tc[j4 * 4 + q];
    }
    Tc[i] = sacc;
  }
  if (lane < 32) {
#pragma unroll
    for (int i = 0; i < 32; ++i) *(bf16_t*)(Tm + i * ST + c * 2) = f2bf(Tc[i]);
  }
}

DI void scan_phaseA_item(const ScanArgs& s, int item, unsigned char* lds) {
  const int c = item & (NCH - 1), h = (item >> 7) & 15, b = item >> 11;
  const int tid = opaque_v(threadIdx.x), lane = tid & 63, wv = tid >> 6, fr = lane & 15, fq = lane >> 4;
  unsigned char* At = lds; unsigned char* Bt = At + 32 * SN; unsigned char* Kt = Bt + 32 * SN;
  unsigned char* AtT = Kt + 32 * SN; unsigned char* BhT = AtT + 64 * ST; unsigned char* KhT = BhT + 64 * ST; unsigned char* VT = KhT + 64 * ST;
  unsigned char* Tm = VT + 64 * ST; unsigned char* Aak = Tm + 32 * ST;
  float* A32 = (float*)(Aak + 32 * ST);
  unsigned char* W1T = (unsigned char*)A32 + 4608; unsigned char* M2T = W1T + 64 * ST; unsigned char* UlT = M2T + 64 * ST;
  float* lwbuf = (float*)W1T;
  const size_t gbase = ((size_t)b * SEQ + (size_t)c * CL) * D + h * HS;
  float bonus; float vv8[8];
  scan_load<false>(s, gbase, h, lds, lwbuf, At, Bt, Kt, nullptr, AtT, BhT, KhT, VT, bonus, vv8, s.Gg + (size_t)item * 64);
  __syncthreads();
  {
    const int mat = wv >> 1, ti = wv & 1;
#pragma unroll
    for (int tj = 0; tj < 2; ++tj) {
      const f32x4 x = tile_mm(At, SN, mat ? Kt : Bt, SN, ti * 16, tj * 16, 2, (f32x4){0.f, 0.f, 0.f, 0.f}, lane);
#pragma unroll
      for (int q = 0; q < 4; ++q) {
        const int i = ti * 16 + fq * 4 + q, j = tj * 16 + fr;
        const float val = (j < i) ? x[q] : 0.f;
        if (mat == 0) A32[i * 36 + j] = val; else *(bf16_t*)(Aak + i * ST + j * 2) = f2bf(val);
      }
    }
  }
  __syncthreads();
  if (wv == 0) scan_tinv(A32, Tm, lane);
  else {
    for (int tile = wv - 1; tile < 8; tile += 3) {
      const int ti = tile >> 2, tv = tile & 3;
      const f32x4 x = tile_mm(Aak, ST, VT, ST, ti * 16, tv * 16, 1, (f32x4){0.f, 0.f, 0.f, 0.f}, lane);
      st_bf16x4(M2T + (tv * 16 + fr) * ST + (ti * 16 + fq * 4) * 2, x);
    }
  }
  __syncthreads();
#pragma unroll
  for (int u = 0; u < 4; ++u) {
    const int tile = wv * 4 + u, which = tile >> 3, ti = (tile >> 2) & 1, tn = tile & 3;
    const f32x4 x = tile_mm(Tm, ST, which ? M2T : AtT, ST, ti * 16, tn * 16, 1, (f32x4){0.f, 0.f, 0.f, 0.f}, lane);
    st_bf16x4((which ? UlT : W1T) + (tn * 16 + fr) * ST + (ti * 16 + fq * 4) * 2, x);
  }
  __syncthreads();
  bf16_t* Pg = s.Pg + (size_t)item * 4096; bf16_t* Qg = qz_ptr(s, item);
#pragma unroll
  for (int u = 0; u < 4; ++u) {
    const int tile = wv * 4 + u, tk = tile >> 2, tn = tile & 3;
    const f32x4 xp = tile_mm(W1T, ST, BhT, ST, tk * 16, tn * 16, 1, (f32x4){0.f, 0.f, 0.f, 0.f}, lane);
    *(u32x2*)(Pg + (tn * 16 + fr) * 64 + tk * 16 + fq * 4) = (u32x2){cvt_pk_bf16(xp[0], xp[1]), cvt_pk_bf16(xp[2], xp[3])};
    f32x4 xq = tile_mm(BhT, ST, UlT, ST, tk * 16, tn * 16, 1, (f32x4){0.f, 0.f, 0.f, 0.f}, lane);
    xq = tile_mm(KhT, ST, VT, ST, tk * 16, tn * 16, 1, xq, lane);
    __hip_atomic_store((unsigned long long*)(Qg + ((tk * 4 + tn) * 64 + lane) * 4), (unsigned long long)cvt_pk_bf16(xq[0], xq[1]) | ((unsigned long long)cvt_pk_bf16(xq[2], xq[3]) << 32), __ATOMIC_RELAXED, __HIP_MEMORY_SCOPE_AGENT);
  }
  __syncthreads();
}

constexpr int PSTR = 144;
constexpr int RSLOT = 64 * PSTR + 8192 + 256;
DI void scan_chain_block(const ScanArgs& s, int bh, unsigned char* lds) {
  const int tid = opaque_v(threadIdx.x), lane = tid & 63, tv = tid >> 6, fr = lane & 15, fq = lane >> 4;
  const int ch0 = bh * NCH;
  u32x4 pr[5];
  auto issue = [&](int c) {
    const bf16_t* Pg = s.Pg + (size_t)(ch0 + c) * 4096; const bf16_t* Qg = qz_ptr(s, ch0 + c);
    pr[0] = *(const u32x4*)(Pg + (size_t)tid * 8); pr[1] = *(const u32x4*)(Pg + (size_t)(tid + 256) * 8);
    pr[2] = *(const u32x4*)(Qg + (size_t)tid * 8); pr[3] = *(const u32x4*)(Qg + (size_t)(tid + 256) * 8);
    if (tid < 16) pr[4] = *(const u32x4*)(s.Gg + (size_t)(ch0 + c) * 64 + tid * 4);
  };
  auto commit = [&](int c) {
    unsigned char* sl = lds + (c & 3) * RSLOT;
    *(u32x4*)(sl + (tid >> 3) * PSTR + (tid & 7) * 16) = pr[0]; *(u32x4*)(sl + ((tid + 256) >> 3) * PSTR + (tid & 7) * 16) = pr[1];
    *(u32x4*)(sl + 64 * PSTR + tid * 16) = pr[2]; *(u32x4*)(sl + 64 * PSTR + (tid + 256) * 16) = pr[3];
    if (tid < 16) *(u32x4*)(sl + 64 * PSTR + 8192 + tid * 16) = pr[4];
  };
  issue(0); commit(0); issue(1); commit(1); issue(2); commit(2);
  __syncthreads();
  f32x4 Z[4];
#pragma unroll
  for (int t = 0; t < 4; ++t) Z[t] = (f32x4){0.f, 0.f, 0.f, 0.f};
  for (int c = 0; c < NCH; ++c) {
    if (c + 3 < NCH) issue(c + 3);
    const unsigned char* sl = lds + (c & 3) * RSLOT;
    bf16_t* Zo = qz_ptr(s, ch0 + c) + (tv * 16 + fr) * 64;
    unsigned zp[4][2];
#pragma unroll
    for (int t = 0; t < 4; ++t) { zp[t][0] = cvt_pk_bf16(Z[t][0], Z[t][1]); zp[t][1] = cvt_pk_bf16(Z[t][2], Z[t][3]); *(u32x2*)(Zo + t * 16 + fq * 4) = (u32x2){zp[t][0], zp[t][1]}; }
    bf16x8 zb[2];
#pragma unroll
    for (int ks = 0; ks < 2; ++ks) { const u32x4 w = {zp[2 * ks][0], zp[2 * ks][1], zp[2 * ks + 1][0], zp[2 * ks + 1][1]}; zb[ks] = __builtin_bit_cast(bf16x8, w); }
#pragma unroll
    for (int t = 0; t < 4; ++t) {
      const u32x2 qv = *(const u32x2*)(sl + 64 * PSTR + ((t * 4 + tv) * 64 + lane) * 8);
      const f32x4 g4 = *(const f32x4*)(sl + 64 * PSTR + 8192 + (t * 16 + fq * 4) * 4);
      f32x4 acc = (f32x4){bf_lo(qv.x) + g4[0] * Z[t][0], bf_hi(qv.x) + g4[1] * Z[t][1], bf_lo(qv.y) + g4[2] * Z[t][2], bf_hi(qv.y) + g4[3] * Z[t][3]};
#pragma unroll
      for (int ks = 0; ks < 2; ++ks) {
        const unsigned char* prow = sl + (t * 16 + fr) * PSTR + ks * 64 + fq * 8;
        const u32x2 p0 = *(const u32x2*)prow, p1 = *(const u32x2*)(prow + 32);
        const u32x4 w = {p0.x, p0.y, p1.x, p1.y};
        acc = __builtin_amdgcn_mfma_f32_16x16x32_bf16(__builtin_bit_cast(bf16x8, w), zb[ks], acc, 0, 0, 0);
      }
      Z[t] = acc;
    }
    if (c + 3 < NCH) commit(c + 3);
    __syncthreads();
  }
}

DI void scan_phaseC_item(const ScanArgs& s, int item, unsigned char* lds) {
  const int c = item & (NCH - 1), h = (item >> 7) & 15, b = item >> 11;
  const int tid = opaque_v(threadIdx.x), lane = tid & 63, wv = tid >> 6, fr = lane & 15, fq = lane >> 4;
  unsigned char* At = lds; unsigned char* Bt = At + 32 * SN; unsigned char* Kt = Bt + 32 * SN; unsigned char* Rt = Kt + 32 * SN;
  unsigned char* VT = Rt + 32 * SN;
  unsigned char* Tm = VT + 64 * ST; unsigned char* Aak = Tm + 32 * ST; unsigned char* Arb = Aak + 32 * ST; unsigned char* Ark = Arb + 32 * ST;
  float* A32 = (float*)(Ark + 32 * ST);
  unsigned char* S0 = (unsigned char*)A32 + 4608;
  unsigned char* X1T = S0 + 64 * SN; unsigned char* UT = X1T + 64 * ST;
  float* Yb = (float*)(UT + 64 * ST);
  float* lwbuf = Yb;
  const size_t gbase = ((size_t)b * SEQ + (size_t)c * CL) * D + h * HS;
  float bonus; float vv8[8];
  {
    const bf16_t* Zg = qz_ptr(s, item);
#pragma unroll
    for (int i = 0; i < 2; ++i) { const int e = (tid + i * 256) * 8, vr = e >> 6, kc = e & 63; *(u32x4*)(S0 + vr * SN + kc * 2) = *(const u32x4*)(Zg + e); }
  }
  scan_load<true>(s, gbase, h, lds, lwbuf, At, Bt, Kt, Rt, nullptr, nullptr, nullptr, VT, bonus, vv8, nullptr);
  __syncthreads();
  {
    const unsigned char* Pm = (wv < 2) ? At : Rt; const unsigned char* Qm = (wv & 1) ? Kt : Bt;
    unsigned char* dst = (wv == 1) ? Aak : (wv == 2 ? Arb : Ark);
#pragma unroll
    for (int t4 = 0; t4 < 4; ++t4) {
      const int ti = t4 >> 1, tj = t4 & 1;
      const f32x4 x = tile_mm(Pm, SN, Qm, SN, ti * 16, tj * 16, 2, (f32x4){0.f, 0.f, 0.f, 0.f}, lane);
#pragma unroll
      for (int q = 0; q < 4; ++q) {
        const int i = ti * 16 + fq * 4 + q, j = tj * 16 + fr;
        const bool keep = (wv < 2) ? (j < i) : (j <= i);
        const float val = keep ? x[q] : 0.f;
        if (wv == 0) A32[i * 36 + j] = val; else *(bf16_t*)(dst + i * ST + j * 2) = f2bf(val);
      }
    }
  }
  __syncthreads();
  if (wv == 0) scan_tinv(A32, Tm, lane);
  else {
    for (int tile = wv - 1; tile < 8; tile += 3) {
      const int ti = tile >> 2, tv = tile & 3;
      f32x4 x = tile_mm(At, SN, S0, SN, ti * 16, tv * 16, 2, (f32x4){0.f, 0.f, 0.f, 0.f}, lane);
      x = tile_mm(Aak, ST, VT, ST, ti * 16, tv * 16, 1, x, lane);
      st_bf16x4(X1T + (tv * 16 + fr) * ST + (ti * 16 + fq * 4) * 2, x);
    }
  }
  __syncthreads();
#pragma unroll
  for (int u = 0; u < 2; ++u) {
    const int tile = wv * 2 + u, ti = tile >> 2, tv = tile & 3;
    const f32x4 x = tile_mm(Tm, ST, X1T, ST, ti * 16, tv * 16, 1, (f32x4){0.f, 0.f, 0.f, 0.f}, lane);
    st_bf16x4(UT + (tv * 16 + fr) * ST + (ti * 16 + fq * 4) * 2, x);
  }
  __syncthreads();
#pragma unroll
  for (int u = 0; u < 2; ++u) {
    const int tile = wv * 2 + u, ti = tile >> 2, tv = tile & 3;
    f32x4 x = tile_mm(Rt, SN, S0, SN, ti * 16, tv * 16, 2, (f32x4){0.f, 0.f, 0.f, 0.f}, lane);
    x = tile_mm(Arb, ST, UT, ST, ti * 16, tv * 16, 1, x, lane);
    x = tile_mm(Ark, ST, VT, ST, ti * 16, tv * 16, 1, x, lane);
#pragma unroll
    for (int q = 0; q < 4; ++q) Yb[(ti * 16 + fq * 4 + q) * 68 + tv * 16 + fr] = x[q];
  }
  __syncthreads();
  {
    const int tt = tid >> 3, c0 = (tid & 7) * 8;
    float yv[8], sum = 0.f;
#pragma unroll
    for (int j = 0; j < 8; ++j) { yv[j] = Yb[tt * 68 + c0 + j]; sum += yv[j]; }
    sum += __shfl_xor(sum, 1); sum += __shfl_xor(sum, 2); sum += __shfl_xor(sum, 4);
    const float mean = sum * (1.f / 64.f);
    float var = 0.f;
#pragma unroll
    for (int j = 0; j < 8; ++j) { const float d = yv[j] - mean; var += d * d; }
    var += __shfl_xor(var, 1); var += __shfl_xor(var, 2); var += __shfl_xor(var, 4);
    const float rstd = rsqrtf(var * (1.f / 64.f) + GN_EPS);
    const size_t off = gbase + (size_t)tt * D + c0;
    float o[8];
#pragma unroll
    for (int j = 0; j < 8; ++j) {
      const int chn = h * HS + c0 + j;
      o[j] = (yv[j] - mean) * rstd * s.lnx_g[chn] + s.lnx_b[chn] + bonus * vv8[j];
    }
    *(u32x4*)(s.r + off) = (u32x4){cvt_pk_bf16(o[0], o[1]), cvt_pk_bf16(o[2], o[3]), cvt_pk_bf16(o[4], o[5]), cvt_pk_bf16(o[6], o[7])};
  }
  __syncthreads();
}

DI void ln_phase(const float* __restrict__ z, const float* __restrict__ lg, const float* __restrict__ lb, float* __restrict__ xo,
                 const float* __restrict__ mod_l, int shift_idx, int scale_idx, bf16_t* __restrict__ ho, int bid, int nblk) {
  const int tq = opaque_v(threadIdx.x); const int lane = tq & 63, wv = tq >> 6;
  for (int row = bid * 4 + wv; row < T; row += nblk * 4) {
    const float* zr = z + (size_t)row * D;
    f32x4 v[4]; float s = 0.f;
#pragma unroll
    for (int i = 0; i < 4; ++i) { v[i] = *(const f32x4*)(zr + i * 256 + lane * 4); s += (v[i][0] + v[i][1]) + (v[i][2] + v[i][3]); }
    const float mean = wave_sum(s) * (1.f / D);
    float q = 0.f;
#pragma unroll
    for (int i = 0; i < 4; ++i) { const f32x4 d = v[i] - mean; q += (d[0] * d[0] + d[1] * d[1]) + (d[2] * d[2] + d[3] * d[3]); }
    const float rstd = rsqrtf(wave_sum(q) * (1.f / D) + LN_EPS);
    const int b = row / SEQ;
#pragma unroll
    for (int i = 0; i < 4; ++i) {
      const int d = i * 256 + lane * 4;
      const f32x4 o = (v[i] - mean) * rstd * *(const f32x4*)(lg + d) + *(const f32x4*)(lb + d);
      *(f32x4*)(xo + (size_t)row * D + d) = o;
      if (!ho) continue;
      const f32x4 sh = *(const f32x4*)(mod_l + (size_t)b * 6144 + shift_idx * D + d), sc = *(const f32x4*)(mod_l + (size_t)b * 6144 + scale_idx * D + d);
      const f32x4 hh = o * (sc + 1.f) + sh;
      *(u32x2*)(ho + (size_t)row * D + d) = (u32x2){cvt_pk_bf16(hh[0], hh[1]), cvt_pk_bf16(hh[2], hh[3])};
    }
  }
}

DI void combine_phase(const unsigned* __restrict__ lists, unsigned short* __restrict__ epk, float* __restrict__ gate, int bid, int nblk) {
  const int tq = opaque_v(threadIdx.x);
  for (int gid = bid * 256 + tq; gid < T * 8; gid += nblk * 256) {
    const unsigned* la = lists + (size_t)gid * 32;
    const unsigned* lb = la + 16;
    float s1[16], s2[16];
#pragma unroll
    for (int i = 0; i < 4; ++i) {
      const u32x4 a = *(const u32x4*)(la + i * 4), b = *(const u32x4*)(lb + i * 4);
      s1[i * 4] = key2f(a.x & ~127u); s1[i * 4 + 1] = key2f(a.y & ~127u); s1[i * 4 + 2] = key2f(a.z & ~127u); s1[i * 4 + 3] = key2f(a.w & ~127u);
      s2[i * 4] = key2f(b.x & ~127u); s2[i * 4 + 1] = key2f(b.y & ~127u); s2[i * 4 + 2] = key2f(b.z & ~127u); s2[i * 4 + 3] = key2f(b.w & ~127u);
    }
    unsigned c[4][16];
    {
      int n = 0;
#pragma unroll
      for (int a = 0; a < 16; ++a)
#pragma unroll
        for (int b = 0; b < 16; ++b)
          if ((a + 1) * (b + 1) <= 16) { c[n >> 4][n & 15] = (f2key(s1[a] + s2[b]) & ~255u) | (unsigned)(255 - (a * 16 + b)); ++n; }
#pragma unroll
      for (int q = 50; q < 64; ++q) c[q >> 4][q & 15] = 0u;
    }
    sort16_desc(c[0]); sort16_desc(c[1]); sort16_desc(c[2]); sort16_desc(c[3]);
#pragma unroll
    for (int e = 0; e < 16; ++e) { c[0][e] = max(c[0][e], c[1][15 - e]); c[2][e] = max(c[2][e], c[3][15 - e]); }
    merge16_desc(c[0]); merge16_desc(c[2]);
#pragma unroll
    for (int e = 0; e < 16; ++e) c[0][e] = max(c[0][e], c[2][15 - e]);
    merge16_desc(c[0]);
    float best[16], den = 0.f;
    const float mx = key2f(c[0][0] & ~255u);
#pragma unroll
    for (int e = 0; e < 16; ++e) { best[e] = __expf(key2f(c[0][e] & ~255u) - mx); den += best[e]; }
    const float inv = 1.f / den;
#pragma unroll
    for (int e = 0; e < 16; ++e) {
      const int pos = 255 - (int)(c[0][e] & 255u), a = pos >> 4, b = pos & 15;
      const int i1 = 127 - (int)(la[a] & 127u), i2 = 127 - (int)(lb[b] & 127u);
      { const int jj = (gid & 7) * 16 + e; epk[(size_t)(gid >> 3) * 128 + (jj < 64 ? 2 * jj : 2 * (jj - 64) + 1)] = (unsigned short)(i1 * 128 + i2); }
      gate[(size_t)gid * 16 + e] = best[e] * inv;
    }
  }
}

DI void table_fp8_phase(const float* __restrict__ src, unsigned char* __restrict__ dst, float* __restrict__ inv, int rows, int bid, int nblk) {
  const int tq = opaque_v(threadIdx.x); const int lane = tq & 63, wv = tq >> 6;
  for (int r = bid * 4 + wv; r < rows; r += nblk * 4) {
    const float* sr = src + (size_t)r * D + lane * 16;
    f32x4 v[4]; float mx = 0.f;
#pragma unroll
    for (int i = 0; i < 4; ++i) { v[i] = __builtin_nontemporal_load((const f32x4*)(sr + i * 4)); mx = fmaxf(mx, fmaxf(fmaxf(fabsf(v[i][0]), fabsf(v[i][1])), fmaxf(fabsf(v[i][2]), fabsf(v[i][3])))); }
#pragma unroll
    for (int o = 32; o >= 1; o >>= 1) mx = fmaxf(mx, __shfl_xor(mx, o));
    const float sc = mx > 0.f ? exp2f(floorf(log2f(384.f / mx))) : 1.f;
    u32x4 o4; unsigned w[4];
#pragma unroll
    for (int i = 0; i < 4; ++i) {
      int pk = 0;
      pk = __builtin_amdgcn_cvt_pk_fp8_f32(v[i][0] * sc, v[i][1] * sc, pk, false);
      pk = __builtin_amdgcn_cvt_pk_fp8_f32(v[i][2] * sc, v[i][3] * sc, pk, true);
      w[i] = (unsigned)pk;
    }
    o4.x = w[0]; o4.y = w[1]; o4.z = w[2]; o4.w = w[3];
    *(u32x4*)(dst + (size_t)r * D + lane * 16) = o4;
    if (lane == 0) inv[r] = 1.f / sc;
  }
}

struct PeerArgs {
  const bf16_t* h2;
  const unsigned char *u8, *v8;
  const float *uinv, *vinv;
  const unsigned* epk; const float* gate;
  float* part;
  float* coef;
  const float* xres;
  const float* gate2;
  float* z;
  unsigned* ctr_u; unsigned* ctr_v;
};
constexpr int PCH = 64;
DI void cvt16_fp8(const u32x4& d, float (&f)[16]) {
  const unsigned w[4] = {d.x, d.y, d.z, d.w};
#pragma unroll
  for (int i = 0; i < 4; ++i) {
    const f32x2 lo = __builtin_amdgcn_cvt_pk_f32_fp8((int)w[i], false), hi = __builtin_amdgcn_cvt_pk_f32_fp8((int)w[i], true);
    f[i * 4] = lo.x; f[i * 4 + 1] = lo.y; f[i * 4 + 2] = hi.x; f[i * 4 + 3] = hi.y;
  }
}
template <bool VPHASE>
DI void peer_slice_phase(const PeerArgs& a, unsigned char* lds) {
  const int tq = opaque_v(threadIdx.x); const int lane = tq & 63, wv = tq >> 6, cc = lane & 7;
  volatile int* nxt = (volatile int*)lds;
  const unsigned xcc = xb_xcc_id() & 7u;
  unsigned* ctr = VPHASE ? a.ctr_v : a.ctr_u;
  for (int ks = 0; ks < 8; ++ks) {
    const int s = (int)((xcc + ks) & 7u);
    for (;;) {
      __syncthreads();
      if (tq == 0) *nxt = (int)atomicAdd(&ctr[s * 16], 1u);
      __syncthreads();
      const int chunk = *nxt;
      if (chunk >= T / PCH) break;
      for (int ti = 0; ti < PCH / 4; ++ti) {
        const int t = chunk * PCH + wv * (PCH / 4) + ti;
        const unsigned ep = a.epk[(size_t)t * 64 + lane];
        const unsigned char* tab = (VPHASE ? a.v8 : a.u8) + s * 128 + cc * 16;
        u32x4 data[16];
        float cv[16];
        float c_lo = 0.f, c_hi = 0.f;
        if (VPHASE) { c_lo = a.coef[(size_t)t * 128 + lane]; c_hi = a.coef[(size_t)t * 128 + 64 + lane]; }
#pragma unroll
        for (int i = 0; i < 16; ++i) {
          const int src = (lane & ~7) | (i & 7);
          const unsigned ev = (unsigned)__shfl((int)ep, src);
          const unsigned e = (i < 8) ? (ev & 0xffffu) : (ev >> 16);
          if (VPHASE) cv[i] = __shfl(i < 8 ? c_lo : c_hi, src);
          data[i] = *(const u32x4*)(tab + (size_t)e * D);
        }
        if (!VPHASE) {
          const u32x4 h0 = *(const u32x4*)(a.h2 + (size_t)t * D + s * 128 + cc * 16), h1 = *(const u32x4*)(a.h2 + (size_t)t * D + s * 128 + cc * 16 + 8);
          float hf[16];
          { const unsigned u[8] = {h0.x, h0.y, h0.z, h0.w, h1.x, h1.y, h1.z, h1.w};
#pragma unroll
            for (int q = 0; q < 8; ++q) { hf[2 * q] = bf_lo(u[q]); hf[2 * q + 1] = bf_hi(u[q]); } }
          float r_lo = 0.f, r_hi = 0.f;
#pragma unroll
          for (int i = 0; i < 16; ++i) {
            float f[16]; cvt16_fp8(data[i], f);
            float d = 0.f;
#pragma unroll
            for (int q = 0; q < 16; ++q) d += f[q] * hf[q];
            d += __shfl_xor(d, 1); d += __shfl_xor(d, 2); d += __shfl_xor(d, 4);
            if ((i & 7) == cc) { if (i < 8) r_lo = d; else r_hi = d; }
          }
          float* pp = a.part + ((size_t)s * T + t) * 128;
          pp[lane] = r_lo; pp[64 + lane] = r_hi;
        } else {
          float acc[16];
#pragma unroll
          for (int q = 0; q < 16; ++q) acc[q] = 0.f;
#pragma unroll
          for (int i = 0; i < 16; ++i) {
            float f[16]; cvt16_fp8(data[i], f);
#pragma unroll
            for (int q = 0; q < 16; ++q) acc[q] += cv[i] * f[q];
          }
          float r8[8], r4[4], r2[2];
          { const bool up = (lane & 8) != 0;
#pragma unroll
            for (int q = 0; q < 8; ++q) { const float keep = up ? acc[8 + q] : acc[q], send = up ? acc[q] : acc[8 + q]; r8[q] = keep + __shfl_xor(send, 8); } }
          { const bool up = (lane & 16) != 0;
#pragma unroll
            for (int q = 0; q < 4; ++q) { const float keep = up ? r8[4 + q] : r8[q], send = up ? r8[q] : r8[4 + q]; r4[q] = keep + __shfl_xor(send, 16); } }
          { const bool up = (lane & 32) != 0;
#pragma unroll
            for (int q = 0; q < 2; ++q) { const float keep = up ? r4[2 + q] : r4[q], send = up ? r4[q] : r4[2 + q]; r2[q] = keep + __shfl_xor(send, 32); } }
          const int col = s * 128 + cc * 16 + ((lane >> 3) & 1) * 8 + ((lane >> 4) & 1) * 4 + ((lane >> 5) & 1) * 2;
          const int b = t / SEQ;
          const f32x2 xv = *(const f32x2*)(a.xres + (size_t)t * D + col), gt = *(const f32x2*)(a.gate2 + (size_t)b * 6144 + col);
          *(f32x2*)(a.z + (size_t)t * D + col) = (f32x2){ALPHA * xv.x + gt.x * r2[0], ALPHA * xv.y + gt.y * r2[1]};
        }
      }
    }
  }
  __syncthreads();
}
DI void peer_coef_phase(const PeerArgs& a, int bid, int nblk) {
  const int tq = opaque_v(threadIdx.x);
  for (int gid = bid * 256 + tq; gid < T * 128; gid += nblk * 256) {
    const int t = gid >> 7, j = gid & 127;
    const unsigned ep = a.epk[(size_t)t * 64 + (j & 63)];
    const unsigned e = (j < 64) ? (ep & 0xffffu) : (ep >> 16);
    float sum = 0.f;
#pragma unroll
    for (int s8 = 0; s8 < 8; ++s8) sum += a.part[((size_t)s8 * T + t) * 128 + j];
    a.coef[gid] = a.gate[gid] * gelu_exact(sum * a.uinv[e]) * a.vinv[e];
  }
}

DI void pool_phase(const bf16_t* __restrict__ zin, bf16_t* __restrict__ pout, int bid, int nblk) {
  const size_t n8 = (size_t)T * D / 8; const int tq = opaque_v(threadIdx.x);
  for (size_t i = (size_t)bid * 256 + tq; i < n8; i += (size_t)nblk * 256) {
    const size_t e = i * 8; const int t = (int)(e / D), d = (int)(e % D), tp = t % SEQ;
    const int win = 2 << (d / 256);
    const int cnt = min(tp + 1, win);
    float s[8], z0[8];
#pragma unroll
    for (int j = 0; j < 8; ++j) { s[j] = 0.f; z0[j] = 0.f; }
    for (int w = 0; w < cnt; ++w) {
      const u32x4 v = *(const u32x4*)(zin + e - (size_t)w * D);
      const unsigned u[4] = {v.x, v.y, v.z, v.w};
#pragma unroll
      for (int j = 0; j < 4; ++j) { const float lo = bf_lo(u[j]), hi = bf_hi(u[j]); s[2 * j] += lo; s[2 * j + 1] += hi; if (w == 0) { z0[2 * j] = lo; z0[2 * j + 1] = hi; } }
    }
    const float ic = 1.f / (float)cnt;
    float o[8];
#pragma unroll
    for (int j = 0; j < 8; ++j) o[j] = s[j] * ic - z0[j];
    *(u32x4*)(pout + e) = (u32x4){cvt_pk_bf16(o[0], o[1]), cvt_pk_bf16(o[2], o[3]), cvt_pk_bf16(o[4], o[5]), cvt_pk_bf16(o[6], o[7])};
  }
}


#define GRID_SYNC() xcd_barrier(xb)

__global__ void __launch_bounds__(256, 2) mega(Params p) {
  __shared__ __attribute__((aligned(16))) unsigned char lds[LDS_BYTES + 16];
  cg::grid_group grid = cg::this_grid();
  const int bid = blockIdx.x, nblk = gridDim.x;
  if (threadIdx.x == 0) { *(volatile LAS unsigned*)(lds + LDS_BYTES) = 0u; *(volatile LAS unsigned*)(lds + LDS_BYTES + 4) = 0u; }
  __syncthreads();
  const XcdBarrier xb = xcd_barrier_post(p.bar, (volatile LAS unsigned*)(lds + LDS_BYTES));
  const float* mod0 = p.mod; const float* mod1 = p.mod + (size_t)NB * 6144;
  bf16_t* S[7];
#pragma unroll
  for (int i = 0; i < 7; ++i) S[i] = (bf16_t*)p.slot[i];

  prologue_phase(p, lds, bid, nblk);
  grid.sync();
  bf16_t *h = S[0], *r = S[1], *k = S[2], *v = S[3], *lw = S[4], *av = S[5];
  bf16_t* tw = p.lora_tmp; bf16_t* ta = tw + (size_t)T * 64; bf16_t* tg = ta + (size_t)T * 64;
  modulate_phase(p.x, mod0, 0, 1, h, bid, nblk);
  GRID_SYNC();
  for (int it = bid; it < 256 * 28; it += nblk) {
    int mt, nt; item_mn(it, 28, mt, nt);
    GemmArgs g; int n0;
    if (nt < 24) { const int j = nt >> 3; n0 = (nt & 7) * 128; g = mk(h, D, p.WT_rkv + (size_t)j * D * D, D, D, D, EPI_BF16, j == 0 ? r : (j == 1 ? k : v), D, p.rw_mu + j * D); }
    else if (nt == 24) { n0 = 0; g = mk(h, D, p.W1T, D, 64, D, EPI_TANH, tw, 64, p.rw_mu + 3 * D); }
    else if (nt == 25) { n0 = 0; g = mk(h, D, p.A1T, D, 64, D, EPI_BF16, ta, 64, p.rw_mu + 4 * D); }
    else { n0 = (nt - 26) * 128; g = mk(h, D, p.G1T, D, 192, D, EPI_SIGMOID, tg, 192, p.rw_mu + 5 * D); }
    gemm_tile(g, mt * 128, n0, lds);
  }
  GRID_SYNC();
  for (int it = bid; it < 256 * 16; it += nblk) {
    int mt, nt; item_mn(it, 16, mt, nt);
    const int j = nt >> 3, n0 = (nt & 7) * 128;
    GemmArgs g;
    if (j == 0) g = mk(tw, 64, p.W2T, 64, D, 64, EPI_LW, lw, D, nullptr, p.rw_w0);
    else g = mk(ta, 64, p.A2T, 64, D, 64, EPI_ASIG, av, D, nullptr, p.rw_a0);
    gemm_tile(g, mt * 128, n0, lds);
  }
  GRID_SYNC();
  {
    ScanArgs s; s.r = r; s.k = k; s.v = v; s.lw = lw; s.a = av; s.k_k = p.rw_k_k; s.k_a = p.rw_k_a; s.r_k = p.rw_r_k; s.lnx_g = p.rw_lnx_g; s.lnx_b = p.rw_lnx_b;
    s.Pg = (bf16_t*)p.out; s.Qz0 = S[0]; s.Qz1 = S[6]; s.Gg = p.Gg;
    for (int it = bid; it < NB * NH * NCH; it += nblk) scan_phaseA_item(s, it, lds);
    GRID_SYNC();
    for (int it = bid; it < NB * NH; it += nblk) scan_chain_block(s, it, lds);
    GRID_SYNC();
    for (int it = bid; it < NB * NH * NCH; it += nblk) scan_phaseC_item(s, it, lds);
    GRID_SYNC();
  }
  for (int it = bid; it < 256 * 8; it += nblk) {
    int mt, nt; item_mn(it, 8, mt, nt);
    gemm_tile(mk(tg, 192, p.G2T, 192, D, 192, EPI_GATE, r, D), mt * 128, nt * 128, lds);
  }
  GRID_SYNC();
  h = r;
  float* z = (float*)p.slot[2];
  for (int it = bid; it < 256 * 8; it += nblk) {
    int mt, nt; item_mn(it, 8, mt, nt);
    gemm_tile(mk(h, D, p.WoT, D, D, D, EPI_Z, z, D, nullptr, p.x, mod0 + 2 * D), mt * 128, nt * 128, lds);
  }
  table_fp8_phase(p.pe_u, p.slot[6], p.tinv, NEXP, bid, nblk);
  table_fp8_phase(p.pe_v, p.slot[6] + ((size_t)16 << 20), p.tinv + NEXP, NEXP, bid, nblk);
  table_fp8_phase(p.pe_u + (size_t)NEXP * D, p.slot[6] + ((size_t)32 << 20), p.tinv + 2 * NEXP, NEXP, bid, nblk);
  table_fp8_phase(p.pe_v + (size_t)NEXP * D, p.slot[6] + ((size_t)48 << 20), p.tinv + 3 * NEXP, NEXP, bid, nblk);
  GRID_SYNC();
  ln_phase(z, p.ln_g + 0 * D, p.ln_b + 0 * D, (float*)p.slot[4], mod0, 3, 4, S[0], bid, nblk);
  GRID_SYNC();

#pragma unroll
  for (int layer = 0; layer < 2; ++layer) {
    const float* modl = layer == 0 ? mod0 : mod1;
    const bf16_t* hp = S[0];
    bf16_t* q = (bf16_t*)p.slot[1];
    unsigned* lists = (unsigned*)p.slot[3];
    unsigned* epk = (unsigned*)(p.slot[3] + ((size_t)32 << 20));
    float* gate = (float*)(p.slot[3] + ((size_t)40 << 20));
    const bf16_t* WqT = p.WqT + (size_t)layer * 2048 * D; const bf16_t* Keys = p.KeysB + (size_t)layer * 16 * 128 * 128;
    for (int it = bid; it < 256 * 16; it += nblk) {
      int mt, nt; item_mn(it, 16, mt, nt);
      gemm_tile(mk(hp, D, WqT, D, 2048, D, EPI_BF16, q, 2048), mt * 128, nt * 128, lds);
    }
    GRID_SYNC();
    for (int it = bid; it < 256 * 16; it += nblk) {
      int mt, grp; item_mn(it, 16, mt, grp);
      scores_topk_tile(q, Keys, lists, mt * 128, grp, lds);
    }
    GRID_SYNC();
    combine_phase(lists, (unsigned short*)epk, gate, bid, nblk);
    GRID_SYNC();
    PeerArgs a; a.h2 = hp;
    a.u8 = p.slot[6] + ((size_t)(layer * 32) << 20); a.v8 = a.u8 + ((size_t)16 << 20);
    a.uinv = p.tinv + (layer * 2) * NEXP; a.vinv = a.uinv + NEXP;
    a.epk = epk; a.gate = gate; a.part = (float*)p.slot[1]; a.coef = (float*)p.slot[3];
    a.xres = (const float*)p.slot[4]; a.gate2 = modl + 5 * D; a.z = (float*)p.slot[1];
    a.ctr_u = p.bar + XCD_BAR_WORDS + (layer * 2) * 128; a.ctr_v = a.ctr_u + 128;
    peer_slice_phase<false>(a, lds);
    GRID_SYNC();
    peer_coef_phase(a, bid, nblk);
    GRID_SYNC();
    peer_slice_phase<true>(a, lds);
    GRID_SYNC();
    if (layer == 1) { ln_phase(a.z, p.ln_g + 3 * D, p.ln_b + 3 * D, p.out, mod1, 0, 1, nullptr, bid, nblk); break; }
    ln_phase(a.z, p.ln_g + 1 * D, p.ln_b + 1 * D, (float*)p.slot[4], mod1, 0, 1, S[0], bid, nblk);
    GRID_SYNC();
    const float* x2 = (const float*)p.slot[4];
    bf16_t *hB = S[0], *zin = S[1], *pp = S[2], *yp = S[1];
    for (int it = bid; it < 256 * 8; it += nblk) {
      int mt, nt; item_mn(it, 8, mt, nt);
      gemm_tile(mk(hB, D, p.PinT, D, D, D, EPI_BF16, zin, D), mt * 128, nt * 128, lds);
    }
    GRID_SYNC();
    pool_phase(zin, pp, bid, nblk);
    GRID_SYNC();
    for (int it = bid; it < 256 * 8; it += nblk) {
      int mt, nt; item_mn(it, 8, mt, nt);
      const int gi = nt >> 1, n0 = (nt & 1) * 128;
      gemm_tile(mk(pp + gi * 256, D, p.WgrpT + (size_t)gi * 256 * 256, 256, 256, 256, EPI_SCALE, yp + gi * 256, D, nullptr, p.pl_scale + gi * 256), mt * 128, n0, lds);
    }
    GRID_SYNC();
    float* z1 = (float*)p.slot[2];
    for (int it = bid; it < 256 * 8; it += nblk) {
      int mt, nt; item_mn(it, 8, mt, nt);
      gemm_tile(mk(yp, D, p.PoutT, D, D, D, EPI_Z, z1, D, nullptr, x2, mod1 + 2 * D), mt * 128, nt * 128, lds);
    }
    GRID_SYNC();
    ln_phase(z1, p.ln_g + 2 * D, p.ln_b + 2 * D, (float*)p.slot[4], mod1, 3, 4, S[0], bid, nblk);
    GRID_SYNC();
  }
}

extern "C" void kernel_launch(void* const* d_in, const int* in_sizes, int n_in, void* d_out, int out_size, void* d_ws, size_t ws_size, hipStream_t stream) {
  Params p{};
  const float** ip = (const float**)&p.x;
  for (int i = 0; i < 30; ++i) ip[i] = (const float*)d_in[i];
  p.out = (float*)d_out;
  unsigned char* w = (unsigned char*)d_ws; size_t off = 0;
  auto take = [&](size_t bytes) { unsigned char* r = w + off; off += (bytes + 255) & ~(size_t)255; return r; };
  p.bar = (unsigned*)take(16384);
  p.mod = (float*)take((size_t)2 * NB * 6144 * 4);
  p.WT_rkv = (bf16_t*)take((size_t)3 * D * D * 2);
  p.W1T = (bf16_t*)take((size_t)128 * D * 2); p.A1T = (bf16_t*)take((size_t)128 * D * 2); p.G1T = (bf16_t*)take((size_t)256 * D * 2);
  p.W2T = (bf16_t*)take((size_t)D * 64 * 2); p.A2T = (bf16_t*)take((size_t)D * 64 * 2); p.G2T = (bf16_t*)take((size_t)D * 192 * 2);
  p.WoT = (bf16_t*)take((size_t)D * D * 2); p.PinT = (bf16_t*)take((size_t)D * D * 2); p.PoutT = (bf16_t*)take((size_t)D * D * 2);
  p.WgrpT = (bf16_t*)take((size_t)4 * 256 * 256 * 2); p.WqT = (bf16_t*)take((size_t)2 * 2048 * D * 2); p.KeysB = (bf16_t*)take((size_t)2 * 16 * 128 * 128 * 2);
  p.tinv = (float*)take((size_t)4 * NEXP * 4);
  p.lora_tmp = (bf16_t*)take((size_t)T * 320 * 2);
  p.Gg = (float*)take((size_t)16384 * 64 * 4);
  for (int i = 0; i < 7; ++i) p.slot[i] = take((size_t)64 << 20);
  if (off > ws_size) return;

  static int grid_blocks = 0;
  if (!grid_blocks) {
    int dev = 0, cus = 0, per_cu = 0;
    hipGetDevice(&dev);
    hipDeviceGetAttribute(&cus, hipDeviceAttributeMultiprocessorCount, dev);
    hipOccupancyMaxActiveBlocksPerMultiprocessor(&per_cu, mega, 256, 0);
    if (per_cu > 2) per_cu = 2;
    if (per_cu < 1) per_cu = 1;
    grid_blocks = cus * per_cu;
  }
  hipMemsetAsync(p.bar, 0, 16384, stream);
  void* args[] = {&p};
  hipLaunchCooperativeKernel((void*)mega, dim3(grid_blocks), dim3(256), args, 0, stream);
}
```

```cpp
#include <hip/hip_runtime.h>
#include <hip/hip_cooperative_groups.h>
#include <stdint.h>
#include <stddef.h>
namespace cg = cooperative_groups;

typedef unsigned short bf16_t;
typedef short bf16x8 __attribute__((ext_vector_type(8)));
typedef float f32x4 __attribute__((ext_vector_type(4)));
typedef float f32x2 __attribute__((ext_vector_type(2)));
typedef unsigned u32x4 __attribute__((ext_vector_type(4)));
typedef unsigned u32x2 __attribute__((ext_vector_type(2)));
#define DI __device__ __forceinline__

constexpr int D = 1024, NB = 8, SEQ = 4096, T = NB * SEQ;
constexpr int NH = 16, HS = 64;
constexpr int NEXP = 16384;
constexpr float ALPHA = 1.4142135623730951f;
constexpr float LN_EPS = 1e-5f, GN_EPS = 64e-5f;
constexpr int LDS_BYTES = 72 * 1024;

typedef __bf16 bf16x2_t __attribute__((ext_vector_type(2)));
DI unsigned cvt_pk_bf16(float lo, float hi) { const f32x2 v = {lo, hi}; return __builtin_bit_cast(unsigned, __builtin_convertvector(v, bf16x2_t)); }
DI float bf_lo(unsigned u) { return __uint_as_float(u << 16); }
DI float bf_hi(unsigned u) { return __uint_as_float(u & 0xffff0000u); }
DI bf16_t f2bf(float f) { unsigned u = __float_as_uint(f); u += 0x7fffu + ((u >> 16) & 1u); return (bf16_t)(u >> 16); }
DI float sigmoidf_(float x) { return 1.f / (1.f + __expf(-x)); }
DI float wave_sum(float v) {
#pragma unroll
  for (int o = 32; o >= 1; o >>= 1) v += __shfl_xor(v, o);
  return v;
}
DI int opaque_v(int x) { asm volatile("" : "+v"(x)); return x; }
DI float gelu_exact(float v) { return 0.5f * v * (1.f + erff(v * 0.70710678118654752f)); }

#define XB_TMO      128
#define XB_XCNT(j)  (256  + 64 * (j))
#define XB_XSUB(j)  (1280 + 64 * (j))
#define XB_XGEN(j)  (2304 + 64 * (j))
#define XB_TOP      3328
#define XB_TOPGEN   3392
#define XCD_BAR_WORDS 3456
#define XB_SPIN_CAP (1u << 22)
#define LAS __attribute__((address_space(3)))
DI unsigned xb_ld(unsigned* p)              { return __hip_atomic_load(p, __ATOMIC_RELAXED, __HIP_MEMORY_SCOPE_AGENT); }
DI unsigned xb_add(unsigned* p, unsigned v) { return __hip_atomic_fetch_add(p, v, __ATOMIC_RELAXED, __HIP_MEMORY_SCOPE_AGENT); }
DI unsigned xb_xcc_id() { return (unsigned)__builtin_amdgcn_s_getreg((3 << 11) | 20) & 0xFu; }
#define XB_SPIN(cond, bar) do { unsigned _sp = 0; while (cond) { __builtin_amdgcn_s_sleep(1); \
    if ((++_sp & 255u) == 0u) { if (xb_ld(&(bar)[XB_TMO])) break; if (_sp > XB_SPIN_CAP) { atomicAdd(&(bar)[XB_TMO], 1u); break; } } } } while (0)
struct XcdBarrier { unsigned* bar; unsigned x; volatile LAS unsigned* st; };
DI XcdBarrier xcd_barrier_post(unsigned* bar, volatile LAS unsigned* st) {
  XcdBarrier b; b.bar = bar; b.x = xb_xcc_id(); b.st = st;
  if (threadIdx.x == 0) (void)xb_add(&bar[XB_XCNT(b.x)], 1u);
  return b;
}
DI void xcd_barrier_complete(unsigned* bar, unsigned x, unsigned& nloc, unsigned& nx) {
  const unsigned G = gridDim.x * gridDim.y * gridDim.z;
  unsigned sum, cnt, mine, sp = 0u;
  for (;;) {
    sum = 0u; cnt = 0u; mine = 0u;
#pragma unroll
    for (unsigned j = 0; j < 16; ++j) { const unsigned c = xb_ld(&bar[XB_XCNT(j)]); sum += c; cnt += (c > 0u) ? 1u : 0u; mine = (j == x) ? c : mine; }
    if (sum == G) break;
    __builtin_amdgcn_s_sleep(1);
    if ((++sp & 255u) == 0u) { if (xb_ld(&bar[XB_TMO])) break; if (sp > XB_SPIN_CAP) { atomicAdd(&bar[XB_TMO], 1u); break; } }
  }
  nloc = mine > 0u ? mine : 1u; nx = cnt > 0u ? cnt : 1u;
}
DI void xcd_barrier(const XcdBarrier& b) {
  asm volatile("s_waitcnt vmcnt(0)" ::: "memory");
  __syncthreads();
  if (threadIdx.x == 0) {
    unsigned* bar = b.bar;
    __builtin_amdgcn_s_waitcnt(0);
    unsigned nloc = b.st[0], nx = b.st[1];
    if (nloc == 0u) { xcd_barrier_complete(bar, b.x, nloc, nx); b.st[0] = nloc; b.st[1] = nx; }
    const unsigned old = xb_add(&bar[XB_XSUB(b.x)], 1u);
    const unsigned gen = old / nloc;
    if (old + 1u == (gen + 1u) * nloc) {
      __builtin_amdgcn_fence(__ATOMIC_RELEASE, "agent");
      asm volatile("s_waitcnt vmcnt(0)" ::: "memory");
      const unsigned og = xb_add(&bar[XB_TOP], 1u);
      const unsigned tg = og / nx;
      if (og + 1u == (tg + 1u) * nx) xb_add(&bar[XB_TOPGEN], 1u);
      else XB_SPIN(xb_ld(&bar[XB_TOPGEN]) == tg, bar);
      __builtin_amdgcn_fence(__ATOMIC_ACQUIRE, "agent");
      xb_add(&bar[XB_XGEN(b.x)], 1u);
      asm volatile("s_waitcnt vmcnt(0)" ::: "memory");
    } else {
      XB_SPIN(xb_ld(&bar[XB_XGEN(b.x)]) == gen, bar);
      __builtin_amdgcn_fence(__ATOMIC_ACQUIRE, "agent");
      asm volatile("s_waitcnt vmcnt(0)" ::: "memory");
    }
  }
  __syncthreads();
}

struct Params {
  const float *x, *c, *ada_w, *ada_b, *ln_g, *ln_b, *rw_mu, *rw_w_rkv, *rw_w0, *rw_w1, *rw_w2, *rw_a0, *rw_a1, *rw_a2, *rw_g1, *rw_g2,
      *rw_k_k, *rw_k_a, *rw_r_k, *rw_lnx_g, *rw_lnx_b, *rw_w_o, *pl_w_in, *pl_w_grp, *pl_scale, *pl_w_out, *pe_w_q, *pe_keys, *pe_u, *pe_v;
  float* out;
  float* mod;
  bf16_t *WT_rkv, *W1T, *A1T, *G1T, *W2T, *A2T, *G2T, *WoT, *PinT, *PoutT, *WgrpT, *WqT, *KeysB;
  unsigned char* slot[7];
  float* tinv;
  bf16_t* lora_tmp;
  float* Gg;
  unsigned* bar;
};

DI void mod_item(const Params& p, int item, unsigned char* lds) {
  float* cond = (float*)lds;
  float (*red)[NB][32] = (float (*)[NB][32])(lds + 32768);
  const int tid = opaque_v(threadIdx.x);
  for (int i = tid; i < NB * D; i += 256) { float v = p.c[i]; cond[i] = v / (1.f + __expf(-v)); }
  __syncthreads();
  const int l = item / 192, cb = item % 192;
  const int col = cb * 32 + (tid & 31), kg = tid >> 5;
  const float* w = p.ada_w + (size_t)l * D * 6144 + col;
  float acc[NB];
#pragma unroll
  for (int b = 0; b < NB; ++b) acc[b] = 0.f;
  for (int k = kg * 128; k < kg * 128 + 128; ++k) {
    const float wv = w[(size_t)k * 6144];
#pragma unroll
    for (int b = 0; b < NB; ++b) acc[b] += cond[b * D + k] * wv;
  }
#pragma unroll
  for (int b = 0; b < NB; ++b) red[kg][b][tid & 31] = acc[b];
  __syncthreads();
  {
    const int b = tid >> 5, cc = tid & 31;
    float s = 0.f;
#pragma unroll
    for (int g = 0; g < 8; ++g) s += red[g][b][cc];
    const int n = cb * 32 + cc;
    p.mod[((size_t)l * NB + b) * 6144 + n] = s + p.ada_b[l * 6144 + n];
  }
  __syncthreads();
}

DI void transpose_item(const float* __restrict__ src, bf16_t* __restrict__ dst, int K, int N, int Kpad, int Npad, size_t sbs, size_t dbs, int item, unsigned char* lds) {
  float (*tile)[33] = (float (*)[33])lds;
  const int nb_n = Npad / 32, nb_k = Kpad / 32;
  const int per = nb_n * nb_k;
  const int bz = item / per, r = item % per;
  const int bk = r / nb_n, bn = r % nb_n;
  src += bz * sbs; dst += bz * dbs;
  const int tq = opaque_v(threadIdx.x); const int tx = tq & 31, ty = tq >> 5;
#pragma unroll
  for (int i = 0; i < 4; ++i) {
    const int k = bk * 32 + ty + i * 8, n = bn * 32 + tx;
    tile[ty + i * 8][tx] = (k < K && n < N) ? src[(size_t)k * N + n] : 0.f;
  }
  __syncthreads();
#pragma unroll
  for (int i = 0; i < 4; ++i) {
    const int n = bn * 32 + ty + i * 8, k = bk * 32 + tx;
    dst[(size_t)n * Kpad + k] = f2bf(tile[tx][ty + i * 8]);
  }
  __syncthreads();
}
DI void cvt_range(const float* __restrict__ src, bf16_t* __restrict__ dst, size_t n8, int bid, int nblk) {
  const int tq = opaque_v(threadIdx.x);
  for (size_t i = (size_t)bid * 256 + tq; i < n8; i += (size_t)nblk * 256) {
    const f32x4 a = *(const f32x4*)(src + i * 8), b = *(const f32x4*)(src + i * 8 + 4);
    u32x4 o; o.x = cvt_pk_bf16(a[0], a[1]); o.y = cvt_pk_bf16(a[2], a[3]); o.z = cvt_pk_bf16(b[0], b[1]); o.w = cvt_pk_bf16(b[2], b[3]);
    *(u32x4*)(dst + i * 8) = o;
  }
}
DI void prologue_phase(const Params& p, unsigned char* lds, int bid, int nblk) {
  constexpr int total = 384 + 3072 + 128 + 128 + 256 + 64 + 64 + 192 + 1024 + 1024 + 1024 + 256 + 4096;
  for (int it = bid; it < total; it += nblk) {
    int r = it;
    if (r < 384) { mod_item(p, r, lds); continue; } r -= 384;
    if (r < 3072) { transpose_item(p.rw_w_rkv, p.WT_rkv, D, D, D, D, (size_t)D * D, (size_t)D * D, r, lds); continue; } r -= 3072;
    if (r < 128) { transpose_item(p.rw_w1, p.W1T, D, 64, D, 128, 0, 0, r, lds); continue; } r -= 128;
    if (r < 128) { transpose_item(p.rw_a1, p.A1T, D, 64, D, 128, 0, 0, r, lds); continue; } r -= 128;
    if (r < 256) { transpose_item(p.rw_g1, p.G1T, D, 160, D, 256, 0, 0, r, lds); continue; } r -= 256;
    if (r < 64) { transpose_item(p.rw_w2, p.W2T, 64, D, 64, D, 0, 0, r, lds); continue; } r -= 64;
    if (r < 64) { transpose_item(p.rw_a2, p.A2T, 64, D, 64, D, 0, 0, r, lds); continue; } r -= 64;
    if (r < 192) { transpose_item(p.rw_g2, p.G2T, 160, D, 192, D, 0, 0, r, lds); continue; } r -= 192;
    if (r < 1024) { transpose_item(p.rw_w_o, p.WoT, D, D, D, D, 0, 0, r, lds); continue; } r -= 1024;
    if (r < 1024) { transpose_item(p.pl_w_in, p.PinT, D, D, D, D, 0, 0, r, lds); continue; } r -= 1024;
    if (r < 1024) { transpose_item(p.pl_w_out, p.PoutT, D, D, D, D, 0, 0, r, lds); continue; } r -= 1024;
    if (r < 256) { transpose_item(p.pl_w_grp, p.WgrpT, 256, 256, 256, 256, (size_t)256 * 256, (size_t)256 * 256, r, lds); continue; } r -= 256;
    transpose_item(p.pe_w_q, p.WqT, D, 2048, D, 2048, (size_t)D * 2048, (size_t)D * 2048, r, lds);
  }
  cvt_range(p.pe_keys, p.KeysB, (size_t)2 * 16 * 128 * 128 / 8, bid, nblk);
}

DI void modulate_phase(const float* __restrict__ x, const float* __restrict__ mod_l, const float* __restrict__ mu, bf16_t* __restrict__ h, bf16_t* __restrict__ xr, bf16_t* __restrict__ xk,
                       bf16_t* __restrict__ xv, int bid, int nblk) {
  const size_t n8 = (size_t)T * D / 8; const int tq = opaque_v(threadIdx.x);
  for (size_t i = (size_t)bid * 256 + tq; i < n8; i += (size_t)nblk * 256) {
    const size_t e = i * 8; const int t = (int)(e / D), d = (int)(e % D), b = t / SEQ;
    const float* sh = mod_l + (size_t)b * 6144 + 0 * D + d; const float* sc = mod_l + (size_t)b * 6144 + 1 * D + d;
    float hv[8], pv[8];
    {
      const f32x4 a0 = *(const f32x4*)(x + e), a1 = *(const f32x4*)(x + e + 4);
      const f32x4 s0 = *(const f32x4*)sh, s1 = *(const f32x4*)(sh + 4), c0 = *(const f32x4*)sc, c1 = *(const f32x4*)(sc + 4);
      const f32x4 r0 = a0 * (c0 + 1.f) + s0, r1 = a1 * (c1 + 1.f) + s1;
      f32x4 q0 = {0.f, 0.f, 0.f, 0.f}, q1 = {0.f, 0.f, 0.f, 0.f};
      if ((t % SEQ) != 0) { const f32x4 b0 = *(const f32x4*)(x + e - D), b1 = *(const f32x4*)(x + e - D + 4); q0 = b0 * (c0 + 1.f) + s0; q1 = b1 * (c1 + 1.f) + s1; }
#pragma unroll
      for (int j = 0; j < 4; ++j) { hv[j] = r0[j]; hv[4 + j] = r1[j]; pv[j] = q0[j]; pv[4 + j] = q1[j]; }
    }
    u32x4 o; o.x = cvt_pk_bf16(hv[0], hv[1]); o.y = cvt_pk_bf16(hv[2], hv[3]); o.z = cvt_pk_bf16(hv[4], hv[5]); o.w = cvt_pk_bf16(hv[6], hv[7]);
    *(u32x4*)(h + e) = o;
#pragma unroll
    for (int n = 0; n < 3; ++n) {
      const f32x4 m0 = *(const f32x4*)(mu + n * D + d), m1 = *(const f32x4*)(mu + n * D + d + 4);
      float w[8];
#pragma unroll
      for (int j = 0; j < 8; ++j) { const float m = j < 4 ? m0[j] : m1[j - 4]; w[j] = hv[j] + (pv[j] - hv[j]) * m; }
      u32x4 q; q.x = cvt_pk_bf16(w[0], w[1]); q.y = cvt_pk_bf16(w[2], w[3]); q.z = cvt_pk_bf16(w[4], w[5]); q.w = cvt_pk_bf16(w[6], w[7]);
      *(u32x4*)((n == 0 ? xr : (n == 1 ? xk : xv)) + e) = q;
    }
  }
}

enum { EPI_BF16 = 0, EPI_TANH, EPI_SIGMOID, EPI_LW, EPI_ASIG, EPI_Z, EPI_SCALE, EPI_GATE };
struct GemmArgs {
  const bf16_t* A; int lda;
  const bf16_t* Bt; int ldb;
  int N, K;
  const float* mu;
  int epi; void* out; int ldc;
  const float* v0; const float* v1;
};

DI int lds_off(int row, int chunk) { return row * 128 + ((chunk ^ (row & 7)) << 4); }

DI void gemm_load_a(const GemmArgs& g, int m0, int k0, int tid, u32x4 (&ra)[4]) {
#pragma unroll
  for (int i = 0; i < 4; ++i) {
    const int row = (tid >> 3) + i * 32, ch = tid & 7;
    const int m = m0 + row;
    const bf16_t* src = g.A + (size_t)m * g.lda + k0 + ch * 8;
    u32x4 v = *(const u32x4*)src;
    if (g.mu) {
      u32x4 pv = {0u, 0u, 0u, 0u};
      if ((m % SEQ) != 0) pv = *(const u32x4*)(src - g.lda);
      const f32x4 m0v = *(const f32x4*)(g.mu + k0 + ch * 8), m1v = *(const f32x4*)(g.mu + k0 + ch * 8 + 4);
      const unsigned hu[4] = {v.x, v.y, v.z, v.w}, pu[4] = {pv.x, pv.y, pv.z, pv.w};
      float o[8];
#pragma unroll
      for (int j = 0; j < 4; ++j) {
        const float h0 = bf_lo(hu[j]), h1 = bf_hi(hu[j]), p0 = bf_lo(pu[j]), p1 = bf_hi(pu[j]);
        const float mu0 = (2 * j < 4) ? m0v[(2 * j) & 3] : m1v[(2 * j) & 3], mu1 = (2 * j + 1 < 4) ? m0v[(2 * j + 1) & 3] : m1v[(2 * j + 1) & 3];
        o[2 * j] = h0 + (p0 - h0) * mu0; o[2 * j + 1] = h1 + (p1 - h1) * mu1;
      }
      v.x = cvt_pk_bf16(o[0], o[1]); v.y = cvt_pk_bf16(o[2], o[3]); v.z = cvt_pk_bf16(o[4], o[5]); v.w = cvt_pk_bf16(o[6], o[7]);
    }
    ra[i] = v;
  }
}
DI void gemm_load_b(const GemmArgs& g, int n0, int k0, int tid, u32x4 (&rb)[4]) {
#pragma unroll
  for (int i = 0; i < 4; ++i) {
    const int row = (tid >> 3) + i * 32, ch = tid & 7;
    rb[i] = *(const u32x4*)(g.Bt + (size_t)(n0 + row) * g.ldb + k0 + ch * 8);
  }
}
DI void gemm_store_lds(unsigned char* buf, int tid, const u32x4 (&r)[4]) {
#pragma unroll
  for (int i = 0; i < 4; ++i) {
    const int row = (tid >> 3) + i * 32, ch = tid & 7;
    *(u32x4*)(buf + lds_off(row, ch)) = r[i];
  }
}

DI unsigned f2key(float f) { unsigned u = __float_as_uint(f); return u ^ ((u >> 31) ? 0xffffffffu : 0x80000000u); }
DI float key2f(unsigned k) { unsigned u = (k >> 31) ? (k ^ 0x80000000u) : ~k; return __uint_as_float(u); }
#define CE_DESC(a, b) { const unsigned _mx = max(a, b), _mn = min(a, b); a = _mx; b = _mn; }
DI void sort16_desc(unsigned (&x)[16]) {
#pragma unroll
  for (int k = 2; k <= 16; k <<= 1) {
#pragma unroll
    for (int j = k >> 1; j > 0; j >>= 1) {
#pragma unroll
      for (int i = 0; i < 16; ++i) {
        const int l = i ^ j;
        if (l > i) {
          if ((i & k) == 0) { CE_DESC(x[i], x[l]); } else { CE_DESC(x[l], x[i]); }
        }
      }
    }
  }
}
DI void merge16_desc(unsigned (&x)[16]) {
#pragma unroll
  for (int j = 8; j > 0; j >>= 1) {
#pragma unroll
    for (int i = 0; i < 16; ++i) { const int l = i ^ j; if (l > i) { CE_DESC(x[i], x[l]); } }
  }
}

DI void gemm_glds(const bf16_t* __restrict__ base, int ld, int r0, int k0, unsigned char* buf, int wid, int lane) {
  const bf16_t* src = base + (size_t)(r0 + wid * 8 + (lane >> 3)) * ld + k0 + (((lane & 7) ^ (lane >> 3)) << 3);
#pragma unroll
  for (int j = 0; j < 4; ++j)
    __builtin_amdgcn_global_load_lds((const unsigned*)(src + (size_t)j * 32 * ld), (unsigned*)(buf + (j * 4 + wid) * 1024), 16, 0, 0);
}
DI void gemm_tile(const GemmArgs& g, int m0, int n0, unsigned char* lds) {
  constexpr int WM = 2, WN = 4 / WM, TM = 128 / WM, TN = 128 / WN, MI = TM / 16, NI = TN / 16;
  const int tid = opaque_v(threadIdx.x), lane = tid & 63, wid = tid >> 6;
  const int wm = wid / WN, wn = wid % WN;
  const int nk = g.K / 64;
  const bool lerp = g.mu != nullptr;
  f32x4 acc[MI][NI];
#pragma unroll
  for (int i = 0; i < MI; ++i)
#pragma unroll
    for (int j = 0; j < NI; ++j) acc[i][j] = (f32x4){0.f, 0.f, 0.f, 0.f};
  u32x4 ra[4];
  if (lerp) { gemm_load_a(g, m0, 0, tid, ra); gemm_store_lds(lds, tid, ra); } else gemm_glds(g.A, g.lda, m0, 0, lds, wid, lane);
  gemm_glds(g.Bt, g.ldb, n0, 0, lds + 16384, wid, lane);
  asm volatile("s_waitcnt vmcnt(0)" ::: "memory");
  __syncthreads();
  const int fr = lane & 15, fq = lane >> 4;
  for (int kt = 0; kt < nk; ++kt) {
    unsigned char* cur = lds + (kt & 1) * 32768;
    unsigned char* nxt = lds + ((kt + 1) & 1) * 32768;
    if (kt + 1 < nk) {
      if (lerp) gemm_load_a(g, m0, (kt + 1) * 64, tid, ra); else gemm_glds(g.A, g.lda, m0, (kt + 1) * 64, nxt, wid, lane);
      gemm_glds(g.Bt, g.ldb, n0, (kt + 1) * 64, nxt + 16384, wid, lane);
    }
#pragma unroll
    for (int ks = 0; ks < 2; ++ks) {
      bf16x8 af[MI], bfr[NI];
#pragma unroll
      for (int i = 0; i < MI; ++i) af[i] = *(const bf16x8*)(cur + lds_off(wm * TM + i * 16 + fr, ks * 4 + fq));
#pragma unroll
      for (int j = 0; j < NI; ++j) bfr[j] = *(const bf16x8*)(cur + 16384 + lds_off(wn * TN + j * 16 + fr, ks * 4 + fq));
#pragma unroll
      for (int i = 0; i < MI; ++i)
#pragma unroll
        for (int j = 0; j < NI; ++j) acc[i][j] = __builtin_amdgcn_mfma_f32_16x16x32_bf16(bfr[j], af[i], acc[i][j], 0, 0, 0);
    }
    if (lerp && kt + 1 < nk) gemm_store_lds(nxt, tid, ra);
    asm volatile("s_waitcnt vmcnt(0)" ::: "memory");
    __syncthreads();
  }
#pragma unroll
  for (int i = 0; i < MI; ++i) {
    const int m = m0 + wm * TM + i * 16 + fr;
#pragma unroll
    for (int j = 0; j < NI; ++j) {
      const int n = n0 + wn * TN + j * 16 + fq * 4;
      if (n >= g.N) continue;
      const f32x4 v = acc[i][j];
      bf16_t* ob = (bf16_t*)g.out + (size_t)m * g.ldc + n;
      switch (g.epi) {
        case EPI_BF16: *(u32x2*)ob = (u32x2){cvt_pk_bf16(v[0], v[1]), cvt_pk_bf16(v[2], v[3])}; break;
        case EPI_TANH: *(u32x2*)ob = (u32x2){cvt_pk_bf16(tanhf(v[0]), tanhf(v[1])), cvt_pk_bf16(tanhf(v[2]), tanhf(v[3]))}; break;
        case EPI_SIGMOID: *(u32x2*)ob = (u32x2){cvt_pk_bf16(sigmoidf_(v[0]), sigmoidf_(v[1])), cvt_pk_bf16(sigmoidf_(v[2]), sigmoidf_(v[3]))}; break;
        case EPI_LW: {
          const f32x4 w0 = *(const f32x4*)(g.v0 + n); float o[4];
#pragma unroll
          for (int q = 0; q < 4; ++q) { const float xx = -(w0[q] + v[q]); const float sp = fmaxf(xx, 0.f) + log1pf(__expf(-fabsf(xx))); o[q] = -__expf(-sp - 0.5f); }
          *(u32x2*)ob = (u32x2){cvt_pk_bf16(o[0], o[1]), cvt_pk_bf16(o[2], o[3])};
        } break;
        case EPI_ASIG: {
          const f32x4 a0 = *(const f32x4*)(g.v0 + n);
          *(u32x2*)ob = (u32x2){cvt_pk_bf16(sigmoidf_(a0[0] + v[0]), sigmoidf_(a0[1] + v[1])), cvt_pk_bf16(sigmoidf_(a0[2] + v[2]), sigmoidf_(a0[3] + v[3]))};
        } break;
        case EPI_Z: {
          const int b = m / SEQ;
          const f32x4 xv = *(const f32x4*)(g.v0 + (size_t)m * D + n), gt = *(const f32x4*)(g.v1 + (size_t)b * 6144 + n);
          *(f32x4*)((float*)g.out + (size_t)m * g.ldc + n) = xv * ALPHA + gt * v;
        } break;
        case EPI_GATE: {
          const u32x2 yv = *(const u32x2*)ob;
          *(u32x2*)ob = (u32x2){cvt_pk_bf16(bf_lo(yv.x) * v[0], bf_hi(yv.x) * v[1]), cvt_pk_bf16(bf_lo(yv.y) * v[2], bf_hi(yv.y) * v[3])};
        } break;
        default: {
          const f32x4 sc = *(const f32x4*)(g.v0 + n);
          *(u32x2*)ob = (u32x2){cvt_pk_bf16(v[0] * sc[0], v[1] * sc[1]), cvt_pk_bf16(v[2] * sc[2], v[3] * sc[3])};
        } break;
      }
    }
  }
}

DI void scores_topk_tile(const bf16_t* __restrict__ q, const bf16_t* __restrict__ keys, unsigned* __restrict__ lists, int m0, int grp, unsigned char* lds) {
  const int tid = opaque_v(threadIdx.x), lane = tid & 63, wm = tid >> 6, fr = lane & 15, fq = lane >> 4;
#pragma unroll
  for (int hk = 0; hk < 2; ++hk)
#pragma unroll
    for (int i = 0; i < 4; ++i) {
      const int row = (tid >> 3) + i * 32, ch = tid & 7;
      const u32x4 va = *(const u32x4*)(q + (size_t)(m0 + row) * 2048 + grp * 128 + hk * 64 + ch * 8);
      const u32x4 vb = *(const u32x4*)(keys + (size_t)grp * 128 * 128 + (size_t)row * 128 + hk * 64 + ch * 8);
      *(u32x4*)(lds + hk * 16384 + lds_off(row, ch)) = va;
      *(u32x4*)(lds + 32768 + hk * 16384 + lds_off(row, ch)) = vb;
    }
  __syncthreads();
  f32x4 acc[2][8];
#pragma unroll
  for (int i = 0; i < 2; ++i)
#pragma unroll
    for (int j = 0; j < 8; ++j) acc[i][j] = (f32x4){0.f, 0.f, 0.f, 0.f};
#pragma unroll
  for (int kk = 0; kk < 4; ++kk) {
    const int hk = kk >> 1, ks = kk & 1;
    bf16x8 af[2];
#pragma unroll
    for (int i = 0; i < 2; ++i) af[i] = *(const bf16x8*)(lds + hk * 16384 + lds_off(wm * 32 + i * 16 + fr, ks * 4 + fq));
#pragma unroll
    for (int j = 0; j < 8; ++j) {
      const bf16x8 bfr = *(const bf16x8*)(lds + 32768 + hk * 16384 + lds_off(j * 16 + fr, ks * 4 + fq));
#pragma unroll
      for (int i = 0; i < 2; ++i) acc[i][j] = __builtin_amdgcn_mfma_f32_16x16x32_bf16(bfr, af[i], acc[i][j], 0, 0, 0);
    }
  }
  __syncthreads();
  constexpr int MI = 2, NI = 8, TM = 32;
  {
#pragma unroll
    for (int i = 0; i < MI; ++i)
#pragma unroll
      for (int j = 0; j < NI; ++j) {
        const int ml = wm * TM + i * 16 + fr, c = j * 4 + fq;
        u32x4 kv;
        kv.x = (f2key(acc[i][j][0]) & ~127u) | (unsigned)(127 - (c * 4 + 0)); kv.y = (f2key(acc[i][j][1]) & ~127u) | (unsigned)(127 - (c * 4 + 1));
        kv.z = (f2key(acc[i][j][2]) & ~127u) | (unsigned)(127 - (c * 4 + 2)); kv.w = (f2key(acc[i][j][3]) & ~127u) | (unsigned)(127 - (c * 4 + 3));
        *(u32x4*)(lds + ml * 528 + (c << 4)) = kv;
      }
    __syncthreads();
    {
      const int ml = wm * 32 + (lane & 31), hf = lane >> 5;
      unsigned a[16], b[16];
#pragma unroll
      for (int ch = 0; ch < 4; ++ch) {
#pragma unroll
        for (int cc = 0; cc < 4; ++cc) {
          const int c = hf * 16 + ch * 4 + cc;
          const u32x4 kv = *(const u32x4*)(lds + ml * 528 + (c << 4));
          b[cc * 4] = kv.x; b[cc * 4 + 1] = kv.y; b[cc * 4 + 2] = kv.z; b[cc * 4 + 3] = kv.w;
        }
        sort16_desc(b);
        if (ch == 0) {
#pragma unroll
          for (int e = 0; e < 16; ++e) a[e] = b[e];
        } else {
#pragma unroll
          for (int e = 0; e < 16; ++e) a[e] = max(a[e], b[15 - e]);
          merge16_desc(a);
        }
      }
#pragma unroll
      for (int e = 0; e < 16; ++e) b[e] = (unsigned)__shfl_xor((int)a[e], 32);
#pragma unroll
      for (int e = 0; e < 16; ++e) a[e] = max(a[e], b[15 - e]);
      merge16_desc(a);
      if (hf == 0) {
        const int m = m0 + ml;
        u32x4* dst = (u32x4*)(lists + ((size_t)m * 16 + grp) * 16);
        dst[0] = (u32x4){a[0], a[1], a[2], a[3]}; dst[1] = (u32x4){a[4], a[5], a[6], a[7]};
        dst[2] = (u32x4){a[8], a[9], a[10], a[11]}; dst[3] = (u32x4){a[12], a[13], a[14], a[15]};
      }
    }
    __syncthreads();
  }
}

DI GemmArgs mk(const bf16_t* A, int lda, const bf16_t* Bt, int ldb, int N, int K, int epi, void* out, int ldc,
               const float* mu = nullptr, const float* v0 = nullptr, const float* v1 = nullptr) {
  GemmArgs g; g.A = A; g.lda = lda; g.Bt = Bt; g.ldb = ldb; g.N = N; g.K = K; g.mu = mu; g.epi = epi; g.out = out; g.ldc = ldc; g.v0 = v0; g.v1 = v1; return g;
}
DI int sched_iters(int ntn, int nblk) {
  const int LB = nblk >> 3; int it = 0;
  for (int n0 = 0; n0 < ntn;) { int NT = min(8, ntn - n0); while (LB % NT) --NT; const int MT = LB / NT; it += (256 + 8 * MT - 1) / (8 * MT); n0 += NT; }
  return it;
}
DI bool sched_mn(int i, int bid, int nblk, int ntn, int& mt, int& nt) {
  const int x = bid & 7, l = bid >> 3, LB = nblk >> 3; int base = 0;
  for (int n0 = 0; n0 < ntn;) {
    int NT = min(8, ntn - n0); while (LB % NT) --NT;
    const int MT = LB / NT, rounds = (256 + 8 * MT - 1) / (8 * MT);
    if (i < base + rounds) { mt = (i - base) * 8 * MT + x * MT + (l % MT); nt = n0 + l / MT; return mt < 256; }
    base += rounds; n0 += NT;
  }
  return false;
}

constexpr int CL = 32;
constexpr int NCH = SEQ / CL;
constexpr int SN = 144, ST = 80;
struct ScanArgs {
  bf16_t* r; const bf16_t *k, *v, *lw, *a;
  const float *k_k, *k_a, *r_k, *lnx_g, *lnx_b;
  bf16_t* Pg;
  bf16_t *Qz0, *Qz1;
  float* Gg;
};
DI int tr_off(int row, int tok) { return row * ST + ((((tok >> 3) ^ ((row >> 3) & 3)) << 4) | ((tok & 7) << 1)); }
template <bool PT, bool QT>
DI f32x4 tile_mm(const unsigned char* P, int ps, const unsigned char* Q, int qs, int i0, int j0, int nks, f32x4 acc, int lane) {
  const int fr = lane & 15, fq = lane >> 4;
  for (int ks = 0; ks < nks; ++ks) {
    const bf16x8 pa = *(const bf16x8*)(PT ? P + tr_off(i0 + fr, fq * 8) : P + (i0 + fr) * ps + ks * 64 + fq * 16);
    const bf16x8 qb = *(const bf16x8*)(QT ? Q + tr_off(j0 + fr, fq * 8) : Q + (j0 + fr) * qs + ks * 64 + fq * 16);
    acc = __builtin_amdgcn_mfma_f32_16x16x32_bf16(pa, qb, acc, 0, 0, 0);
  }
  return acc;
}
DI bf16_t* qz_ptr(const ScanArgs& s, int ch) { return ((ch >> 13) ? s.Qz1 : s.Qz0) + (size_t)(ch & 8191) * 4096; }
DI void st_bf16x4(unsigned char* p, const f32x4& v) { *(u32x2*)p = (u32x2){cvt_pk_bf16(v[0], v[1]), cvt_pk_bf16(v[2], v[3])}; }

struct ScanIn { u32x4 r, k, v, w, a, z0, z1; };
template <bool PHASE_C>
DI void scan_fetch(const ScanArgs& s, int item, ScanIn& in) {
  const int c = item & (NCH - 1), h = (item >> 7) & 15, b = item >> 11;
  const int tid = opaque_v(threadIdx.x), tt = tid >> 3, c0 = (tid & 7) * 8;
  const size_t off = ((size_t)b * SEQ + (size_t)c * CL + tt) * D + h * HS + c0;
  in.k = *(const u32x4*)(s.k + off); in.v = *(const u32x4*)(s.v + off); in.w = *(const u32x4*)(s.lw + off); in.a = *(const u32x4*)(s.a + off);
  if (PHASE_C) {
    in.r = *(const u32x4*)(s.r + off);
    const bf16_t* Zg = qz_ptr(s, item);
    in.z0 = *(const u32x4*)(Zg + tid * 8); in.z1 = *(const u32x4*)(Zg + (tid + 256) * 8);
  }
}
template <bool PHASE_C>
DI void scan_load(const ScanArgs& s, const ScanIn& in, int h, float* lwbuf, unsigned char* At, unsigned char* Bt, unsigned char* Kt, unsigned char* Rt,
                  unsigned char* AtT, unsigned char* BhT, unsigned char* KhT, unsigned char* VT, float& bonus, float (&vout)[8], float* Gout) {
  const int tid = opaque_v(threadIdx.x), tt = tid >> 3, c0 = (tid & 7) * 8;
  const u32x4 vk = in.k, vv = in.v, vw = in.w, va = in.a;
  u32x4 vr = {0u, 0u, 0u, 0u};
  if (PHASE_C) vr = in.r;
  float fr_[8], fk[8], fv[8], fw[8], fa[8];
  { const unsigned ur[4] = {vr.x, vr.y, vr.z, vr.w}, uk[4] = {vk.x, vk.y, vk.z, vk.w}, uv[4] = {vv.x, vv.y, vv.z, vv.w}, uw[4] = {vw.x, vw.y, vw.z, vw.w}, ua[4] = {va.x, va.y, va.z, va.w};
#pragma unroll
    for (int j = 0; j < 4; ++j) {
      fr_[2 * j] = bf_lo(ur[j]); fr_[2 * j + 1] = bf_hi(ur[j]); fk[2 * j] = bf_lo(uk[j]); fk[2 * j + 1] = bf_hi(uk[j]);
      fv[2 * j] = bf_lo(uv[j]); fv[2 * j + 1] = bf_hi(uv[j]); fw[2 * j] = bf_lo(uw[j]); fw[2 * j + 1] = bf_hi(uw[j]);
      fa[2 * j] = bf_lo(ua[j]); fa[2 * j + 1] = bf_hi(ua[j]);
    } }
  *(f32x4*)(lwbuf + tt * 64 + c0) = (f32x4){fw[0], fw[1], fw[2], fw[3]}; *(f32x4*)(lwbuf + tt * 64 + c0 + 4) = (f32x4){fw[4], fw[5], fw[6], fw[7]};
  float kkr[8], nrm = 0.f, bon = 0.f, kp[8];
#pragma unroll
  for (int j = 0; j < 8; ++j) {
    const int ch = h * HS + c0 + j;
    kkr[j] = fk[j] * s.k_k[ch]; nrm += kkr[j] * kkr[j];
    kp[j] = fk[j] * (1.f + (fa[j] - 1.f) * s.k_a[ch]);
    if (PHASE_C) bon += fr_[j] * kp[j] * s.r_k[ch];
  }
  nrm += __shfl_xor(nrm, 1); nrm += __shfl_xor(nrm, 2); nrm += __shfl_xor(nrm, 4);
  if (PHASE_C) { bon += __shfl_xor(bon, 1); bon += __shfl_xor(bon, 2); bon += __shfl_xor(bon, 4); }
  bonus = bon;
  const float inv = rsqrtf(fmaxf(nrm, 1e-24f));
  __syncthreads();
  {
    const int c = tid & 63, sg = tid >> 6;
    float run = 0.f;
#pragma unroll
    for (int i = 0; i < 8; ++i) { run += lwbuf[(sg * 8 + i) * 64 + c]; lwbuf[(sg * 8 + i) * 64 + c] = run; }
  }
  __syncthreads();
  float cum[8], cl[8];
  {
    const int sg = tt >> 3;
#pragma unroll
    for (int hh = 0; hh < 2; ++hh) {
      const f32x4 me = *(const f32x4*)(lwbuf + tt * 64 + c0 + hh * 4);
      const f32x4 s0 = *(const f32x4*)(lwbuf + 7 * 64 + c0 + hh * 4), s1 = *(const f32x4*)(lwbuf + 15 * 64 + c0 + hh * 4),
                  s2 = *(const f32x4*)(lwbuf + 23 * 64 + c0 + hh * 4), s3 = *(const f32x4*)(lwbuf + 31 * 64 + c0 + hh * 4);
#pragma unroll
      for (int q = 0; q < 4; ++q) {
        const float pre = (sg > 0 ? s0[q] : 0.f) + (sg > 1 ? s1[q] : 0.f) + (sg > 2 ? s2[q] : 0.f);
        cum[hh * 4 + q] = me[q] + pre; cl[hh * 4 + q] = (s0[q] + s1[q]) + (s2[q] + s3[q]);
      }
    }
  }
  float at[8], bt[8], kt[8], rt[8], bh[8], kh[8];
#pragma unroll
  for (int j = 0; j < 8; ++j) {
    const float kk = kkr[j] * inv, bb = kk * fa[j];
    const float ein = __expf(cum[j]), eneg = __expf(-cum[j]), eex = __expf(cum[j] - fw[j]), eend = __expf(cl[j] - cum[j]);
    at[j] = -kk * eex; bt[j] = bb * eneg; kt[j] = kp[j] * eneg; rt[j] = fr_[j] * ein; bh[j] = bb * eend; kh[j] = kp[j] * eend;
    vout[j] = fv[j];
  }
  *(u32x4*)(At + tt * SN + c0 * 2) = (u32x4){cvt_pk_bf16(at[0], at[1]), cvt_pk_bf16(at[2], at[3]), cvt_pk_bf16(at[4], at[5]), cvt_pk_bf16(at[6], at[7])};
  *(u32x4*)(Bt + tt * SN + c0 * 2) = (u32x4){cvt_pk_bf16(bt[0], bt[1]), cvt_pk_bf16(bt[2], bt[3]), cvt_pk_bf16(bt[4], bt[5]), cvt_pk_bf16(bt[6], bt[7])};
  *(u32x4*)(Kt + tt * SN + c0 * 2) = (u32x4){cvt_pk_bf16(kt[0], kt[1]), cvt_pk_bf16(kt[2], kt[3]), cvt_pk_bf16(kt[4], kt[5]), cvt_pk_bf16(kt[6], kt[7])};
  if (PHASE_C) *(u32x4*)(Rt + tt * SN + c0 * 2) = (u32x4){cvt_pk_bf16(rt[0], rt[1]), cvt_pk_bf16(rt[2], rt[3]), cvt_pk_bf16(rt[4], rt[5]), cvt_pk_bf16(rt[6], rt[7])};
#pragma unroll
  for (int j = 0; j < 8; ++j) {
    *(bf16_t*)(VT + tr_off(c0 + j, tt)) = f2bf(fv[j]);
    if (!PHASE_C) {
      *(bf16_t*)(AtT + tr_off(c0 + j, tt)) = f2bf(at[j]);
      *(bf16_t*)(BhT + tr_off(c0 + j, tt)) = f2bf(bh[j]);
      *(bf16_t*)(KhT + tr_off(c0 + j, tt)) = f2bf(kh[j]);
    }
  }
  if (!PHASE_C && tt == 0 && Gout) {
#pragma unroll
    for (int j = 0; j < 8; ++j) Gout[c0 + j] = __expf(cl[j]);
  }
}
DI void scan_tinv(const float* A32, unsigned char* Tm, int lane) {
  const int c = lane & 31;
  float Tc[32];
#pragma unroll
  for (int i = 0; i < 32; ++i) {
    float s0 = (i == c) ? 1.f : 0.f, s1 = 0.f, s2 = 0.f, s3 = 0.f;
#pragma unroll
    for (int j4 = 0; j4 < (i + 3) / 4; ++j4) {
      const f32x4 a4 = *(const f32x4*)(A32 + i * 36 + j4 * 4);
      if (j4 * 4 + 0 < i) s0 += a4[0] * Tc[j4 * 4 + 0];
      if (j4 * 4 + 1 < i) s1 += a4[1] * Tc[j4 * 4 + 1];
      if (j4 * 4 + 2 < i) s2 += a4[2] * Tc[j4 * 4 + 2];
      if (j4 * 4 + 3 < i) s3 += a4[3] * Tc[j4 * 4 + 3];
    }
    Tc[i] = (s0 + s1) + (s2 + s3);
  }
  if (lane < 32) {
#pragma unroll
    for (int i = 0; i < 32; ++i) *(bf16_t*)(Tm + i * ST + c * 2) = f2bf(Tc[i]);
  }
}

DI void scan_phaseA_item(const ScanArgs& s, int item, const ScanIn& in, unsigned char* lds) {
  const int c = item & (NCH - 1), h = (item >> 7) & 15, b = item >> 11;
  const int tid = opaque_v(threadIdx.x), lane = tid & 63, wv = tid >> 6, fr = lane & 15, fq = lane >> 4;
  unsigned char* At = lds; unsigned char* Bt = At + 32 * SN; unsigned char* Kt = Bt + 32 * SN;
  unsigned char* AtT = Kt + 32 * SN; unsigned char* BhT = AtT + 64 * ST; unsigned char* KhT = BhT + 64 * ST; unsigned char* VT = KhT + 64 * ST;
  unsigned char* Tm = VT + 64 * ST; unsigned char* Aak = Tm + 32 * ST;
  float* A32 = (float*)(Aak + 32 * ST);
  unsigned char* W1T = (unsigned char*)A32 + 4608; unsigned char* M2T = W1T + 64 * ST; unsigned char* UlT = M2T + 64 * ST;
  float* lwbuf = (float*)W1T;
  const size_t gbase = ((size_t)b * SEQ + (size_t)c * CL) * D + h * HS;
  float bonus; float vv8[8];
  scan_load<false>(s, in, h, lwbuf, At, Bt, Kt, nullptr, AtT, BhT, KhT, VT, bonus, vv8, s.Gg + (size_t)item * 64);
  __syncthreads();
  {
    const int mat = wv >> 1, ti = wv & 1;
#pragma unroll
    for (int tj = 0; tj < 2; ++tj) {
      const f32x4 x = tile_mm<false, false>(At, SN, mat ? Kt : Bt, SN, ti * 16, tj * 16, 2, (f32x4){0.f, 0.f, 0.f, 0.f}, lane);
#pragma unroll
      for (int q = 0; q < 4; ++q) {
        const int i = ti * 16 + fq * 4 + q, j = tj * 16 + fr;
        const float val = (j < i) ? x[q] : 0.f;
        if (mat == 0) A32[i * 36 + j] = val; else *(bf16_t*)(Aak + i * ST + j * 2) = f2bf(val);
      }
    }
  }
  __syncthreads();
  if (wv == 0) scan_tinv(A32, Tm, lane);
  else {
    for (int tile = wv - 1; tile < 8; tile += 3) {
      const int ti = tile >> 2, tv = tile & 3;
      const f32x4 x = tile_mm<false, true>(Aak, ST, VT, ST, ti * 16, tv * 16, 1, (f32x4){0.f, 0.f, 0.f, 0.f}, lane);
      st_bf16x4(M2T + tr_off(tv * 16 + fr, ti * 16 + fq * 4), x);
    }
  }
  __syncthreads();
#pragma unroll
  for (int u = 0; u < 4; ++u) {
    const int tile = wv * 4 + u, which = tile >> 3, ti = (tile >> 2) & 1, tn = tile & 3;
    const f32x4 x = tile_mm<false, true>(Tm, ST, which ? M2T : AtT, ST, ti * 16, tn * 16, 1, (f32x4){0.f, 0.f, 0.f, 0.f}, lane);
    st_bf16x4((which ? UlT : W1T) + tr_off(tn * 16 + fr, ti * 16 + fq * 4), x);
  }
  __syncthreads();
  bf16_t* Pg = s.Pg + (size_t)item * 4096; bf16_t* Qg = qz_ptr(s, item);
#pragma unroll
  for (int u = 0; u < 4; ++u) {
    const int tile = wv * 4 + u, tk = tile >> 2, tn = tile & 3;
    const f32x4 xp = tile_mm<true, true>(W1T, ST, BhT, ST, tk * 16, tn * 16, 1, (f32x4){0.f, 0.f, 0.f, 0.f}, lane);
    *(u32x2*)(Pg + (tn * 16 + fr) * 64 + tk * 16 + fq * 4) = (u32x2){cvt_pk_bf16(xp[0], xp[1]), cvt_pk_bf16(xp[2], xp[3])};
    f32x4 xq = tile_mm<true, true>(BhT, ST, UlT, ST, tk * 16, tn * 16, 1, (f32x4){0.f, 0.f, 0.f, 0.f}, lane);
    xq = tile_mm<true, true>(KhT, ST, VT, ST, tk * 16, tn * 16, 1, xq, lane);
    __hip_atomic_store((unsigned long long*)(Qg + ((tk * 4 + tn) * 64 + lane) * 4), (unsigned long long)cvt_pk_bf16(xq[0], xq[1]) | ((unsigned long long)cvt_pk_bf16(xq[2], xq[3]) << 32), __ATOMIC_RELAXED, __HIP_MEMORY_SCOPE_AGENT);
  }
  __syncthreads();
}

constexpr int PSTR = 144;
constexpr int RSLOT = 64 * PSTR + 8192 + 256;
DI void scan_chain_block(const ScanArgs& s, int bh, unsigned char* lds) {
  const int tid = opaque_v(threadIdx.x), lane = tid & 63, tv = tid >> 6, fr = lane & 15, fq = lane >> 4;
  const int ch0 = bh * NCH;
  u32x4 pr[5];
  auto issue = [&](int c) {
    const bf16_t* Pg = s.Pg + (size_t)(ch0 + c) * 4096; const bf16_t* Qg = qz_ptr(s, ch0 + c);
    pr[0] = *(const u32x4*)(Pg + (size_t)tid * 8); pr[1] = *(const u32x4*)(Pg + (size_t)(tid + 256) * 8);
    pr[2] = *(const u32x4*)(Qg + (size_t)tid * 8); pr[3] = *(const u32x4*)(Qg + (size_t)(tid + 256) * 8);
    if (tid < 16) pr[4] = *(const u32x4*)(s.Gg + (size_t)(ch0 + c) * 64 + tid * 4);
  };
  auto commit = [&](int c) {
    unsigned char* sl = lds + (c & 3) * RSLOT;
    *(u32x4*)(sl + (tid >> 3) * PSTR + (tid & 7) * 16) = pr[0]; *(u32x4*)(sl + ((tid + 256) >> 3) * PSTR + (tid & 7) * 16) = pr[1];
    *(u32x4*)(sl + 64 * PSTR + tid * 16) = pr[2]; *(u32x4*)(sl + 64 * PSTR + (tid + 256) * 16) = pr[3];
    if (tid < 16) *(u32x4*)(sl + 64 * PSTR + 8192 + tid * 16) = pr[4];
  };
  issue(0); commit(0); issue(1); commit(1); issue(2); commit(2);
  __syncthreads();
  f32x4 Z[4];
#pragma unroll
  for (int t = 0; t < 4; ++t) Z[t] = (f32x4){0.f, 0.f, 0.f, 0.f};
  for (int c = 0; c < NCH; ++c) {
    if (c + 3 < NCH) issue(c + 3);
    const unsigned char* sl = lds + (c & 3) * RSLOT;
    bf16_t* Zo = qz_ptr(s, ch0 + c) + (tv * 16 + fr) * 64;
    unsigned zp[4][2];
#pragma unroll
    for (int t = 0; t < 4; ++t) { zp[t][0] = cvt_pk_bf16(Z[t][0], Z[t][1]); zp[t][1] = cvt_pk_bf16(Z[t][2], Z[t][3]); *(u32x2*)(Zo + t * 16 + fq * 4) = (u32x2){zp[t][0], zp[t][1]}; }
    bf16x8 zb[2];
#pragma unroll
    for (int ks = 0; ks < 2; ++ks) { const u32x4 w = {zp[2 * ks][0], zp[2 * ks][1], zp[2 * ks + 1][0], zp[2 * ks + 1][1]}; zb[ks] = __builtin_bit_cast(bf16x8, w); }
#pragma unroll
    for (int t = 0; t < 4; ++t) {
      const u32x2 qv = *(const u32x2*)(sl + 64 * PSTR + ((t * 4 + tv) * 64 + lane) * 8);
      const f32x4 g4 = *(const f32x4*)(sl + 64 * PSTR + 8192 + (t * 16 + fq * 4) * 4);
      f32x4 acc = (f32x4){bf_lo(qv.x) + g4[0] * Z[t][0], bf_hi(qv.x) + g4[1] * Z[t][1], bf_lo(qv.y) + g4[2] * Z[t][2], bf_hi(qv.y) + g4[3] * Z[t][3]};
#pragma unroll
      for (int ks = 0; ks < 2; ++ks) {
        const unsigned char* prow = sl + (t * 16 + fr) * PSTR + ks * 64 + fq * 8;
        const u32x2 p0 = *(const u32x2*)prow, p1 = *(const u32x2*)(prow + 32);
        const u32x4 w = {p0.x, p0.y, p1.x, p1.y};
        acc = __builtin_amdgcn_mfma_f32_16x16x32_bf16(__builtin_bit_cast(bf16x8, w), zb[ks], acc, 0, 0, 0);
      }
      Z[t] = acc;
    }
    if (c + 3 < NCH) commit(c + 3);
    __syncthreads();
  }
}

DI void scan_phaseC_item(const ScanArgs& s, int item, const ScanIn& in, unsigned char* lds) {
  const int c = item & (NCH - 1), h = (item >> 7) & 15, b = item >> 11;
  const int tid = opaque_v(threadIdx.x), lane = tid & 63, wv = tid >> 6, fr = lane & 15, fq = lane >> 4;
  unsigned char* At = lds; unsigned char* Bt = At + 32 * SN; unsigned char* Kt = Bt + 32 * SN; unsigned char* Rt = Kt + 32 * SN;
  unsigned char* VT = Rt + 32 * SN;
  unsigned char* Tm = VT + 64 * ST; unsigned char* Aak = Tm + 32 * ST; unsigned char* Arb = Aak + 32 * ST; unsigned char* Ark = Arb + 32 * ST;
  float* A32 = (float*)(Ark + 32 * ST);
  unsigned char* S0 = (unsigned char*)A32 + 4608;
  unsigned char* X1T = S0 + 64 * SN; unsigned char* UT = X1T + 64 * ST;
  float* Yb = (float*)(UT + 64 * ST);
  float* lwbuf = Yb;
  const size_t gbase = ((size_t)b * SEQ + (size_t)c * CL) * D + h * HS;
  float bonus; float vv8[8];
  { const int e0 = tid * 8, e1 = (tid + 256) * 8;
    *(u32x4*)(S0 + (e0 >> 6) * SN + (e0 & 63) * 2) = in.z0; *(u32x4*)(S0 + (e1 >> 6) * SN + (e1 & 63) * 2) = in.z1; }
  scan_load<true>(s, in, h, lwbuf, At, Bt, Kt, Rt, nullptr, nullptr, nullptr, VT, bonus, vv8, nullptr);
  __syncthreads();
  {
    const unsigned char* Pm = (wv < 2) ? At : Rt; const unsigned char* Qm = (wv & 1) ? Kt : Bt;
    unsigned char* dst = (wv == 1) ? Aak : (wv == 2 ? Arb : Ark);
#pragma unroll
    for (int t4 = 0; t4 < 4; ++t4) {
      const int ti = t4 >> 1, tj = t4 & 1;
      const f32x4 x = tile_mm<false, false>(Pm, SN, Qm, SN, ti * 16, tj * 16, 2, (f32x4){0.f, 0.f, 0.f, 0.f}, lane);
#pragma unroll
      for (int q = 0; q < 4; ++q) {
        const int i = ti * 16 + fq * 4 + q, j = tj * 16 + fr;
        const bool keep = (wv < 2) ? (j < i) : (j <= i);
        const float val = keep ? x[q] : 0.f;
        if (wv == 0) A32[i * 36 + j] = val; else *(bf16_t*)(dst + i * ST + j * 2) = f2bf(val);
      }
    }
  }
  __syncthreads();
  if (wv == 0) scan_tinv(A32, Tm, lane);
  else {
    for (int tile = wv - 1; tile < 8; tile += 3) {
      const int ti = tile >> 2, tv = tile & 3;
      f32x4 x = tile_mm<false, false>(At, SN, S0, SN, ti * 16, tv * 16, 2, (f32x4){0.f, 0.f, 0.f, 0.f}, lane);
      x = tile_mm<false, true>(Aak, ST, VT, ST, ti * 16, tv * 16, 1, x, lane);
      st_bf16x4(X1T + tr_off(tv * 16 + fr, ti * 16 + fq * 4), x);
    }
  }
  __syncthreads();
#pragma unroll
  for (int u = 0; u < 2; ++u) {
    const int tile = wv * 2 + u, ti = tile >> 2, tv = tile & 3;
    const f32x4 x = tile_mm<false, true>(Tm, ST, X1T, ST, ti * 16, tv * 16, 1, (f32x4){0.f, 0.f, 0.f, 0.f}, lane);
    st_bf16x4(UT + tr_off(tv * 16 + fr, ti * 16 + fq * 4), x);
  }
  __syncthreads();
#pragma unroll
  for (int u = 0; u < 2; ++u) {
    const int tile = wv * 2 + u, ti = tile >> 2, tv = tile & 3;
    f32x4 x = tile_mm<false, false>(Rt, SN, S0, SN, ti * 16, tv * 16, 2, (f32x4){0.f, 0.f, 0.f, 0.f}, lane);
    x = tile_mm<false, true>(Arb, ST, UT, ST, ti * 16, tv * 16, 1, x, lane);
    x = tile_mm<false, true>(Ark, ST, VT, ST, ti * 16, tv * 16, 1, x, lane);
#pragma unroll
    for (int q = 0; q < 4; ++q) Yb[(ti * 16 + fq * 4 + q) * 68 + tv * 16 + fr] = x[q];
  }
  __syncthreads();
  {
    const int tt = tid >> 3, c0 = (tid & 7) * 8;
    float yv[8], sum = 0.f;
#pragma unroll
    for (int j = 0; j < 8; ++j) { yv[j] = Yb[tt * 68 + c0 + j]; sum += yv[j]; }
    sum += __shfl_xor(sum, 1); sum += __shfl_xor(sum, 2); sum += __shfl_xor(sum, 4);
    const float mean = sum * (1.f / 64.f);
    float var = 0.f;
#pragma unroll
    for (int j = 0; j < 8; ++j) { const float d = yv[j] - mean; var += d * d; }
    var += __shfl_xor(var, 1); var += __shfl_xor(var, 2); var += __shfl_xor(var, 4);
    const float rstd = rsqrtf(var * (1.f / 64.f) + GN_EPS);
    const size_t off = gbase + (size_t)tt * D + c0;
    float o[8];
#pragma unroll
    for (int j = 0; j < 8; ++j) {
      const int chn = h * HS + c0 + j;
      o[j] = (yv[j] - mean) * rstd * s.lnx_g[chn] + s.lnx_b[chn] + bonus * vv8[j];
    }
    *(u32x4*)(s.r + off) = (u32x4){cvt_pk_bf16(o[0], o[1]), cvt_pk_bf16(o[2], o[3]), cvt_pk_bf16(o[4], o[5]), cvt_pk_bf16(o[6], o[7])};
  }
  __syncthreads();
}

DI void ln_phase(const float* __restrict__ z, const float* __restrict__ lg, const float* __restrict__ lb, float* __restrict__ xo,
                 const float* __restrict__ mod_l, int shift_idx, int scale_idx, bf16_t* __restrict__ ho, int bid, int nblk) {
  const int tq = opaque_v(threadIdx.x); const int lane = tq & 63, wv = tq >> 6;
  for (int row = bid * 4 + wv; row < T; row += nblk * 4) {
    const float* zr = z + (size_t)row * D;
    f32x4 v[4]; float s = 0.f;
#pragma unroll
    for (int i = 0; i < 4; ++i) { v[i] = *(const f32x4*)(zr + i * 256 + lane * 4); s += (v[i][0] + v[i][1]) + (v[i][2] + v[i][3]); }
    const float mean = wave_sum(s) * (1.f / D);
    float q = 0.f;
#pragma unroll
    for (int i = 0; i < 4; ++i) { const f32x4 d = v[i] - mean; q += (d[0] * d[0] + d[1] * d[1]) + (d[2] * d[2] + d[3] * d[3]); }
    const float rstd = rsqrtf(wave_sum(q) * (1.f / D) + LN_EPS);
    const int b = row / SEQ;
#pragma unroll
    for (int i = 0; i < 4; ++i) {
      const int d = i * 256 + lane * 4;
      const f32x4 o = (v[i] - mean) * rstd * *(const f32x4*)(lg + d) + *(const f32x4*)(lb + d);
      *(f32x4*)(xo + (size_t)row * D + d) = o;
      if (!ho) continue;
      const f32x4 sh = *(const f32x4*)(mod_l + (size_t)b * 6144 + shift_idx * D + d), sc = *(const f32x4*)(mod_l + (size_t)b * 6144 + scale_idx * D + d);
      const f32x4 hh = o * (sc + 1.f) + sh;
      *(u32x2*)(ho + (size_t)row * D + d) = (u32x2){cvt_pk_bf16(hh[0], hh[1]), cvt_pk_bf16(hh[2], hh[3])};
    }
  }
}

DI void combine_phase(const unsigned* __restrict__ lists, unsigned short* __restrict__ epk, float* __restrict__ gate, int bid, int nblk) {
  const int tq = opaque_v(threadIdx.x);
  for (int gid = bid * 256 + tq; gid < T * 8; gid += nblk * 256) {
    const unsigned* la = lists + (size_t)gid * 32;
    const unsigned* lb = la + 16;
    float s1[16], s2[16];
#pragma unroll
    for (int i = 0; i < 4; ++i) {
      const u32x4 a = *(const u32x4*)(la + i * 4), b = *(const u32x4*)(lb + i * 4);
      s1[i * 4] = key2f(a.x & ~127u); s1[i * 4 + 1] = key2f(a.y & ~127u); s1[i * 4 + 2] = key2f(a.z & ~127u); s1[i * 4 + 3] = key2f(a.w & ~127u);
      s2[i * 4] = key2f(b.x & ~127u); s2[i * 4 + 1] = key2f(b.y & ~127u); s2[i * 4 + 2] = key2f(b.z & ~127u); s2[i * 4 + 3] = key2f(b.w & ~127u);
    }
    unsigned c[4][16];
    {
      int n = 0;
#pragma unroll
      for (int a = 0; a < 16; ++a)
#pragma unroll
        for (int b = 0; b < 16; ++b)
          if ((a + 1) * (b + 1) <= 16) { c[n >> 4][n & 15] = (f2key(s1[a] + s2[b]) & ~255u) | (unsigned)(255 - (a * 16 + b)); ++n; }
#pragma unroll
      for (int q = 50; q < 64; ++q) c[q >> 4][q & 15] = 0u;
    }
    sort16_desc(c[0]); sort16_desc(c[1]); sort16_desc(c[2]); sort16_desc(c[3]);
#pragma unroll
    for (int e = 0; e < 16; ++e) { c[0][e] = max(c[0][e], c[1][15 - e]); c[2][e] = max(c[2][e], c[3][15 - e]); }
    merge16_desc(c[0]); merge16_desc(c[2]);
#pragma unroll
    for (int e = 0; e < 16; ++e) c[0][e] = max(c[0][e], c[2][15 - e]);
    merge16_desc(c[0]);
    float best[16], den = 0.f;
    const float mx = key2f(c[0][0] & ~255u);
#pragma unroll
    for (int e = 0; e < 16; ++e) { best[e] = __expf(key2f(c[0][e] & ~255u) - mx); den += best[e]; }
    const float inv = 1.f / den;
#pragma unroll
    for (int e = 0; e < 16; ++e) {
      const int pos = 255 - (int)(c[0][e] & 255u), a = pos >> 4, b = pos & 15;
      const int i1 = 127 - (int)(la[a] & 127u), i2 = 127 - (int)(lb[b] & 127u);
      { const int jj = (gid & 7) * 16 + e; epk[(size_t)(gid >> 3) * 128 + (jj < 64 ? 2 * jj : 2 * (jj - 64) + 1)] = (unsigned short)(i1 * 128 + i2); }
      gate[(size_t)gid * 16 + e] = best[e] * inv;
    }
  }
}

DI void table_fp8_phase(const float* __restrict__ src, unsigned char* __restrict__ dst, float* __restrict__ inv, int rows, int bid, int nblk) {
  const int tq = opaque_v(threadIdx.x); const int lane = tq & 63, wv = tq >> 6;
  for (int r = bid * 4 + wv; r < rows; r += nblk * 4) {
    const float* sr = src + (size_t)r * D + lane * 16;
    f32x4 v[4]; float mx = 0.f;
#pragma unroll
    for (int i = 0; i < 4; ++i) { v[i] = __builtin_nontemporal_load((const f32x4*)(sr + i * 4)); mx = fmaxf(mx, fmaxf(fmaxf(fabsf(v[i][0]), fabsf(v[i][1])), fmaxf(fabsf(v[i][2]), fabsf(v[i][3])))); }
#pragma unroll
    for (int o = 32; o >= 1; o >>= 1) mx = fmaxf(mx, __shfl_xor(mx, o));
    const float sc = mx > 0.f ? exp2f(floorf(log2f(384.f / mx))) : 1.f;
    u32x4 o4; unsigned w[4];
#pragma unroll
    for (int i = 0; i < 4; ++i) {
      int pk = 0;
      pk = __builtin_amdgcn_cvt_pk_fp8_f32(v[i][0] * sc, v[i][1] * sc, pk, false);
      pk = __builtin_amdgcn_cvt_pk_fp8_f32(v[i][2] * sc, v[i][3] * sc, pk, true);
      w[i] = (unsigned)pk;
    }
    o4.x = w[0]; o4.y = w[1]; o4.z = w[2]; o4.w = w[3];
    *(u32x4*)(dst + (size_t)r * D + lane * 16) = o4;
    if (lane == 0) inv[r] = 1.f / sc;
  }
}

struct PeerArgs {
  const bf16_t* h2;
  const unsigned char *u8, *v8;
  const float *uinv, *vinv;
  const unsigned* epk; const float* gate;
  float* part;
  float* coef;
  const float* xres;
  const float* gate2;
  float* z;
  unsigned* ctr_u; unsigned* ctr_v;
};
constexpr int PCH = 64;
DI void cvt16_fp8(const u32x4& d, float (&f)[16]) {
  const unsigned w[4] = {d.x, d.y, d.z, d.w};
#pragma unroll
  for (int i = 0; i < 4; ++i) {
    const f32x2 lo = __builtin_amdgcn_cvt_pk_f32_fp8((int)w[i], false), hi = __builtin_amdgcn_cvt_pk_f32_fp8((int)w[i], true);
    f[i * 4] = lo.x; f[i * 4 + 1] = lo.y; f[i * 4 + 2] = hi.x; f[i * 4 + 3] = hi.y;
  }
}
template <bool VPHASE>
DI void peer_slice_phase(const PeerArgs& a, unsigned char* lds) {
  const int tq = opaque_v(threadIdx.x); const int lane = tq & 63, wv = tq >> 6, cc = lane & 7;
  volatile int* nxt = (volatile int*)lds;
  const unsigned xcc = xb_xcc_id() & 7u;
  unsigned* ctr = VPHASE ? a.ctr_v : a.ctr_u;
  for (int ks = 0; ks < 8; ++ks) {
    const int s = (int)((xcc + ks) & 7u);
    for (;;) {
      __syncthreads();
      if (tq == 0) *nxt = (int)atomicAdd(&ctr[s * 16], 1u);
      __syncthreads();
      const int chunk = *nxt;
      if (chunk >= T / PCH) break;
      for (int ti = 0; ti < PCH / 4; ++ti) {
        const int t = chunk * PCH + wv * (PCH / 4) + ti;
        const unsigned ep = a.epk[(size_t)t * 64 + lane];
        const unsigned char* tab = (VPHASE ? a.v8 : a.u8) + s * 128 + cc * 16;
        u32x4 data[16];
        float cv[16];
        float c_lo = 0.f, c_hi = 0.f;
        if (VPHASE) { c_lo = a.coef[(size_t)t * 128 + lane]; c_hi = a.coef[(size_t)t * 128 + 64 + lane]; }
#pragma unroll
        for (int i = 0; i < 16; ++i) {
          const int src = (lane & ~7) | (i & 7);
          const unsigned ev = (unsigned)__shfl((int)ep, src);
          const unsigned e = (i < 8) ? (ev & 0xffffu) : (ev >> 16);
          if (VPHASE) cv[i] = __shfl(i < 8 ? c_lo : c_hi, src);
          data[i] = *(const u32x4*)(tab + (size_t)e * D);
        }
        if (!VPHASE) {
          const u32x4 h0 = *(const u32x4*)(a.h2 + (size_t)t * D + s * 128 + cc * 16), h1 = *(const u32x4*)(a.h2 + (size_t)t * D + s * 128 + cc * 16 + 8);
          float hf[16];
          { const unsigned u[8] = {h0.x, h0.y, h0.z, h0.w, h1.x, h1.y, h1.z, h1.w};
#pragma unroll
            for (int q = 0; q < 8; ++q) { hf[2 * q] = bf_lo(u[q]); hf[2 * q + 1] = bf_hi(u[q]); } }
          float r_lo = 0.f, r_hi = 0.f;
#pragma unroll
          for (int i = 0; i < 16; ++i) {
            float f[16]; cvt16_fp8(data[i], f);
            float d = 0.f;
#pragma unroll
            for (int q = 0; q < 16; ++q) d += f[q] * hf[q];
            d += __shfl_xor(d, 1); d += __shfl_xor(d, 2); d += __shfl_xor(d, 4);
            if ((i & 7) == cc) { if (i < 8) r_lo = d; else r_hi = d; }
          }
          float* pp = a.part + ((size_t)s * T + t) * 128;
          pp[lane] = r_lo; pp[64 + lane] = r_hi;
        } else {
          float acc[16];
#pragma unroll
          for (int q = 0; q < 16; ++q) acc[q] = 0.f;
#pragma unroll
          for (int i = 0; i < 16; ++i) {
            float f[16]; cvt16_fp8(data[i], f);
#pragma unroll
            for (int q = 0; q < 16; ++q) acc[q] += cv[i] * f[q];
          }
          float r8[8], r4[4], r2[2];
          { const bool up = (lane & 8) != 0;
#pragma unroll
            for (int q = 0; q < 8; ++q) { const float keep = up ? acc[8 + q] : acc[q], send = up ? acc[q] : acc[8 + q]; r8[q] = keep + __shfl_xor(send, 8); } }
          { const bool up = (lane & 16) != 0;
#pragma unroll
            for (int q = 0; q < 4; ++q) { const float keep = up ? r8[4 + q] : r8[q], send = up ? r8[q] : r8[4 + q]; r4[q] = keep + __shfl_xor(send, 16); } }
          { const bool up = (lane & 32) != 0;
#pragma unroll
            for (int q = 0; q < 2; ++q) { const float keep = up ? r4[2 + q] : r4[q], send = up ? r4[q] : r4[2 + q]; r2[q] = keep + __shfl_xor(send, 32); } }
          const int col = s * 128 + cc * 16 + ((lane >> 3) & 1) * 8 + ((lane >> 4) & 1) * 4 + ((lane >> 5) & 1) * 2;
          const int b = t / SEQ;
          const f32x2 xv = *(const f32x2*)(a.xres + (size_t)t * D + col), gt = *(const f32x2*)(a.gate2 + (size_t)b * 6144 + col);
          *(f32x2*)(a.z + (size_t)t * D + col) = (f32x2){ALPHA * xv.x + gt.x * r2[0], ALPHA * xv.y + gt.y * r2[1]};
        }
      }
    }
  }
  __syncthreads();
}
DI void peer_coef_phase(const PeerArgs& a, int bid, int nblk) {
  const int tq = opaque_v(threadIdx.x);
  for (int gid = bid * 256 + tq; gid < T * 128; gid += nblk * 256) {
    const int t = gid >> 7, j = gid & 127;
    const unsigned ep = a.epk[(size_t)t * 64 + (j & 63)];
    const unsigned e = (j < 64) ? (ep & 0xffffu) : (ep >> 16);
    float sum = 0.f;
#pragma unroll
    for (int s8 = 0; s8 < 8; ++s8) sum += a.part[((size_t)s8 * T + t) * 128 + j];
    a.coef[gid] = a.gate[gid] * gelu_exact(sum * a.uinv[e]) * a.vinv[e];
  }
}

DI void pool_phase(const bf16_t* __restrict__ zin, bf16_t* __restrict__ pout, int bid, int nblk) {
  const size_t n8 = (size_t)T * D / 8; const int tq = opaque_v(threadIdx.x);
  for (size_t i = (size_t)bid * 256 + tq; i < n8; i += (size_t)nblk * 256) {
    const size_t e = i * 8; const int t = (int)(e / D), d = (int)(e % D), tp = t % SEQ;
    const int win = 2 << (d / 256);
    const int cnt = min(tp + 1, win);
    float s[8], z0[8];
#pragma unroll
    for (int j = 0; j < 8; ++j) { s[j] = 0.f; z0[j] = 0.f; }
    for (int w = 0; w < cnt; ++w) {
      const u32x4 v = *(const u32x4*)(zin + e - (size_t)w * D);
      const unsigned u[4] = {v.x, v.y, v.z, v.w};
#pragma unroll
      for (int j = 0; j < 4; ++j) { const float lo = bf_lo(u[j]), hi = bf_hi(u[j]); s[2 * j] += lo; s[2 * j + 1] += hi; if (w == 0) { z0[2 * j] = lo; z0[2 * j + 1] = hi; } }
    }
    const float ic = 1.f / (float)cnt;
    float o[8];
#pragma unroll
    for (int j = 0; j < 8; ++j) o[j] = s[j] * ic - z0[j];
    *(u32x4*)(pout + e) = (u32x4){cvt_pk_bf16(o[0], o[1]), cvt_pk_bf16(o[2], o[3]), cvt_pk_bf16(o[4], o[5]), cvt_pk_bf16(o[6], o[7])};
  }
}


#define GRID_SYNC() xcd_barrier(xb)

__global__ void __launch_bounds__(256, 2) mega(Params p) {
  __shared__ __attribute__((aligned(16))) unsigned char lds[LDS_BYTES + 16];
  cg::grid_group grid = cg::this_grid();
  const int bid = blockIdx.x, nblk = gridDim.x;
  if (threadIdx.x == 0) { *(volatile LAS unsigned*)(lds + LDS_BYTES) = 0u; *(volatile LAS unsigned*)(lds + LDS_BYTES + 4) = 0u; }
  __syncthreads();
  const XcdBarrier xb = xcd_barrier_post(p.bar, (volatile LAS unsigned*)(lds + LDS_BYTES));
  const float* mod0 = p.mod; const float* mod1 = p.mod + (size_t)NB * 6144;
  bf16_t* S[7];
#pragma unroll
  for (int i = 0; i < 7; ++i) S[i] = (bf16_t*)p.slot[i];

  prologue_phase(p, lds, bid, nblk);
  grid.sync();
  bf16_t *h = S[0], *r = S[1], *k = S[2], *v = S[3], *lw = S[4], *av = S[5];
  bf16_t* tw = p.lora_tmp; bf16_t* ta = tw + (size_t)T * 64; bf16_t* tg = ta + (size_t)T * 64;
  modulate_phase(p.x, mod0, p.rw_mu, h, S[4], S[5], S[6], bid, nblk);
  GRID_SYNC();
  for (int it = 0, nit = sched_iters(28, nblk); it < nit; ++it) {
    int mt, nt; if (!sched_mn(it, bid, nblk, 28, mt, nt)) continue;
    GemmArgs g; int n0;
    if (nt < 24) { const int j = nt >> 3; n0 = (nt & 7) * 128; g = mk(S[4 + j], D, p.WT_rkv + (size_t)j * D * D, D, D, D, EPI_BF16, j == 0 ? r : (j == 1 ? k : v), D); }
    else if (nt == 24) { n0 = 0; g = mk(h, D, p.W1T, D, 64, D, EPI_TANH, tw, 64, p.rw_mu + 3 * D); }
    else if (nt == 25) { n0 = 0; g = mk(h, D, p.A1T, D, 64, D, EPI_BF16, ta, 64, p.rw_mu + 4 * D); }
    else { n0 = (nt - 26) * 128; g = mk(h, D, p.G1T, D, 192, D, EPI_SIGMOID, tg, 192, p.rw_mu + 5 * D); }
    gemm_tile(g, mt * 128, n0, lds);
  }
  GRID_SYNC();
  for (int it = 0, nit = sched_iters(16, nblk); it < nit; ++it) {
    int mt, nt; if (!sched_mn(it, bid, nblk, 16, mt, nt)) continue;
    const int j = nt >> 3, n0 = (nt & 7) * 128;
    GemmArgs g;
    if (j == 0) g = mk(tw, 64, p.W2T, 64, D, 64, EPI_LW, lw, D, nullptr, p.rw_w0);
    else g = mk(ta, 64, p.A2T, 64, D, 64, EPI_ASIG, av, D, nullptr, p.rw_a0);
    gemm_tile(g, mt * 128, n0, lds);
  }
  GRID_SYNC();
  {
    ScanArgs s; s.r = r; s.k = k; s.v = v; s.lw = lw; s.a = av; s.k_k = p.rw_k_k; s.k_a = p.rw_k_a; s.r_k = p.rw_r_k; s.lnx_g = p.rw_lnx_g; s.lnx_b = p.rw_lnx_b;
    s.Pg = (bf16_t*)p.out; s.Qz0 = S[0]; s.Qz1 = S[6]; s.Gg = p.Gg;
    { ScanIn cur, nxt; if (bid < NB * NH * NCH) scan_fetch<false>(s, bid, cur);
      for (int it = bid; it < NB * NH * NCH; it += nblk) { if (it + nblk < NB * NH * NCH) scan_fetch<false>(s, it + nblk, nxt); scan_phaseA_item(s, it, cur, lds); cur = nxt; } }
    GRID_SYNC();
    for (int it = bid; it < NB * NH; it += nblk) scan_chain_block(s, it, lds);
    GRID_SYNC();
    { ScanIn cur, nxt; if (bid < NB * NH * NCH) scan_fetch<true>(s, bid, cur);
      for (int it = bid; it < NB * NH * NCH; it += nblk) { if (it + nblk < NB * NH * NCH) scan_fetch<true>(s, it + nblk, nxt); scan_phaseC_item(s, it, cur, lds); cur = nxt; } }
    GRID_SYNC();
  }
  for (int it = 0, nit = sched_iters(8, nblk); it < nit; ++it) {
    int mt, nt; if (!sched_mn(it, bid, nblk, 8, mt, nt)) continue;
    gemm_tile(mk(tg, 192, p.G2T, 192, D, 192, EPI_GATE, r, D), mt * 128, nt * 128, lds);
  }
  GRID_SYNC();
  h = r;
  float* z = (float*)p.slot[2];
  for (int it = 0, nit = sched_iters(8, nblk); it < nit; ++it) {
    int mt, nt; if (!sched_mn(it, bid, nblk, 8, mt, nt)) continue;
    gemm_tile(mk(h, D, p.WoT, D, D, D, EPI_Z, z, D, nullptr, p.x, mod0 + 2 * D), mt * 128, nt * 128, lds);
  }
  table_fp8_phase(p.pe_u, p.slot[6], p.tinv, NEXP, bid, nblk);
  table_fp8_phase(p.pe_v, p.slot[6] + ((size_t)16 << 20), p.tinv + NEXP, NEXP, bid, nblk);
  table_fp8_phase(p.pe_u + (size_t)NEXP * D, p.slot[6] + ((size_t)32 << 20), p.tinv + 2 * NEXP, NEXP, bid, nblk);
  table_fp8_phase(p.pe_v + (size_t)NEXP * D, p.slot[6] + ((size_t)48 << 20), p.tinv + 3 * NEXP, NEXP, bid, nblk);
  GRID_SYNC();
  ln_phase(z, p.ln_g + 0 * D, p.ln_b + 0 * D, (float*)p.slot[4], mod0, 3, 4, S[0], bid, nblk);
  GRID_SYNC();

#pragma unroll
  for (int layer = 0; layer < 2; ++layer) {
    const float* modl = layer == 0 ? mod0 : mod1;
    const bf16_t* hp = S[0];
    bf16_t* q = (bf16_t*)p.slot[1];
    unsigned* lists = (unsigned*)p.slot[3];
    unsigned* epk = (unsigned*)(p.slot[3] + ((size_t)32 << 20));
    float* gate = (float*)(p.slot[3] + ((size_t)40 << 20));
    const bf16_t* WqT = p.WqT + (size_t)layer * 2048 * D; const bf16_t* Keys = p.KeysB + (size_t)layer * 16 * 128 * 128;
    for (int it = 0, nit = sched_iters(16, nblk); it < nit; ++it) {
      int mt, nt; if (!sched_mn(it, bid, nblk, 16, mt, nt)) continue;
      gemm_tile(mk(hp, D, WqT, D, 2048, D, EPI_BF16, q, 2048), mt * 128, nt * 128, lds);
    }
    GRID_SYNC();
    for (int it = 0, nit = sched_iters(16, nblk); it < nit; ++it) {
      int mt, grp; if (!sched_mn(it, bid, nblk, 16, mt, grp)) continue;
      scores_topk_tile(q, Keys, lists, mt * 128, grp, lds);
    }
    GRID_SYNC();
    combine_phase(lists, (unsigned short*)epk, gate, bid, nblk);
    GRID_SYNC();
    PeerArgs a; a.h2 = hp;
    a.u8 = p.slot[6] + ((size_t)(layer * 32) << 20); a.v8 = a.u8 + ((size_t)16 << 20);
    a.uinv = p.tinv + (layer * 2) * NEXP; a.vinv = a.uinv + NEXP;
    a.epk = epk; a.gate = gate; a.part = (float*)p.slot[1]; a.coef = (float*)p.slot[3];
    a.xres = (const float*)p.slot[4]; a.gate2 = modl + 5 * D; a.z = (float*)p.slot[1];
    a.ctr_u = p.bar + XCD_BAR_WORDS + (layer * 2) * 128; a.ctr_v = a.ctr_u + 128;
    peer_slice_phase<false>(a, lds);
    GRID_SYNC();
    peer_coef_phase(a, bid, nblk);
    GRID_SYNC();
    peer_slice_phase<true>(a, lds);
    GRID_SYNC();
    if (layer == 1) { ln_phase(a.z, p.ln_g + 3 * D, p.ln_b + 3 * D, p.out, mod1, 0, 1, nullptr, bid, nblk); break; }
    ln_phase(a.z, p.ln_g + 1 * D, p.ln_b + 1 * D, (float*)p.slot[4], mod1, 0, 1, S[0], bid, nblk);
    GRID_SYNC();
    const float* x2 = (const float*)p.slot[4];
    bf16_t *hB = S[0], *zin = S[1], *pp = S[2], *yp = S[1];
    for (int it = 0, nit = sched_iters(8, nblk); it < nit; ++it) {
      int mt, nt; if (!sched_mn(it, bid, nblk, 8, mt, nt)) continue;
      gemm_tile(mk(hB, D, p.PinT, D, D, D, EPI_BF16, zin, D), mt * 128, nt * 128, lds);
    }
    GRID_SYNC();
    pool_phase(zin, pp, bid, nblk);
    GRID_SYNC();
    for (int it = 0, nit = sched_iters(8, nblk); it < nit; ++it) {
      int mt, nt; if (!sched_mn(it, bid, nblk, 8, mt, nt)) continue;
      const int gi = nt >> 1, n0 = (nt & 1) * 128;
      gemm_tile(mk(pp + gi * 256, D, p.WgrpT + (size_t)gi * 256 * 256, 256, 256, 256, EPI_SCALE, yp + gi * 256, D, nullptr, p.pl_scale + gi * 256), mt * 128, n0, lds);
    }
    GRID_SYNC();
    float* z1 = (float*)p.slot[2];
    for (int it = 0, nit = sched_iters(8, nblk); it < nit; ++it) {
      int mt, nt; if (!sched_mn(it, bid, nblk, 8, mt, nt)) continue;
      gemm_tile(mk(yp, D, p.PoutT, D, D, D, EPI_Z, z1, D, nullptr, x2, mod1 + 2 * D), mt * 128, nt * 128, lds);
    }
    GRID_SYNC();
    ln_phase(z1, p.ln_g + 2 * D, p.ln_b + 2 * D, (float*)p.slot[4], mod1, 3, 4, S[0], bid, nblk);
    GRID_SYNC();
  }
}

extern "C" void kernel_launch(void* const* d_in, const int* in_sizes, int n_in, void* d_out, int out_size, void* d_ws, size_t ws_size, hipStream_t stream) {
  Params p{};
  const float** ip = (const float**)&p.x;
  for (int i = 0; i < 30; ++i) ip[i] = (const float*)d_in[i];
  p.out = (float*)d_out;
  unsigned char* w = (unsigned char*)d_ws; size_t off = 0;
  auto take = [&](size_t bytes) { unsigned char* r = w + off; off += (bytes + 255) & ~(size_t)255; return r; };
  p.bar = (unsigned*)take(16384);
  p.mod = (float*)take((size_t)2 * NB * 6144 * 4);
  p.WT_rkv = (bf16_t*)take((size_t)3 * D * D * 2);
  p.W1T = (bf16_t*)take((size_t)128 * D * 2); p.A1T = (bf16_t*)take((size_t)128 * D * 2); p.G1T = (bf16_t*)take((size_t)256 * D * 2);
  p.W2T = (bf16_t*)take((size_t)D * 64 * 2); p.A2T = (bf16_t*)take((size_t)D * 64 * 2); p.G2T = (bf16_t*)take((size_t)D * 192 * 2);
  p.WoT = (bf16_t*)take((size_t)D * D * 2); p.PinT = (bf16_t*)take((size_t)D * D * 2); p.PoutT = (bf16_t*)take((size_t)D * D * 2);
  p.WgrpT = (bf16_t*)take((size_t)4 * 256 * 256 * 2); p.WqT = (bf16_t*)take((size_t)2 * 2048 * D * 2); p.KeysB = (bf16_t*)take((size_t)2 * 16 * 128 * 128 * 2);
  p.tinv = (float*)take((size_t)4 * NEXP * 4);
  p.lora_tmp = (bf16_t*)take((size_t)T * 320 * 2);
  p.Gg = (float*)take((size_t)16384 * 64 * 4);
  for (int i = 0; i < 7; ++i) p.slot[i] = take((size_t)64 << 20);
  if (off > ws_size) return;

  static int grid_blocks = 0;
  if (!grid_blocks) {
    int dev = 0, cus = 0, per_cu = 0;
    hipGetDevice(&dev);
    hipDeviceGetAttribute(&cus, hipDeviceAttributeMultiprocessorCount, dev);
    hipOccupancyMaxActiveBlocksPerMultiprocessor(&per_cu, mega, 256, 0);
    if (per_cu > 2) per_cu = 2;
    if (per_cu < 1) per_cu = 1;
    grid_blocks = cus * per_cu;
  }
  hipMemsetAsync(p.bar, 0, 16384, stream);
  void* args[] = {&p};
  hipLaunchCooperativeKernel((void*)mega, dim3(grid_blocks), dim3(256), args, 0, stream);
}
```

```cpp
#include <hip/hip_runtime.h>
#include <hip/hip_cooperative_groups.h>
#include <stdint.h>
#include <stddef.h>
namespace cg = cooperative_groups;

typedef unsigned short bf16_t;
typedef short bf16x8 __attribute__((ext_vector_type(8)));
typedef float f32x4 __attribute__((ext_vector_type(4)));
typedef float f32x2 __attribute__((ext_vector_type(2)));
typedef unsigned u32x4 __attribute__((ext_vector_type(4)));
typedef unsigned u32x2 __attribute__((ext_vector_type(2)));
#define DI __device__ __forceinline__

constexpr int D = 1024, NB = 8, SEQ = 4096, T = NB * SEQ;
constexpr int NH = 16, HS = 64;
constexpr int NEXP = 16384;
constexpr float ALPHA = 1.4142135623730951f;
constexpr float LN_EPS = 1e-5f, GN_EPS = 64e-5f;
constexpr int LDS_BYTES = 72 * 1024;

typedef __bf16 bf16x2_t __attribute__((ext_vector_type(2)));
DI unsigned cvt_pk_bf16(float lo, float hi) { const f32x2 v = {lo, hi}; return __builtin_bit_cast(unsigned, __builtin_convertvector(v, bf16x2_t)); }
DI float bf_lo(unsigned u) { return __uint_as_float(u << 16); }
DI float bf_hi(unsigned u) { return __uint_as_float(u & 0xffff0000u); }
DI bf16_t f2bf(float f) { unsigned u = __float_as_uint(f); u += 0x7fffu + ((u >> 16) & 1u); return (bf16_t)(u >> 16); }
DI float sigmoidf_(float x) { return 1.f / (1.f + __expf(-x)); }
DI float wave_sum(float v) {
#pragma unroll
  for (int o = 32; o >= 1; o >>= 1) v += __shfl_xor(v, o);
  return v;
}
DI int opaque_v(int x) { asm volatile("" : "+v"(x)); return x; }
DI float gelu_exact(float v) { return 0.5f * v * (1.f + erff(v * 0.70710678118654752f)); }

#define XB_TMO      128
#define XB_XCNT(j)  (256  + 64 * (j))
#define XB_XSUB(j)  (1280 + 64 * (j))
#define XB_XGEN(j)  (2304 + 64 * (j))
#define XB_TOP      3328
#define XB_TOPGEN   3392
#define XCD_BAR_WORDS 3456
#define XB_SPIN_CAP (1u << 22)
#define LAS __attribute__((address_space(3)))
DI unsigned xb_ld(unsigned* p)              { return __hip_atomic_load(p, __ATOMIC_RELAXED, __HIP_MEMORY_SCOPE_AGENT); }
DI unsigned xb_add(unsigned* p, unsigned v) { return __hip_atomic_fetch_add(p, v, __ATOMIC_RELAXED, __HIP_MEMORY_SCOPE_AGENT); }
DI unsigned xb_xcc_id() { return (unsigned)__builtin_amdgcn_s_getreg((3 << 11) | 20) & 0xFu; }
#define XB_SPIN(cond, bar) do { unsigned _sp = 0; while (cond) { __builtin_amdgcn_s_sleep(1); \
    if ((++_sp & 255u) == 0u) { if (xb_ld(&(bar)[XB_TMO])) break; if (_sp > XB_SPIN_CAP) { atomicAdd(&(bar)[XB_TMO], 1u); break; } } } } while (0)
struct XcdBarrier { unsigned* bar; unsigned x; volatile LAS unsigned* st; };
DI XcdBarrier xcd_barrier_post(unsigned* bar, volatile LAS unsigned* st) {
  XcdBarrier b; b.bar = bar; b.x = xb_xcc_id(); b.st = st;
  if (threadIdx.x == 0) (void)xb_add(&bar[XB_XCNT(b.x)], 1u);
  return b;
}
DI void xcd_barrier_complete(unsigned* bar, unsigned x, unsigned& nloc, unsigned& nx) {
  const unsigned G = gridDim.x * gridDim.y * gridDim.z;
  unsigned sum, cnt, mine, sp = 0u;
  for (;;) {
    sum = 0u; cnt = 0u; mine = 0u;
#pragma unroll
    for (unsigned j = 0; j < 16; ++j) { const unsigned c = xb_ld(&bar[XB_XCNT(j)]); sum += c; cnt += (c > 0u) ? 1u : 0u; mine = (j == x) ? c : mine; }
    if (sum == G) break;
    __builtin_amdgcn_s_sleep(1);
    if ((++sp & 255u) == 0u) { if (xb_ld(&bar[XB_TMO])) break; if (sp > XB_SPIN_CAP) { atomicAdd(&bar[XB_TMO], 1u); break; } }
  }
  nloc = mine > 0u ? mine : 1u; nx = cnt > 0u ? cnt : 1u;
}
DI void xcd_barrier(const XcdBarrier& b) {
  asm volatile("s_waitcnt vmcnt(0)" ::: "memory");
  __syncthreads();
  if (threadIdx.x == 0) {
    unsigned* bar = b.bar;
    __builtin_amdgcn_s_waitcnt(0);
    unsigned nloc = b.st[0], nx = b.st[1];
    if (nloc == 0u) { xcd_barrier_complete(bar, b.x, nloc, nx); b.st[0] = nloc; b.st[1] = nx; }
    const unsigned old = xb_add(&bar[XB_XSUB(b.x)], 1u);
    const unsigned gen = old / nloc;
    if (old + 1u == (gen + 1u) * nloc) {
      __builtin_amdgcn_fence(__ATOMIC_RELEASE, "agent");
      asm volatile("s_waitcnt vmcnt(0)" ::: "memory");
      const unsigned og = xb_add(&bar[XB_TOP], 1u);
      const unsigned tg = og / nx;
      if (og + 1u == (tg + 1u) * nx) xb_add(&bar[XB_TOPGEN], 1u);
      else XB_SPIN(xb_ld(&bar[XB_TOPGEN]) == tg, bar);
      __builtin_amdgcn_fence(__ATOMIC_ACQUIRE, "agent");
      xb_add(&bar[XB_XGEN(b.x)], 1u);
      asm volatile("s_waitcnt vmcnt(0)" ::: "memory");
    } else {
      XB_SPIN(xb_ld(&bar[XB_XGEN(b.x)]) == gen, bar);
      __builtin_amdgcn_fence(__ATOMIC_ACQUIRE, "agent");
      asm volatile("s_waitcnt vmcnt(0)" ::: "memory");
    }
  }
  __syncthreads();
}

struct Params {
  const float *x, *c, *ada_w, *ada_b, *ln_g, *ln_b, *rw_mu, *rw_w_rkv, *rw_w0, *rw_w1, *rw_w2, *rw_a0, *rw_a1, *rw_a2, *rw_g1, *rw_g2,
      *rw_k_k, *rw_k_a, *rw_r_k, *rw_lnx_g, *rw_lnx_b, *rw_w_o, *pl_w_in, *pl_w_grp, *pl_scale, *pl_w_out, *pe_w_q, *pe_keys, *pe_u, *pe_v;
  float* out;
  float* mod;
  bf16_t *WT_rkv, *W1T, *A1T, *G1T, *W2T, *A2T, *G2T, *WoT, *PinT, *PoutT, *WgrpS, *WcT, *WqB, *WeffT, *KeysB;
  unsigned char* slot[7];
  float* tinv;
  bf16_t* lora_tmp;
  float* Gg;
  unsigned* bar;
};

DI void mod_item(const Params& p, int item, unsigned char* lds) {
  float* cond = (float*)lds;
  float (*red)[NB][32] = (float (*)[NB][32])(lds + 32768);
  const int tid = opaque_v(threadIdx.x);
  for (int i = tid; i < NB * D; i += 256) { float v = p.c[i]; cond[i] = v / (1.f + __expf(-v)); }
  __syncthreads();
  const int l = item / 192, cb = item % 192;
  const int col = cb * 32 + (tid & 31), kg = tid >> 5;
  const float* w = p.ada_w + (size_t)l * D * 6144 + col;
  float acc[NB];
#pragma unroll
  for (int b = 0; b < NB; ++b) acc[b] = 0.f;
  for (int k = kg * 128; k < kg * 128 + 128; ++k) {
    const float wv = w[(size_t)k * 6144];
#pragma unroll
    for (int b = 0; b < NB; ++b) acc[b] += cond[b * D + k] * wv;
  }
#pragma unroll
  for (int b = 0; b < NB; ++b) red[kg][b][tid & 31] = acc[b];
  __syncthreads();
  {
    const int b = tid >> 5, cc = tid & 31;
    float s = 0.f;
#pragma unroll
    for (int g = 0; g < 8; ++g) s += red[g][b][cc];
    const int n = cb * 32 + cc;
    p.mod[((size_t)l * NB + b) * 6144 + n] = s + p.ada_b[l * 6144 + n];
  }
  __syncthreads();
}

DI void transpose_item(const float* __restrict__ src, bf16_t* __restrict__ dst, int K, int N, int Kpad, int Npad, size_t sbs, size_t dbs, int item, unsigned char* lds) {
  float (*tile)[33] = (float (*)[33])lds;
  const int nb_n = Npad / 32, nb_k = Kpad / 32;
  const int per = nb_n * nb_k;
  const int bz = item / per, r = item % per;
  const int bk = r / nb_n, bn = r % nb_n;
  src += bz * sbs; dst += bz * dbs;
  const int tq = opaque_v(threadIdx.x); const int tx = tq & 31, ty = tq >> 5;
#pragma unroll
  for (int i = 0; i < 4; ++i) {
    const int k = bk * 32 + ty + i * 8, n = bn * 32 + tx;
    tile[ty + i * 8][tx] = (k < K && n < N) ? src[(size_t)k * N + n] : 0.f;
  }
  __syncthreads();
#pragma unroll
  for (int i = 0; i < 4; ++i) {
    const int n = bn * 32 + ty + i * 8, k = bk * 32 + tx;
    dst[(size_t)n * Kpad + k] = f2bf(tile[tx][ty + i * 8]);
  }
  __syncthreads();
}
DI void cvt_range(const float* __restrict__ src, bf16_t* __restrict__ dst, size_t n8, int bid, int nblk) {
  const int tq = opaque_v(threadIdx.x);
  for (size_t i = (size_t)bid * 256 + tq; i < n8; i += (size_t)nblk * 256) {
    const f32x4 a = *(const f32x4*)(src + i * 8), b = *(const f32x4*)(src + i * 8 + 4);
    u32x4 o; o.x = cvt_pk_bf16(a[0], a[1]); o.y = cvt_pk_bf16(a[2], a[3]); o.z = cvt_pk_bf16(b[0], b[1]); o.w = cvt_pk_bf16(b[2], b[3]);
    *(u32x4*)(dst + i * 8) = o;
  }
}
DI void prologue_phase(const Params& p, unsigned char* lds, int bid, int nblk) {
  constexpr int total = 384 + 3072 + 128 + 128 + 256 + 64 + 64 + 192 + 1024 + 1024 + 1024;
  for (int it = bid; it < total; it += nblk) {
    int r = it;
    if (r < 384) { mod_item(p, r, lds); continue; } r -= 384;
    if (r < 3072) { transpose_item(p.rw_w_rkv, p.WT_rkv, D, D, D, D, (size_t)D * D, (size_t)D * D, r, lds); continue; } r -= 3072;
    if (r < 128) { transpose_item(p.rw_w1, p.W1T, D, 64, D, 128, 0, 0, r, lds); continue; } r -= 128;
    if (r < 128) { transpose_item(p.rw_a1, p.A1T, D, 64, D, 128, 0, 0, r, lds); continue; } r -= 128;
    if (r < 256) { transpose_item(p.rw_g1, p.G1T, D, 160, D, 256, 0, 0, r, lds); continue; } r -= 256;
    if (r < 64) { transpose_item(p.rw_w2, p.W2T, 64, D, 64, D, 0, 0, r, lds); continue; } r -= 64;
    if (r < 64) { transpose_item(p.rw_a2, p.A2T, 64, D, 64, D, 0, 0, r, lds); continue; } r -= 64;
    if (r < 192) { transpose_item(p.rw_g2, p.G2T, 160, D, 192, D, 0, 0, r, lds); continue; } r -= 192;
    if (r < 1024) { transpose_item(p.rw_w_o, p.WoT, D, D, D, D, 0, 0, r, lds); continue; } r -= 1024;
    if (r < 1024) { transpose_item(p.pl_w_in, p.PinT, D, D, D, D, 0, 0, r, lds); continue; } r -= 1024;
    transpose_item(p.pl_w_out, p.PoutT, D, D, D, D, 0, 0, r, lds);
  }
  cvt_range(p.pe_keys, p.KeysB, (size_t)2 * 16 * 128 * 128 / 8, bid, nblk);
  cvt_range(p.pe_w_q, p.WqB, (size_t)2 * D * 2048 / 8, bid, nblk);
  {
    const int tq = opaque_v(threadIdx.x);
    for (int i = bid * 256 + tq; i < 4 * 256 * 256 / 8; i += nblk * 256) {
      const int e0 = (i * 8) & 255, g4 = (i * 8) >> 16;
      const f32x4 a0 = *(const f32x4*)(p.pl_w_grp + (size_t)i * 8), a1 = *(const f32x4*)(p.pl_w_grp + (size_t)i * 8 + 4);
      const f32x4 s0 = *(const f32x4*)(p.pl_scale + g4 * 256 + e0), s1 = *(const f32x4*)(p.pl_scale + g4 * 256 + e0 + 4);
      const f32x4 b0 = a0 * s0, b1 = a1 * s1;
      *(u32x4*)(p.WgrpS + (size_t)i * 8) = (u32x4){cvt_pk_bf16(b0[0], b0[1]), cvt_pk_bf16(b0[2], b0[3]), cvt_pk_bf16(b1[0], b1[1]), cvt_pk_bf16(b1[2], b1[3])};
    }
  }
}

DI void modulate_phase(const float* __restrict__ x, const float* __restrict__ mod_l, const float* __restrict__ mu, bf16_t* __restrict__ h, bf16_t* __restrict__ xr, bf16_t* __restrict__ xk,
                       bf16_t* __restrict__ xv, int bid, int nblk) {
  const size_t n8 = (size_t)T * D / 8; const int tq = opaque_v(threadIdx.x);
  for (size_t i = (size_t)bid * 256 + tq; i < n8; i += (size_t)nblk * 256) {
    const size_t e = i * 8; const int t = (int)(e / D), d = (int)(e % D), b = t / SEQ;
    const float* sh = mod_l + (size_t)b * 6144 + 0 * D + d; const float* sc = mod_l + (size_t)b * 6144 + 1 * D + d;
    float hv[8], pv[8];
    {
      const f32x4 a0 = *(const f32x4*)(x + e), a1 = *(const f32x4*)(x + e + 4);
      const f32x4 s0 = *(const f32x4*)sh, s1 = *(const f32x4*)(sh + 4), c0 = *(const f32x4*)sc, c1 = *(const f32x4*)(sc + 4);
      const f32x4 r0 = a0 * (c0 + 1.f) + s0, r1 = a1 * (c1 + 1.f) + s1;
      f32x4 q0 = {0.f, 0.f, 0.f, 0.f}, q1 = {0.f, 0.f, 0.f, 0.f};
      if ((t % SEQ) != 0) { const f32x4 b0 = *(const f32x4*)(x + e - D), b1 = *(const f32x4*)(x + e - D + 4); q0 = b0 * (c0 + 1.f) + s0; q1 = b1 * (c1 + 1.f) + s1; }
#pragma unroll
      for (int j = 0; j < 4; ++j) { hv[j] = r0[j]; hv[4 + j] = r1[j]; pv[j] = q0[j]; pv[4 + j] = q1[j]; }
    }
    u32x4 o; o.x = cvt_pk_bf16(hv[0], hv[1]); o.y = cvt_pk_bf16(hv[2], hv[3]); o.z = cvt_pk_bf16(hv[4], hv[5]); o.w = cvt_pk_bf16(hv[6], hv[7]);
    *(u32x4*)(h + e) = o;
#pragma unroll
    for (int n = 0; n < 3; ++n) {
      const f32x4 m0 = *(const f32x4*)(mu + n * D + d), m1 = *(const f32x4*)(mu + n * D + d + 4);
      float w[8];
#pragma unroll
      for (int j = 0; j < 8; ++j) { const float m = j < 4 ? m0[j] : m1[j - 4]; w[j] = hv[j] + (pv[j] - hv[j]) * m; }
      u32x4 q; q.x = cvt_pk_bf16(w[0], w[1]); q.y = cvt_pk_bf16(w[2], w[3]); q.z = cvt_pk_bf16(w[4], w[5]); q.w = cvt_pk_bf16(w[6], w[7]);
      *(u32x4*)((n == 0 ? xr : (n == 1 ? xk : xv)) + e) = q;
    }
  }
}

enum { EPI_BF16 = 0, EPI_TANH, EPI_SIGMOID, EPI_LW, EPI_ASIG, EPI_Z, EPI_SCALE, EPI_GATE, EPI_TOPK };
struct GemmArgs {
  const bf16_t* A; int lda;
  const bf16_t* Bt; int ldb;
  int N, K;
  const float* mu;
  int epi; void* out; int ldc;
  const float* v0; const float* v1;
};

DI int lds_off(int row, int chunk) { return row * 128 + ((chunk ^ (row & 7)) << 4); }

DI void gemm_load_a(const GemmArgs& g, int m0, int k0, int tid, u32x4 (&ra)[4]) {
#pragma unroll
  for (int i = 0; i < 4; ++i) {
    const int row = (tid >> 3) + i * 32, ch = tid & 7;
    const int m = m0 + row;
    const bf16_t* src = g.A + (size_t)m * g.lda + k0 + ch * 8;
    u32x4 v = *(const u32x4*)src;
    if (g.mu) {
      u32x4 pv = {0u, 0u, 0u, 0u};
      if ((m % SEQ) != 0) pv = *(const u32x4*)(src - g.lda);
      const f32x4 m0v = *(const f32x4*)(g.mu + k0 + ch * 8), m1v = *(const f32x4*)(g.mu + k0 + ch * 8 + 4);
      const unsigned hu[4] = {v.x, v.y, v.z, v.w}, pu[4] = {pv.x, pv.y, pv.z, pv.w};
      float o[8];
#pragma unroll
      for (int j = 0; j < 4; ++j) {
        const float h0 = bf_lo(hu[j]), h1 = bf_hi(hu[j]), p0 = bf_lo(pu[j]), p1 = bf_hi(pu[j]);
        const float mu0 = (2 * j < 4) ? m0v[(2 * j) & 3] : m1v[(2 * j) & 3], mu1 = (2 * j + 1 < 4) ? m0v[(2 * j + 1) & 3] : m1v[(2 * j + 1) & 3];
        o[2 * j] = h0 + (p0 - h0) * mu0; o[2 * j + 1] = h1 + (p1 - h1) * mu1;
      }
      v.x = cvt_pk_bf16(o[0], o[1]); v.y = cvt_pk_bf16(o[2], o[3]); v.z = cvt_pk_bf16(o[4], o[5]); v.w = cvt_pk_bf16(o[6], o[7]);
    }
    ra[i] = v;
  }
}
DI void gemm_load_b(const GemmArgs& g, int n0, int k0, int tid, u32x4 (&rb)[4]) {
#pragma unroll
  for (int i = 0; i < 4; ++i) {
    const int row = (tid >> 3) + i * 32, ch = tid & 7;
    rb[i] = *(const u32x4*)(g.Bt + (size_t)(n0 + row) * g.ldb + k0 + ch * 8);
  }
}
DI void gemm_store_lds(unsigned char* buf, int tid, const u32x4 (&r)[4]) {
#pragma unroll
  for (int i = 0; i < 4; ++i) {
    const int row = (tid >> 3) + i * 32, ch = tid & 7;
    *(u32x4*)(buf + lds_off(row, ch)) = r[i];
  }
}

DI unsigned f2key(float f) { unsigned u = __float_as_uint(f); return u ^ ((u >> 31) ? 0xffffffffu : 0x80000000u); }
DI float key2f(unsigned k) { unsigned u = (k >> 31) ? (k ^ 0x80000000u) : ~k; return __uint_as_float(u); }
#define CE_DESC(a, b) { const unsigned _mx = max(a, b), _mn = min(a, b); a = _mx; b = _mn; }
DI void sort16_desc(unsigned (&x)[16]) {
#pragma unroll
  for (int k = 2; k <= 16; k <<= 1) {
#pragma unroll
    for (int j = k >> 1; j > 0; j >>= 1) {
#pragma unroll
      for (int i = 0; i < 16; ++i) {
        const int l = i ^ j;
        if (l > i) {
          if ((i & k) == 0) { CE_DESC(x[i], x[l]); } else { CE_DESC(x[l], x[i]); }
        }
      }
    }
  }
}
DI void merge16_desc(unsigned (&x)[16]) {
#pragma unroll
  for (int j = 8; j > 0; j >>= 1) {
#pragma unroll
    for (int i = 0; i < 16; ++i) { const int l = i ^ j; if (l > i) { CE_DESC(x[i], x[l]); } }
  }
}

DI void gemm_glds(const bf16_t* __restrict__ base, int ld, int r0, int k0, unsigned char* buf, int wid, int lane) {
  const bf16_t* src = base + (size_t)(r0 + wid * 8 + (lane >> 3)) * ld + k0 + (((lane & 7) ^ (lane >> 3)) << 3);
#pragma unroll
  for (int j = 0; j < 4; ++j)
    __builtin_amdgcn_global_load_lds((const unsigned*)(src + (size_t)j * 32 * ld), (unsigned*)(buf + (j * 4 + wid) * 1024), 16, 0, 0);
}
DI void gemm_tile(const GemmArgs& g, int m0, int n0, unsigned char* lds) {
  constexpr int WM = 2, WN = 4 / WM, TM = 128 / WM, TN = 128 / WN, MI = TM / 16, NI = TN / 16;
  const int tid = opaque_v(threadIdx.x), lane = tid & 63, wid = tid >> 6;
  const int wm = wid / WN, wn = wid % WN;
  const int nk = g.K / 64;
  const bool lerp = g.mu != nullptr;
  f32x4 acc[MI][NI];
#pragma unroll
  for (int i = 0; i < MI; ++i)
#pragma unroll
    for (int j = 0; j < NI; ++j) acc[i][j] = (f32x4){0.f, 0.f, 0.f, 0.f};
  u32x4 ra[4];
  if (lerp) { gemm_load_a(g, m0, 0, tid, ra); gemm_store_lds(lds, tid, ra); } else gemm_glds(g.A, g.lda, m0, 0, lds, wid, lane);
  gemm_glds(g.Bt, g.ldb, n0, 0, lds + 16384, wid, lane);
  asm volatile("s_waitcnt vmcnt(0)" ::: "memory");
  __syncthreads();
  const int fr = lane & 15, fq = lane >> 4;
  for (int kt = 0; kt < nk; ++kt) {
    unsigned char* cur = lds + (kt & 1) * 32768;
    unsigned char* nxt = lds + ((kt + 1) & 1) * 32768;
    if (kt + 1 < nk) {
      if (lerp) gemm_load_a(g, m0, (kt + 1) * 64, tid, ra); else gemm_glds(g.A, g.lda, m0, (kt + 1) * 64, nxt, wid, lane);
      gemm_glds(g.Bt, g.ldb, n0, (kt + 1) * 64, nxt + 16384, wid, lane);
    }
#pragma unroll
    for (int ks = 0; ks < 2; ++ks) {
      bf16x8 af[MI], bfr[NI];
#pragma unroll
      for (int i = 0; i < MI; ++i) af[i] = *(const bf16x8*)(cur + lds_off(wm * TM + i * 16 + fr, ks * 4 + fq));
#pragma unroll
      for (int j = 0; j < NI; ++j) bfr[j] = *(const bf16x8*)(cur + 16384 + lds_off(wn * TN + j * 16 + fr, ks * 4 + fq));
#pragma unroll
      for (int i = 0; i < MI; ++i)
#pragma unroll
        for (int j = 0; j < NI; ++j) acc[i][j] = __builtin_amdgcn_mfma_f32_16x16x32_bf16(bfr[j], af[i], acc[i][j], 0, 0, 0);
    }
    if (lerp && kt + 1 < nk) gemm_store_lds(nxt, tid, ra);
    asm volatile("s_waitcnt vmcnt(0)" ::: "memory");
    __syncthreads();
  }
  if (g.epi == EPI_TOPK) {
    unsigned* lists = (unsigned*)g.out;
    const int grp = n0 >> 7;
#pragma unroll
    for (int i = 0; i < MI; ++i)
#pragma unroll
      for (int j = 0; j < NI; ++j) {
        const int ml = wm * TM + i * 16 + fr, c = wn * 16 + j * 4 + fq;
        u32x4 kv;
        kv.x = (f2key(acc[i][j][0]) & ~127u) | (unsigned)(127 - (c * 4 + 0)); kv.y = (f2key(acc[i][j][1]) & ~127u) | (unsigned)(127 - (c * 4 + 1));
        kv.z = (f2key(acc[i][j][2]) & ~127u) | (unsigned)(127 - (c * 4 + 2)); kv.w = (f2key(acc[i][j][3]) & ~127u) | (unsigned)(127 - (c * 4 + 3));
        *(u32x4*)(lds + ml * 528 + (c << 4)) = kv;
      }
    __syncthreads();
    {
      const int ml = wid * 32 + (lane & 31), hf = lane >> 5;
      unsigned a[16], b[16];
#pragma unroll
      for (int ch = 0; ch < 4; ++ch) {
#pragma unroll
        for (int cc = 0; cc < 4; ++cc) {
          const int c = hf * 16 + ch * 4 + cc;
          const u32x4 kv = *(const u32x4*)(lds + ml * 528 + (c << 4));
          b[cc * 4] = kv.x; b[cc * 4 + 1] = kv.y; b[cc * 4 + 2] = kv.z; b[cc * 4 + 3] = kv.w;
        }
        sort16_desc(b);
        if (ch == 0) {
#pragma unroll
          for (int e = 0; e < 16; ++e) a[e] = b[e];
        } else {
#pragma unroll
          for (int e = 0; e < 16; ++e) a[e] = max(a[e], b[15 - e]);
          merge16_desc(a);
        }
      }
#pragma unroll
      for (int e = 0; e < 16; ++e) b[e] = (unsigned)__shfl_xor((int)a[e], 32);
#pragma unroll
      for (int e = 0; e < 16; ++e) a[e] = max(a[e], b[15 - e]);
      merge16_desc(a);
      if (hf == 0) {
        const int m = m0 + ml;
        u32x4* dst = (u32x4*)(lists + ((size_t)m * 16 + grp) * 16);
        dst[0] = (u32x4){a[0], a[1], a[2], a[3]}; dst[1] = (u32x4){a[4], a[5], a[6], a[7]};
        dst[2] = (u32x4){a[8], a[9], a[10], a[11]}; dst[3] = (u32x4){a[12], a[13], a[14], a[15]};
      }
    }
    __syncthreads();
    return;
  }
#pragma unroll
  for (int i = 0; i < MI; ++i) {
    const int m = m0 + wm * TM + i * 16 + fr;
#pragma unroll
    for (int j = 0; j < NI; ++j) {
      const int n = n0 + wn * TN + j * 16 + fq * 4;
      if (n >= g.N) continue;
      const f32x4 v = acc[i][j];
      bf16_t* ob = (bf16_t*)g.out + (size_t)m * g.ldc + n;
      switch (g.epi) {
        case EPI_BF16: *(u32x2*)ob = (u32x2){cvt_pk_bf16(v[0], v[1]), cvt_pk_bf16(v[2], v[3])}; break;
        case EPI_TANH: *(u32x2*)ob = (u32x2){cvt_pk_bf16(tanhf(v[0]), tanhf(v[1])), cvt_pk_bf16(tanhf(v[2]), tanhf(v[3]))}; break;
        case EPI_SIGMOID: *(u32x2*)ob = (u32x2){cvt_pk_bf16(sigmoidf_(v[0]), sigmoidf_(v[1])), cvt_pk_bf16(sigmoidf_(v[2]), sigmoidf_(v[3]))}; break;
        case EPI_LW: {
          const f32x4 w0 = *(const f32x4*)(g.v0 + n); float o[4];
#pragma unroll
          for (int q = 0; q < 4; ++q) { const float xx = -(w0[q] + v[q]); const float sp = fmaxf(xx, 0.f) + log1pf(__expf(-fabsf(xx))); o[q] = -__expf(-sp - 0.5f); }
          *(u32x2*)ob = (u32x2){cvt_pk_bf16(o[0], o[1]), cvt_pk_bf16(o[2], o[3])};
        } break;
        case EPI_ASIG: {
          const f32x4 a0 = *(const f32x4*)(g.v0 + n);
          *(u32x2*)ob = (u32x2){cvt_pk_bf16(sigmoidf_(a0[0] + v[0]), sigmoidf_(a0[1] + v[1])), cvt_pk_bf16(sigmoidf_(a0[2] + v[2]), sigmoidf_(a0[3] + v[3]))};
        } break;
        case EPI_Z: {
          const int b = m / SEQ;
          const f32x4 xv = *(const f32x4*)(g.v0 + (size_t)m * D + n), gt = *(const f32x4*)(g.v1 + (size_t)b * 6144 + n);
          *(f32x4*)((float*)g.out + (size_t)m * g.ldc + n) = xv * ALPHA + gt * v;
        } break;
        case EPI_GATE: {
          const u32x2 yv = *(const u32x2*)ob;
          *(u32x2*)ob = (u32x2){cvt_pk_bf16(bf_lo(yv.x) * v[0], bf_hi(yv.x) * v[1]), cvt_pk_bf16(bf_lo(yv.y) * v[2], bf_hi(yv.y) * v[3])};
        } break;
        default: {
          const f32x4 sc = *(const f32x4*)(g.v0 + n);
          *(u32x2*)ob = (u32x2){cvt_pk_bf16(v[0] * sc[0], v[1] * sc[1]), cvt_pk_bf16(v[2] * sc[2], v[3] * sc[3])};
        } break;
      }
    }
  }
}

DI GemmArgs mk(const bf16_t* A, int lda, const bf16_t* Bt, int ldb, int N, int K, int epi, void* out, int ldc,
               const float* mu = nullptr, const float* v0 = nullptr, const float* v1 = nullptr) {
  GemmArgs g; g.A = A; g.lda = lda; g.Bt = Bt; g.ldb = ldb; g.N = N; g.K = K; g.mu = mu; g.epi = epi; g.out = out; g.ldc = ldc; g.v0 = v0; g.v1 = v1; return g;
}
DI int sched_iters(int ntn, int nblk) {
  const int LB = nblk >> 3; int it = 0;
  for (int n0 = 0; n0 < ntn;) { int NT = min(8, ntn - n0); while (LB % NT) --NT; const int MT = LB / NT; it += (256 + 8 * MT - 1) / (8 * MT); n0 += NT; }
  return it;
}
DI bool sched_mn(int i, int bid, int nblk, int ntn, int& mt, int& nt) {
  const int x = bid & 7, l = bid >> 3, LB = nblk >> 3; int base = 0;
  for (int n0 = 0; n0 < ntn;) {
    int NT = min(8, ntn - n0); while (LB % NT) --NT;
    const int MT = LB / NT, rounds = (256 + 8 * MT - 1) / (8 * MT);
    if (i < base + rounds) { mt = (i - base) * 8 * MT + x * MT + (l % MT); nt = n0 + l / MT; return mt < 256; }
    base += rounds; n0 += NT;
  }
  return false;
}

constexpr int CL = 32;
constexpr int NCH = SEQ / CL;
constexpr int SN = 144, ST = 80;
struct ScanArgs {
  bf16_t* r; const bf16_t *k, *v, *lw, *a;
  const float *k_k, *k_a, *r_k, *lnx_g, *lnx_b;
  bf16_t* Pg;
  bf16_t *Qz0, *Qz1;
  float* Gg;
};
DI int tr_off(int row, int tok) { return row * ST + ((((tok >> 3) ^ ((row >> 3) & 3)) << 4) | ((tok & 7) << 1)); }
template <bool PT, bool QT>
DI f32x4 tile_mm(const unsigned char* P, int ps, const unsigned char* Q, int qs, int i0, int j0, int nks, f32x4 acc, int lane) {
  const int fr = lane & 15, fq = lane >> 4;
  for (int ks = 0; ks < nks; ++ks) {
    const bf16x8 pa = *(const bf16x8*)(PT ? P + tr_off(i0 + fr, fq * 8) : P + (i0 + fr) * ps + ks * 64 + fq * 16);
    const bf16x8 qb = *(const bf16x8*)(QT ? Q + tr_off(j0 + fr, fq * 8) : Q + (j0 + fr) * qs + ks * 64 + fq * 16);
    acc = __builtin_amdgcn_mfma_f32_16x16x32_bf16(pa, qb, acc, 0, 0, 0);
  }
  return acc;
}
DI bf16_t* qz_ptr(const ScanArgs& s, int ch) { return ((ch >> 13) ? s.Qz1 : s.Qz0) + (size_t)(ch & 8191) * 4096; }
DI void st_bf16x4(unsigned char* p, const f32x4& v) { *(u32x2*)p = (u32x2){cvt_pk_bf16(v[0], v[1]), cvt_pk_bf16(v[2], v[3])}; }

struct ScanIn { u32x4 r, k, v, w, a, z0, z1; };
template <bool PHASE_C>
DI void scan_fetch(const ScanArgs& s, int item, ScanIn& in) {
  const int c = item & (NCH - 1), h = (item >> 7) & 15, b = item >> 11;
  const int tid = opaque_v(threadIdx.x), tt = tid >> 3, c0 = (tid & 7) * 8;
  const size_t off = ((size_t)b * SEQ + (size_t)c * CL + tt) * D + h * HS + c0;
  in.k = *(const u32x4*)(s.k + off); in.v = *(const u32x4*)(s.v + off); in.w = *(const u32x4*)(s.lw + off); in.a = *(const u32x4*)(s.a + off);
  if (PHASE_C) {
    in.r = *(const u32x4*)(s.r + off);
    const bf16_t* Zg = qz_ptr(s, item);
    in.z0 = *(const u32x4*)(Zg + tid * 8); in.z1 = *(const u32x4*)(Zg + (tid + 256) * 8);
  }
}
template <bool PHASE_C>
DI void scan_load(const ScanArgs& s, const ScanIn& in, int h, float* lwbuf, unsigned char* At, unsigned char* Bt, unsigned char* Kt, unsigned char* Rt,
                  unsigned char* AtT, unsigned char* BhT, unsigned char* KhT, unsigned char* VT, float& bonus, float (&vout)[8], float* Gout) {
  const int tid = opaque_v(threadIdx.x), tt = tid >> 3, c0 = (tid & 7) * 8;
  const u32x4 vk = in.k, vv = in.v, vw = in.w, va = in.a;
  u32x4 vr = {0u, 0u, 0u, 0u};
  if (PHASE_C) vr = in.r;
  float fr_[8], fk[8], fv[8], fw[8], fa[8];
  { const unsigned ur[4] = {vr.x, vr.y, vr.z, vr.w}, uk[4] = {vk.x, vk.y, vk.z, vk.w}, uv[4] = {vv.x, vv.y, vv.z, vv.w}, uw[4] = {vw.x, vw.y, vw.z, vw.w}, ua[4] = {va.x, va.y, va.z, va.w};
#pragma unroll
    for (int j = 0; j < 4; ++j) {
      fr_[2 * j] = bf_lo(ur[j]); fr_[2 * j + 1] = bf_hi(ur[j]); fk[2 * j] = bf_lo(uk[j]); fk[2 * j + 1] = bf_hi(uk[j]);
      fv[2 * j] = bf_lo(uv[j]); fv[2 * j + 1] = bf_hi(uv[j]); fw[2 * j] = bf_lo(uw[j]); fw[2 * j + 1] = bf_hi(uw[j]);
      fa[2 * j] = bf_lo(ua[j]); fa[2 * j + 1] = bf_hi(ua[j]);
    } }
  *(f32x4*)(lwbuf + tt * 64 + c0) = (f32x4){fw[0], fw[1], fw[2], fw[3]}; *(f32x4*)(lwbuf + tt * 64 + c0 + 4) = (f32x4){fw[4], fw[5], fw[6], fw[7]};
  float kkr[8], nrm = 0.f, bon = 0.f, kp[8];
#pragma unroll
  for (int j = 0; j < 8; ++j) {
    const int ch = h * HS + c0 + j;
    kkr[j] = fk[j] * s.k_k[ch]; nrm += kkr[j] * kkr[j];
    kp[j] = fk[j] * (1.f + (fa[j] - 1.f) * s.k_a[ch]);
    if (PHASE_C) bon += fr_[j] * kp[j] * s.r_k[ch];
  }
  nrm += __shfl_xor(nrm, 1); nrm += __shfl_xor(nrm, 2); nrm += __shfl_xor(nrm, 4);
  if (PHASE_C) { bon += __shfl_xor(bon, 1); bon += __shfl_xor(bon, 2); bon += __shfl_xor(bon, 4); }
  bonus = bon;
  const float inv = rsqrtf(fmaxf(nrm, 1e-24f));
  __syncthreads();
  {
    const int c = tid & 63, sg = tid >> 6;
    float run = 0.f;
#pragma unroll
    for (int i = 0; i < 8; ++i) { run += lwbuf[(sg * 8 + i) * 64 + c]; lwbuf[(sg * 8 + i) * 64 + c] = run; }
  }
  __syncthreads();
  float cum[8], cl[8];
  {
    const int sg = tt >> 3;
#pragma unroll
    for (int hh = 0; hh < 2; ++hh) {
      const f32x4 me = *(const f32x4*)(lwbuf + tt * 64 + c0 + hh * 4);
      const f32x4 s0 = *(const f32x4*)(lwbuf + 7 * 64 + c0 + hh * 4), s1 = *(const f32x4*)(lwbuf + 15 * 64 + c0 + hh * 4),
                  s2 = *(const f32x4*)(lwbuf + 23 * 64 + c0 + hh * 4), s3 = *(const f32x4*)(lwbuf + 31 * 64 + c0 + hh * 4);
#pragma unroll
      for (int q = 0; q < 4; ++q) {
        const float pre = (sg > 0 ? s0[q] : 0.f) + (sg > 1 ? s1[q] : 0.f) + (sg > 2 ? s2[q] : 0.f);
        cum[hh * 4 + q] = me[q] + pre; cl[hh * 4 + q] = (s0[q] + s1[q]) + (s2[q] + s3[q]);
      }
    }
  }
  float at[8], bt[8], kt[8], rt[8], bh[8], kh[8];
#pragma unroll
  for (int j = 0; j < 8; ++j) {
    const float kk = kkr[j] * inv, bb = kk * fa[j];
    const float ein = __expf(cum[j]), eneg = __expf(-cum[j]), eex = __expf(cum[j] - fw[j]), eend = __expf(cl[j] - cum[j]);
    at[j] = -kk * eex; bt[j] = bb * eneg; kt[j] = kp[j] * eneg; rt[j] = fr_[j] * ein; bh[j] = bb * eend; kh[j] = kp[j] * eend;
    vout[j] = fv[j];
  }
  *(u32x4*)(At + tt * SN + c0 * 2) = (u32x4){cvt_pk_bf16(at[0], at[1]), cvt_pk_bf16(at[2], at[3]), cvt_pk_bf16(at[4], at[5]), cvt_pk_bf16(at[6], at[7])};
  *(u32x4*)(Bt + tt * SN + c0 * 2) = (u32x4){cvt_pk_bf16(bt[0], bt[1]), cvt_pk_bf16(bt[2], bt[3]), cvt_pk_bf16(bt[4], bt[5]), cvt_pk_bf16(bt[6], bt[7])};
  *(u32x4*)(Kt + tt * SN + c0 * 2) = (u32x4){cvt_pk_bf16(kt[0], kt[1]), cvt_pk_bf16(kt[2], kt[3]), cvt_pk_bf16(kt[4], kt[5]), cvt_pk_bf16(kt[6], kt[7])};
  if (PHASE_C) *(u32x4*)(Rt + tt * SN + c0 * 2) = (u32x4){cvt_pk_bf16(rt[0], rt[1]), cvt_pk_bf16(rt[2], rt[3]), cvt_pk_bf16(rt[4], rt[5]), cvt_pk_bf16(rt[6], rt[7])};
#pragma unroll
  for (int j = 0; j < 8; ++j) {
    *(bf16_t*)(VT + tr_off(c0 + j, tt)) = f2bf(fv[j]);
    if (!PHASE_C) {
      *(bf16_t*)(AtT + tr_off(c0 + j, tt)) = f2bf(at[j]);
      *(bf16_t*)(BhT + tr_off(c0 + j, tt)) = f2bf(bh[j]);
      *(bf16_t*)(KhT + tr_off(c0 + j, tt)) = f2bf(kh[j]);
    }
  }
  if (!PHASE_C && tt == 0 && Gout) {
#pragma unroll
    for (int j = 0; j < 8; ++j) Gout[c0 + j] = __expf(cl[j]);
  }
}
DI void scan_tinv(const float* A32, unsigned char* Tm, int lane) {
  const int c = lane & 31;
  float Tc[32];
#pragma unroll
  for (int i = 0; i < 32; ++i) {
    float s0 = (i == c) ? 1.f : 0.f, s1 = 0.f, s2 = 0.f, s3 = 0.f;
#pragma unroll
    for (int j4 = 0; j4 < (i + 3) / 4; ++j4) {
      const f32x4 a4 = *(const f32x4*)(A32 + i * 36 + j4 * 4);
      if (j4 * 4 + 0 < i) s0 += a4[0] * Tc[j4 * 4 + 0];
      if (j4 * 4 + 1 < i) s1 += a4[1] * Tc[j4 * 4 + 1];
      if (j4 * 4 + 2 < i) s2 += a4[2] * Tc[j4 * 4 + 2];
      if (j4 * 4 + 3 < i) s3 += a4[3] * Tc[j4 * 4 + 3];
    }
    Tc[i] = (s0 + s1) + (s2 + s3);
  }
  if (lane < 32) {
#pragma unroll
    for (int i = 0; i < 32; ++i) *(bf16_t*)(Tm + i * ST + c * 2) = f2bf(Tc[i]);
  }
}

DI void scan_phaseA_item(const ScanArgs& s, int item, const ScanIn& in, unsigned char* lds) {
  const int c = item & (NCH - 1), h = (item >> 7) & 15, b = item >> 11;
  const int tid = opaque_v(threadIdx.x), lane = tid & 63, wv = tid >> 6, fr = lane & 15, fq = lane >> 4;
  unsigned char* At = lds; unsigned char* Bt = At + 32 * SN; unsigned char* Kt = Bt + 32 * SN;
  unsigned char* AtT = Kt + 32 * SN; unsigned char* BhT = AtT + 64 * ST; unsigned char* KhT = BhT + 64 * ST; unsigned char* VT = KhT + 64 * ST;
  unsigned char* Tm = VT + 64 * ST; unsigned char* Aak = Tm + 32 * ST;
  float* A32 = (float*)(Aak + 32 * ST);
  unsigned char* W1T = (unsigned char*)A32 + 4608; unsigned char* M2T = W1T + 64 * ST; unsigned char* UlT = M2T + 64 * ST;
  float* lwbuf = (float*)W1T;
  const size_t gbase = ((size_t)b * SEQ + (size_t)c * CL) * D + h * HS;
  float bonus; float vv8[8];
  scan_load<false>(s, in, h, lwbuf, At, Bt, Kt, nullptr, AtT, BhT, KhT, VT, bonus, vv8, s.Gg + (size_t)item * 64);
  __syncthreads();
  {
    const int mat = wv >> 1, ti = wv & 1;
#pragma unroll
    for (int tj = 0; tj < 2; ++tj) {
      const f32x4 x = tile_mm<false, false>(At, SN, mat ? Kt : Bt, SN, ti * 16, tj * 16, 2, (f32x4){0.f, 0.f, 0.f, 0.f}, lane);
#pragma unroll
      for (int q = 0; q < 4; ++q) {
        const int i = ti * 16 + fq * 4 + q, j = tj * 16 + fr;
        const float val = (j < i) ? x[q] : 0.f;
        if (mat == 0) A32[i * 36 + j] = val; else *(bf16_t*)(Aak + i * ST + j * 2) = f2bf(val);
      }
    }
  }
  __syncthreads();
  if (wv == 0) scan_tinv(A32, Tm, lane);
  else {
    for (int tile = wv - 1; tile < 8; tile += 3) {
      const int ti = tile >> 2, tv = tile & 3;
      const f32x4 x = tile_mm<false, true>(Aak, ST, VT, ST, ti * 16, tv * 16, 1, (f32x4){0.f, 0.f, 0.f, 0.f}, lane);
      st_bf16x4(M2T + tr_off(tv * 16 + fr, ti * 16 + fq * 4), x);
    }
  }
  __syncthreads();
#pragma unroll
  for (int u = 0; u < 4; ++u) {
    const int tile = wv * 4 + u, which = tile >> 3, ti = (tile >> 2) & 1, tn = tile & 3;
    const f32x4 x = tile_mm<false, true>(Tm, ST, which ? M2T : AtT, ST, ti * 16, tn * 16, 1, (f32x4){0.f, 0.f, 0.f, 0.f}, lane);
    st_bf16x4((which ? UlT : W1T) + tr_off(tn * 16 + fr, ti * 16 + fq * 4), x);
  }
  __syncthreads();
  bf16_t* Pg = s.Pg + (size_t)item * 4096; bf16_t* Qg = qz_ptr(s, item);
#pragma unroll
  for (int u = 0; u < 4; ++u) {
    const int tile = wv * 4 + u, tk = tile >> 2, tn = tile & 3;
    const f32x4 xp = tile_mm<true, true>(W1T, ST, BhT, ST, tk * 16, tn * 16, 1, (f32x4){0.f, 0.f, 0.f, 0.f}, lane);
    *(u32x2*)(Pg + (tn * 16 + fr) * 64 + tk * 16 + fq * 4) = (u32x2){cvt_pk_bf16(xp[0], xp[1]), cvt_pk_bf16(xp[2], xp[3])};
    f32x4 xq = tile_mm<true, true>(BhT, ST, UlT, ST, tk * 16, tn * 16, 1, (f32x4){0.f, 0.f, 0.f, 0.f}, lane);
    xq = tile_mm<true, true>(KhT, ST, VT, ST, tk * 16, tn * 16, 1, xq, lane);
    __hip_atomic_store((unsigned long long*)(Qg + ((tk * 4 + tn) * 64 + lane) * 4), (unsigned long long)cvt_pk_bf16(xq[0], xq[1]) | ((unsigned long long)cvt_pk_bf16(xq[2], xq[3]) << 32), __ATOMIC_RELAXED, __HIP_MEMORY_SCOPE_AGENT);
  }
  __syncthreads();
}

constexpr int PSTR = 144;
constexpr int RSLOT = 64 * PSTR + 8192 + 256;
DI void scan_chain_block(const ScanArgs& s, int bh, unsigned char* lds) {
  const int tid = opaque_v(threadIdx.x), lane = tid & 63, tv = tid >> 6, fr = lane & 15, fq = lane >> 4;
  const int ch0 = bh * NCH;
  u32x4 pr[5];
  auto issue = [&](int c) {
    const bf16_t* Pg = s.Pg + (size_t)(ch0 + c) * 4096; const bf16_t* Qg = qz_ptr(s, ch0 + c);
    pr[0] = *(const u32x4*)(Pg + (size_t)tid * 8); pr[1] = *(const u32x4*)(Pg + (size_t)(tid + 256) * 8);
    pr[2] = *(const u32x4*)(Qg + (size_t)tid * 8); pr[3] = *(const u32x4*)(Qg + (size_t)(tid + 256) * 8);
    if (tid < 16) pr[4] = *(const u32x4*)(s.Gg + (size_t)(ch0 + c) * 64 + tid * 4);
  };
  auto commit = [&](int c) {
    unsigned char* sl = lds + (c & 3) * RSLOT;
    *(u32x4*)(sl + (tid >> 3) * PSTR + (tid & 7) * 16) = pr[0]; *(u32x4*)(sl + ((tid + 256) >> 3) * PSTR + (tid & 7) * 16) = pr[1];
    *(u32x4*)(sl + 64 * PSTR + tid * 16) = pr[2]; *(u32x4*)(sl + 64 * PSTR + (tid + 256) * 16) = pr[3];
    if (tid < 16) *(u32x4*)(sl + 64 * PSTR + 8192 + tid * 16) = pr[4];
  };
  issue(0); commit(0); issue(1); commit(1); issue(2); commit(2);
  __syncthreads();
  f32x4 Z[4];
#pragma unroll
  for (int t = 0; t < 4; ++t) Z[t] = (f32x4){0.f, 0.f, 0.f, 0.f};
  for (int c = 0; c < NCH; ++c) {
    if (c + 3 < NCH) issue(c + 3);
    const unsigned char* sl = lds + (c & 3) * RSLOT;
    bf16_t* Zo = qz_ptr(s, ch0 + c) + (tv * 16 + fr) * 64;
    unsigned zp[4][2];
#pragma unroll
    for (int t = 0; t < 4; ++t) { zp[t][0] = cvt_pk_bf16(Z[t][0], Z[t][1]); zp[t][1] = cvt_pk_bf16(Z[t][2], Z[t][3]); *(u32x2*)(Zo + t * 16 + fq * 4) = (u32x2){zp[t][0], zp[t][1]}; }
    bf16x8 zb[2];
#pragma unroll
    for (int ks = 0; ks < 2; ++ks) { const u32x4 w = {zp[2 * ks][0], zp[2 * ks][1], zp[2 * ks + 1][0], zp[2 * ks + 1][1]}; zb[ks] = __builtin_bit_cast(bf16x8, w); }
#pragma unroll
    for (int t = 0; t < 4; ++t) {
      const u32x2 qv = *(const u32x2*)(sl + 64 * PSTR + ((t * 4 + tv) * 64 + lane) * 8);
      const f32x4 g4 = *(const f32x4*)(sl + 64 * PSTR + 8192 + (t * 16 + fq * 4) * 4);
      f32x4 acc = (f32x4){bf_lo(qv.x) + g4[0] * Z[t][0], bf_hi(qv.x) + g4[1] * Z[t][1], bf_lo(qv.y) + g4[2] * Z[t][2], bf_hi(qv.y) + g4[3] * Z[t][3]};
#pragma unroll
      for (int ks = 0; ks < 2; ++ks) {
        const unsigned char* prow = sl + (t * 16 + fr) * PSTR + ks * 64 + fq * 8;
        const u32x2 p0 = *(const u32x2*)prow, p1 = *(const u32x2*)(prow + 32);
        const u32x4 w = {p0.x, p0.y, p1.x, p1.y};
        acc = __builtin_amdgcn_mfma_f32_16x16x32_bf16(__builtin_bit_cast(bf16x8, w), zb[ks], acc, 0, 0, 0);
      }
      Z[t] = acc;
    }
    if (c + 3 < NCH) commit(c + 3);
    __syncthreads();
  }
}

DI void scan_phaseC_item(const ScanArgs& s, int item, const ScanIn& in, unsigned char* lds) {
  const int c = item & (NCH - 1), h = (item >> 7) & 15, b = item >> 11;
  const int tid = opaque_v(threadIdx.x), lane = tid & 63, wv = tid >> 6, fr = lane & 15, fq = lane >> 4;
  unsigned char* At = lds; unsigned char* Bt = At + 32 * SN; unsigned char* Kt = Bt + 32 * SN; unsigned char* Rt = Kt + 32 * SN;
  unsigned char* VT = Rt + 32 * SN;
  unsigned char* Tm = VT + 64 * ST; unsigned char* Aak = Tm + 32 * ST; unsigned char* Arb = Aak + 32 * ST; unsigned char* Ark = Arb + 32 * ST;
  float* A32 = (float*)(Ark + 32 * ST);
  unsigned char* S0 = (unsigned char*)A32 + 4608;
  unsigned char* X1T = S0 + 64 * SN; unsigned char* UT = X1T + 64 * ST;
  float* Yb = (float*)(UT + 64 * ST);
  float* lwbuf = Yb;
  const size_t gbase = ((size_t)b * SEQ + (size_t)c * CL) * D + h * HS;
  float bonus; float vv8[8];
  { const int e0 = tid * 8, e1 = (tid + 256) * 8;
    *(u32x4*)(S0 + (e0 >> 6) * SN + (e0 & 63) * 2) = in.z0; *(u32x4*)(S0 + (e1 >> 6) * SN + (e1 & 63) * 2) = in.z1; }
  scan_load<true>(s, in, h, lwbuf, At, Bt, Kt, Rt, nullptr, nullptr, nullptr, VT, bonus, vv8, nullptr);
  __syncthreads();
  {
    const unsigned char* Pm = (wv < 2) ? At : Rt; const unsigned char* Qm = (wv & 1) ? Kt : Bt;
    unsigned char* dst = (wv == 1) ? Aak : (wv == 2 ? Arb : Ark);
#pragma unroll
    for (int t4 = 0; t4 < 4; ++t4) {
      const int ti = t4 >> 1, tj = t4 & 1;
      const f32x4 x = tile_mm<false, false>(Pm, SN, Qm, SN, ti * 16, tj * 16, 2, (f32x4){0.f, 0.f, 0.f, 0.f}, lane);
#pragma unroll
      for (int q = 0; q < 4; ++q) {
        const int i = ti * 16 + fq * 4 + q, j = tj * 16 + fr;
        const bool keep = (wv < 2) ? (j < i) : (j <= i);
        const float val = keep ? x[q] : 0.f;
        if (wv == 0) A32[i * 36 + j] = val; else *(bf16_t*)(dst + i * ST + j * 2) = f2bf(val);
      }
    }
  }
  __syncthreads();
  if (wv == 0) scan_tinv(A32, Tm, lane);
  else {
    for (int tile = wv - 1; tile < 8; tile += 3) {
      const int ti = tile >> 2, tv = tile & 3;
      f32x4 x = tile_mm<false, false>(At, SN, S0, SN, ti * 16, tv * 16, 2, (f32x4){0.f, 0.f, 0.f, 0.f}, lane);
      x = tile_mm<false, true>(Aak, ST, VT, ST, ti * 16, tv * 16, 1, x, lane);
      st_bf16x4(X1T + tr_off(tv * 16 + fr, ti * 16 + fq * 4), x);
    }
  }
  __syncthreads();
#pragma unroll
  for (int u = 0; u < 2; ++u) {
    const int tile = wv * 2 + u, ti = tile >> 2, tv = tile & 3;
    const f32x4 x = tile_mm<false, true>(Tm, ST, X1T, ST, ti * 16, tv * 16, 1, (f32x4){0.f, 0.f, 0.f, 0.f}, lane);
    st_bf16x4(UT + tr_off(tv * 16 + fr, ti * 16 + fq * 4), x);
  }
  __syncthreads();
#pragma unroll
  for (int u = 0; u < 2; ++u) {
    const int tile = wv * 2 + u, ti = tile >> 2, tv = tile & 3;
    f32x4 x = tile_mm<false, false>(Rt, SN, S0, SN, ti * 16, tv * 16, 2, (f32x4){0.f, 0.f, 0.f, 0.f}, lane);
    x = tile_mm<false, true>(Arb, ST, UT, ST, ti * 16, tv * 16, 1, x, lane);
    x = tile_mm<false, true>(Ark, ST, VT, ST, ti * 16, tv * 16, 1, x, lane);
#pragma unroll
    for (int q = 0; q < 4; ++q) Yb[(ti * 16 + fq * 4 + q) * 68 + tv * 16 + fr] = x[q];
  }
  __syncthreads();
  {
    const int tt = tid >> 3, c0 = (tid & 7) * 8;
    float yv[8], sum = 0.f;
#pragma unroll
    for (int j = 0; j < 8; ++j) { yv[j] = Yb[tt * 68 + c0 + j]; sum += yv[j]; }
    sum += __shfl_xor(sum, 1); sum += __shfl_xor(sum, 2); sum += __shfl_xor(sum, 4);
    const float mean = sum * (1.f / 64.f);
    float var = 0.f;
#pragma unroll
    for (int j = 0; j < 8; ++j) { const float d = yv[j] - mean; var += d * d; }
    var += __shfl_xor(var, 1); var += __shfl_xor(var, 2); var += __shfl_xor(var, 4);
    const float rstd = rsqrtf(var * (1.f / 64.f) + GN_EPS);
    const size_t off = gbase + (size_t)tt * D + c0;
    float o[8];
#pragma unroll
    for (int j = 0; j < 8; ++j) {
      const int chn = h * HS + c0 + j;
      o[j] = (yv[j] - mean) * rstd * s.lnx_g[chn] + s.lnx_b[chn] + bonus * vv8[j];
    }
    *(u32x4*)(s.r + off) = (u32x4){cvt_pk_bf16(o[0], o[1]), cvt_pk_bf16(o[2], o[3]), cvt_pk_bf16(o[4], o[5]), cvt_pk_bf16(o[6], o[7])};
  }
  __syncthreads();
}

DI void ln_phase(const float* __restrict__ z, const float* __restrict__ lg, const float* __restrict__ lb, float* __restrict__ xo,
                 const float* __restrict__ mod_l, int shift_idx, int scale_idx, bf16_t* __restrict__ ho, int bid, int nblk) {
  const int tq = opaque_v(threadIdx.x); const int lane = tq & 63, wv = tq >> 6;
  for (int row = bid * 4 + wv; row < T; row += nblk * 4) {
    const float* zr = z + (size_t)row * D;
    f32x4 v[4]; float s = 0.f;
#pragma unroll
    for (int i = 0; i < 4; ++i) { v[i] = *(const f32x4*)(zr + i * 256 + lane * 4); s += (v[i][0] + v[i][1]) + (v[i][2] + v[i][3]); }
    const float mean = wave_sum(s) * (1.f / D);
    float q = 0.f;
#pragma unroll
    for (int i = 0; i < 4; ++i) { const f32x4 d = v[i] - mean; q += (d[0] * d[0] + d[1] * d[1]) + (d[2] * d[2] + d[3] * d[3]); }
    const float rstd = rsqrtf(wave_sum(q) * (1.f / D) + LN_EPS);
    const int b = row / SEQ;
#pragma unroll
    for (int i = 0; i < 4; ++i) {
      const int d = i * 256 + lane * 4;
      const f32x4 o = (v[i] - mean) * rstd * *(const f32x4*)(lg + d) + *(const f32x4*)(lb + d);
      *(f32x4*)(xo + (size_t)row * D + d) = o;
      if (!ho) continue;
      const f32x4 sh = *(const f32x4*)(mod_l + (size_t)b * 6144 + shift_idx * D + d), sc = *(const f32x4*)(mod_l + (size_t)b * 6144 + scale_idx * D + d);
      const f32x4 hh = o * (sc + 1.f) + sh;
      *(u32x2*)(ho + (size_t)row * D + d) = (u32x2){cvt_pk_bf16(hh[0], hh[1]), cvt_pk_bf16(hh[2], hh[3])};
    }
  }
}

DI void combine_phase(const unsigned* __restrict__ lists, unsigned short* __restrict__ epk, float* __restrict__ gate, int bid, int nblk) {
  const int tq = opaque_v(threadIdx.x);
  for (int gid = bid * 256 + tq; gid < T * 8; gid += nblk * 256) {
    const unsigned* la = lists + (size_t)gid * 32;
    const unsigned* lb = la + 16;
    float s1[16], s2[16];
#pragma unroll
    for (int i = 0; i < 4; ++i) {
      const u32x4 a = *(const u32x4*)(la + i * 4), b = *(const u32x4*)(lb + i * 4);
      s1[i * 4] = key2f(a.x & ~127u); s1[i * 4 + 1] = key2f(a.y & ~127u); s1[i * 4 + 2] = key2f(a.z & ~127u); s1[i * 4 + 3] = key2f(a.w & ~127u);
      s2[i * 4] = key2f(b.x & ~127u); s2[i * 4 + 1] = key2f(b.y & ~127u); s2[i * 4 + 2] = key2f(b.z & ~127u); s2[i * 4 + 3] = key2f(b.w & ~127u);
    }
    unsigned c[4][16];
    {
      int n = 0;
#pragma unroll
      for (int a = 0; a < 16; ++a)
#pragma unroll
        for (int b = 0; b < 16; ++b)
          if ((a + 1) * (b + 1) <= 16) { c[n >> 4][n & 15] = (f2key(s1[a] + s2[b]) & ~255u) | (unsigned)(255 - (a * 16 + b)); ++n; }
#pragma unroll
      for (int q = 50; q < 64; ++q) c[q >> 4][q & 15] = 0u;
    }
    sort16_desc(c[0]); sort16_desc(c[1]); sort16_desc(c[2]); sort16_desc(c[3]);
#pragma unroll
    for (int e = 0; e < 16; ++e) { c[0][e] = max(c[0][e], c[1][15 - e]); c[2][e] = max(c[2][e], c[3][15 - e]); }
    merge16_desc(c[0]); merge16_desc(c[2]);
#pragma unroll
    for (int e = 0; e < 16; ++e) c[0][e] = max(c[0][e], c[2][15 - e]);
    merge16_desc(c[0]);
    float best[16], den = 0.f;
    const float mx = key2f(c[0][0] & ~255u);
#pragma unroll
    for (int e = 0; e < 16; ++e) { best[e] = __expf(key2f(c[0][e] & ~255u) - mx); den += best[e]; }
    const float inv = 1.f / den;
#pragma unroll
    for (int e = 0; e < 16; ++e) {
      const int pos = 255 - (int)(c[0][e] & 255u), a = pos >> 4, b = pos & 15;
      const int i1 = 127 - (int)(la[a] & 127u), i2 = 127 - (int)(lb[b] & 127u);
      { const int jj = (gid & 7) * 16 + e; epk[(size_t)(gid >> 3) * 128 + (jj < 64 ? 2 * jj : 2 * (jj - 64) + 1)] = (unsigned short)(i1 * 128 + i2); }
      gate[(size_t)gid * 16 + e] = best[e] * inv;
    }
  }
}

DI void table_fp8_phase(const float* __restrict__ src, unsigned char* __restrict__ dst, float* __restrict__ inv, int rows, int bid, int nblk) {
  const int tq = opaque_v(threadIdx.x); const int lane = tq & 63, wv = tq >> 6;
  for (int r = bid * 4 + wv; r < rows; r += nblk * 4) {
    const float* sr = src + (size_t)r * D + lane * 16;
    f32x4 v[4]; float mx = 0.f;
#pragma unroll
    for (int i = 0; i < 4; ++i) { v[i] = __builtin_nontemporal_load((const f32x4*)(sr + i * 4)); mx = fmaxf(mx, fmaxf(fmaxf(fabsf(v[i][0]), fabsf(v[i][1])), fmaxf(fabsf(v[i][2]), fabsf(v[i][3])))); }
#pragma unroll
    for (int o = 32; o >= 1; o >>= 1) mx = fmaxf(mx, __shfl_xor(mx, o));
    const float sc = mx > 0.f ? exp2f(floorf(log2f(384.f / mx))) : 1.f;
    u32x4 o4; unsigned w[4];
#pragma unroll
    for (int i = 0; i < 4; ++i) {
      int pk = 0;
      pk = __builtin_amdgcn_cvt_pk_fp8_f32(v[i][0] * sc, v[i][1] * sc, pk, false);
      pk = __builtin_amdgcn_cvt_pk_fp8_f32(v[i][2] * sc, v[i][3] * sc, pk, true);
      w[i] = (unsigned)pk;
    }
    o4.x = w[0]; o4.y = w[1]; o4.z = w[2]; o4.w = w[3];
    *(u32x4*)(dst + (size_t)r * D + lane * 16) = o4;
    if (lane == 0) inv[r] = 1.f / sc;
  }
}

struct PeerArgs {
  const bf16_t* h2;
  const unsigned char *u8, *v8;
  const float *uinv, *vinv;
  const unsigned* epk; const float* gate;
  float* part;
  float* coef;
  const float* xres;
  const float* gate2;
  float* z;
  unsigned* ctr_u; unsigned* ctr_v;
};
constexpr int PCH = 64;
DI void cvt16_fp8(const u32x4& d, float (&f)[16]) {
  const unsigned w[4] = {d.x, d.y, d.z, d.w};
#pragma unroll
  for (int i = 0; i < 4; ++i) {
    const f32x2 lo = __builtin_amdgcn_cvt_pk_f32_fp8((int)w[i], false), hi = __builtin_amdgcn_cvt_pk_f32_fp8((int)w[i], true);
    f[i * 4] = lo.x; f[i * 4 + 1] = lo.y; f[i * 4 + 2] = hi.x; f[i * 4 + 3] = hi.y;
  }
}
template <bool VPHASE>
DI void peer_slice_phase(const PeerArgs& a, unsigned char* lds) {
  const int tq = opaque_v(threadIdx.x); const int lane = tq & 63, wv = tq >> 6, cc = lane & 7;
  volatile int* nxt = (volatile int*)lds;
  const unsigned xcc = xb_xcc_id() & 7u;
  unsigned* ctr = VPHASE ? a.ctr_v : a.ctr_u;
  for (int ks = 0; ks < 8; ++ks) {
    const int s = (int)((xcc + ks) & 7u);
    for (;;) {
      __syncthreads();
      if (tq == 0) *nxt = (int)atomicAdd(&ctr[s * 16], 1u);
      __syncthreads();
      const int chunk = *nxt;
      if (chunk >= T / PCH) break;
      for (int ti = 0; ti < PCH / 4; ++ti) {
        const int t = chunk * PCH + wv * (PCH / 4) + ti;
        const unsigned ep = a.epk[(size_t)t * 64 + lane];
        const unsigned char* tab = (VPHASE ? a.v8 : a.u8) + s * 128 + cc * 16;
        u32x4 data[16];
        float cv[16];
        float c_lo = 0.f, c_hi = 0.f;
        if (VPHASE) { c_lo = a.coef[(size_t)t * 128 + lane]; c_hi = a.coef[(size_t)t * 128 + 64 + lane]; }
#pragma unroll
        for (int i = 0; i < 16; ++i) {
          const int src = (lane & ~7) | (i & 7);
          const unsigned ev = (unsigned)__shfl((int)ep, src);
          const unsigned e = (i < 8) ? (ev & 0xffffu) : (ev >> 16);
          if (VPHASE) cv[i] = __shfl(i < 8 ? c_lo : c_hi, src);
          data[i] = *(const u32x4*)(tab + (size_t)e * D);
        }
        if (!VPHASE) {
          const u32x4 h0 = *(const u32x4*)(a.h2 + (size_t)t * D + s * 128 + cc * 16), h1 = *(const u32x4*)(a.h2 + (size_t)t * D + s * 128 + cc * 16 + 8);
          float hf[16];
          { const unsigned u[8] = {h0.x, h0.y, h0.z, h0.w, h1.x, h1.y, h1.z, h1.w};
#pragma unroll
            for (int q = 0; q < 8; ++q) { hf[2 * q] = bf_lo(u[q]); hf[2 * q + 1] = bf_hi(u[q]); } }
          float r_lo = 0.f, r_hi = 0.f;
#pragma unroll
          for (int i = 0; i < 16; ++i) {
            float f[16]; cvt16_fp8(data[i], f);
            float d = 0.f;
#pragma unroll
            for (int q = 0; q < 16; ++q) d += f[q] * hf[q];
            d += __shfl_xor(d, 1); d += __shfl_xor(d, 2); d += __shfl_xor(d, 4);
            if ((i & 7) == cc) { if (i < 8) r_lo = d; else r_hi = d; }
          }
          float* pp = a.part + ((size_t)s * T + t) * 128;
          pp[lane] = r_lo; pp[64 + lane] = r_hi;
        } else {
          float acc[16];
#pragma unroll
          for (int q = 0; q < 16; ++q) acc[q] = 0.f;
#pragma unroll
          for (int i = 0; i < 16; ++i) {
            float f[16]; cvt16_fp8(data[i], f);
#pragma unroll
            for (int q = 0; q < 16; ++q) acc[q] += cv[i] * f[q];
          }
          float r8[8], r4[4], r2[2];
          { const bool up = (lane & 8) != 0;
#pragma unroll
            for (int q = 0; q < 8; ++q) { const float keep = up ? acc[8 + q] : acc[q], send = up ? acc[q] : acc[8 + q]; r8[q] = keep + __shfl_xor(send, 8); } }
          { const bool up = (lane & 16) != 0;
#pragma unroll
            for (int q = 0; q < 4; ++q) { const float keep = up ? r8[4 + q] : r8[q], send = up ? r8[q] : r8[4 + q]; r4[q] = keep + __shfl_xor(send, 16); } }
          { const bool up = (lane & 32) != 0;
#pragma unroll
            for (int q = 0; q < 2; ++q) { const float keep = up ? r4[2 + q] : r4[q], send = up ? r4[q] : r4[2 + q]; r2[q] = keep + __shfl_xor(send, 32); } }
          const int col = s * 128 + cc * 16 + ((lane >> 3) & 1) * 8 + ((lane >> 4) & 1) * 4 + ((lane >> 5) & 1) * 2;
          const int b = t / SEQ;
          const f32x2 xv = *(const f32x2*)(a.xres + (size_t)t * D + col), gt = *(const f32x2*)(a.gate2 + (size_t)b * 6144 + col);
          *(f32x2*)(a.z + (size_t)t * D + col) = (f32x2){ALPHA * xv.x + gt.x * r2[0], ALPHA * xv.y + gt.y * r2[1]};
        }
      }
    }
  }
  __syncthreads();
}
DI void peer_coef_phase(const PeerArgs& a, int bid, int nblk) {
  const int tq = opaque_v(threadIdx.x);
  for (int gid = bid * 256 + tq; gid < T * 128; gid += nblk * 256) {
    const int t = gid >> 7, j = gid & 127;
    const unsigned ep = a.epk[(size_t)t * 64 + (j & 63)];
    const unsigned e = (j < 64) ? (ep & 0xffffu) : (ep >> 16);
    float sum = 0.f;
#pragma unroll
    for (int s8 = 0; s8 < 8; ++s8) sum += a.part[((size_t)s8 * T + t) * 128 + j];
    a.coef[gid] = a.gate[gid] * gelu_exact(sum * a.uinv[e]) * a.vinv[e];
  }
}

DI void pool_phase(const bf16_t* __restrict__ zin, bf16_t* __restrict__ pout, int bid, int nblk) {
  const size_t n8 = (size_t)T * D / 8; const int tq = opaque_v(threadIdx.x);
  for (size_t i = (size_t)bid * 256 + tq; i < n8; i += (size_t)nblk * 256) {
    const size_t e = i * 8; const int t = (int)(e / D), d = (int)(e % D), tp = t % SEQ;
    const int win = 2 << (d / 256);
    const int cnt = min(tp + 1, win);
    float s[8], z0[8];
#pragma unroll
    for (int j = 0; j < 8; ++j) { s[j] = 0.f; z0[j] = 0.f; }
    for (int w = 0; w < cnt; ++w) {
      const u32x4 v = *(const u32x4*)(zin + e - (size_t)w * D);
      const unsigned u[4] = {v.x, v.y, v.z, v.w};
#pragma unroll
      for (int j = 0; j < 4; ++j) { const float lo = bf_lo(u[j]), hi = bf_hi(u[j]); s[2 * j] += lo; s[2 * j + 1] += hi; if (w == 0) { z0[2 * j] = lo; z0[2 * j + 1] = hi; } }
    }
    const float ic = 1.f / (float)cnt;
    float o[8];
#pragma unroll
    for (int j = 0; j < 8; ++j) o[j] = s[j] * ic - z0[j];
    *(u32x4*)(pout + e) = (u32x4){cvt_pk_bf16(o[0], o[1]), cvt_pk_bf16(o[2], o[3]), cvt_pk_bf16(o[4], o[5]), cvt_pk_bf16(o[6], o[7])};
  }
}


#define GRID_SYNC() xcd_barrier(xb)

__global__ void __launch_bounds__(256, 2) mega(Params p) {
  __shared__ __attribute__((aligned(16))) unsigned char lds[LDS_BYTES + 16];
  cg::grid_group grid = cg::this_grid();
  const int bid = blockIdx.x, nblk = gridDim.x;
  if (threadIdx.x == 0) { *(volatile LAS unsigned*)(lds + LDS_BYTES) = 0u; *(volatile LAS unsigned*)(lds + LDS_BYTES + 4) = 0u; }
  __syncthreads();
  const XcdBarrier xb = xcd_barrier_post(p.bar, (volatile LAS unsigned*)(lds + LDS_BYTES));
  const float* mod0 = p.mod; const float* mod1 = p.mod + (size_t)NB * 6144;
  bf16_t* S[7];
#pragma unroll
  for (int i = 0; i < 7; ++i) S[i] = (bf16_t*)p.slot[i];

  prologue_phase(p, lds, bid, nblk);
  grid.sync();
  bf16_t *h = S[0], *r = S[1], *k = S[2], *v = S[3], *lw = S[4], *av = S[5];
  bf16_t* tw = p.lora_tmp; bf16_t* ta = tw + (size_t)T * 64; bf16_t* tg = ta + (size_t)T * 64;
  modulate_phase(p.x, mod0, p.rw_mu, h, S[4], S[5], S[6], bid, nblk);
  for (int it = bid; it < 4 * 8 * 2; it += nblk) {
    const int nt = it & 1, mt = (it >> 1) & 7, g4 = it >> 4;
    gemm_tile(mk(p.PoutT + g4 * 256, D, p.WgrpS + (size_t)g4 * 256 * 256, 256, 256, 256, EPI_BF16, p.WcT + g4 * 256, D), mt * 128, nt * 128, lds);
  }
  for (int it = bid; it < 2 * 16 * 8; it += nblk) {
    const int nt = it & 7, gl = it >> 3;
    gemm_tile(mk(p.KeysB + (size_t)gl * 128 * 128, 128, p.WqB + (size_t)(gl >> 4) * D * 2048 + (gl & 15) * 128, 2048, D, 128, EPI_BF16, p.WeffT + (size_t)gl * 128 * D, D), 0, nt * 128, lds);
  }
  GRID_SYNC();
  for (int it = 0, nit = sched_iters(28, nblk); it < nit; ++it) {
    int mt, nt; if (!sched_mn(it, bid, nblk, 28, mt, nt)) continue;
    GemmArgs g; int n0;
    if (nt < 24) { const int j = nt >> 3; n0 = (nt & 7) * 128; g = mk(S[4 + j], D, p.WT_rkv + (size_t)j * D * D, D, D, D, EPI_BF16, j == 0 ? r : (j == 1 ? k : v), D); }
    else if (nt == 24) { n0 = 0; g = mk(h, D, p.W1T, D, 64, D, EPI_TANH, tw, 64, p.rw_mu + 3 * D); }
    else if (nt == 25) { n0 = 0; g = mk(h, D, p.A1T, D, 64, D, EPI_BF16, ta, 64, p.rw_mu + 4 * D); }
    else { n0 = (nt - 26) * 128; g = mk(h, D, p.G1T, D, 192, D, EPI_SIGMOID, tg, 192, p.rw_mu + 5 * D); }
    gemm_tile(g, mt * 128, n0, lds);
  }
  GRID_SYNC();
  for (int it = 0, nit = sched_iters(16, nblk); it < nit; ++it) {
    int mt, nt; if (!sched_mn(it, bid, nblk, 16, mt, nt)) continue;
    const int j = nt >> 3, n0 = (nt & 7) * 128;
    GemmArgs g;
    if (j == 0) g = mk(tw, 64, p.W2T, 64, D, 64, EPI_LW, lw, D, nullptr, p.rw_w0);
    else g = mk(ta, 64, p.A2T, 64, D, 64, EPI_ASIG, av, D, nullptr, p.rw_a0);
    gemm_tile(g, mt * 128, n0, lds);
  }
  GRID_SYNC();
  {
    ScanArgs s; s.r = r; s.k = k; s.v = v; s.lw = lw; s.a = av; s.k_k = p.rw_k_k; s.k_a = p.rw_k_a; s.r_k = p.rw_r_k; s.lnx_g = p.rw_lnx_g; s.lnx_b = p.rw_lnx_b;
    s.Pg = (bf16_t*)p.out; s.Qz0 = S[0]; s.Qz1 = S[6]; s.Gg = p.Gg;
    { ScanIn cur, nxt; if (bid < NB * NH * NCH) scan_fetch<false>(s, bid, cur);
      for (int it = bid; it < NB * NH * NCH; it += nblk) { if (it + nblk < NB * NH * NCH) scan_fetch<false>(s, it + nblk, nxt); scan_phaseA_item(s, it, cur, lds); cur = nxt; } }
    GRID_SYNC();
    for (int it = bid; it < NB * NH; it += nblk) scan_chain_block(s, it, lds);
    GRID_SYNC();
    { ScanIn cur, nxt; if (bid < NB * NH * NCH) scan_fetch<true>(s, bid, cur);
      for (int it = bid; it < NB * NH * NCH; it += nblk) { if (it + nblk < NB * NH * NCH) scan_fetch<true>(s, it + nblk, nxt); scan_phaseC_item(s, it, cur, lds); cur = nxt; } }
    GRID_SYNC();
  }
  for (int it = 0, nit = sched_iters(8, nblk); it < nit; ++it) {
    int mt, nt; if (!sched_mn(it, bid, nblk, 8, mt, nt)) continue;
    gemm_tile(mk(tg, 192, p.G2T, 192, D, 192, EPI_GATE, r, D), mt * 128, nt * 128, lds);
  }
  GRID_SYNC();
  h = r;
  float* z = (float*)p.slot[2];
  for (int it = 0, nit = sched_iters(8, nblk); it < nit; ++it) {
    int mt, nt; if (!sched_mn(it, bid, nblk, 8, mt, nt)) continue;
    gemm_tile(mk(h, D, p.WoT, D, D, D, EPI_Z, z, D, nullptr, p.x, mod0 + 2 * D), mt * 128, nt * 128, lds);
  }
  table_fp8_phase(p.pe_u, p.slot[6], p.tinv, NEXP, bid, nblk);
  table_fp8_phase(p.pe_v, p.slot[6] + ((size_t)16 << 20), p.tinv + NEXP, NEXP, bid, nblk);
  table_fp8_phase(p.pe_u + (size_t)NEXP * D, p.slot[6] + ((size_t)32 << 20), p.tinv + 2 * NEXP, NEXP, bid, nblk);
  table_fp8_phase(p.pe_v + (size_t)NEXP * D, p.slot[6] + ((size_t)48 << 20), p.tinv + 3 * NEXP, NEXP, bid, nblk);
  GRID_SYNC();
  ln_phase(z, p.ln_g + 0 * D, p.ln_b + 0 * D, (float*)p.slot[4], mod0, 3, 4, S[0], bid, nblk);
  GRID_SYNC();

#pragma unroll
  for (int layer = 0; layer < 2; ++layer) {
    const float* modl = layer == 0 ? mod0 : mod1;
    const bf16_t* hp = layer == 0 ? S[0] : S[3];
    unsigned char* lsl = layer == 0 ? p.slot[3] : p.slot[0];
    unsigned* lists = (unsigned*)lsl;
    unsigned* epk = (unsigned*)(lsl + ((size_t)32 << 20));
    float* gate = (float*)(lsl + ((size_t)40 << 20));
    for (int it = 0, nit = sched_iters(16, nblk); it < nit; ++it) {
      int mt, grp; if (!sched_mn(it, bid, nblk, 16, mt, grp)) continue;
      gemm_tile(mk(hp, D, p.WeffT + (size_t)layer * 2048 * D, D, 2048, D, EPI_TOPK, lists, 0), mt * 128, grp * 128, lds);
    }
    GRID_SYNC();
    combine_phase(lists, (unsigned short*)epk, gate, bid, nblk);
    GRID_SYNC();
    PeerArgs a; a.h2 = hp;
    a.u8 = p.slot[6] + ((size_t)(layer * 32) << 20); a.v8 = a.u8 + ((size_t)16 << 20);
    a.uinv = p.tinv + (layer * 2) * NEXP; a.vinv = a.uinv + NEXP;
    a.epk = epk; a.gate = gate; a.part = (float*)p.slot[1]; a.coef = (float*)lsl;
    a.xres = (const float*)p.slot[4]; a.gate2 = modl + 5 * D; a.z = (float*)p.slot[1];
    a.ctr_u = p.bar + XCD_BAR_WORDS + (layer * 2) * 128; a.ctr_v = a.ctr_u + 128;
    peer_slice_phase<false>(a, lds);
    GRID_SYNC();
    peer_coef_phase(a, bid, nblk);
    GRID_SYNC();
    peer_slice_phase<true>(a, lds);
    GRID_SYNC();
    if (layer == 1) { ln_phase(a.z, p.ln_g + 3 * D, p.ln_b + 3 * D, p.out, mod1, 0, 1, nullptr, bid, nblk); break; }
    ln_phase(a.z, p.ln_g + 1 * D, p.ln_b + 1 * D, (float*)p.slot[4], mod1, 0, 1, S[0], bid, nblk);
    GRID_SYNC();
    const float* x2 = (const float*)p.slot[4];
    bf16_t *hB = S[0], *zin = S[1], *pp = S[2];
    for (int it = 0, nit = sched_iters(8, nblk); it < nit; ++it) {
      int mt, nt; if (!sched_mn(it, bid, nblk, 8, mt, nt)) continue;
      gemm_tile(mk(hB, D, p.PinT, D, D, D, EPI_BF16, zin, D), mt * 128, nt * 128, lds);
    }
    GRID_SYNC();
    pool_phase(zin, pp, bid, nblk);
    GRID_SYNC();
    float* z1 = (float*)p.slot[0];
    for (int it = 0, nit = sched_iters(8, nblk); it < nit; ++it) {
      int mt, nt; if (!sched_mn(it, bid, nblk, 8, mt, nt)) continue;
      gemm_tile(mk(pp, D, p.WcT, D, D, D, EPI_Z, z1, D, nullptr, x2, mod1 + 2 * D), mt * 128, nt * 128, lds);
    }
    GRID_SYNC();
    ln_phase(z1, p.ln_g + 2 * D, p.ln_b + 2 * D, (float*)p.slot[4], mod1, 3, 4, S[3], bid, nblk);
    GRID_SYNC();
  }
}

extern "C" void kernel_launch(void* const* d_in, const int* in_sizes, int n_in, void* d_out, int out_size, void* d_ws, size_t ws_size, hipStream_t stream) {
  Params p{};
  const float** ip = (const float**)&p.x;
  for (int i = 0; i < 30; ++i) ip[i] = (const float*)d_in[i];
  p.out = (float*)d_out;
  unsigned char* w = (unsigned char*)d_ws; size_t off = 0;
  auto take = [&](size_t bytes) { unsigned char* r = w + off; off += (bytes + 255) & ~(size_t)255; return r; };
  p.bar = (unsigned*)take(16384);
  p.mod = (float*)take((size_t)2 * NB * 6144 * 4);
  p.WT_rkv = (bf16_t*)take((size_t)3 * D * D * 2);
  p.W1T = (bf16_t*)take((size_t)128 * D * 2); p.A1T = (bf16_t*)take((size_t)128 * D * 2); p.G1T = (bf16_t*)take((size_t)256 * D * 2);
  p.W2T = (bf16_t*)take((size_t)D * 64 * 2); p.A2T = (bf16_t*)take((size_t)D * 64 * 2); p.G2T = (bf16_t*)take((size_t)D * 192 * 2);
  p.WoT = (bf16_t*)take((size_t)D * D * 2); p.PinT = (bf16_t*)take((size_t)D * D * 2); p.PoutT = (bf16_t*)take((size_t)D * D * 2);
  p.WgrpS = (bf16_t*)take((size_t)4 * 256 * 256 * 2); p.WcT = (bf16_t*)take((size_t)D * D * 2); p.WqB = (bf16_t*)take((size_t)2 * 2048 * D * 2); p.WeffT = (bf16_t*)take((size_t)2 * 2048 * D * 2); p.KeysB = (bf16_t*)take((size_t)2 * 16 * 128 * 128 * 2);
  p.tinv = (float*)take((size_t)4 * NEXP * 4);
  p.lora_tmp = (bf16_t*)take((size_t)T * 320 * 2);
  p.Gg = (float*)take((size_t)16384 * 64 * 4);
  for (int i = 0; i < 7; ++i) p.slot[i] = take((size_t)64 << 20);
  if (off > ws_size) return;

  static int grid_blocks = 0;
  if (!grid_blocks) {
    int dev = 0, cus = 0, per_cu = 0;
    hipGetDevice(&dev);
    hipDeviceGetAttribute(&cus, hipDeviceAttributeMultiprocessorCount, dev);
    hipOccupancyMaxActiveBlocksPerMultiprocessor(&per_cu, mega, 256, 0);
    if (per_cu > 2) per_cu = 2;
    if (per_cu < 1) per_cu = 1;
    grid_blocks = cus * per_cu;
  }
  hipMemsetAsync(p.bar, 0, 16384, stream);
  void* args[] = {&p};
  hipLaunchCooperativeKernel((void*)mega, dim3(grid_blocks), dim3(256), args, 0, stream);
}
```

```cpp
#include <hip/hip_runtime.h>
#include <hip/hip_cooperative_groups.h>
#include <stdint.h>
#include <stddef.h>
namespace cg = cooperative_groups;

typedef unsigned short bf16_t;
typedef short bf16x8 __attribute__((ext_vector_type(8)));
typedef float f32x4 __attribute__((ext_vector_type(4)));
typedef float f32x2 __attribute__((ext_vector_type(2)));
typedef unsigned u32x4 __attribute__((ext_vector_type(4)));
typedef unsigned u32x2 __attribute__((ext_vector_type(2)));
#define DI __device__ __forceinline__

constexpr int D = 1024, NB = 8, SEQ = 4096, T = NB * SEQ;
constexpr int NH = 16, HS = 64;
constexpr int NEXP = 16384;
constexpr float ALPHA = 1.4142135623730951f;
constexpr float LN_EPS = 1e-5f, GN_EPS = 64e-5f;
constexpr int LDS_BYTES = 72 * 1024;

typedef __bf16 bf16x2_t __attribute__((ext_vector_type(2)));
DI unsigned cvt_pk_bf16(float lo, float hi) { const f32x2 v = {lo, hi}; return __builtin_bit_cast(unsigned, __builtin_convertvector(v, bf16x2_t)); }
DI float bf_lo(unsigned u) { return __uint_as_float(u << 16); }
DI float bf_hi(unsigned u) { return __uint_as_float(u & 0xffff0000u); }
DI bf16_t f2bf(float f) { unsigned u = __float_as_uint(f); u += 0x7fffu + ((u >> 16) & 1u); return (bf16_t)(u >> 16); }
DI float sigmoidf_(float x) { return 1.f / (1.f + __expf(-x)); }
DI float wave_sum(float v) {
#pragma unroll
  for (int o = 32; o >= 1; o >>= 1) v += __shfl_xor(v, o);
  return v;
}
DI int opaque_v(int x) { asm volatile("" : "+v"(x)); return x; }
DI float gelu_exact(float v) {
  const float av = fabsf(v), t = __builtin_amdgcn_rcpf(av * 0.2316418882f + 1.0f);
  float q = t * 0.5307027145f + (-0.7265760135f); q = q * t + 0.7107068705f; q = q * t + (-0.142248368f); q = q * t + 0.127414796f; q = q * t;
  const float m = v * (q * __builtin_amdgcn_exp2f((v * v) * (-0.72134752044f)));
  return v < 0.f ? m : v - m;
}

#define XB_TMO      128
#define XB_XCNT(j)  (256  + 64 * (j))
#define XB_XSUB(j)  (1280 + 64 * (j))
#define XB_XGEN(j)  (2304 + 64 * (j))
#define XB_TOP      3328
#define XB_TOPGEN   3392
#define XCD_BAR_WORDS 3456
#define XB_SPIN_CAP (1u << 22)
#define LAS __attribute__((address_space(3)))
DI unsigned xb_ld(unsigned* p)              { return __hip_atomic_load(p, __ATOMIC_RELAXED, __HIP_MEMORY_SCOPE_AGENT); }
DI unsigned xb_add(unsigned* p, unsigned v) { return __hip_atomic_fetch_add(p, v, __ATOMIC_RELAXED, __HIP_MEMORY_SCOPE_AGENT); }
DI unsigned xb_xcc_id() { return (unsigned)__builtin_amdgcn_s_getreg((3 << 11) | 20) & 0xFu; }
#define XB_SPIN(cond, bar) do { unsigned _sp = 0; while (cond) { __builtin_amdgcn_s_sleep(1); \
    if ((++_sp & 255u) == 0u) { if (xb_ld(&(bar)[XB_TMO])) break; if (_sp > XB_SPIN_CAP) { atomicAdd(&(bar)[XB_TMO], 1u); break; } } } } while (0)
struct XcdBarrier { unsigned* bar; unsigned x; volatile LAS unsigned* st; };
DI XcdBarrier xcd_barrier_post(unsigned* bar, volatile LAS unsigned* st) {
  XcdBarrier b; b.bar = bar; b.x = xb_xcc_id(); b.st = st;
  if (threadIdx.x == 0) (void)xb_add(&bar[XB_XCNT(b.x)], 1u);
  return b;
}
DI void xcd_barrier_complete(unsigned* bar, unsigned x, unsigned& nloc, unsigned& nx) {
  const unsigned G = gridDim.x * gridDim.y * gridDim.z;
  unsigned sum, cnt, mine, sp = 0u;
  for (;;) {
    sum = 0u; cnt = 0u; mine = 0u;
#pragma unroll
    for (unsigned j = 0; j < 16; ++j) { const unsigned c = xb_ld(&bar[XB_XCNT(j)]); sum += c; cnt += (c > 0u) ? 1u : 0u; mine = (j == x) ? c : mine; }
    if (sum == G) break;
    __builtin_amdgcn_s_sleep(1);
    if ((++sp & 255u) == 0u) { if (xb_ld(&bar[XB_TMO])) break; if (sp > XB_SPIN_CAP) { atomicAdd(&bar[XB_TMO], 1u); break; } }
  }
  nloc = mine > 0u ? mine : 1u; nx = cnt > 0u ? cnt : 1u;
}
DI void xcd_barrier(const XcdBarrier& b) {
  asm volatile("s_waitcnt vmcnt(0)" ::: "memory");
  __syncthreads();
  if (threadIdx.x == 0) {
    unsigned* bar = b.bar;
    __builtin_amdgcn_s_waitcnt(0);
    unsigned nloc = b.st[0], nx = b.st[1];
    if (nloc == 0u) { xcd_barrier_complete(bar, b.x, nloc, nx); b.st[0] = nloc; b.st[1] = nx; }
    const unsigned old = xb_add(&bar[XB_XSUB(b.x)], 1u);
    const unsigned gen = old / nloc;
    if (old + 1u == (gen + 1u) * nloc) {
      __builtin_amdgcn_fence(__ATOMIC_RELEASE, "agent");
      asm volatile("s_waitcnt vmcnt(0)" ::: "memory");
      const unsigned og = xb_add(&bar[XB_TOP], 1u);
      const unsigned tg = og / nx;
      if (og + 1u == (tg + 1u) * nx) xb_add(&bar[XB_TOPGEN], 1u);
      else XB_SPIN(xb_ld(&bar[XB_TOPGEN]) == tg, bar);
      __builtin_amdgcn_fence(__ATOMIC_ACQUIRE, "agent");
      xb_add(&bar[XB_XGEN(b.x)], 1u);
      asm volatile("s_waitcnt vmcnt(0)" ::: "memory");
    } else {
      XB_SPIN(xb_ld(&bar[XB_XGEN(b.x)]) == gen, bar);
      __builtin_amdgcn_fence(__ATOMIC_ACQUIRE, "agent");
      asm volatile("s_waitcnt vmcnt(0)" ::: "memory");
    }
  }
  __syncthreads();
}

struct Params {
  const float *x, *c, *ada_w, *ada_b, *ln_g, *ln_b, *rw_mu, *rw_w_rkv, *rw_w0, *rw_w1, *rw_w2, *rw_a0, *rw_a1, *rw_a2, *rw_g1, *rw_g2,
      *rw_k_k, *rw_k_a, *rw_r_k, *rw_lnx_g, *rw_lnx_b, *rw_w_o, *pl_w_in, *pl_w_grp, *pl_scale, *pl_w_out, *pe_w_q, *pe_keys, *pe_u, *pe_v;
  float* out;
  float* mod;
  bf16_t *WT_rkv, *W1T, *A1T, *G1T, *W2T, *A2T, *G2T, *WoT, *PinT, *PoutT, *WgrpS, *WcT, *WqB, *WeffT, *KeysB;
  unsigned char* slot[7];
  float* tinv;
  bf16_t* lora_tmp;
  float* Gg;
  unsigned* bar;
};

DI void mod_item(const Params& p, int item, unsigned char* lds) {
  float* cond = (float*)lds;
  float (*red)[NB][32] = (float (*)[NB][32])(lds + 32768);
  const int tid = opaque_v(threadIdx.x);
  for (int i = tid; i < NB * D; i += 256) { float v = p.c[i]; cond[i] = v / (1.f + __expf(-v)); }
  __syncthreads();
  const int l = item / 192, cb = item % 192;
  const int col = cb * 32 + (tid & 31), kg = tid >> 5;
  const float* w = p.ada_w + (size_t)l * D * 6144 + col;
  float acc[NB];
#pragma unroll
  for (int b = 0; b < NB; ++b) acc[b] = 0.f;
  for (int k = kg * 128; k < kg * 128 + 128; k += 8) {
    float wv[8];
#pragma unroll
    for (int u = 0; u < 8; ++u) wv[u] = w[(size_t)(k + u) * 6144];
#pragma unroll
    for (int u = 0; u < 8; ++u)
#pragma unroll
      for (int b = 0; b < NB; ++b) acc[b] += cond[b * D + k + u] * wv[u];
  }
#pragma unroll
  for (int b = 0; b < NB; ++b) red[kg][b][tid & 31] = acc[b];
  __syncthreads();
  {
    const int b = tid >> 5, cc = tid & 31;
    float s = 0.f;
#pragma unroll
    for (int g = 0; g < 8; ++g) s += red[g][b][cc];
    const int n = cb * 32 + cc;
    p.mod[((size_t)l * NB + b) * 6144 + n] = s + p.ada_b[l * 6144 + n];
  }
  __syncthreads();
}

DI void transpose_item(const float* __restrict__ src, bf16_t* __restrict__ dst, int K, int N, int Kpad, int Npad, size_t sbs, size_t dbs, int item, unsigned char* lds) {
  float (*tile)[33] = (float (*)[33])lds;
  const int nb_n = Npad / 32, nb_k = Kpad / 32;
  const int per = nb_n * nb_k;
  const int bz = item / per, r = item % per;
  const int bk = r / nb_n, bn = r % nb_n;
  src += bz * sbs; dst += bz * dbs;
  const int tq = opaque_v(threadIdx.x); const int tx = tq & 31, ty = tq >> 5;
#pragma unroll
  for (int i = 0; i < 4; ++i) {
    const int k = bk * 32 + ty + i * 8, n = bn * 32 + tx;
    tile[ty + i * 8][tx] = (k < K && n < N) ? src[(size_t)k * N + n] : 0.f;
  }
  __syncthreads();
#pragma unroll
  for (int i = 0; i < 4; ++i) {
    const int n = bn * 32 + ty + i * 8, k = bk * 32 + tx;
    dst[(size_t)n * Kpad + k] = f2bf(tile[tx][ty + i * 8]);
  }
  __syncthreads();
}
DI void cvt_range(const float* __restrict__ src, bf16_t* __restrict__ dst, size_t n8, int bid, int nblk) {
  const int tq = opaque_v(threadIdx.x);
  for (size_t i = (size_t)bid * 256 + tq; i < n8; i += (size_t)nblk * 256) {
    const f32x4 a = *(const f32x4*)(src + i * 8), b = *(const f32x4*)(src + i * 8 + 4);
    u32x4 o; o.x = cvt_pk_bf16(a[0], a[1]); o.y = cvt_pk_bf16(a[2], a[3]); o.z = cvt_pk_bf16(b[0], b[1]); o.w = cvt_pk_bf16(b[2], b[3]);
    *(u32x4*)(dst + i * 8) = o;
  }
}
DI void prologue_phase(const Params& p, unsigned char* lds, int bid, int nblk) {
  constexpr int total = 384 + 3072 + 128 + 128 + 256 + 64 + 64 + 192 + 1024 + 1024 + 1024;
  for (int it = bid; it < total; it += nblk) {
    int r = it;
    if (r < 384) { mod_item(p, r, lds); continue; } r -= 384;
    if (r < 3072) { transpose_item(p.rw_w_rkv, p.WT_rkv, D, D, D, D, (size_t)D * D, (size_t)D * D, r, lds); continue; } r -= 3072;
    if (r < 128) { transpose_item(p.rw_w1, p.W1T, D, 64, D, 128, 0, 0, r, lds); continue; } r -= 128;
    if (r < 128) { transpose_item(p.rw_a1, p.A1T, D, 64, D, 128, 0, 0, r, lds); continue; } r -= 128;
    if (r < 256) { transpose_item(p.rw_g1, p.G1T, D, 160, D, 256, 0, 0, r, lds); continue; } r -= 256;
    if (r < 64) { transpose_item(p.rw_w2, p.W2T, 64, D, 64, D, 0, 0, r, lds); continue; } r -= 64;
    if (r < 64) { transpose_item(p.rw_a2, p.A2T, 64, D, 64, D, 0, 0, r, lds); continue; } r -= 64;
    if (r < 192) { transpose_item(p.rw_g2, p.G2T, 160, D, 192, D, 0, 0, r, lds); continue; } r -= 192;
    if (r < 1024) { transpose_item(p.rw_w_o, p.WoT, D, D, D, D, 0, 0, r, lds); continue; } r -= 1024;
    if (r < 1024) { transpose_item(p.pl_w_in, p.PinT, D, D, D, D, 0, 0, r, lds); continue; } r -= 1024;
    transpose_item(p.pl_w_out, p.PoutT, D, D, D, D, 0, 0, r, lds);
  }
  cvt_range(p.pe_keys, p.KeysB, (size_t)2 * 16 * 128 * 128 / 8, bid, nblk);
  cvt_range(p.pe_w_q, p.WqB, (size_t)2 * D * 2048 / 8, bid, nblk);
  {
    const int tq = opaque_v(threadIdx.x);
    for (int i = bid * 256 + tq; i < 4 * 256 * 256 / 8; i += nblk * 256) {
      const int e0 = (i * 8) & 255, g4 = (i * 8) >> 16;
      const f32x4 a0 = *(const f32x4*)(p.pl_w_grp + (size_t)i * 8), a1 = *(const f32x4*)(p.pl_w_grp + (size_t)i * 8 + 4);
      const f32x4 s0 = *(const f32x4*)(p.pl_scale + g4 * 256 + e0), s1 = *(const f32x4*)(p.pl_scale + g4 * 256 + e0 + 4);
      const f32x4 b0 = a0 * s0, b1 = a1 * s1;
      *(u32x4*)(p.WgrpS + (size_t)i * 8) = (u32x4){cvt_pk_bf16(b0[0], b0[1]), cvt_pk_bf16(b0[2], b0[3]), cvt_pk_bf16(b1[0], b1[1]), cvt_pk_bf16(b1[2], b1[3])};
    }
  }
}

DI void modulate_phase(const float* __restrict__ x, const float* __restrict__ mod_l, const float* __restrict__ mu, bf16_t* __restrict__ h, bf16_t* __restrict__ xr, bf16_t* __restrict__ xk,
                       bf16_t* __restrict__ xv, int bid, int nblk) {
  const size_t n8 = (size_t)T * D / 8; const int tq = opaque_v(threadIdx.x);
  for (size_t i = (size_t)bid * 256 + tq; i < n8; i += (size_t)nblk * 256) {
    const size_t e = i * 8; const int t = (int)(e / D), d = (int)(e % D), b = t / SEQ;
    const float* sh = mod_l + (size_t)b * 6144 + 0 * D + d; const float* sc = mod_l + (size_t)b * 6144 + 1 * D + d;
    float hv[8], pv[8];
    {
      const f32x4 a0 = *(const f32x4*)(x + e), a1 = *(const f32x4*)(x + e + 4);
      const f32x4 s0 = *(const f32x4*)sh, s1 = *(const f32x4*)(sh + 4), c0 = *(const f32x4*)sc, c1 = *(const f32x4*)(sc + 4);
      const f32x4 r0 = a0 * (c0 + 1.f) + s0, r1 = a1 * (c1 + 1.f) + s1;
      f32x4 q0 = {0.f, 0.f, 0.f, 0.f}, q1 = {0.f, 0.f, 0.f, 0.f};
      if ((t % SEQ) != 0) { const f32x4 b0 = *(const f32x4*)(x + e - D), b1 = *(const f32x4*)(x + e - D + 4); q0 = b0 * (c0 + 1.f) + s0; q1 = b1 * (c1 + 1.f) + s1; }
#pragma unroll
      for (int j = 0; j < 4; ++j) { hv[j] = r0[j]; hv[4 + j] = r1[j]; pv[j] = q0[j]; pv[4 + j] = q1[j]; }
    }
    u32x4 o; o.x = cvt_pk_bf16(hv[0], hv[1]); o.y = cvt_pk_bf16(hv[2], hv[3]); o.z = cvt_pk_bf16(hv[4], hv[5]); o.w = cvt_pk_bf16(hv[6], hv[7]);
    *(u32x4*)(h + e) = o;
#pragma unroll
    for (int n = 0; n < 3; ++n) {
      const f32x4 m0 = *(const f32x4*)(mu + n * D + d), m1 = *(const f32x4*)(mu + n * D + d + 4);
      float w[8];
#pragma unroll
      for (int j = 0; j < 8; ++j) { const float m = j < 4 ? m0[j] : m1[j - 4]; w[j] = hv[j] + (pv[j] - hv[j]) * m; }
      u32x4 q; q.x = cvt_pk_bf16(w[0], w[1]); q.y = cvt_pk_bf16(w[2], w[3]); q.z = cvt_pk_bf16(w[4], w[5]); q.w = cvt_pk_bf16(w[6], w[7]);
      *(u32x4*)((n == 0 ? xr : (n == 1 ? xk : xv)) + e) = q;
    }
  }
}

enum { EPI_BF16 = 0, EPI_TANH, EPI_SIGMOID, EPI_LW, EPI_ASIG, EPI_Z, EPI_SCALE, EPI_GATE, EPI_TOPK };
struct GemmArgs {
  const bf16_t* A; int lda;
  const bf16_t* Bt; int ldb;
  int N, K;
  const float* mu;
  int epi; void* out; int ldc;
  const float* v0; const float* v1;
};

DI int lds_off(int row, int chunk) { return row * 128 + ((chunk ^ (row & 7)) << 4); }

DI void gemm_load_a(const GemmArgs& g, int m0, int k0, int tid, u32x4 (&ra)[4]) {
#pragma unroll
  for (int i = 0; i < 4; ++i) {
    const int row = (tid >> 3) + i * 32, ch = tid & 7;
    const int m = m0 + row;
    const bf16_t* src = g.A + (size_t)m * g.lda + k0 + ch * 8;
    u32x4 v = *(const u32x4*)src;
    if (g.mu) {
      u32x4 pv = {0u, 0u, 0u, 0u};
      if ((m % SEQ) != 0) pv = *(const u32x4*)(src - g.lda);
      const f32x4 m0v = *(const f32x4*)(g.mu + k0 + ch * 8), m1v = *(const f32x4*)(g.mu + k0 + ch * 8 + 4);
      const unsigned hu[4] = {v.x, v.y, v.z, v.w}, pu[4] = {pv.x, pv.y, pv.z, pv.w};
      float o[8];
#pragma unroll
      for (int j = 0; j < 4; ++j) {
        const float h0 = bf_lo(hu[j]), h1 = bf_hi(hu[j]), p0 = bf_lo(pu[j]), p1 = bf_hi(pu[j]);
        const float mu0 = (2 * j < 4) ? m0v[(2 * j) & 3] : m1v[(2 * j) & 3], mu1 = (2 * j + 1 < 4) ? m0v[(2 * j + 1) & 3] : m1v[(2 * j + 1) & 3];
        o[2 * j] = h0 + (p0 - h0) * mu0; o[2 * j + 1] = h1 + (p1 - h1) * mu1;
      }
      v.x = cvt_pk_bf16(o[0], o[1]); v.y = cvt_pk_bf16(o[2], o[3]); v.z = cvt_pk_bf16(o[4], o[5]); v.w = cvt_pk_bf16(o[6], o[7]);
    }
    ra[i] = v;
  }
}
DI void gemm_load_b(const GemmArgs& g, int n0, int k0, int tid, u32x4 (&rb)[4]) {
#pragma unroll
  for (int i = 0; i < 4; ++i) {
    const int row = (tid >> 3) + i * 32, ch = tid & 7;
    rb[i] = *(const u32x4*)(g.Bt + (size_t)(n0 + row) * g.ldb + k0 + ch * 8);
  }
}
DI void gemm_store_lds(unsigned char* buf, int tid, const u32x4 (&r)[4]) {
#pragma unroll
  for (int i = 0; i < 4; ++i) {
    const int row = (tid >> 3) + i * 32, ch = tid & 7;
    *(u32x4*)(buf + lds_off(row, ch)) = r[i];
  }
}

DI unsigned f2key(float f) { unsigned u = __float_as_uint(f); return u ^ ((u >> 31) ? 0xffffffffu : 0x80000000u); }
DI float key2f(unsigned k) { unsigned u = (k >> 31) ? (k ^ 0x80000000u) : ~k; return __uint_as_float(u); }
#define CE_DESC(a, b) { const unsigned _mx = max(a, b), _mn = min(a, b); a = _mx; b = _mn; }
DI void sort16_desc(unsigned (&x)[16]) {
#pragma unroll
  for (int k = 2; k <= 16; k <<= 1) {
#pragma unroll
    for (int j = k >> 1; j > 0; j >>= 1) {
#pragma unroll
      for (int i = 0; i < 16; ++i) {
        const int l = i ^ j;
        if (l > i) {
          if ((i & k) == 0) { CE_DESC(x[i], x[l]); } else { CE_DESC(x[l], x[i]); }
        }
      }
    }
  }
}
DI void merge16_desc(unsigned (&x)[16]) {
#pragma unroll
  for (int j = 8; j > 0; j >>= 1) {
#pragma unroll
    for (int i = 0; i < 16; ++i) { const int l = i ^ j; if (l > i) { CE_DESC(x[i], x[l]); } }
  }
}

DI void gemm_glds(const bf16_t* __restrict__ base, int ld, int r0, int k0, unsigned char* buf, int wid, int lane) {
  const bf16_t* src = base + (size_t)(r0 + wid * 8 + (lane >> 3)) * ld + k0 + (((lane & 7) ^ (lane >> 3)) << 3);
#pragma unroll
  for (int j = 0; j < 4; ++j)
    __builtin_amdgcn_global_load_lds((const unsigned*)(src + (size_t)j * 32 * ld), (unsigned*)(buf + (j * 4 + wid) * 1024), 16, 0, 0);
}
DI void gemm_tile(const GemmArgs& g, int m0, int n0, unsigned char* lds) {
  constexpr int WM = 2, WN = 4 / WM, TM = 128 / WM, TN = 128 / WN, MI = TM / 16, NI = TN / 16;
  const int tid = opaque_v(threadIdx.x), lane = tid & 63, wid = tid >> 6;
  const int wm = wid / WN, wn = wid % WN;
  const int nk = g.K / 64;
  const bool lerp = g.mu != nullptr;
  f32x4 acc[MI][NI];
#pragma unroll
  for (int i = 0; i < MI; ++i)
#pragma unroll
    for (int j = 0; j < NI; ++j) acc[i][j] = (f32x4){0.f, 0.f, 0.f, 0.f};
  u32x4 ra[4];
  if (lerp) { gemm_load_a(g, m0, 0, tid, ra); gemm_store_lds(lds, tid, ra); } else gemm_glds(g.A, g.lda, m0, 0, lds, wid, lane);
  gemm_glds(g.Bt, g.ldb, n0, 0, lds + 16384, wid, lane);
  asm volatile("s_waitcnt vmcnt(0)" ::: "memory");
  __syncthreads();
  const int fr = lane & 15, fq = lane >> 4;
  for (int kt = 0; kt < nk; ++kt) {
    unsigned char* cur = lds + (kt & 1) * 32768;
    unsigned char* nxt = lds + ((kt + 1) & 1) * 32768;
    if (kt + 1 < nk) {
      if (lerp) gemm_load_a(g, m0, (kt + 1) * 64, tid, ra); else gemm_glds(g.A, g.lda, m0, (kt + 1) * 64, nxt, wid, lane);
      gemm_glds(g.Bt, g.ldb, n0, (kt + 1) * 64, nxt + 16384, wid, lane);
    }
#pragma unroll
    for (int ks = 0; ks < 2; ++ks) {
      bf16x8 af[MI], bfr[NI];
#pragma unroll
      for (int i = 0; i < MI; ++i) af[i] = *(const bf16x8*)(cur + lds_off(wm * TM + i * 16 + fr, ks * 4 + fq));
#pragma unroll
      for (int j = 0; j < NI; ++j) bfr[j] = *(const bf16x8*)(cur + 16384 + lds_off(wn * TN + j * 16 + fr, ks * 4 + fq));
#pragma unroll
      for (int i = 0; i < MI; ++i)
#pragma unroll
        for (int j = 0; j < NI; ++j) acc[i][j] = __builtin_amdgcn_mfma_f32_16x16x32_bf16(bfr[j], af[i], acc[i][j], 0, 0, 0);
    }
    if (lerp && kt + 1 < nk) gemm_store_lds(nxt, tid, ra);
    asm volatile("s_waitcnt vmcnt(0)" ::: "memory");
    __syncthreads();
  }
  if (g.epi == EPI_TOPK) {
    unsigned* lists = (unsigned*)g.out;
    const int grp = n0 >> 7;
#pragma unroll
    for (int i = 0; i < MI; ++i)
#pragma unroll
      for (int j = 0; j < NI; ++j) {
        const int ml = wm * TM + i * 16 + fr, c = wn * 16 + j * 4 + fq;
        u32x4 kv;
        kv.x = (f2key(acc[i][j][0]) & ~127u) | (unsigned)(127 - (c * 4 + 0)); kv.y = (f2key(acc[i][j][1]) & ~127u) | (unsigned)(127 - (c * 4 + 1));
        kv.z = (f2key(acc[i][j][2]) & ~127u) | (unsigned)(127 - (c * 4 + 2)); kv.w = (f2key(acc[i][j][3]) & ~127u) | (unsigned)(127 - (c * 4 + 3));
        *(u32x4*)(lds + ml * 528 + (c << 4)) = kv;
      }
    __syncthreads();
    {
      const int ml = wid * 32 + (lane & 31), hf = lane >> 5;
      unsigned a[16], b[16];
#pragma unroll
      for (int ch = 0; ch < 4; ++ch) {
#pragma unroll
        for (int cc = 0; cc < 4; ++cc) {
          const int c = hf * 16 + ch * 4 + cc;
          const u32x4 kv = *(const u32x4*)(lds + ml * 528 + (c << 4));
          b[cc * 4] = kv.x; b[cc * 4 + 1] = kv.y; b[cc * 4 + 2] = kv.z; b[cc * 4 + 3] = kv.w;
        }
        sort16_desc(b);
        if (ch == 0) {
#pragma unroll
          for (int e = 0; e < 16; ++e) a[e] = b[e];
        } else {
#pragma unroll
          for (int e = 0; e < 16; ++e) a[e] = max(a[e], b[15 - e]);
          merge16_desc(a);
        }
      }
#pragma unroll
      for (int e = 0; e < 16; ++e) b[e] = (unsigned)__shfl_xor((int)a[e], 32);
#pragma unroll
      for (int e = 0; e < 16; ++e) a[e] = max(a[e], b[15 - e]);
      merge16_desc(a);
      if (hf == 0) {
        const int m = m0 + ml;
        u32x4* dst = (u32x4*)(lists + ((size_t)m * 16 + grp) * 16);
        dst[0] = (u32x4){a[0], a[1], a[2], a[3]}; dst[1] = (u32x4){a[4], a[5], a[6], a[7]};
        dst[2] = (u32x4){a[8], a[9], a[10], a[11]}; dst[3] = (u32x4){a[12], a[13], a[14], a[15]};
      }
    }
    __syncthreads();
    return;
  }
#pragma unroll
  for (int i = 0; i < MI; ++i) {
    const int m = m0 + wm * TM + i * 16 + fr;
#pragma unroll
    for (int j = 0; j < NI; ++j) {
      const int n = n0 + wn * TN + j * 16 + fq * 4;
      if (n >= g.N) continue;
      const f32x4 v = acc[i][j];
      bf16_t* ob = (bf16_t*)g.out + (size_t)m * g.ldc + n;
      switch (g.epi) {
        case EPI_BF16: *(u32x2*)ob = (u32x2){cvt_pk_bf16(v[0], v[1]), cvt_pk_bf16(v[2], v[3])}; break;
        case EPI_TANH: *(u32x2*)ob = (u32x2){cvt_pk_bf16(tanhf(v[0]), tanhf(v[1])), cvt_pk_bf16(tanhf(v[2]), tanhf(v[3]))}; break;
        case EPI_SIGMOID: *(u32x2*)ob = (u32x2){cvt_pk_bf16(sigmoidf_(v[0]), sigmoidf_(v[1])), cvt_pk_bf16(sigmoidf_(v[2]), sigmoidf_(v[3]))}; break;
        case EPI_LW: {
          const f32x4 w0 = *(const f32x4*)(g.v0 + n); float o[4];
#pragma unroll
          for (int q = 0; q < 4; ++q) { const float xx = -(w0[q] + v[q]); const float sp = fmaxf(xx, 0.f) + __logf(1.f + __expf(-fabsf(xx))); o[q] = -__expf(-sp - 0.5f); }
          *(u32x2*)ob = (u32x2){cvt_pk_bf16(o[0], o[1]), cvt_pk_bf16(o[2], o[3])};
        } break;
        case EPI_ASIG: {
          const f32x4 a0 = *(const f32x4*)(g.v0 + n);
          *(u32x2*)ob = (u32x2){cvt_pk_bf16(sigmoidf_(a0[0] + v[0]), sigmoidf_(a0[1] + v[1])), cvt_pk_bf16(sigmoidf_(a0[2] + v[2]), sigmoidf_(a0[3] + v[3]))};
        } break;
        case EPI_Z: {
          const int b = m / SEQ;
          const f32x4 xv = *(const f32x4*)(g.v0 + (size_t)m * D + n), gt = *(const f32x4*)(g.v1 + (size_t)b * 6144 + n);
          *(f32x4*)((float*)g.out + (size_t)m * g.ldc + n) = xv * ALPHA + gt * v;
        } break;
        case EPI_GATE: {
          const u32x2 yv = *(const u32x2*)ob;
          *(u32x2*)ob = (u32x2){cvt_pk_bf16(bf_lo(yv.x) * v[0], bf_hi(yv.x) * v[1]), cvt_pk_bf16(bf_lo(yv.y) * v[2], bf_hi(yv.y) * v[3])};
        } break;
        default: {
          const f32x4 sc = *(const f32x4*)(g.v0 + n);
          *(u32x2*)ob = (u32x2){cvt_pk_bf16(v[0] * sc[0], v[1] * sc[1]), cvt_pk_bf16(v[2] * sc[2], v[3] * sc[3])};
        } break;
      }
    }
  }
}

DI GemmArgs mk(const bf16_t* A, int lda, const bf16_t* Bt, int ldb, int N, int K, int epi, void* out, int ldc,
               const float* mu = nullptr, const float* v0 = nullptr, const float* v1 = nullptr) {
  GemmArgs g; g.A = A; g.lda = lda; g.Bt = Bt; g.ldb = ldb; g.N = N; g.K = K; g.mu = mu; g.epi = epi; g.out = out; g.ldc = ldc; g.v0 = v0; g.v1 = v1; return g;
}
DI int sched_iters(int ntn, int nblk) {
  const int LB = nblk >> 3; int it = 0;
  for (int n0 = 0; n0 < ntn;) { int NT = min(8, ntn - n0); while (LB % NT) --NT; const int MT = LB / NT; it += (256 + 8 * MT - 1) / (8 * MT); n0 += NT; }
  return it;
}
DI bool sched_mn(int i, int bid, int nblk, int ntn, int& mt, int& nt) {
  const int x = bid & 7, l = bid >> 3, LB = nblk >> 3; int base = 0;
  for (int n0 = 0; n0 < ntn;) {
    int NT = min(8, ntn - n0); while (LB % NT) --NT;
    const int MT = LB / NT, rounds = (256 + 8 * MT - 1) / (8 * MT);
    if (i < base + rounds) { mt = (i - base) * 8 * MT + x * MT + (l % MT); nt = n0 + l / MT; return mt < 256; }
    base += rounds; n0 += NT;
  }
  return false;
}

constexpr int CL = 32;
constexpr int NCH = SEQ / CL;
constexpr int SN = 144, ST = 80;
struct ScanArgs {
  bf16_t* r; const bf16_t *k, *v, *lw, *a;
  const float *k_k, *k_a, *r_k, *lnx_g, *lnx_b;
  bf16_t* Pg;
  bf16_t *Qz0, *Qz1;
  float* Gg;
};
DI int tr_off(int row, int tok) { return row * ST + ((((tok >> 3) ^ ((row >> 3) & 3)) << 4) | ((tok & 7) << 1)); }
template <bool PT, bool QT>
DI f32x4 tile_mm(const unsigned char* P, int ps, const unsigned char* Q, int qs, int i0, int j0, int nks, f32x4 acc, int lane) {
  const int fr = lane & 15, fq = lane >> 4;
  for (int ks = 0; ks < nks; ++ks) {
    const bf16x8 pa = *(const bf16x8*)(PT ? P + tr_off(i0 + fr, fq * 8) : P + (i0 + fr) * ps + ks * 64 + fq * 16);
    const bf16x8 qb = *(const bf16x8*)(QT ? Q + tr_off(j0 + fr, fq * 8) : Q + (j0 + fr) * qs + ks * 64 + fq * 16);
    acc = __builtin_amdgcn_mfma_f32_16x16x32_bf16(pa, qb, acc, 0, 0, 0);
  }
  return acc;
}
DI bf16_t* qz_ptr(const ScanArgs& s, int ch) { return ((ch >> 13) ? s.Qz1 : s.Qz0) + (size_t)(ch & 8191) * 4096; }
DI void st_bf16x4(unsigned char* p, const f32x4& v) { *(u32x2*)p = (u32x2){cvt_pk_bf16(v[0], v[1]), cvt_pk_bf16(v[2], v[3])}; }

struct ScanIn { u32x4 r, k, v, w, a, z0, z1; };
template <bool PHASE_C>
DI void scan_fetch(const ScanArgs& s, int item, ScanIn& in) {
  const int c = item & (NCH - 1), h = (item >> 7) & 15, b = item >> 11;
  const int tid = opaque_v(threadIdx.x), tt = tid >> 3, c0 = (tid & 7) * 8;
  const size_t off = ((size_t)b * SEQ + (size_t)c * CL + tt) * D + h * HS + c0;
  in.k = *(const u32x4*)(s.k + off); in.v = *(const u32x4*)(s.v + off); in.w = *(const u32x4*)(s.lw + off); in.a = *(const u32x4*)(s.a + off);
  if (PHASE_C) {
    in.r = *(const u32x4*)(s.r + off);
    const bf16_t* Zg = qz_ptr(s, item);
    in.z0 = *(const u32x4*)(Zg + tid * 8); in.z1 = *(const u32x4*)(Zg + (tid + 256) * 8);
  }
}
template <bool PHASE_C>
DI void scan_load(const ScanArgs& s, const ScanIn& in, int h, float* lwbuf, unsigned char* At, unsigned char* Bt, unsigned char* Kt, unsigned char* Rt,
                  unsigned char* AtT, unsigned char* BhT, unsigned char* KhT, unsigned char* VT, float& bonus, float (&vout)[8], float* Gout) {
  const int tid = opaque_v(threadIdx.x), tt = tid >> 3, c0 = (tid & 7) * 8;
  const u32x4 vk = in.k, vv = in.v, vw = in.w, va = in.a;
  u32x4 vr = {0u, 0u, 0u, 0u};
  if (PHASE_C) vr = in.r;
  float fr_[8], fk[8], fv[8], fw[8], fa[8];
  { const unsigned ur[4] = {vr.x, vr.y, vr.z, vr.w}, uk[4] = {vk.x, vk.y, vk.z, vk.w}, uv[4] = {vv.x, vv.y, vv.z, vv.w}, uw[4] = {vw.x, vw.y, vw.z, vw.w}, ua[4] = {va.x, va.y, va.z, va.w};
#pragma unroll
    for (int j = 0; j < 4; ++j) {
      fr_[2 * j] = bf_lo(ur[j]); fr_[2 * j + 1] = bf_hi(ur[j]); fk[2 * j] = bf_lo(uk[j]); fk[2 * j + 1] = bf_hi(uk[j]);
      fv[2 * j] = bf_lo(uv[j]); fv[2 * j + 1] = bf_hi(uv[j]); fw[2 * j] = bf_lo(uw[j]); fw[2 * j + 1] = bf_hi(uw[j]);
      fa[2 * j] = bf_lo(ua[j]); fa[2 * j + 1] = bf_hi(ua[j]);
    } }
  *(f32x4*)(lwbuf + tt * 64 + c0) = (f32x4){fw[0], fw[1], fw[2], fw[3]}; *(f32x4*)(lwbuf + tt * 64 + c0 + 4) = (f32x4){fw[4], fw[5], fw[6], fw[7]};
  float kkr[8], nrm = 0.f, bon = 0.f, kp[8];
#pragma unroll
  for (int j = 0; j < 8; ++j) {
    const int ch = h * HS + c0 + j;
    kkr[j] = fk[j] * s.k_k[ch]; nrm += kkr[j] * kkr[j];
    kp[j] = fk[j] * (1.f + (fa[j] - 1.f) * s.k_a[ch]);
    if (PHASE_C) bon += fr_[j] * kp[j] * s.r_k[ch];
  }
  nrm += __shfl_xor(nrm, 1); nrm += __shfl_xor(nrm, 2); nrm += __shfl_xor(nrm, 4);
  if (PHASE_C) { bon += __shfl_xor(bon, 1); bon += __shfl_xor(bon, 2); bon += __shfl_xor(bon, 4); }
  bonus = bon;
  const float inv = rsqrtf(fmaxf(nrm, 1e-24f));
  __syncthreads();
  {
    const int c = tid & 63, sg = tid >> 6;
    float run = 0.f;
#pragma unroll
    for (int i = 0; i < 8; ++i) { run += lwbuf[(sg * 8 + i) * 64 + c]; lwbuf[(sg * 8 + i) * 64 + c] = run; }
  }
  __syncthreads();
  float cum[8], cl[8];
  {
    const int sg = tt >> 3;
#pragma unroll
    for (int hh = 0; hh < 2; ++hh) {
      const f32x4 me = *(const f32x4*)(lwbuf + tt * 64 + c0 + hh * 4);
      const f32x4 s0 = *(const f32x4*)(lwbuf + 7 * 64 + c0 + hh * 4), s1 = *(const f32x4*)(lwbuf + 15 * 64 + c0 + hh * 4),
                  s2 = *(const f32x4*)(lwbuf + 23 * 64 + c0 + hh * 4), s3 = *(const f32x4*)(lwbuf + 31 * 64 + c0 + hh * 4);
#pragma unroll
      for (int q = 0; q < 4; ++q) {
        const float pre = (sg > 0 ? s0[q] : 0.f) + (sg > 1 ? s1[q] : 0.f) + (sg > 2 ? s2[q] : 0.f);
        cum[hh * 4 + q] = me[q] + pre; cl[hh * 4 + q] = (s0[q] + s1[q]) + (s2[q] + s3[q]);
      }
    }
  }
  float at[8], bt[8], kt[8], rt[8], bh[8], kh[8];
#pragma unroll
  for (int j = 0; j < 8; ++j) {
    const float kk = kkr[j] * inv, bb = kk * fa[j];
    const float ein = __expf(cum[j]), eneg = __expf(-cum[j]), eex = __expf(cum[j] - fw[j]), eend = __expf(cl[j] - cum[j]);
    at[j] = -kk * eex; bt[j] = bb * eneg; kt[j] = kp[j] * eneg; rt[j] = fr_[j] * ein; bh[j] = bb * eend; kh[j] = kp[j] * eend;
    vout[j] = fv[j];
  }
  *(u32x4*)(At + tt * SN + c0 * 2) = (u32x4){cvt_pk_bf16(at[0], at[1]), cvt_pk_bf16(at[2], at[3]), cvt_pk_bf16(at[4], at[5]), cvt_pk_bf16(at[6], at[7])};
  *(u32x4*)(Bt + tt * SN + c0 * 2) = (u32x4){cvt_pk_bf16(bt[0], bt[1]), cvt_pk_bf16(bt[2], bt[3]), cvt_pk_bf16(bt[4], bt[5]), cvt_pk_bf16(bt[6], bt[7])};
  *(u32x4*)(Kt + tt * SN + c0 * 2) = (u32x4){cvt_pk_bf16(kt[0], kt[1]), cvt_pk_bf16(kt[2], kt[3]), cvt_pk_bf16(kt[4], kt[5]), cvt_pk_bf16(kt[6], kt[7])};
  if (PHASE_C) *(u32x4*)(Rt + tt * SN + c0 * 2) = (u32x4){cvt_pk_bf16(rt[0], rt[1]), cvt_pk_bf16(rt[2], rt[3]), cvt_pk_bf16(rt[4], rt[5]), cvt_pk_bf16(rt[6], rt[7])};
#pragma unroll
  for (int j = 0; j < 8; ++j) {
    *(bf16_t*)(VT + tr_off(c0 + j, tt)) = f2bf(fv[j]);
    if (!PHASE_C) {
      *(bf16_t*)(AtT + tr_off(c0 + j, tt)) = f2bf(at[j]);
      *(bf16_t*)(BhT + tr_off(c0 + j, tt)) = f2bf(bh[j]);
      *(bf16_t*)(KhT + tr_off(c0 + j, tt)) = f2bf(kh[j]);
    }
  }
  if (!PHASE_C && tt == 0 && Gout) {
#pragma unroll
    for (int j = 0; j < 8; ++j) Gout[c0 + j] = __expf(cl[j]);
  }
}
DI void scan_tinv(const float* A32, unsigned char* Tm, int lane) {
  const int c = lane & 31;
  float Tc[32];
#pragma unroll
  for (int i = 0; i < 32; ++i) {
    float s0 = (i == c) ? 1.f : 0.f, s1 = 0.f, s2 = 0.f, s3 = 0.f;
#pragma unroll
    for (int j4 = 0; j4 < (i + 3) / 4; ++j4) {
      const f32x4 a4 = *(const f32x4*)(A32 + i * 36 + j4 * 4);
      if (j4 * 4 + 0 < i) s0 += a4[0] * Tc[j4 * 4 + 0];
      if (j4 * 4 + 1 < i) s1 += a4[1] * Tc[j4 * 4 + 1];
      if (j4 * 4 + 2 < i) s2 += a4[2] * Tc[j4 * 4 + 2];
      if (j4 * 4 + 3 < i) s3 += a4[3] * Tc[j4 * 4 + 3];
    }
    Tc[i] = (s0 + s1) + (s2 + s3);
  }
  if (lane < 32) {
#pragma unroll
    for (int i = 0; i < 32; ++i) *(bf16_t*)(Tm + i * ST + c * 2) = f2bf(Tc[i]);
  }
}

DI void scan_phaseA_item(const ScanArgs& s, int item, const ScanIn& in, unsigned char* lds) {
  const int c = item & (NCH - 1), h = (item >> 7) & 15, b = item >> 11;
  const int tid = opaque_v(threadIdx.x), lane = tid & 63, wv = tid >> 6, fr = lane & 15, fq = lane >> 4;
  unsigned char* At = lds; unsigned char* Bt = At + 32 * SN; unsigned char* Kt = Bt + 32 * SN;
  unsigned char* AtT = Kt + 32 * SN; unsigned char* BhT = AtT + 64 * ST; unsigned char* KhT = BhT + 64 * ST; unsigned char* VT = KhT + 64 * ST;
  unsigned char* Tm = VT + 64 * ST; unsigned char* Aak = Tm + 32 * ST;
  float* A32 = (float*)(Aak + 32 * ST);
  unsigned char* W1T = (unsigned char*)A32 + 4608; unsigned char* M2T = W1T + 64 * ST; unsigned char* UlT = M2T + 64 * ST;
  float* lwbuf = (float*)W1T;
  const size_t gbase = ((size_t)b * SEQ + (size_t)c * CL) * D + h * HS;
  float bonus; float vv8[8];
  scan_load<false>(s, in, h, lwbuf, At, Bt, Kt, nullptr, AtT, BhT, KhT, VT, bonus, vv8, s.Gg + (size_t)item * 64);
  __syncthreads();
  {
    const int mat = wv >> 1, ti = wv & 1;
#pragma unroll
    for (int tj = 0; tj < 2; ++tj) {
      const f32x4 x = tile_mm<false, false>(At, SN, mat ? Kt : Bt, SN, ti * 16, tj * 16, 2, (f32x4){0.f, 0.f, 0.f, 0.f}, lane);
#pragma unroll
      for (int q = 0; q < 4; ++q) {
        const int i = ti * 16 + fq * 4 + q, j = tj * 16 + fr;
        const float val = (j < i) ? x[q] : 0.f;
        if (mat == 0) A32[i * 36 + j] = val; else *(bf16_t*)(Aak + i * ST + j * 2) = f2bf(val);
      }
    }
  }
  __syncthreads();
  if (wv == 0) scan_tinv(A32, Tm, lane);
  else {
    for (int tile = wv - 1; tile < 8; tile += 3) {
      const int ti = tile >> 2, tv = tile & 3;
      const f32x4 x = tile_mm<false, true>(Aak, ST, VT, ST, ti * 16, tv * 16, 1, (f32x4){0.f, 0.f, 0.f, 0.f}, lane);
      st_bf16x4(M2T + tr_off(tv * 16 + fr, ti * 16 + fq * 4), x);
    }
  }
  __syncthreads();
#pragma unroll
  for (int u = 0; u < 4; ++u) {
    const int tile = wv * 4 + u, which = tile >> 3, ti = (tile >> 2) & 1, tn = tile & 3;
    const f32x4 x = tile_mm<false, true>(Tm, ST, which ? M2T : AtT, ST, ti * 16, tn * 16, 1, (f32x4){0.f, 0.f, 0.f, 0.f}, lane);
    st_bf16x4((which ? UlT : W1T) + tr_off(tn * 16 + fr, ti * 16 + fq * 4), x);
  }
  __syncthreads();
  bf16_t* Pg = s.Pg + (size_t)item * 4096; bf16_t* Qg = qz_ptr(s, item);
#pragma unroll
  for (int u = 0; u < 4; ++u) {
    const int tile = wv * 4 + u, tk = tile >> 2, tn = tile & 3;
    const f32x4 xp = tile_mm<true, true>(W1T, ST, BhT, ST, tk * 16, tn * 16, 1, (f32x4){0.f, 0.f, 0.f, 0.f}, lane);
    *(u32x2*)(Pg + (tn * 16 + fr) * 64 + tk * 16 + fq * 4) = (u32x2){cvt_pk_bf16(xp[0], xp[1]), cvt_pk_bf16(xp[2], xp[3])};
    f32x4 xq = tile_mm<true, true>(BhT, ST, UlT, ST, tk * 16, tn * 16, 1, (f32x4){0.f, 0.f, 0.f, 0.f}, lane);
    xq = tile_mm<true, true>(KhT, ST, VT, ST, tk * 16, tn * 16, 1, xq, lane);
    __hip_atomic_store((unsigned long long*)(Qg + ((tk * 4 + tn) * 64 + lane) * 4), (unsigned long long)cvt_pk_bf16(xq[0], xq[1]) | ((unsigned long long)cvt_pk_bf16(xq[2], xq[3]) << 32), __ATOMIC_RELAXED, __HIP_MEMORY_SCOPE_AGENT);
  }
  __syncthreads();
}

constexpr int PSTR = 144;
constexpr int RSLOT = 64 * PSTR + 8192 + 256;
DI void scan_chain_block(const ScanArgs& s, int bh, unsigned char* lds) {
  const int tid = opaque_v(threadIdx.x), lane = tid & 63, tv = tid >> 6, fr = lane & 15, fq = lane >> 4;
  const int ch0 = bh * NCH;
  u32x4 pr[5];
  auto issue = [&](int c) {
    const bf16_t* Pg = s.Pg + (size_t)(ch0 + c) * 4096; const bf16_t* Qg = qz_ptr(s, ch0 + c);
    pr[0] = *(const u32x4*)(Pg + (size_t)tid * 8); pr[1] = *(const u32x4*)(Pg + (size_t)(tid + 256) * 8);
    pr[2] = *(const u32x4*)(Qg + (size_t)tid * 8); pr[3] = *(const u32x4*)(Qg + (size_t)(tid + 256) * 8);
    if (tid < 16) pr[4] = *(const u32x4*)(s.Gg + (size_t)(ch0 + c) * 64 + tid * 4);
  };
  auto commit = [&](int c) {
    unsigned char* sl = lds + (c & 3) * RSLOT;
    *(u32x4*)(sl + (tid >> 3) * PSTR + (tid & 7) * 16) = pr[0]; *(u32x4*)(sl + ((tid + 256) >> 3) * PSTR + (tid & 7) * 16) = pr[1];
    *(u32x4*)(sl + 64 * PSTR + tid * 16) = pr[2]; *(u32x4*)(sl + 64 * PSTR + (tid + 256) * 16) = pr[3];
    if (tid < 16) *(u32x4*)(sl + 64 * PSTR + 8192 + tid * 16) = pr[4];
  };
  issue(0); commit(0); issue(1); commit(1); issue(2); commit(2);
  __syncthreads();
  f32x4 Z[4];
#pragma unroll
  for (int t = 0; t < 4; ++t) Z[t] = (f32x4){0.f, 0.f, 0.f, 0.f};
  for (int c = 0; c < NCH; ++c) {
    if (c + 3 < NCH) issue(c + 3);
    const unsigned char* sl = lds + (c & 3) * RSLOT;
    bf16_t* Zo = qz_ptr(s, ch0 + c) + (tv * 16 + fr) * 64;
    unsigned zp[4][2];
#pragma unroll
    for (int t = 0; t < 4; ++t) { zp[t][0] = cvt_pk_bf16(Z[t][0], Z[t][1]); zp[t][1] = cvt_pk_bf16(Z[t][2], Z[t][3]); *(u32x2*)(Zo + t * 16 + fq * 4) = (u32x2){zp[t][0], zp[t][1]}; }
    bf16x8 zb[2];
#pragma unroll
    for (int ks = 0; ks < 2; ++ks) { const u32x4 w = {zp[2 * ks][0], zp[2 * ks][1], zp[2 * ks + 1][0], zp[2 * ks + 1][1]}; zb[ks] = __builtin_bit_cast(bf16x8, w); }
#pragma unroll
    for (int t = 0; t < 4; ++t) {
      const u32x2 qv = *(const u32x2*)(sl + 64 * PSTR + ((t * 4 + tv) * 64 + lane) * 8);
      const f32x4 g4 = *(const f32x4*)(sl + 64 * PSTR + 8192 + (t * 16 + fq * 4) * 4);
      f32x4 acc = (f32x4){bf_lo(qv.x) + g4[0] * Z[t][0], bf_hi(qv.x) + g4[1] * Z[t][1], bf_lo(qv.y) + g4[2] * Z[t][2], bf_hi(qv.y) + g4[3] * Z[t][3]};
#pragma unroll
      for (int ks = 0; ks < 2; ++ks) {
        const unsigned char* prow = sl + (t * 16 + fr) * PSTR + ks * 64 + fq * 8;
        const u32x2 p0 = *(const u32x2*)prow, p1 = *(const u32x2*)(prow + 32);
        const u32x4 w = {p0.x, p0.y, p1.x, p1.y};
        acc = __builtin_amdgcn_mfma_f32_16x16x32_bf16(__builtin_bit_cast(bf16x8, w), zb[ks], acc, 0, 0, 0);
      }
      Z[t] = acc;
    }
    if (c + 3 < NCH) commit(c + 3);
    __syncthreads();
  }
}

DI void scan_phaseC_item(const ScanArgs& s, int item, const ScanIn& in, unsigned char* lds) {
  const int c = item & (NCH - 1), h = (item >> 7) & 15, b = item >> 11;
  const int tid = opaque_v(threadIdx.x), lane = tid & 63, wv = tid >> 6, fr = lane & 15, fq = lane >> 4;
  unsigned char* At = lds; unsigned char* Bt = At + 32 * SN; unsigned char* Kt = Bt + 32 * SN; unsigned char* Rt = Kt + 32 * SN;
  unsigned char* VT = Rt + 32 * SN;
  unsigned char* Tm = VT + 64 * ST; unsigned char* Aak = Tm + 32 * ST; unsigned char* Arb = Aak + 32 * ST; unsigned char* Ark = Arb + 32 * ST;
  float* A32 = (float*)(Ark + 32 * ST);
  unsigned char* S0 = (unsigned char*)A32 + 4608;
  unsigned char* X1T = S0 + 64 * SN; unsigned char* UT = X1T + 64 * ST;
  float* Yb = (float*)(UT + 64 * ST);
  float* lwbuf = Yb;
  const size_t gbase = ((size_t)b * SEQ + (size_t)c * CL) * D + h * HS;
  float bonus; float vv8[8];
  { const int e0 = tid * 8, e1 = (tid + 256) * 8;
    *(u32x4*)(S0 + (e0 >> 6) * SN + (e0 & 63) * 2) = in.z0; *(u32x4*)(S0 + (e1 >> 6) * SN + (e1 & 63) * 2) = in.z1; }
  scan_load<true>(s, in, h, lwbuf, At, Bt, Kt, Rt, nullptr, nullptr, nullptr, VT, bonus, vv8, nullptr);
  __syncthreads();
  {
    const unsigned char* Pm = (wv < 2) ? At : Rt; const unsigned char* Qm = (wv & 1) ? Kt : Bt;
    unsigned char* dst = (wv == 1) ? Aak : (wv == 2 ? Arb : Ark);
#pragma unroll
    for (int t4 = 0; t4 < 4; ++t4) {
      const int ti = t4 >> 1, tj = t4 & 1;
      const f32x4 x = tile_mm<false, false>(Pm, SN, Qm, SN, ti * 16, tj * 16, 2, (f32x4){0.f, 0.f, 0.f, 0.f}, lane);
#pragma unroll
      for (int q = 0; q < 4; ++q) {
        const int i = ti * 16 + fq * 4 + q, j = tj * 16 + fr;
        const bool keep = (wv < 2) ? (j < i) : (j <= i);
        const float val = keep ? x[q] : 0.f;
        if (wv == 0) A32[i * 36 + j] = val; else *(bf16_t*)(dst + i * ST + j * 2) = f2bf(val);
      }
    }
  }
  __syncthreads();
  if (wv == 0) scan_tinv(A32, Tm, lane);
  else {
    for (int tile = wv - 1; tile < 8; tile += 3) {
      const int ti = tile >> 2, tv = tile & 3;
      f32x4 x = tile_mm<false, false>(At, SN, S0, SN, ti * 16, tv * 16, 2, (f32x4){0.f, 0.f, 0.f, 0.f}, lane);
      x = tile_mm<false, true>(Aak, ST, VT, ST, ti * 16, tv * 16, 1, x, lane);
      st_bf16x4(X1T + tr_off(tv * 16 + fr, ti * 16 + fq * 4), x);
    }
  }
  __syncthreads();
#pragma unroll
  for (int u = 0; u < 2; ++u) {
    const int tile = wv * 2 + u, ti = tile >> 2, tv = tile & 3;
    const f32x4 x = tile_mm<false, true>(Tm, ST, X1T, ST, ti * 16, tv * 16, 1, (f32x4){0.f, 0.f, 0.f, 0.f}, lane);
    st_bf16x4(UT + tr_off(tv * 16 + fr, ti * 16 + fq * 4), x);
  }
  __syncthreads();
#pragma unroll
  for (int u = 0; u < 2; ++u) {
    const int tile = wv * 2 + u, ti = tile >> 2, tv = tile & 3;
    f32x4 x = tile_mm<false, false>(Rt, SN, S0, SN, ti * 16, tv * 16, 2, (f32x4){0.f, 0.f, 0.f, 0.f}, lane);
    x = tile_mm<false, true>(Arb, ST, UT, ST, ti * 16, tv * 16, 1, x, lane);
    x = tile_mm<false, true>(Ark, ST, VT, ST, ti * 16, tv * 16, 1, x, lane);
#pragma unroll
    for (int q = 0; q < 4; ++q) Yb[(ti * 16 + fq * 4 + q) * 68 + tv * 16 + fr] = x[q];
  }
  __syncthreads();
  {
    const int tt = tid >> 3, c0 = (tid & 7) * 8;
    float yv[8], sum = 0.f;
#pragma unroll
    for (int j = 0; j < 8; ++j) { yv[j] = Yb[tt * 68 + c0 + j]; sum += yv[j]; }
    sum += __shfl_xor(sum, 1); sum += __shfl_xor(sum, 2); sum += __shfl_xor(sum, 4);
    const float mean = sum * (1.f / 64.f);
    float var = 0.f;
#pragma unroll
    for (int j = 0; j < 8; ++j) { const float d = yv[j] - mean; var += d * d; }
    var += __shfl_xor(var, 1); var += __shfl_xor(var, 2); var += __shfl_xor(var, 4);
    const float rstd = rsqrtf(var * (1.f / 64.f) + GN_EPS);
    const size_t off = gbase + (size_t)tt * D + c0;
    float o[8];
#pragma unroll
    for (int j = 0; j < 8; ++j) {
      const int chn = h * HS + c0 + j;
      o[j] = (yv[j] - mean) * rstd * s.lnx_g[chn] + s.lnx_b[chn] + bonus * vv8[j];
    }
    *(u32x4*)(s.r + off) = (u32x4){cvt_pk_bf16(o[0], o[1]), cvt_pk_bf16(o[2], o[3]), cvt_pk_bf16(o[4], o[5]), cvt_pk_bf16(o[6], o[7])};
  }
  __syncthreads();
}

DI void ln_phase(const float* __restrict__ z, const float* __restrict__ lg, const float* __restrict__ lb, float* __restrict__ xo,
                 const float* __restrict__ mod_l, int shift_idx, int scale_idx, bf16_t* __restrict__ ho, int bid, int nblk) {
  const int tq = opaque_v(threadIdx.x); const int lane = tq & 63, wv = tq >> 6;
  constexpr int RW = 4;
  for (int row0 = (bid * 4 + wv) * RW; row0 < T; row0 += nblk * 4 * RW) {
    f32x4 v[RW][4];
#pragma unroll
    for (int r = 0; r < RW; ++r)
#pragma unroll
      for (int i = 0; i < 4; ++i) v[r][i] = *(const f32x4*)(z + (size_t)(row0 + r) * D + i * 256 + lane * 4);
    const int b = row0 / SEQ;
#pragma unroll
    for (int r = 0; r < RW; ++r) {
      float s = 0.f;
#pragma unroll
      for (int i = 0; i < 4; ++i) s += (v[r][i][0] + v[r][i][1]) + (v[r][i][2] + v[r][i][3]);
      const float mean = wave_sum(s) * (1.f / D);
      float q = 0.f;
#pragma unroll
      for (int i = 0; i < 4; ++i) { const f32x4 d = v[r][i] - mean; q += (d[0] * d[0] + d[1] * d[1]) + (d[2] * d[2] + d[3] * d[3]); }
      const float rstd = rsqrtf(wave_sum(q) * (1.f / D) + LN_EPS);
      const int row = row0 + r;
#pragma unroll
      for (int i = 0; i < 4; ++i) {
        const int d = i * 256 + lane * 4;
        const f32x4 o = (v[r][i] - mean) * rstd * *(const f32x4*)(lg + d) + *(const f32x4*)(lb + d);
        *(f32x4*)(xo + (size_t)row * D + d) = o;
        if (!ho) continue;
        const f32x4 sh = *(const f32x4*)(mod_l + (size_t)b * 6144 + shift_idx * D + d), sc = *(const f32x4*)(mod_l + (size_t)b * 6144 + scale_idx * D + d);
        const f32x4 hh = o * (sc + 1.f) + sh;
        *(u32x2*)(ho + (size_t)row * D + d) = (u32x2){cvt_pk_bf16(hh[0], hh[1]), cvt_pk_bf16(hh[2], hh[3])};
      }
    }
  }
}

DI void combine_phase(const unsigned* __restrict__ lists, unsigned short* __restrict__ epk, float* __restrict__ gate, int bid, int nblk) {
  const int tq = opaque_v(threadIdx.x);
  for (int gid = bid * 256 + tq; gid < T * 8; gid += nblk * 256) {
    const unsigned* la = lists + (size_t)gid * 32;
    const unsigned* lb = la + 16;
    float s1[16], s2[16];
#pragma unroll
    for (int i = 0; i < 4; ++i) {
      const u32x4 a = *(const u32x4*)(la + i * 4), b = *(const u32x4*)(lb + i * 4);
      s1[i * 4] = key2f(a.x & ~127u); s1[i * 4 + 1] = key2f(a.y & ~127u); s1[i * 4 + 2] = key2f(a.z & ~127u); s1[i * 4 + 3] = key2f(a.w & ~127u);
      s2[i * 4] = key2f(b.x & ~127u); s2[i * 4 + 1] = key2f(b.y & ~127u); s2[i * 4 + 2] = key2f(b.z & ~127u); s2[i * 4 + 3] = key2f(b.w & ~127u);
    }
    unsigned c[4][16];
    {
      int n = 0;
#pragma unroll
      for (int a = 0; a < 16; ++a)
#pragma unroll
        for (int b = 0; b < 16; ++b)
          if ((a + 1) * (b + 1) <= 16) { c[n >> 4][n & 15] = (f2key(s1[a] + s2[b]) & ~255u) | (unsigned)(255 - (a * 16 + b)); ++n; }
#pragma unroll
      for (int q = 50; q < 64; ++q) c[q >> 4][q & 15] = 0u;
    }
    sort16_desc(c[0]); sort16_desc(c[1]); sort16_desc(c[2]); sort16_desc(c[3]);
#pragma unroll
    for (int e = 0; e < 16; ++e) { c[0][e] = max(c[0][e], c[1][15 - e]); c[2][e] = max(c[2][e], c[3][15 - e]); }
    merge16_desc(c[0]); merge16_desc(c[2]);
#pragma unroll
    for (int e = 0; e < 16; ++e) c[0][e] = max(c[0][e], c[2][15 - e]);
    merge16_desc(c[0]);
    float best[16], den = 0.f;
    const float mx = key2f(c[0][0] & ~255u);
#pragma unroll
    for (int e = 0; e < 16; ++e) { best[e] = __expf(key2f(c[0][e] & ~255u) - mx); den += best[e]; }
    const float inv = 1.f / den;
#pragma unroll
    for (int e = 0; e < 16; ++e) {
      const int pos = 255 - (int)(c[0][e] & 255u), a = pos >> 4, b = pos & 15;
      const int i1 = 127 - (int)(la[a] & 127u), i2 = 127 - (int)(lb[b] & 127u);
      { const int jj = (gid & 7) * 16 + e; epk[(size_t)(gid >> 3) * 128 + (jj < 64 ? 2 * jj : 2 * (jj - 64) + 1)] = (unsigned short)(i1 * 128 + i2); }
      gate[(size_t)gid * 16 + e] = best[e] * inv;
    }
  }
}

DI void table_fp8_phase(const float* __restrict__ src, unsigned char* __restrict__ dst, float* __restrict__ inv, int rows, int bid, int nblk) {
  const int tq = opaque_v(threadIdx.x); const int lane = tq & 63, wv = tq >> 6;
  for (int r0 = (bid * 4 + wv) * 4; r0 < rows; r0 += nblk * 16) {
    f32x4 v[4][4];
#pragma unroll
    for (int rr = 0; rr < 4; ++rr)
#pragma unroll
      for (int i = 0; i < 4; ++i) v[rr][i] = __builtin_nontemporal_load((const f32x4*)(src + (size_t)(r0 + rr) * D + lane * 16 + i * 4));
#pragma unroll
    for (int rr = 0; rr < 4; ++rr) {
      float mx = 0.f;
#pragma unroll
      for (int i = 0; i < 4; ++i) mx = fmaxf(mx, fmaxf(fmaxf(fabsf(v[rr][i][0]), fabsf(v[rr][i][1])), fmaxf(fabsf(v[rr][i][2]), fabsf(v[rr][i][3]))));
#pragma unroll
      for (int o = 32; o >= 1; o >>= 1) mx = fmaxf(mx, __shfl_xor(mx, o));
      const float sc = mx > 0.f ? exp2f(floorf(log2f(384.f / mx))) : 1.f;
      unsigned w[4];
#pragma unroll
      for (int i = 0; i < 4; ++i) {
        int pk = 0;
        pk = __builtin_amdgcn_cvt_pk_fp8_f32(v[rr][i][0] * sc, v[rr][i][1] * sc, pk, false);
        pk = __builtin_amdgcn_cvt_pk_fp8_f32(v[rr][i][2] * sc, v[rr][i][3] * sc, pk, true);
        w[i] = (unsigned)pk;
      }
      *(u32x4*)(dst + (size_t)(r0 + rr) * D + lane * 16) = (u32x4){w[0], w[1], w[2], w[3]};
      if (lane == 0) inv[r0 + rr] = 1.f / sc;
    }
  }
}

struct PeerArgs {
  const bf16_t* h2;
  const unsigned char *u8, *v8;
  const float *uinv, *vinv;
  const unsigned* epk; const float* gate;
  float* part;
  float* coef;
  const float* xres;
  const float* gate2;
  float* z;
  unsigned* ctr_u; unsigned* ctr_v;
};
constexpr int PCH = 64;
DI void cvt16_fp8(const u32x4& d, float (&f)[16]) {
  const unsigned w[4] = {d.x, d.y, d.z, d.w};
#pragma unroll
  for (int i = 0; i < 4; ++i) {
    const f32x2 lo = __builtin_amdgcn_cvt_pk_f32_fp8((int)w[i], false), hi = __builtin_amdgcn_cvt_pk_f32_fp8((int)w[i], true);
    f[i * 4] = lo.x; f[i * 4 + 1] = lo.y; f[i * 4 + 2] = hi.x; f[i * 4 + 3] = hi.y;
  }
}
template <bool VPHASE>
DI void peer_slice_phase(const PeerArgs& a, unsigned char* lds) {
  const int tq = opaque_v(threadIdx.x); const int lane = tq & 63, wv = tq >> 6, cc = lane & 7;
  volatile int* nxt = (volatile int*)lds;
  const unsigned xcc = xb_xcc_id() & 7u;
  unsigned* ctr = VPHASE ? a.ctr_v : a.ctr_u;
  for (int ks = 0; ks < 8; ++ks) {
    const int s = (int)((xcc + ks) & 7u);
    for (;;) {
      __syncthreads();
      if (tq == 0) *nxt = (int)atomicAdd(&ctr[s * 16], 1u);
      __syncthreads();
      const int chunk = *nxt;
      if (chunk >= T / PCH) break;
      for (int ti = 0; ti < PCH / 4; ++ti) {
        const int t = chunk * PCH + wv * (PCH / 4) + ti;
        const unsigned ep = a.epk[(size_t)t * 64 + lane];
        const unsigned char* tab = (VPHASE ? a.v8 : a.u8) + s * 128 + cc * 16;
        u32x4 data[16];
        float cv[16];
        float c_lo = 0.f, c_hi = 0.f;
        if (VPHASE) { c_lo = a.coef[(size_t)t * 128 + lane]; c_hi = a.coef[(size_t)t * 128 + 64 + lane]; }
#pragma unroll
        for (int i = 0; i < 16; ++i) {
          const int src = (lane & ~7) | (i & 7);
          const unsigned ev = (unsigned)__shfl((int)ep, src);
          const unsigned e = (i < 8) ? (ev & 0xffffu) : (ev >> 16);
          if (VPHASE) cv[i] = __shfl(i < 8 ? c_lo : c_hi, src);
          data[i] = *(const u32x4*)(tab + (size_t)e * D);
        }
        if (!VPHASE) {
          const u32x4 h0 = *(const u32x4*)(a.h2 + (size_t)t * D + s * 128 + cc * 16), h1 = *(const u32x4*)(a.h2 + (size_t)t * D + s * 128 + cc * 16 + 8);
          float hf[16];
          { const unsigned u[8] = {h0.x, h0.y, h0.z, h0.w, h1.x, h1.y, h1.z, h1.w};
#pragma unroll
            for (int q = 0; q < 8; ++q) { hf[2 * q] = bf_lo(u[q]); hf[2 * q + 1] = bf_hi(u[q]); } }
          float r_lo = 0.f, r_hi = 0.f;
#pragma unroll
          for (int i = 0; i < 16; ++i) {
            float f[16]; cvt16_fp8(data[i], f);
            float d = 0.f;
#pragma unroll
            for (int q = 0; q < 16; ++q) d += f[q] * hf[q];
            d += __builtin_bit_cast(float, __builtin_amdgcn_update_dpp(0, __builtin_bit_cast(int, d), 0xB1, 0xF, 0xF, true));
            d += __builtin_bit_cast(float, __builtin_amdgcn_update_dpp(0, __builtin_bit_cast(int, d), 0x4E, 0xF, 0xF, true));
            d += __builtin_bit_cast(float, __builtin_amdgcn_update_dpp(0, __builtin_bit_cast(int, d), 0x141, 0xF, 0xF, true));
            if ((i & 7) == cc) { if (i < 8) r_lo = d; else r_hi = d; }
          }
          float* pp = a.part + ((size_t)s * T + t) * 128;
          pp[lane] = r_lo; pp[64 + lane] = r_hi;
        } else {
          float acc[16];
#pragma unroll
          for (int q = 0; q < 16; ++q) acc[q] = 0.f;
#pragma unroll
          for (int i = 0; i < 16; ++i) {
            float f[16]; cvt16_fp8(data[i], f);
#pragma unroll
            for (int q = 0; q < 16; ++q) acc[q] += cv[i] * f[q];
          }
          float r8[8], r4[4], r2[2];
          { const bool up = (lane & 8) != 0;
#pragma unroll
            for (int q = 0; q < 8; ++q) { const float keep = up ? acc[8 + q] : acc[q], send = up ? acc[q] : acc[8 + q]; r8[q] = keep + __shfl_xor(send, 8); } }
          { const bool up = (lane & 16) != 0;
#pragma unroll
            for (int q = 0; q < 4; ++q) { const float keep = up ? r8[4 + q] : r8[q], send = up ? r8[q] : r8[4 + q]; r4[q] = keep + __shfl_xor(send, 16); } }
          { const bool up = (lane & 32) != 0;
#pragma unroll
            for (int q = 0; q < 2; ++q) { const float keep = up ? r4[2 + q] : r4[q], send = up ? r4[q] : r4[2 + q]; r2[q] = keep + __shfl_xor(send, 32); } }
          const int col = s * 128 + cc * 16 + ((lane >> 3) & 1) * 8 + ((lane >> 4) & 1) * 4 + ((lane >> 5) & 1) * 2;
          const int b = t / SEQ;
          const f32x2 xv = *(const f32x2*)(a.xres + (size_t)t * D + col), gt = *(const f32x2*)(a.gate2 + (size_t)b * 6144 + col);
          *(f32x2*)(a.z + (size_t)t * D + col) = (f32x2){ALPHA * xv.x + gt.x * r2[0], ALPHA * xv.y + gt.y * r2[1]};
        }
      }
    }
  }
  __syncthreads();
}
DI void peer_coef_phase(const PeerArgs& a, int bid, int nblk) {
  const int tq = opaque_v(threadIdx.x);
  for (int gid = bid * 256 + tq; gid < T * 128; gid += nblk * 256) {
    const int t = gid >> 7, j = gid & 127;
    const unsigned ep = a.epk[(size_t)t * 64 + (j & 63)];
    const unsigned e = (j < 64) ? (ep & 0xffffu) : (ep >> 16);
    float sum = 0.f;
#pragma unroll
    for (int s8 = 0; s8 < 8; ++s8) sum += a.part[((size_t)s8 * T + t) * 128 + j];
    a.coef[gid] = a.gate[gid] * gelu_exact(sum * a.uinv[e]) * a.vinv[e];
  }
}

DI void pool_phase(const bf16_t* __restrict__ zin, bf16_t* __restrict__ pout, int bid, int nblk) {
  const int tq = opaque_v(threadIdx.x);
  constexpr int SEG = 32;
  for (int it = bid * 256 + tq; it < (T / SEG) * (D / 8); it += nblk * 256) {
    const int ch = it & 127, seg = it >> 7;
    const int d = ch * 8, win = 2 << (d / 256);
    const int t0 = seg * SEG, tp0 = t0 % SEQ;
    float s[8];
#pragma unroll
    for (int j = 0; j < 8; ++j) s[j] = 0.f;
    for (int w = 1; w < win; ++w) {
      if (tp0 - w < 0) break;
      const u32x4 v = *(const u32x4*)(zin + (size_t)(t0 - w) * D + d);
      const unsigned u[4] = {v.x, v.y, v.z, v.w};
#pragma unroll
      for (int j = 0; j < 4; ++j) { s[2 * j] += bf_lo(u[j]); s[2 * j + 1] += bf_hi(u[j]); }
    }
#pragma unroll 4
    for (int i = 0; i < SEG; ++i) {
      const int t = t0 + i, tp = tp0 + i;
      const u32x4 v = *(const u32x4*)(zin + (size_t)t * D + d);
      const unsigned u[4] = {v.x, v.y, v.z, v.w};
      float z0[8];
#pragma unroll
      for (int j = 0; j < 4; ++j) { z0[2 * j] = bf_lo(u[j]); z0[2 * j + 1] = bf_hi(u[j]); }
#pragma unroll
      for (int j = 0; j < 8; ++j) s[j] += z0[j];
      const int cnt = min(tp + 1, win);
      const float ic = 1.f / (float)cnt;
      float o[8];
#pragma unroll
      for (int j = 0; j < 8; ++j) o[j] = s[j] * ic - z0[j];
      *(u32x4*)(pout + (size_t)t * D + d) = (u32x4){cvt_pk_bf16(o[0], o[1]), cvt_pk_bf16(o[2], o[3]), cvt_pk_bf16(o[4], o[5]), cvt_pk_bf16(o[6], o[7])};
      if (tp + 1 >= win) {
        const u32x4 vo = *(const u32x4*)(zin + (size_t)(t - win + 1) * D + d);
        const unsigned uo[4] = {vo.x, vo.y, vo.z, vo.w};
#pragma unroll
        for (int j = 0; j < 4; ++j) { s[2 * j] -= bf_lo(uo[j]); s[2 * j + 1] -= bf_hi(uo[j]); }
      }
    }
  }
}

#define GRID_SYNC() xcd_barrier(xb)

__global__ void __launch_bounds__(256, 2) mega(Params p) {
  __shared__ __attribute__((aligned(16))) unsigned char lds[LDS_BYTES + 16];
  cg::grid_group grid = cg::this_grid();
  const int bid = blockIdx.x, nblk = gridDim.x;
  if (threadIdx.x == 0) { *(volatile LAS unsigned*)(lds + LDS_BYTES) = 0u; *(volatile LAS unsigned*)(lds + LDS_BYTES + 4) = 0u; }
  __syncthreads();
  const XcdBarrier xb = xcd_barrier_post(p.bar, (volatile LAS unsigned*)(lds + LDS_BYTES));
  const float* mod0 = p.mod; const float* mod1 = p.mod + (size_t)NB * 6144;
  bf16_t* S[7];
#pragma unroll
  for (int i = 0; i < 7; ++i) S[i] = (bf16_t*)p.slot[i];

  prologue_phase(p, lds, bid, nblk);
  grid.sync();
  bf16_t *h = S[0], *r = S[1], *k = S[2], *v = S[3], *lw = S[4], *av = S[5];
  bf16_t* tw = p.lora_tmp; bf16_t* ta = tw + (size_t)T * 64; bf16_t* tg = ta + (size_t)T * 64;
  modulate_phase(p.x, mod0, p.rw_mu, h, S[4], S[5], S[6], bid, nblk);
  for (int it = bid; it < 4 * 8 * 2; it += nblk) {
    const int nt = it & 1, mt = (it >> 1) & 7, g4 = it >> 4;
    gemm_tile(mk(p.PoutT + g4 * 256, D, p.WgrpS + (size_t)g4 * 256 * 256, 256, 256, 256, EPI_BF16, p.WcT + g4 * 256, D), mt * 128, nt * 128, lds);
  }
  for (int it = bid; it < 2 * 16 * 8; it += nblk) {
    const int nt = it & 7, gl = it >> 3;
    gemm_tile(mk(p.KeysB + (size_t)gl * 128 * 128, 128, p.WqB + (size_t)(gl >> 4) * D * 2048 + (gl & 15) * 128, 2048, D, 128, EPI_BF16, p.WeffT + (size_t)gl * 128 * D, D), 0, nt * 128, lds);
  }
  GRID_SYNC();
  for (int it = 0, nit = sched_iters(28, nblk); it < nit; ++it) {
    int mt, nt; if (!sched_mn(it, bid, nblk, 28, mt, nt)) continue;
    GemmArgs g; int n0;
    if (nt < 24) { const int j = nt >> 3; n0 = (nt & 7) * 128; g = mk(S[4 + j], D, p.WT_rkv + (size_t)j * D * D, D, D, D, EPI_BF16, j == 0 ? r : (j == 1 ? k : v), D); }
    else if (nt == 24) { n0 = 0; g = mk(h, D, p.W1T, D, 64, D, EPI_TANH, tw, 64, p.rw_mu + 3 * D); }
    else if (nt == 25) { n0 = 0; g = mk(h, D, p.A1T, D, 64, D, EPI_BF16, ta, 64, p.rw_mu + 4 * D); }
    else { n0 = (nt - 26) * 128; g = mk(h, D, p.G1T, D, 192, D, EPI_SIGMOID, tg, 192, p.rw_mu + 5 * D); }
    gemm_tile(g, mt * 128, n0, lds);
  }
  GRID_SYNC();
  for (int it = 0, nit = sched_iters(16, nblk); it < nit; ++it) {
    int mt, nt; if (!sched_mn(it, bid, nblk, 16, mt, nt)) continue;
    const int j = nt >> 3, n0 = (nt & 7) * 128;
    GemmArgs g;
    if (j == 0) g = mk(tw, 64, p.W2T, 64, D, 64, EPI_LW, lw, D, nullptr, p.rw_w0);
    else g = mk(ta, 64, p.A2T, 64, D, 64, EPI_ASIG, av, D, nullptr, p.rw_a0);
    gemm_tile(g, mt * 128, n0, lds);
  }
  GRID_SYNC();
  {
    ScanArgs s; s.r = r; s.k = k; s.v = v; s.lw = lw; s.a = av; s.k_k = p.rw_k_k; s.k_a = p.rw_k_a; s.r_k = p.rw_r_k; s.lnx_g = p.rw_lnx_g; s.lnx_b = p.rw_lnx_b;
    s.Pg = (bf16_t*)p.out; s.Qz0 = S[0]; s.Qz1 = S[6]; s.Gg = p.Gg;
    { ScanIn cur, nxt; if (bid < NB * NH * NCH) scan_fetch<false>(s, bid, cur);
      for (int it = bid; it < NB * NH * NCH; it += nblk) { if (it + nblk < NB * NH * NCH) scan_fetch<false>(s, it + nblk, nxt); scan_phaseA_item(s, it, cur, lds); cur = nxt; } }
    GRID_SYNC();
    for (int it = bid; it < NB * NH; it += nblk) scan_chain_block(s, it, lds);
    GRID_SYNC();
    { ScanIn cur, nxt; if (bid < NB * NH * NCH) scan_fetch<true>(s, bid, cur);
      for (int it = bid; it < NB * NH * NCH; it += nblk) { if (it + nblk < NB * NH * NCH) scan_fetch<true>(s, it + nblk, nxt); scan_phaseC_item(s, it, cur, lds); cur = nxt; } }
    GRID_SYNC();
  }
  for (int it = 0, nit = sched_iters(8, nblk); it < nit; ++it) {
    int mt, nt; if (!sched_mn(it, bid, nblk, 8, mt, nt)) continue;
    gemm_tile(mk(tg, 192, p.G2T, 192, D, 192, EPI_GATE, r, D), mt * 128, nt * 128, lds);
  }
  GRID_SYNC();
  h = r;
  float* z = (float*)p.slot[2];
  for (int it = 0, nit = sched_iters(8, nblk); it < nit; ++it) {
    int mt, nt; if (!sched_mn(it, bid, nblk, 8, mt, nt)) continue;
    gemm_tile(mk(h, D, p.WoT, D, D, D, EPI_Z, z, D, nullptr, p.x, mod0 + 2 * D), mt * 128, nt * 128, lds);
  }
  table_fp8_phase(p.pe_u, p.slot[6], p.tinv, NEXP, bid, nblk);
  table_fp8_phase(p.pe_v, p.slot[6] + ((size_t)16 << 20), p.tinv + NEXP, NEXP, bid, nblk);
  table_fp8_phase(p.pe_u + (size_t)NEXP * D, p.slot[6] + ((size_t)32 << 20), p.tinv + 2 * NEXP, NEXP, bid, nblk);
  table_fp8_phase(p.pe_v + (size_t)NEXP * D, p.slot[6] + ((size_t)48 << 20), p.tinv + 3 * NEXP, NEXP, bid, nblk);
  GRID_SYNC();
  ln_phase(z, p.ln_g + 0 * D, p.ln_b + 0 * D, (float*)p.slot[4], mod0, 3, 4, S[0], bid, nblk);
  GRID_SYNC();

#pragma unroll
  for (int layer = 0; layer < 2; ++layer) {
    const float* modl = layer == 0 ? mod0 : mod1;
    const bf16_t* hp = layer == 0 ? S[0] : S[3];
    unsigned char* lsl = layer == 0 ? p.slot[3] : p.slot[0];
    unsigned* lists = (unsigned*)lsl;
    unsigned* epk = (unsigned*)(lsl + ((size_t)32 << 20));
    float* gate = (float*)(lsl + ((size_t)40 << 20));
    for (int it = 0, nit = sched_iters(16, nblk); it < nit; ++it) {
      int mt, grp; if (!sched_mn(it, bid, nblk, 16, mt, grp)) continue;
      gemm_tile(mk(hp, D, p.WeffT + (size_t)layer * 2048 * D, D, 2048, D, EPI_TOPK, lists, 0), mt * 128, grp * 128, lds);
    }
    GRID_SYNC();
    combine_phase(lists, (unsigned short*)epk, gate, bid, nblk);
    GRID_SYNC();
    PeerArgs a; a.h2 = hp;
    a.u8 = p.slot[6] + ((size_t)(layer * 32) << 20); a.v8 = a.u8 + ((size_t)16 << 20);
    a.uinv = p.tinv + (layer * 2) * NEXP; a.vinv = a.uinv + NEXP;
    a.epk = epk; a.gate = gate; a.part = (float*)p.slot[1]; a.coef = (float*)lsl;
    a.xres = (const float*)p.slot[4]; a.gate2 = modl + 5 * D; a.z = (float*)p.slot[1];
    a.ctr_u = p.bar + XCD_BAR_WORDS + (layer * 2) * 128; a.ctr_v = a.ctr_u + 128;
    peer_slice_phase<false>(a, lds);
    GRID_SYNC();
    peer_coef_phase(a, bid, nblk);
    GRID_SYNC();
    peer_slice_phase<true>(a, lds);
    GRID_SYNC();
    if (layer == 1) { ln_phase(a.z, p.ln_g + 3 * D, p.ln_b + 3 * D, p.out, mod1, 0, 1, nullptr, bid, nblk); break; }
    ln_phase(a.z, p.ln_g + 1 * D, p.ln_b + 1 * D, (float*)p.slot[4], mod1, 0, 1, S[0], bid, nblk);
    GRID_SYNC();
    const float* x2 = (const float*)p.slot[4];
    bf16_t *hB = S[0], *zin = S[1], *pp = S[2];
    for (int it = 0, nit = sched_iters(8, nblk); it < nit; ++it) {
      int mt, nt; if (!sched_mn(it, bid, nblk, 8, mt, nt)) continue;
      gemm_tile(mk(hB, D, p.PinT, D, D, D, EPI_BF16, zin, D), mt * 128, nt * 128, lds);
    }
    GRID_SYNC();
    pool_phase(zin, pp, bid, nblk);
    GRID_SYNC();
    float* z1 = (float*)p.slot[0];
    for (int it = 0, nit = sched_iters(8, nblk); it < nit; ++it) {
      int mt, nt; if (!sched_mn(it, bid, nblk, 8, mt, nt)) continue;
      gemm_tile(mk(pp, D, p.WcT, D, D, D, EPI_Z, z1, D, nullptr, x2, mod1 + 2 * D), mt * 128, nt * 128, lds);
    }
    GRID_SYNC();
    ln_phase(z1, p.ln_g + 2 * D, p.ln_b + 2 * D, (float*)p.slot[4], mod1, 3, 4, S[3], bid, nblk);
    GRID_SYNC();
  }
}

extern "C" void kernel_launch(void* const* d_in, const int* in_sizes, int n_in, void* d_out, int out_size, void* d_ws, size_t ws_size, hipStream_t stream) {
  Params p{};
  const float** ip = (const float**)&p.x;
  for (int i = 0; i < 30; ++i) ip[i] = (const float*)d_in[i];
  p.out = (float*)d_out;
  unsigned char* w = (unsigned char*)d_ws; size_t off = 0;
  auto take = [&](size_t bytes) { unsigned char* r = w + off; off += (bytes + 255) & ~(size_t)255; return r; };
  p.bar = (unsigned*)take(16384);
  p.mod = (float*)take((size_t)2 * NB * 6144 * 4);
  p.WT_rkv = (bf16_t*)take((size_t)3 * D * D * 2);
  p.W1T = (bf16_t*)take((size_t)128 * D * 2); p.A1T = (bf16_t*)take((size_t)128 * D * 2); p.G1T = (bf16_t*)take((size_t)256 * D * 2);
  p.W2T = (bf16_t*)take((size_t)D * 64 * 2); p.A2T = (bf16_t*)take((size_t)D * 64 * 2); p.G2T = (bf16_t*)take((size_t)D * 192 * 2);
  p.WoT = (bf16_t*)take((size_t)D * D * 2); p.PinT = (bf16_t*)take((size_t)D * D * 2); p.PoutT = (bf16_t*)take((size_t)D * D * 2);
  p.WgrpS = (bf16_t*)take((size_t)4 * 256 * 256 * 2); p.WcT = (bf16_t*)take((size_t)D * D * 2); p.WqB = (bf16_t*)take((size_t)2 * 2048 * D * 2); p.WeffT = (bf16_t*)take((size_t)2 * 2048 * D * 2); p.KeysB = (bf16_t*)take((size_t)2 * 16 * 128 * 128 * 2);
  p.tinv = (float*)take((size_t)4 * NEXP * 4);
  p.lora_tmp = (bf16_t*)take((size_t)T * 320 * 2);
  p.Gg = (float*)take((size_t)16384 * 64 * 4);
  for (int i = 0; i < 7; ++i) p.slot[i] = take((size_t)64 << 20);
  if (off > ws_size) return;

  static int grid_blocks = 0;
  if (!grid_blocks) {
    int dev = 0, cus = 0, per_cu = 0;
    hipGetDevice(&dev);
    hipDeviceGetAttribute(&cus, hipDeviceAttributeMultiprocessorCount, dev);
    hipOccupancyMaxActiveBlocksPerMultiprocessor(&per_cu, mega, 256, 0);
    if (per_cu > 2) per_cu = 2;
    if (per_cu < 1) per_cu = 1;
    grid_blocks = cus * per_cu;
  }
  hipMemsetAsync(p.bar, 0, 16384, stream);
  void* args[] = {&p};
  hipLaunchCooperativeKernel((void*)mega, dim3(grid_blocks), dim3(256), args, 0, stream);
}
```

```cpp
#include <hip/hip_runtime.h>
#include <hip/hip_cooperative_groups.h>
#include <stdint.h>
#include <stddef.h>
namespace cg = cooperative_groups;

typedef unsigned short bf16_t;
typedef short bf16x8 __attribute__((ext_vector_type(8)));
typedef float f32x4 __attribute__((ext_vector_type(4)));
typedef float f32x2 __attribute__((ext_vector_type(2)));
typedef unsigned u32x4 __attribute__((ext_vector_type(4)));
typedef unsigned u32x2 __attribute__((ext_vector_type(2)));
#define DI __device__ __forceinline__

constexpr int D = 1024, NB = 8, SEQ = 4096, T = NB * SEQ;
constexpr int NH = 16, HS = 64;
constexpr int NEXP = 16384;
constexpr float ALPHA = 1.4142135623730951f;
constexpr float LN_EPS = 1e-5f, GN_EPS = 64e-5f;
constexpr int LDS_BYTES = 72 * 1024;

typedef __bf16 bf16x2_t __attribute__((ext_vector_type(2)));
DI unsigned cvt_pk_bf16(float lo, float hi) { const f32x2 v = {lo, hi}; return __builtin_bit_cast(unsigned, __builtin_convertvector(v, bf16x2_t)); }
DI float bf_lo(unsigned u) { return __uint_as_float(u << 16); }
DI float bf_hi(unsigned u) { return __uint_as_float(u & 0xffff0000u); }
DI bf16_t f2bf(float f) { unsigned u = __float_as_uint(f); u += 0x7fffu + ((u >> 16) & 1u); return (bf16_t)(u >> 16); }
DI float sigmoidf_(float x) { return 1.f / (1.f + __expf(-x)); }
DI float wave_sum(float v) {
#pragma unroll
  for (int o = 32; o >= 1; o >>= 1) v += __shfl_xor(v, o);
  return v;
}
DI int opaque_v(int x) { asm volatile("" : "+v"(x)); return x; }
DI float gelu_exact(float v) {
  const float av = fabsf(v), t = __builtin_amdgcn_rcpf(av * 0.2316418882f + 1.0f);
  float q = t * 0.5307027145f + (-0.7265760135f); q = q * t + 0.7107068705f; q = q * t + (-0.142248368f); q = q * t + 0.127414796f; q = q * t;
  const float m = v * (q * __builtin_amdgcn_exp2f((v * v) * (-0.72134752044f)));
  return v < 0.f ? m : v - m;
}

#define XB_TMO      128
#define XB_XCNT(j)  (256  + 64 * (j))
#define XB_XSUB(j)  (1280 + 64 * (j))
#define XB_XGEN(j)  (2304 + 64 * (j))
#define XB_TOP      3328
#define XB_TOPGEN   3392
#define XCD_BAR_WORDS 3456
#define XB_SPIN_CAP (1u << 22)
#define LAS __attribute__((address_space(3)))
DI unsigned xb_ld(unsigned* p)              { return __hip_atomic_load(p, __ATOMIC_RELAXED, __HIP_MEMORY_SCOPE_AGENT); }
DI unsigned xb_add(unsigned* p, unsigned v) { return __hip_atomic_fetch_add(p, v, __ATOMIC_RELAXED, __HIP_MEMORY_SCOPE_AGENT); }
DI unsigned xb_xcc_id() { return (unsigned)__builtin_amdgcn_s_getreg((3 << 11) | 20) & 0xFu; }
#define XB_SPIN(cond, bar) do { unsigned _sp = 0; while (cond) { __builtin_amdgcn_s_sleep(1); \
    if ((++_sp & 255u) == 0u) { if (xb_ld(&(bar)[XB_TMO])) break; if (_sp > XB_SPIN_CAP) { atomicAdd(&(bar)[XB_TMO], 1u); break; } } } } while (0)
struct XcdBarrier { unsigned* bar; unsigned x; volatile LAS unsigned* st; };
DI XcdBarrier xcd_barrier_post(unsigned* bar, volatile LAS unsigned* st) {
  XcdBarrier b; b.bar = bar; b.x = xb_xcc_id(); b.st = st;
  if (threadIdx.x == 0) (void)xb_add(&bar[XB_XCNT(b.x)], 1u);
  return b;
}
DI void xcd_barrier_complete(unsigned* bar, unsigned x, unsigned& nloc, unsigned& nx) {
  const unsigned G = gridDim.x * gridDim.y * gridDim.z;
  unsigned sum, cnt, mine, sp = 0u;
  for (;;) {
    sum = 0u; cnt = 0u; mine = 0u;
#pragma unroll
    for (unsigned j = 0; j < 16; ++j) { const unsigned c = xb_ld(&bar[XB_XCNT(j)]); sum += c; cnt += (c > 0u) ? 1u : 0u; mine = (j == x) ? c : mine; }
    if (sum == G) break;
    __builtin_amdgcn_s_sleep(1);
    if ((++sp & 255u) == 0u) { if (xb_ld(&bar[XB_TMO])) break; if (sp > XB_SPIN_CAP) { atomicAdd(&bar[XB_TMO], 1u); break; } }
  }
  nloc = mine > 0u ? mine : 1u; nx = cnt > 0u ? cnt : 1u;
}
DI void xcd_barrier(const XcdBarrier& b) {
  asm volatile("s_waitcnt vmcnt(0)" ::: "memory");
  __syncthreads();
  if (threadIdx.x == 0) {
    unsigned* bar = b.bar;
    __builtin_amdgcn_s_waitcnt(0);
    unsigned nloc = b.st[0], nx = b.st[1];
    if (nloc == 0u) { xcd_barrier_complete(bar, b.x, nloc, nx); b.st[0] = nloc; b.st[1] = nx; }
    const unsigned old = xb_add(&bar[XB_XSUB(b.x)], 1u);
    const unsigned gen = old / nloc;
    if (old + 1u == (gen + 1u) * nloc) {
      __builtin_amdgcn_fence(__ATOMIC_RELEASE, "agent");
      asm volatile("s_waitcnt vmcnt(0)" ::: "memory");
      const unsigned og = xb_add(&bar[XB_TOP], 1u);
      const unsigned tg = og / nx;
      if (og + 1u == (tg + 1u) * nx) xb_add(&bar[XB_TOPGEN], 1u);
      else XB_SPIN(xb_ld(&bar[XB_TOPGEN]) == tg, bar);
      __builtin_amdgcn_fence(__ATOMIC_ACQUIRE, "agent");
      xb_add(&bar[XB_XGEN(b.x)], 1u);
      asm volatile("s_waitcnt vmcnt(0)" ::: "memory");
    } else {
      XB_SPIN(xb_ld(&bar[XB_XGEN(b.x)]) == gen, bar);
      __builtin_amdgcn_fence(__ATOMIC_ACQUIRE, "agent");
      asm volatile("s_waitcnt vmcnt(0)" ::: "memory");
    }
  }
  __syncthreads();
}

struct Params {
  const float *x, *c, *ada_w, *ada_b, *ln_g, *ln_b, *rw_mu, *rw_w_rkv, *rw_w0, *rw_w1, *rw_w2, *rw_a0, *rw_a1, *rw_a2, *rw_g1, *rw_g2,
      *rw_k_k, *rw_k_a, *rw_r_k, *rw_lnx_g, *rw_lnx_b, *rw_w_o, *pl_w_in, *pl_w_grp, *pl_scale, *pl_w_out, *pe_w_q, *pe_keys, *pe_u, *pe_v;
  float* out;
  float* mod;
  bf16_t *WT_rkv, *W1T, *A1T, *G1T, *W2T, *A2T, *G2T, *WoT, *PinT, *PoutT, *WgrpS, *WcT, *WqB, *WeffT, *KeysB;
  unsigned char* slot[7];
  float* tinv;
  bf16_t* lora_tmp;
  float* Gg;
  unsigned* bar;
};

DI void mod_item(const Params& p, int item, unsigned char* lds) {
  float* cond = (float*)lds;
  float (*red)[NB][32] = (float (*)[NB][32])(lds + 32768);
  const int tid = opaque_v(threadIdx.x);
  for (int i = tid; i < NB * D; i += 256) { float v = p.c[i]; cond[i] = v / (1.f + __expf(-v)); }
  __syncthreads();
  const int l = item / 192, cb = item % 192;
  const int col = cb * 32 + (tid & 31), kg = tid >> 5;
  const float* w = p.ada_w + (size_t)l * D * 6144 + col;
  float acc[NB];
#pragma unroll
  for (int b = 0; b < NB; ++b) acc[b] = 0.f;
  for (int k = kg * 128; k < kg * 128 + 128; k += 8) {
    float wv[8];
#pragma unroll
    for (int u = 0; u < 8; ++u) wv[u] = w[(size_t)(k + u) * 6144];
#pragma unroll
    for (int u = 0; u < 8; ++u)
#pragma unroll
      for (int b = 0; b < NB; ++b) acc[b] += cond[b * D + k + u] * wv[u];
  }
#pragma unroll
  for (int b = 0; b < NB; ++b) red[kg][b][tid & 31] = acc[b];
  __syncthreads();
  {
    const int b = tid >> 5, cc = tid & 31;
    float s = 0.f;
#pragma unroll
    for (int g = 0; g < 8; ++g) s += red[g][b][cc];
    const int n = cb * 32 + cc;
    p.mod[((size_t)l * NB + b) * 6144 + n] = s + p.ada_b[l * 6144 + n];
  }
  __syncthreads();
}

DI void transpose_item(const float* __restrict__ src, bf16_t* __restrict__ dst, int K, int N, int Kpad, int Npad, size_t sbs, size_t dbs, int item, unsigned char* lds) {
  float (*tile)[33] = (float (*)[33])lds;
  const int nb_n = Npad / 32, nb_k = Kpad / 32;
  const int per = nb_n * nb_k;
  const int bz = item / per, r = item % per;
  const int bk = r / nb_n, bn = r % nb_n;
  src += bz * sbs; dst += bz * dbs;
  const int tq = opaque_v(threadIdx.x); const int tx = tq & 31, ty = tq >> 5;
#pragma unroll
  for (int i = 0; i < 4; ++i) {
    const int k = bk * 32 + ty + i * 8, n = bn * 32 + tx;
    tile[ty + i * 8][tx] = (k < K && n < N) ? src[(size_t)k * N + n] : 0.f;
  }
  __syncthreads();
#pragma unroll
  for (int i = 0; i < 4; ++i) {
    const int n = bn * 32 + ty + i * 8, k = bk * 32 + tx;
    dst[(size_t)n * Kpad + k] = f2bf(tile[tx][ty + i * 8]);
  }
  __syncthreads();
}
DI void cvt_range(const float* __restrict__ src, bf16_t* __restrict__ dst, size_t n8, int bid, int nblk) {
  const int tq = opaque_v(threadIdx.x);
  for (size_t i = (size_t)bid * 256 + tq; i < n8; i += (size_t)nblk * 256) {
    const f32x4 a = *(const f32x4*)(src + i * 8), b = *(const f32x4*)(src + i * 8 + 4);
    u32x4 o; o.x = cvt_pk_bf16(a[0], a[1]); o.y = cvt_pk_bf16(a[2], a[3]); o.z = cvt_pk_bf16(b[0], b[1]); o.w = cvt_pk_bf16(b[2], b[3]);
    *(u32x4*)(dst + i * 8) = o;
  }
}
DI void prologue_phase(const Params& p, unsigned char* lds, int bid, int nblk) {
  constexpr int total = 384 + 3072 + 128 + 128 + 256 + 64 + 64 + 192 + 1024 + 1024 + 1024;
  for (int it = bid; it < total; it += nblk) {
    int r = it;
    if (r < 384) { mod_item(p, r, lds); continue; } r -= 384;
    if (r < 3072) { transpose_item(p.rw_w_rkv, p.WT_rkv, D, D, D, D, (size_t)D * D, (size_t)D * D, r, lds); continue; } r -= 3072;
    if (r < 128) { transpose_item(p.rw_w1, p.W1T, D, 64, D, 128, 0, 0, r, lds); continue; } r -= 128;
    if (r < 128) { transpose_item(p.rw_a1, p.A1T, D, 64, D, 128, 0, 0, r, lds); continue; } r -= 128;
    if (r < 256) { transpose_item(p.rw_g1, p.G1T, D, 160, D, 256, 0, 0, r, lds); continue; } r -= 256;
    if (r < 64) { transpose_item(p.rw_w2, p.W2T, 64, D, 64, D, 0, 0, r, lds); continue; } r -= 64;
    if (r < 64) { transpose_item(p.rw_a2, p.A2T, 64, D, 64, D, 0, 0, r, lds); continue; } r -= 64;
    if (r < 192) { transpose_item(p.rw_g2, p.G2T, 160, D, 192, D, 0, 0, r, lds); continue; } r -= 192;
    if (r < 1024) { transpose_item(p.rw_w_o, p.WoT, D, D, D, D, 0, 0, r, lds); continue; } r -= 1024;
    if (r < 1024) { transpose_item(p.pl_w_in, p.PinT, D, D, D, D, 0, 0, r, lds); continue; } r -= 1024;
    transpose_item(p.pl_w_out, p.PoutT, D, D, D, D, 0, 0, r, lds);
  }
  cvt_range(p.pe_keys, p.KeysB, (size_t)2 * 16 * 128 * 128 / 8, bid, nblk);
  cvt_range(p.pe_w_q, p.WqB, (size_t)2 * D * 2048 / 8, bid, nblk);
  {
    const int tq = opaque_v(threadIdx.x);
    for (int i = bid * 256 + tq; i < 4 * 256 * 256 / 8; i += nblk * 256) {
      const int e0 = (i * 8) & 255, g4 = (i * 8) >> 16;
      const f32x4 a0 = *(const f32x4*)(p.pl_w_grp + (size_t)i * 8), a1 = *(const f32x4*)(p.pl_w_grp + (size_t)i * 8 + 4);
      const f32x4 s0 = *(const f32x4*)(p.pl_scale + g4 * 256 + e0), s1 = *(const f32x4*)(p.pl_scale + g4 * 256 + e0 + 4);
      const f32x4 b0 = a0 * s0, b1 = a1 * s1;
      *(u32x4*)(p.WgrpS + (size_t)i * 8) = (u32x4){cvt_pk_bf16(b0[0], b0[1]), cvt_pk_bf16(b0[2], b0[3]), cvt_pk_bf16(b1[0], b1[1]), cvt_pk_bf16(b1[2], b1[3])};
    }
  }
}

DI void modulate_phase(const float* __restrict__ x, const float* __restrict__ mod_l, const float* __restrict__ mu, bf16_t* __restrict__ h, bf16_t* __restrict__ xr, bf16_t* __restrict__ xk,
                       bf16_t* __restrict__ xv, int bid, int nblk) {
  const size_t n8 = (size_t)T * D / 8; const int tq = opaque_v(threadIdx.x);
  for (size_t i = (size_t)bid * 256 + tq; i < n8; i += (size_t)nblk * 256) {
    const size_t e = i * 8; const int t = (int)(e / D), d = (int)(e % D), b = t / SEQ;
    const float* sh = mod_l + (size_t)b * 6144 + 0 * D + d; const float* sc = mod_l + (size_t)b * 6144 + 1 * D + d;
    float hv[8], pv[8];
    {
      const f32x4 a0 = *(const f32x4*)(x + e), a1 = *(const f32x4*)(x + e + 4);
      const f32x4 s0 = *(const f32x4*)sh, s1 = *(const f32x4*)(sh + 4), c0 = *(const f32x4*)sc, c1 = *(const f32x4*)(sc + 4);
      const f32x4 r0 = a0 * (c0 + 1.f) + s0, r1 = a1 * (c1 + 1.f) + s1;
      f32x4 q0 = {0.f, 0.f, 0.f, 0.f}, q1 = {0.f, 0.f, 0.f, 0.f};
      if ((t % SEQ) != 0) { const f32x4 b0 = *(const f32x4*)(x + e - D), b1 = *(const f32x4*)(x + e - D + 4); q0 = b0 * (c0 + 1.f) + s0; q1 = b1 * (c1 + 1.f) + s1; }
#pragma unroll
      for (int j = 0; j < 4; ++j) { hv[j] = r0[j]; hv[4 + j] = r1[j]; pv[j] = q0[j]; pv[4 + j] = q1[j]; }
    }
    u32x4 o; o.x = cvt_pk_bf16(hv[0], hv[1]); o.y = cvt_pk_bf16(hv[2], hv[3]); o.z = cvt_pk_bf16(hv[4], hv[5]); o.w = cvt_pk_bf16(hv[6], hv[7]);
    *(u32x4*)(h + e) = o;
#pragma unroll
    for (int n = 0; n < 3; ++n) {
      const f32x4 m0 = *(const f32x4*)(mu + n * D + d), m1 = *(const f32x4*)(mu + n * D + d + 4);
      float w[8];
#pragma unroll
      for (int j = 0; j < 8; ++j) { const float m = j < 4 ? m0[j] : m1[j - 4]; w[j] = hv[j] + (pv[j] - hv[j]) * m; }
      u32x4 q; q.x = cvt_pk_bf16(w[0], w[1]); q.y = cvt_pk_bf16(w[2], w[3]); q.z = cvt_pk_bf16(w[4], w[5]); q.w = cvt_pk_bf16(w[6], w[7]);
      *(u32x4*)((n == 0 ? xr : (n == 1 ? xk : xv)) + e) = q;
    }
  }
}

enum { EPI_BF16 = 0, EPI_TANH, EPI_SIGMOID, EPI_LW, EPI_ASIG, EPI_Z, EPI_SCALE, EPI_GATE, EPI_TOPK };
struct GemmArgs {
  const bf16_t* A; int lda;
  const bf16_t* Bt; int ldb;
  int N, K;
  const float* mu;
  int epi; void* out; int ldc;
  const float* v0; const float* v1;
};

DI int lds_off(int row, int chunk) { return row * 128 + ((chunk ^ (row & 7)) << 4); }

DI void gemm_load_a(const GemmArgs& g, int m0, int k0, int tid, u32x4 (&ra)[4]) {
#pragma unroll
  for (int i = 0; i < 4; ++i) {
    const int row = (tid >> 3) + i * 32, ch = tid & 7;
    const int m = m0 + row;
    const bf16_t* src = g.A + (size_t)m * g.lda + k0 + ch * 8;
    u32x4 v = *(const u32x4*)src;
    if (g.mu) {
      u32x4 pv = {0u, 0u, 0u, 0u};
      if ((m % SEQ) != 0) pv = *(const u32x4*)(src - g.lda);
      const f32x4 m0v = *(const f32x4*)(g.mu + k0 + ch * 8), m1v = *(const f32x4*)(g.mu + k0 + ch * 8 + 4);
      const unsigned hu[4] = {v.x, v.y, v.z, v.w}, pu[4] = {pv.x, pv.y, pv.z, pv.w};
      float o[8];
#pragma unroll
      for (int j = 0; j < 4; ++j) {
        const float h0 = bf_lo(hu[j]), h1 = bf_hi(hu[j]), p0 = bf_lo(pu[j]), p1 = bf_hi(pu[j]);
        const float mu0 = (2 * j < 4) ? m0v[(2 * j) & 3] : m1v[(2 * j) & 3], mu1 = (2 * j + 1 < 4) ? m0v[(2 * j + 1) & 3] : m1v[(2 * j + 1) & 3];
        o[2 * j] = h0 + (p0 - h0) * mu0; o[2 * j + 1] = h1 + (p1 - h1) * mu1;
      }
      v.x = cvt_pk_bf16(o[0], o[1]); v.y = cvt_pk_bf16(o[2], o[3]); v.z = cvt_pk_bf16(o[4], o[5]); v.w = cvt_pk_bf16(o[6], o[7]);
    }
    ra[i] = v;
  }
}
DI void gemm_load_b(const GemmArgs& g, int n0, int k0, int tid, u32x4 (&rb)[4]) {
#pragma unroll
  for (int i = 0; i < 4; ++i) {
    const int row = (tid >> 3) + i * 32, ch = tid & 7;
    rb[i] = *(const u32x4*)(g.Bt + (size_t)(n0 + row) * g.ldb + k0 + ch * 8);
  }
}
DI void gemm_store_lds(unsigned char* buf, int tid, const u32x4 (&r)[4]) {
#pragma unroll
  for (int i = 0; i < 4; ++i) {
    const int row = (tid >> 3) + i * 32, ch = tid & 7;
    *(u32x4*)(buf + lds_off(row, ch)) = r[i];
  }
}

DI unsigned f2key(float f) { unsigned u = __float_as_uint(f); return u ^ ((u >> 31) ? 0xffffffffu : 0x80000000u); }
DI float key2f(unsigned k) { unsigned u = (k >> 31) ? (k ^ 0x80000000u) : ~k; return __uint_as_float(u); }
#define CE_DESC(a, b) { const unsigned _mx = max(a, b), _mn = min(a, b); a = _mx; b = _mn; }
DI void sort16_desc(unsigned (&x)[16]) {
#pragma unroll
  for (int k = 2; k <= 16; k <<= 1) {
#pragma unroll
    for (int j = k >> 1; j > 0; j >>= 1) {
#pragma unroll
      for (int i = 0; i < 16; ++i) {
        const int l = i ^ j;
        if (l > i) {
          if ((i & k) == 0) { CE_DESC(x[i], x[l]); } else { CE_DESC(x[l], x[i]); }
        }
      }
    }
  }
}
DI void merge16_desc(unsigned (&x)[16]) {
#pragma unroll
  for (int j = 8; j > 0; j >>= 1) {
#pragma unroll
    for (int i = 0; i < 16; ++i) { const int l = i ^ j; if (l > i) { CE_DESC(x[i], x[l]); } }
  }
}

DI void gemm_glds(const bf16_t* __restrict__ base, int ld, int r0, int k0, unsigned char* buf, int wid, int lane) {
  const bf16_t* src = base + (size_t)(r0 + wid * 8 + (lane >> 3)) * ld + k0 + (((lane & 7) ^ (lane >> 3)) << 3);
#pragma unroll
  for (int j = 0; j < 4; ++j)
    __builtin_amdgcn_global_load_lds((const unsigned*)(src + (size_t)j * 32 * ld), (unsigned*)(buf + (j * 4 + wid) * 1024), 16, 0, 0);
}
DI void gemm_tile(const GemmArgs& g, int m0, int n0, unsigned char* lds) {
  constexpr int WM = 2, WN = 4 / WM, TM = 128 / WM, TN = 128 / WN, MI = TM / 16, NI = TN / 16;
  const int tid = opaque_v(threadIdx.x), lane = tid & 63, wid = tid >> 6;
  const int wm = wid / WN, wn = wid % WN;
  const int nk = g.K / 64;
  const bool lerp = g.mu != nullptr;
  f32x4 acc[MI][NI];
#pragma unroll
  for (int i = 0; i < MI; ++i)
#pragma unroll
    for (int j = 0; j < NI; ++j) acc[i][j] = (f32x4){0.f, 0.f, 0.f, 0.f};
  u32x4 ra[4];
  if (lerp) { gemm_load_a(g, m0, 0, tid, ra); gemm_store_lds(lds, tid, ra); } else gemm_glds(g.A, g.lda, m0, 0, lds, wid, lane);
  gemm_glds(g.Bt, g.ldb, n0, 0, lds + 16384, wid, lane);
  asm volatile("s_waitcnt vmcnt(0)" ::: "memory");
  __syncthreads();
  const int fr = lane & 15, fq = lane >> 4;
  for (int kt = 0; kt < nk; ++kt) {
    unsigned char* cur = lds + (kt & 1) * 32768;
    unsigned char* nxt = lds + ((kt + 1) & 1) * 32768;
    if (kt + 1 < nk) {
      if (lerp) gemm_load_a(g, m0, (kt + 1) * 64, tid, ra); else gemm_glds(g.A, g.lda, m0, (kt + 1) * 64, nxt, wid, lane);
      gemm_glds(g.Bt, g.ldb, n0, (kt + 1) * 64, nxt + 16384, wid, lane);
    }
#pragma unroll
    for (int ks = 0; ks < 2; ++ks) {
      bf16x8 af[MI], bfr[NI];
#pragma unroll
      for (int i = 0; i < MI; ++i) af[i] = *(const bf16x8*)(cur + lds_off(wm * TM + i * 16 + fr, ks * 4 + fq));
#pragma unroll
      for (int j = 0; j < NI; ++j) bfr[j] = *(const bf16x8*)(cur + 16384 + lds_off(wn * TN + j * 16 + fr, ks * 4 + fq));
#pragma unroll
      for (int i = 0; i < MI; ++i)
#pragma unroll
        for (int j = 0; j < NI; ++j) acc[i][j] = __builtin_amdgcn_mfma_f32_16x16x32_bf16(bfr[j], af[i], acc[i][j], 0, 0, 0);
    }
    if (lerp && kt + 1 < nk) gemm_store_lds(nxt, tid, ra);
    asm volatile("s_waitcnt vmcnt(0)" ::: "memory");
    __syncthreads();
  }
  if (g.epi == EPI_TOPK) {
    unsigned* lists = (unsigned*)g.out;
    const int grp = n0 >> 7;
#pragma unroll
    for (int i = 0; i < MI; ++i)
#pragma unroll
      for (int j = 0; j < NI; ++j) {
        const int ml = wm * TM + i * 16 + fr, c = wn * 16 + j * 4 + fq;
        u32x4 kv;
        kv.x = (f2key(acc[i][j][0]) & ~127u) | (unsigned)(127 - (c * 4 + 0)); kv.y = (f2key(acc[i][j][1]) & ~127u) | (unsigned)(127 - (c * 4 + 1));
        kv.z = (f2key(acc[i][j][2]) & ~127u) | (unsigned)(127 - (c * 4 + 2)); kv.w = (f2key(acc[i][j][3]) & ~127u) | (unsigned)(127 - (c * 4 + 3));
        *(u32x4*)(lds + ml * 528 + (c << 4)) = kv;
      }
    __syncthreads();
    {
      const int ml = wid * 32 + (lane & 31), hf = lane >> 5;
      unsigned a[16], b[16];
#pragma unroll
      for (int ch = 0; ch < 4; ++ch) {
#pragma unroll
        for (int cc = 0; cc < 4; ++cc) {
          const int c = hf * 16 + ch * 4 + cc;
          const u32x4 kv = *(const u32x4*)(lds + ml * 528 + (c << 4));
          b[cc * 4] = kv.x; b[cc * 4 + 1] = kv.y; b[cc * 4 + 2] = kv.z; b[cc * 4 + 3] = kv.w;
        }
        sort16_desc(b);
        if (ch == 0) {
#pragma unroll
          for (int e = 0; e < 16; ++e) a[e] = b[e];
        } else {
#pragma unroll
          for (int e = 0; e < 16; ++e) a[e] = max(a[e], b[15 - e]);
          merge16_desc(a);
        }
      }
#pragma unroll
      for (int e = 0; e < 16; ++e) b[e] = (unsigned)__shfl_xor((int)a[e], 32);
#pragma unroll
      for (int e = 0; e < 16; ++e) a[e] = max(a[e], b[15 - e]);
      merge16_desc(a);
      if (hf == 0) {
        const int m = m0 + ml;
        u32x4* dst = (u32x4*)(lists + ((size_t)m * 16 + grp) * 16);
        dst[0] = (u32x4){a[0], a[1], a[2], a[3]}; dst[1] = (u32x4){a[4], a[5], a[6], a[7]};
        dst[2] = (u32x4){a[8], a[9], a[10], a[11]}; dst[3] = (u32x4){a[12], a[13], a[14], a[15]};
      }
    }
    __syncthreads();
    return;
  }
#pragma unroll
  for (int i = 0; i < MI; ++i) {
    const int m = m0 + wm * TM + i * 16 + fr;
#pragma unroll
    for (int j = 0; j < NI; ++j) {
      const int n = n0 + wn * TN + j * 16 + fq * 4;
      if (n >= g.N) continue;
      const f32x4 v = acc[i][j];
      bf16_t* ob = (bf16_t*)g.out + (size_t)m * g.ldc + n;
      switch (g.epi) {
        case EPI_BF16: *(u32x2*)ob = (u32x2){cvt_pk_bf16(v[0], v[1]), cvt_pk_bf16(v[2], v[3])}; break;
        case EPI_TANH: *(u32x2*)ob = (u32x2){cvt_pk_bf16(tanhf(v[0]), tanhf(v[1])), cvt_pk_bf16(tanhf(v[2]), tanhf(v[3]))}; break;
        case EPI_SIGMOID: *(u32x2*)ob = (u32x2){cvt_pk_bf16(sigmoidf_(v[0]), sigmoidf_(v[1])), cvt_pk_bf16(sigmoidf_(v[2]), sigmoidf_(v[3]))}; break;
        case EPI_LW: {
          const f32x4 w0 = *(const f32x4*)(g.v0 + n); float o[4];
#pragma unroll
          for (int q = 0; q < 4; ++q) { const float xx = -(w0[q] + v[q]); const float sp = fmaxf(xx, 0.f) + __logf(1.f + __expf(-fabsf(xx))); o[q] = -__expf(-sp - 0.5f); }
          *(u32x2*)ob = (u32x2){cvt_pk_bf16(o[0], o[1]), cvt_pk_bf16(o[2], o[3])};
        } break;
        case EPI_ASIG: {
          const f32x4 a0 = *(const f32x4*)(g.v0 + n);
          *(u32x2*)ob = (u32x2){cvt_pk_bf16(sigmoidf_(a0[0] + v[0]), sigmoidf_(a0[1] + v[1])), cvt_pk_bf16(sigmoidf_(a0[2] + v[2]), sigmoidf_(a0[3] + v[3]))};
        } break;
        case EPI_Z: {
          const int b = m / SEQ;
          const f32x4 xv = *(const f32x4*)(g.v0 + (size_t)m * D + n), gt = *(const f32x4*)(g.v1 + (size_t)b * 6144 + n);
          *(f32x4*)((float*)g.out + (size_t)m * g.ldc + n) = xv * ALPHA + gt * v;
        } break;
        case EPI_GATE: {
          const u32x2 yv = *(const u32x2*)ob;
          *(u32x2*)ob = (u32x2){cvt_pk_bf16(bf_lo(yv.x) * v[0], bf_hi(yv.x) * v[1]), cvt_pk_bf16(bf_lo(yv.y) * v[2], bf_hi(yv.y) * v[3])};
        } break;
        default: {
          const f32x4 sc = *(const f32x4*)(g.v0 + n);
          *(u32x2*)ob = (u32x2){cvt_pk_bf16(v[0] * sc[0], v[1] * sc[1]), cvt_pk_bf16(v[2] * sc[2], v[3] * sc[3])};
        } break;
      }
    }
  }
}

DI GemmArgs mk(const bf16_t* A, int lda, const bf16_t* Bt, int ldb, int N, int K, int epi, void* out, int ldc,
               const float* mu = nullptr, const float* v0 = nullptr, const float* v1 = nullptr) {
  GemmArgs g; g.A = A; g.lda = lda; g.Bt = Bt; g.ldb = ldb; g.N = N; g.K = K; g.mu = mu; g.epi = epi; g.out = out; g.ldc = ldc; g.v0 = v0; g.v1 = v1; return g;
}
DI int sched_iters(int ntn, int nblk) {
  const int LB = nblk >> 3; int it = 0;
  for (int n0 = 0; n0 < ntn;) { int NT = min(8, ntn - n0); while (LB % NT) --NT; const int MT = LB / NT; it += (256 + 8 * MT - 1) / (8 * MT); n0 += NT; }
  return it;
}
DI bool sched_mn(int i, int bid, int nblk, int ntn, int& mt, int& nt) {
  const int x = bid & 7, l = bid >> 3, LB = nblk >> 3; int base = 0;
  for (int n0 = 0; n0 < ntn;) {
    int NT = min(8, ntn - n0); while (LB % NT) --NT;
    const int MT = LB / NT, rounds = (256 + 8 * MT - 1) / (8 * MT);
    if (i < base + rounds) { mt = (i - base) * 8 * MT + x * MT + (l % MT); nt = n0 + l / MT; return mt < 256; }
    base += rounds; n0 += NT;
  }
  return false;
}

constexpr int CL = 32;
constexpr int NCH = SEQ / CL;
constexpr int SN = 144, ST = 80;
struct ScanArgs {
  bf16_t* r; const bf16_t *k, *v, *lw, *a;
  const float *k_k, *k_a, *r_k, *lnx_g, *lnx_b;
  bf16_t* Pg;
  bf16_t *Qz0, *Qz1;
  float* Gg;
};
DI int tr_off(int row, int tok) { return row * ST + ((((tok >> 3) ^ ((row >> 3) & 3)) << 4) | ((tok & 7) << 1)); }
template <bool PT, bool QT>
DI f32x4 tile_mm(const unsigned char* P, int ps, const unsigned char* Q, int qs, int i0, int j0, int nks, f32x4 acc, int lane) {
  const int fr = lane & 15, fq = lane >> 4;
  for (int ks = 0; ks < nks; ++ks) {
    const bf16x8 pa = *(const bf16x8*)(PT ? P + tr_off(i0 + fr, fq * 8) : P + (i0 + fr) * ps + ks * 64 + fq * 16);
    const bf16x8 qb = *(const bf16x8*)(QT ? Q + tr_off(j0 + fr, fq * 8) : Q + (j0 + fr) * qs + ks * 64 + fq * 16);
    acc = __builtin_amdgcn_mfma_f32_16x16x32_bf16(pa, qb, acc, 0, 0, 0);
  }
  return acc;
}
DI bf16_t* qz_ptr(const ScanArgs& s, int ch) { return ((ch >> 13) ? s.Qz1 : s.Qz0) + (size_t)(ch & 8191) * 4096; }
DI void st_bf16x4(unsigned char* p, const f32x4& v) { *(u32x2*)p = (u32x2){cvt_pk_bf16(v[0], v[1]), cvt_pk_bf16(v[2], v[3])}; }

struct ScanIn { u32x4 r, k, v, w, a, z0, z1; };
template <bool PHASE_C>
DI void scan_fetch(const ScanArgs& s, int item, ScanIn& in) {
  const int c = item & (NCH - 1), h = (item >> 7) & 15, b = item >> 11;
  const int tid = opaque_v(threadIdx.x), tt = tid >> 3, c0 = (tid & 7) * 8;
  const size_t off = ((size_t)b * SEQ + (size_t)c * CL + tt) * D + h * HS + c0;
  in.k = *(const u32x4*)(s.k + off); in.v = *(const u32x4*)(s.v + off); in.w = *(const u32x4*)(s.lw + off); in.a = *(const u32x4*)(s.a + off);
  if (PHASE_C) {
    in.r = *(const u32x4*)(s.r + off);
    const bf16_t* Zg = qz_ptr(s, item);
    in.z0 = *(const u32x4*)(Zg + tid * 8); in.z1 = *(const u32x4*)(Zg + (tid + 256) * 8);
  }
}
template <bool PHASE_C>
DI void scan_load(const ScanArgs& s, const ScanIn& in, int h, float* lwbuf, unsigned char* At, unsigned char* Bt, unsigned char* Kt, unsigned char* Rt,
                  unsigned char* AtT, unsigned char* BhT, unsigned char* KhT, unsigned char* VT, float& bonus, float (&vout)[8], float* Gout) {
  const int tid = opaque_v(threadIdx.x), tt = tid >> 3, c0 = (tid & 7) * 8;
  const u32x4 vk = in.k, vv = in.v, vw = in.w, va = in.a;
  u32x4 vr = {0u, 0u, 0u, 0u};
  if (PHASE_C) vr = in.r;
  float fr_[8], fk[8], fv[8], fw[8], fa[8];
  { const unsigned ur[4] = {vr.x, vr.y, vr.z, vr.w}, uk[4] = {vk.x, vk.y, vk.z, vk.w}, uv[4] = {vv.x, vv.y, vv.z, vv.w}, uw[4] = {vw.x, vw.y, vw.z, vw.w}, ua[4] = {va.x, va.y, va.z, va.w};
#pragma unroll
    for (int j = 0; j < 4; ++j) {
      fr_[2 * j] = bf_lo(ur[j]); fr_[2 * j + 1] = bf_hi(ur[j]); fk[2 * j] = bf_lo(uk[j]); fk[2 * j + 1] = bf_hi(uk[j]);
      fv[2 * j] = bf_lo(uv[j]); fv[2 * j + 1] = bf_hi(uv[j]); fw[2 * j] = bf_lo(uw[j]); fw[2 * j + 1] = bf_hi(uw[j]);
      fa[2 * j] = bf_lo(ua[j]); fa[2 * j + 1] = bf_hi(ua[j]);
    } }
  *(f32x4*)(lwbuf + tt * 64 + c0) = (f32x4){fw[0], fw[1], fw[2], fw[3]}; *(f32x4*)(lwbuf + tt * 64 + c0 + 4) = (f32x4){fw[4], fw[5], fw[6], fw[7]};
  float kkr[8], nrm = 0.f, bon = 0.f, kp[8];
#pragma unroll
  for (int j = 0; j < 8; ++j) {
    const int ch = h * HS + c0 + j;
    kkr[j] = fk[j] * s.k_k[ch]; nrm += kkr[j] * kkr[j];
    kp[j] = fk[j] * (1.f + (fa[j] - 1.f) * s.k_a[ch]);
    if (PHASE_C) bon += fr_[j] * kp[j] * s.r_k[ch];
  }
  nrm += __shfl_xor(nrm, 1); nrm += __shfl_xor(nrm, 2); nrm += __shfl_xor(nrm, 4);
  if (PHASE_C) { bon += __shfl_xor(bon, 1); bon += __shfl_xor(bon, 2); bon += __shfl_xor(bon, 4); }
  bonus = bon;
  const float inv = rsqrtf(fmaxf(nrm, 1e-24f));
  __syncthreads();
  {
    const int c = tid & 63, sg = tid >> 6;
    float run = 0.f;
#pragma unroll
    for (int i = 0; i < 8; ++i) { run += lwbuf[(sg * 8 + i) * 64 + c]; lwbuf[(sg * 8 + i) * 64 + c] = run; }
  }
  __syncthreads();
  float cum[8], cl[8];
  {
    const int sg = tt >> 3;
#pragma unroll
    for (int hh = 0; hh < 2; ++hh) {
      const f32x4 me = *(const f32x4*)(lwbuf + tt * 64 + c0 + hh * 4);
      const f32x4 s0 = *(const f32x4*)(lwbuf + 7 * 64 + c0 + hh * 4), s1 = *(const f32x4*)(lwbuf + 15 * 64 + c0 + hh * 4),
                  s2 = *(const f32x4*)(lwbuf + 23 * 64 + c0 + hh * 4), s3 = *(const f32x4*)(lwbuf + 31 * 64 + c0 + hh * 4);
#pragma unroll
      for (int q = 0; q < 4; ++q) {
        const float pre = (sg > 0 ? s0[q] : 0.f) + (sg > 1 ? s1[q] : 0.f) + (sg > 2 ? s2[q] : 0.f);
        cum[hh * 4 + q] = me[q] + pre; cl[hh * 4 + q] = (s0[q] + s1[q]) + (s2[q] + s3[q]);
      }
    }
  }
  float at[8], bt[8], kt[8], rt[8], bh[8], kh[8];
#pragma unroll
  for (int j = 0; j < 8; ++j) {
    const float kk = kkr[j] * inv, bb = kk * fa[j];
    const float ein = __expf(cum[j]), eneg = __expf(-cum[j]), eex = __expf(cum[j] - fw[j]), eend = __expf(cl[j] - cum[j]);
    at[j] = -kk * eex; bt[j] = bb * eneg; kt[j] = kp[j] * eneg; rt[j] = fr_[j] * ein; bh[j] = bb * eend; kh[j] = kp[j] * eend;
    vout[j] = fv[j];
  }
  *(u32x4*)(At + tt * SN + c0 * 2) = (u32x4){cvt_pk_bf16(at[0], at[1]), cvt_pk_bf16(at[2], at[3]), cvt_pk_bf16(at[4], at[5]), cvt_pk_bf16(at[6], at[7])};
  *(u32x4*)(Bt + tt * SN + c0 * 2) = (u32x4){cvt_pk_bf16(bt[0], bt[1]), cvt_pk_bf16(bt[2], bt[3]), cvt_pk_bf16(bt[4], bt[5]), cvt_pk_bf16(bt[6], bt[7])};
  *(u32x4*)(Kt + tt * SN + c0 * 2) = (u32x4){cvt_pk_bf16(kt[0], kt[1]), cvt_pk_bf16(kt[2], kt[3]), cvt_pk_bf16(kt[4], kt[5]), cvt_pk_bf16(kt[6], kt[7])};
  if (PHASE_C) *(u32x4*)(Rt + tt * SN + c0 * 2) = (u32x4){cvt_pk_bf16(rt[0], rt[1]), cvt_pk_bf16(rt[2], rt[3]), cvt_pk_bf16(rt[4], rt[5]), cvt_pk_bf16(rt[6], rt[7])};
#pragma unroll
  for (int j = 0; j < 8; ++j) {
    *(bf16_t*)(VT + tr_off(c0 + j, tt)) = f2bf(fv[j]);
    if (!PHASE_C) {
      *(bf16_t*)(AtT + tr_off(c0 + j, tt)) = f2bf(at[j]);
      *(bf16_t*)(BhT + tr_off(c0 + j, tt)) = f2bf(bh[j]);
      *(bf16_t*)(KhT + tr_off(c0 + j, tt)) = f2bf(kh[j]);
    }
  }
  if (!PHASE_C && tt == 0 && Gout) {
#pragma unroll
    for (int j = 0; j < 8; ++j) Gout[c0 + j] = __expf(cl[j]);
  }
}
DI void scan_tinv(const float* A32, unsigned char* Tm, int lane) {
  const int c = lane & 31;
  float Tc[32];
#pragma unroll
  for (int i = 0; i < 32; ++i) {
    float s0 = (i == c) ? 1.f : 0.f, s1 = 0.f, s2 = 0.f, s3 = 0.f;
#pragma unroll
    for (int j4 = 0; j4 < (i + 3) / 4; ++j4) {
      const f32x4 a4 = *(const f32x4*)(A32 + i * 36 + j4 * 4);
      if (j4 * 4 + 0 < i) s0 += a4[0] * Tc[j4 * 4 + 0];
      if (j4 * 4 + 1 < i) s1 += a4[1] * Tc[j4 * 4 + 1];
      if (j4 * 4 + 2 < i) s2 += a4[2] * Tc[j4 * 4 + 2];
      if (j4 * 4 + 3 < i) s3 += a4[3] * Tc[j4 * 4 + 3];
    }
    Tc[i] = (s0 + s1) + (s2 + s3);
  }
  if (lane < 32) {
#pragma unroll
    for (int i = 0; i < 32; ++i) *(bf16_t*)(Tm + i * ST + c * 2) = f2bf(Tc[i]);
  }
}

DI void scan_phaseA_item(const ScanArgs& s, int item, const ScanIn& in, unsigned char* lds) {
  const int c = item & (NCH - 1), h = (item >> 7) & 15, b = item >> 11;
  const int tid = opaque_v(threadIdx.x), lane = tid & 63, wv = tid >> 6, fr = lane & 15, fq = lane >> 4;
  unsigned char* At = lds; unsigned char* Bt = At + 32 * SN; unsigned char* Kt = Bt + 32 * SN;
  unsigned char* AtT = Kt + 32 * SN; unsigned char* BhT = AtT + 64 * ST; unsigned char* KhT = BhT + 64 * ST; unsigned char* VT = KhT + 64 * ST;
  unsigned char* Tm = VT + 64 * ST; unsigned char* Aak = Tm + 32 * ST;
  float* A32 = (float*)(Aak + 32 * ST);
  unsigned char* W1T = (unsigned char*)A32 + 4608; unsigned char* M2T = W1T + 64 * ST; unsigned char* UlT = M2T + 64 * ST;
  float* lwbuf = (float*)W1T;
  const size_t gbase = ((size_t)b * SEQ + (size_t)c * CL) * D + h * HS;
  float bonus; float vv8[8];
  scan_load<false>(s, in, h, lwbuf, At, Bt, Kt, nullptr, AtT, BhT, KhT, VT, bonus, vv8, s.Gg + (size_t)item * 64);
  __syncthreads();
  {
    const int mat = wv >> 1, ti = wv & 1;
#pragma unroll
    for (int tj = 0; tj < 2; ++tj) {
      const f32x4 x = tile_mm<false, false>(At, SN, mat ? Kt : Bt, SN, ti * 16, tj * 16, 2, (f32x4){0.f, 0.f, 0.f, 0.f}, lane);
#pragma unroll
      for (int q = 0; q < 4; ++q) {
        const int i = ti * 16 + fq * 4 + q, j = tj * 16 + fr;
        const float val = (j < i) ? x[q] : 0.f;
        if (mat == 0) A32[i * 36 + j] = val; else *(bf16_t*)(Aak + i * ST + j * 2) = f2bf(val);
      }
    }
  }
  __syncthreads();
  if (wv == 0) scan_tinv(A32, Tm, lane);
  else {
    for (int tile = wv - 1; tile < 8; tile += 3) {
      const int ti = tile >> 2, tv = tile & 3;
      const f32x4 x = tile_mm<false, true>(Aak, ST, VT, ST, ti * 16, tv * 16, 1, (f32x4){0.f, 0.f, 0.f, 0.f}, lane);
      st_bf16x4(M2T + tr_off(tv * 16 + fr, ti * 16 + fq * 4), x);
    }
  }
  __syncthreads();
#pragma unroll
  for (int u = 0; u < 4; ++u) {
    const int tile = wv * 4 + u, which = tile >> 3, ti = (tile >> 2) & 1, tn = tile & 3;
    const f32x4 x = tile_mm<false, true>(Tm, ST, which ? M2T : AtT, ST, ti * 16, tn * 16, 1, (f32x4){0.f, 0.f, 0.f, 0.f}, lane);
    st_bf16x4((which ? UlT : W1T) + tr_off(tn * 16 + fr, ti * 16 + fq * 4), x);
  }
  __syncthreads();
  bf16_t* Pg = s.Pg + (size_t)item * 4096; bf16_t* Qg = qz_ptr(s, item);
#pragma unroll
  for (int u = 0; u < 4; ++u) {
    const int tile = wv * 4 + u, tk = tile >> 2, tn = tile & 3;
    const f32x4 xp = tile_mm<true, true>(W1T, ST, BhT, ST, tk * 16, tn * 16, 1, (f32x4){0.f, 0.f, 0.f, 0.f}, lane);
    *(u32x2*)(Pg + (tn * 16 + fr) * 64 + tk * 16 + fq * 4) = (u32x2){cvt_pk_bf16(xp[0], xp[1]), cvt_pk_bf16(xp[2], xp[3])};
    f32x4 xq = tile_mm<true, true>(BhT, ST, UlT, ST, tk * 16, tn * 16, 1, (f32x4){0.f, 0.f, 0.f, 0.f}, lane);
    xq = tile_mm<true, true>(KhT, ST, VT, ST, tk * 16, tn * 16, 1, xq, lane);
    __hip_atomic_store((unsigned long long*)(Qg + ((tk * 4 + tn) * 64 + lane) * 4), (unsigned long long)cvt_pk_bf16(xq[0], xq[1]) | ((unsigned long long)cvt_pk_bf16(xq[2], xq[3]) << 32), __ATOMIC_RELAXED, __HIP_MEMORY_SCOPE_AGENT);
  }
  __syncthreads();
}

constexpr int PSTR = 144;
constexpr int RSLOT = 64 * PSTR + 8192 + 256;
DI void scan_chain_block(const ScanArgs& s, int bh, unsigned char* lds) {
  const int tid = opaque_v(threadIdx.x), lane = tid & 63, tv = tid >> 6, fr = lane & 15, fq = lane >> 4;
  const int ch0 = bh * NCH;
  u32x4 pr[5];
  auto issue = [&](int c) {
    const bf16_t* Pg = s.Pg + (size_t)(ch0 + c) * 4096; const bf16_t* Qg = qz_ptr(s, ch0 + c);
    pr[0] = *(const u32x4*)(Pg + (size_t)tid * 8); pr[1] = *(const u32x4*)(Pg + (size_t)(tid + 256) * 8);
    pr[2] = *(const u32x4*)(Qg + (size_t)tid * 8); pr[3] = *(const u32x4*)(Qg + (size_t)(tid + 256) * 8);
    if (tid < 16) pr[4] = *(const u32x4*)(s.Gg + (size_t)(ch0 + c) * 64 + tid * 4);
  };
  auto commit = [&](int c) {
    unsigned char* sl = lds + (c & 3) * RSLOT;
    *(u32x4*)(sl + (tid >> 3) * PSTR + (tid & 7) * 16) = pr[0]; *(u32x4*)(sl + ((tid + 256) >> 3) * PSTR + (tid & 7) * 16) = pr[1];
    *(u32x4*)(sl + 64 * PSTR + tid * 16) = pr[2]; *(u32x4*)(sl + 64 * PSTR + (tid + 256) * 16) = pr[3];
    if (tid < 16) *(u32x4*)(sl + 64 * PSTR + 8192 + tid * 16) = pr[4];
  };
  issue(0); commit(0); issue(1); commit(1); issue(2); commit(2);
  __syncthreads();
  f32x4 Z[4];
#pragma unroll
  for (int t = 0; t < 4; ++t) Z[t] = (f32x4){0.f, 0.f, 0.f, 0.f};
  for (int c = 0; c < NCH; ++c) {
    if (c + 3 < NCH) issue(c + 3);
    const unsigned char* sl = lds + (c & 3) * RSLOT;
    bf16_t* Zo = qz_ptr(s, ch0 + c) + (tv * 16 + fr) * 64;
    unsigned zp[4][2];
#pragma unroll
    for (int t = 0; t < 4; ++t) { zp[t][0] = cvt_pk_bf16(Z[t][0], Z[t][1]); zp[t][1] = cvt_pk_bf16(Z[t][2], Z[t][3]); *(u32x2*)(Zo + t * 16 + fq * 4) = (u32x2){zp[t][0], zp[t][1]}; }
    bf16x8 zb[2];
#pragma unroll
    for (int ks = 0; ks < 2; ++ks) { const u32x4 w = {zp[2 * ks][0], zp[2 * ks][1], zp[2 * ks + 1][0], zp[2 * ks + 1][1]}; zb[ks] = __builtin_bit_cast(bf16x8, w); }
#pragma unroll
    for (int t = 0; t < 4; ++t) {
      const u32x2 qv = *(const u32x2*)(sl + 64 * PSTR + ((t * 4 + tv) * 64 + lane) * 8);
      const f32x4 g4 = *(const f32x4*)(sl + 64 * PSTR + 8192 + (t * 16 + fq * 4) * 4);
      f32x4 acc = (f32x4){bf_lo(qv.x) + g4[0] * Z[t][0], bf_hi(qv.x) + g4[1] * Z[t][1], bf_lo(qv.y) + g4[2] * Z[t][2], bf_hi(qv.y) + g4[3] * Z[t][3]};
#pragma unroll
      for (int ks = 0; ks < 2; ++ks) {
        const unsigned char* prow = sl + (t * 16 + fr) * PSTR + ks * 64 + fq * 8;
        const u32x2 p0 = *(const u32x2*)prow, p1 = *(const u32x2*)(prow + 32);
        const u32x4 w = {p0.x, p0.y, p1.x, p1.y};
        acc = __builtin_amdgcn_mfma_f32_16x16x32_bf16(__builtin_bit_cast(bf16x8, w), zb[ks], acc, 0, 0, 0);
      }
      Z[t] = acc;
    }
    if (c + 3 < NCH) commit(c + 3);
    __syncthreads();
  }
}

DI void scan_phaseC_item(const ScanArgs& s, int item, const ScanIn& in, unsigned char* lds) {
  const int c = item & (NCH - 1), h = (item >> 7) & 15, b = item >> 11;
  const int tid = opaque_v(threadIdx.x), lane = tid & 63, wv = tid >> 6, fr = lane & 15, fq = lane >> 4;
  unsigned char* At = lds; unsigned char* Bt = At + 32 * SN; unsigned char* Kt = Bt + 32 * SN; unsigned char* Rt = Kt + 32 * SN;
  unsigned char* VT = Rt + 32 * SN;
  unsigned char* Tm = VT + 64 * ST; unsigned char* Aak = Tm + 32 * ST; unsigned char* Arb = Aak + 32 * ST; unsigned char* Ark = Arb + 32 * ST;
  float* A32 = (float*)(Ark + 32 * ST);
  unsigned char* S0 = (unsigned char*)A32 + 4608;
  unsigned char* X1T = S0 + 64 * SN; unsigned char* UT = X1T + 64 * ST;
  float* Yb = (float*)(UT + 64 * ST);
  float* lwbuf = Yb;
  const size_t gbase = ((size_t)b * SEQ + (size_t)c * CL) * D + h * HS;
  float bonus; float vv8[8];
  { const int e0 = tid * 8, e1 = (tid + 256) * 8;
    *(u32x4*)(S0 + (e0 >> 6) * SN + (e0 & 63) * 2) = in.z0; *(u32x4*)(S0 + (e1 >> 6) * SN + (e1 & 63) * 2) = in.z1; }
  scan_load<true>(s, in, h, lwbuf, At, Bt, Kt, Rt, nullptr, nullptr, nullptr, VT, bonus, vv8, nullptr);
  __syncthreads();
  {
    const unsigned char* Pm = (wv < 2) ? At : Rt; const unsigned char* Qm = (wv & 1) ? Kt : Bt;
    unsigned char* dst = (wv == 1) ? Aak : (wv == 2 ? Arb : Ark);
#pragma unroll
    for (int t4 = 0; t4 < 4; ++t4) {
      const int ti = t4 >> 1, tj = t4 & 1;
      const f32x4 x = tile_mm<false, false>(Pm, SN, Qm, SN, ti * 16, tj * 16, 2, (f32x4){0.f, 0.f, 0.f, 0.f}, lane);
#pragma unroll
      for (int q = 0; q < 4; ++q) {
        const int i = ti * 16 + fq * 4 + q, j = tj * 16 + fr;
        const bool keep = (wv < 2) ? (j < i) : (j <= i);
        const float val = keep ? x[q] : 0.f;
        if (wv == 0) A32[i * 36 + j] = val; else *(bf16_t*)(dst + i * ST + j * 2) = f2bf(val);
      }
    }
  }
  __syncthreads();
  if (wv == 0) scan_tinv(A32, Tm, lane);
  else {
    for (int tile = wv - 1; tile < 8; tile += 3) {
      const int ti = tile >> 2, tv = tile & 3;
      f32x4 x = tile_mm<false, false>(At, SN, S0, SN, ti * 16, tv * 16, 2, (f32x4){0.f, 0.f, 0.f, 0.f}, lane);
      x = tile_mm<false, true>(Aak, ST, VT, ST, ti * 16, tv * 16, 1, x, lane);
      st_bf16x4(X1T + tr_off(tv * 16 + fr, ti * 16 + fq * 4), x);
    }
  }
  __syncthreads();
#pragma unroll
  for (int u = 0; u < 2; ++u) {
    const int tile = wv * 2 + u, ti = tile >> 2, tv = tile & 3;
    const f32x4 x = tile_mm<false, true>(Tm, ST, X1T, ST, ti * 16, tv * 16, 1, (f32x4){0.f, 0.f, 0.f, 0.f}, lane);
    st_bf16x4(UT + tr_off(tv * 16 + fr, ti * 16 + fq * 4), x);
  }
  __syncthreads();
#pragma unroll
  for (int u = 0; u < 2; ++u) {
    const int tile = wv * 2 + u, ti = tile >> 2, tv = tile & 3;
    f32x4 x = tile_mm<false, false>(Rt, SN, S0, SN, ti * 16, tv * 16, 2, (f32x4){0.f, 0.f, 0.f, 0.f}, lane);
    x = tile_mm<false, true>(Arb, ST, UT, ST, ti * 16, tv * 16, 1, x, lane);
    x = tile_mm<false, true>(Ark, ST, VT, ST, ti * 16, tv * 16, 1, x, lane);
#pragma unroll
    for (int q = 0; q < 4; ++q) Yb[(ti * 16 + fq * 4 + q) * 68 + tv * 16 + fr] = x[q];
  }
  __syncthreads();
  {
    const int tt = tid >> 3, c0 = (tid & 7) * 8;
    float yv[8], sum = 0.f;
#pragma unroll
    for (int j = 0; j < 8; ++j) { yv[j] = Yb[tt * 68 + c0 + j]; sum += yv[j]; }
    sum += __shfl_xor(sum, 1); sum += __shfl_xor(sum, 2); sum += __shfl_xor(sum, 4);
    const float mean = sum * (1.f / 64.f);
    float var = 0.f;
#pragma unroll
    for (int j = 0; j < 8; ++j) { const float d = yv[j] - mean; var += d * d; }
    var += __shfl_xor(var, 1); var += __shfl_xor(var, 2); var += __shfl_xor(var, 4);
    const float rstd = rsqrtf(var * (1.f / 64.f) + GN_EPS);
    const size_t off = gbase + (size_t)tt * D + c0;
    float o[8];
#pragma unroll
    for (int j = 0; j < 8; ++j) {
      const int chn = h * HS + c0 + j;
      o[j] = (yv[j] - mean) * rstd * s.lnx_g[chn] + s.lnx_b[chn] + bonus * vv8[j];
    }
    *(u32x4*)(s.r + off) = (u32x4){cvt_pk_bf16(o[0], o[1]), cvt_pk_bf16(o[2], o[3]), cvt_pk_bf16(o[4], o[5]), cvt_pk_bf16(o[6], o[7])};
  }
  __syncthreads();
}

DI void ln_phase(const float* __restrict__ z, const float* __restrict__ lg, const float* __restrict__ lb, float* __restrict__ xo,
                 const float* __restrict__ mod_l, int shift_idx, int scale_idx, bf16_t* __restrict__ ho, int bid, int nblk) {
  const int tq = opaque_v(threadIdx.x); const int lane = tq & 63, wv = tq >> 6;
  constexpr int RW = 4;
  for (int row0 = (bid * 4 + wv) * RW; row0 < T; row0 += nblk * 4 * RW) {
    f32x4 v[RW][4];
#pragma unroll
    for (int r = 0; r < RW; ++r)
#pragma unroll
      for (int i = 0; i < 4; ++i) v[r][i] = *(const f32x4*)(z + (size_t)(row0 + r) * D + i * 256 + lane * 4);
    const int b = row0 / SEQ;
#pragma unroll
    for (int r = 0; r < RW; ++r) {
      float s = 0.f;
#pragma unroll
      for (int i = 0; i < 4; ++i) s += (v[r][i][0] + v[r][i][1]) + (v[r][i][2] + v[r][i][3]);
      const float mean = wave_sum(s) * (1.f / D);
      float q = 0.f;
#pragma unroll
      for (int i = 0; i < 4; ++i) { const f32x4 d = v[r][i] - mean; q += (d[0] * d[0] + d[1] * d[1]) + (d[2] * d[2] + d[3] * d[3]); }
      const float rstd = rsqrtf(wave_sum(q) * (1.f / D) + LN_EPS);
      const int row = row0 + r;
#pragma unroll
      for (int i = 0; i < 4; ++i) {
        const int d = i * 256 + lane * 4;
        const f32x4 o = (v[r][i] - mean) * rstd * *(const f32x4*)(lg + d) + *(const f32x4*)(lb + d);
        *(f32x4*)(xo + (size_t)row * D + d) = o;
        if (!ho) continue;
        const f32x4 sh = *(const f32x4*)(mod_l + (size_t)b * 6144 + shift_idx * D + d), sc = *(const f32x4*)(mod_l + (size_t)b * 6144 + scale_idx * D + d);
        const f32x4 hh = o * (sc + 1.f) + sh;
        *(u32x2*)(ho + (size_t)row * D + d) = (u32x2){cvt_pk_bf16(hh[0], hh[1]), cvt_pk_bf16(hh[2], hh[3])};
      }
    }
  }
}

DI void combine_phase(const unsigned* __restrict__ lists, unsigned short* __restrict__ epk, float* __restrict__ gate, int bid, int nblk) {
  const int tq = opaque_v(threadIdx.x);
  for (int gid = bid * 256 + tq; gid < T * 8; gid += nblk * 256) {
    const unsigned* la = lists + (size_t)gid * 32;
    const unsigned* lb = la + 16;
    float s1[16], s2[16];
#pragma unroll
    for (int i = 0; i < 4; ++i) {
      const u32x4 a = *(const u32x4*)(la + i * 4), b = *(const u32x4*)(lb + i * 4);
      s1[i * 4] = key2f(a.x & ~127u); s1[i * 4 + 1] = key2f(a.y & ~127u); s1[i * 4 + 2] = key2f(a.z & ~127u); s1[i * 4 + 3] = key2f(a.w & ~127u);
      s2[i * 4] = key2f(b.x & ~127u); s2[i * 4 + 1] = key2f(b.y & ~127u); s2[i * 4 + 2] = key2f(b.z & ~127u); s2[i * 4 + 3] = key2f(b.w & ~127u);
    }
    unsigned c[4][16];
    {
      int n = 0;
#pragma unroll
      for (int a = 0; a < 16; ++a)
#pragma unroll
        for (int b = 0; b < 16; ++b)
          if ((a + 1) * (b + 1) <= 16) { c[n >> 4][n & 15] = (f2key(s1[a] + s2[b]) & ~255u) | (unsigned)(255 - (a * 16 + b)); ++n; }
#pragma unroll
      for (int q = 50; q < 64; ++q) c[q >> 4][q & 15] = 0u;
    }
    sort16_desc(c[0]); sort16_desc(c[1]); sort16_desc(c[2]); sort16_desc(c[3]);
#pragma unroll
    for (int e = 0; e < 16; ++e) { c[0][e] = max(c[0][e], c[1][15 - e]); c[2][e] = max(c[2][e], c[3][15 - e]); }
    merge16_desc(c[0]); merge16_desc(c[2]);
#pragma unroll
    for (int e = 0; e < 16; ++e) c[0][e] = max(c[0][e], c[2][15 - e]);
    merge16_desc(c[0]);
    float best[16], den = 0.f;
    const float mx = key2f(c[0][0] & ~255u);
#pragma unroll
    for (int e = 0; e < 16; ++e) { best[e] = __expf(key2f(c[0][e] & ~255u) - mx); den += best[e]; }
    const float inv = 1.f / den;
    unsigned idw[8];
#pragma unroll
    for (int e = 0; e < 16; ++e) {
      const int pos = 255 - (int)(c[0][e] & 255u), a = pos >> 4, b = pos & 15;
      const unsigned i1 = 127u - (la[a] & 127u), i2 = 127u - (lb[b] & 127u);
      const unsigned id = i1 * 128u + i2;
      if (e & 1) idw[e >> 1] |= id << 16; else idw[e >> 1] = id;
      best[e] *= inv;
    }
    {
      unsigned pw[8];
#pragma unroll
      for (int q = 0; q < 8; ++q) pw[q] = (unsigned)__shfl_xor((int)idw[q], 4);
      const int hh = gid & 7; const bool lowh = hh < 4;
      unsigned dw[16];
#pragma unroll
      for (int e = 0; e < 16; ++e) {
        const unsigned mine = (idw[e >> 1] >> ((e & 1) * 16)) & 0xffffu, other = (pw[e >> 1] >> ((e & 1) * 16)) & 0xffffu;
        dw[e] = lowh ? (mine | (other << 16)) : (other | (mine << 16));
      }
      u32x4* ed = (u32x4*)((unsigned*)epk + (size_t)(gid >> 3) * 64 + (hh & 3) * 16 + (lowh ? 0 : 8));
      if (lowh) { ed[0] = (u32x4){dw[0], dw[1], dw[2], dw[3]}; ed[1] = (u32x4){dw[4], dw[5], dw[6], dw[7]}; }
      else { ed[0] = (u32x4){dw[8], dw[9], dw[10], dw[11]}; ed[1] = (u32x4){dw[12], dw[13], dw[14], dw[15]}; }
    }
    f32x4* gd = (f32x4*)(gate + (size_t)gid * 16);
#pragma unroll
    for (int q = 0; q < 4; ++q) gd[q] = (f32x4){best[q * 4], best[q * 4 + 1], best[q * 4 + 2], best[q * 4 + 3]};
  }
}

DI void table_fp8_phase(const float* __restrict__ src, unsigned char* __restrict__ dst, float* __restrict__ inv, int rows, int bid, int nblk) {
  const int tq = opaque_v(threadIdx.x); const int lane = tq & 63, wv = tq >> 6;
  for (int r0 = (bid * 4 + wv) * 4; r0 < rows; r0 += nblk * 16) {
    f32x4 v[4][4];
#pragma unroll
    for (int rr = 0; rr < 4; ++rr)
#pragma unroll
      for (int i = 0; i < 4; ++i) v[rr][i] = __builtin_nontemporal_load((const f32x4*)(src + (size_t)(r0 + rr) * D + lane * 16 + i * 4));
#pragma unroll
    for (int rr = 0; rr < 4; ++rr) {
      float mx = 0.f;
#pragma unroll
      for (int i = 0; i < 4; ++i) mx = fmaxf(mx, fmaxf(fmaxf(fabsf(v[rr][i][0]), fabsf(v[rr][i][1])), fmaxf(fabsf(v[rr][i][2]), fabsf(v[rr][i][3]))));
#pragma unroll
      for (int o = 32; o >= 1; o >>= 1) mx = fmaxf(mx, __shfl_xor(mx, o));
      const float sc = mx > 0.f ? exp2f(floorf(log2f(384.f / mx))) : 1.f;
      unsigned w[4];
#pragma unroll
      for (int i = 0; i < 4; ++i) {
        int pk = 0;
        pk = __builtin_amdgcn_cvt_pk_fp8_f32(v[rr][i][0] * sc, v[rr][i][1] * sc, pk, false);
        pk = __builtin_amdgcn_cvt_pk_fp8_f32(v[rr][i][2] * sc, v[rr][i][3] * sc, pk, true);
        w[i] = (unsigned)pk;
      }
      *(u32x4*)(dst + (size_t)(r0 + rr) * D + lane * 16) = (u32x4){w[0], w[1], w[2], w[3]};
      if (lane == 0) inv[r0 + rr] = 1.f / sc;
    }
  }
}

struct PeerArgs {
  const bf16_t* h2;
  const unsigned char *u8, *v8;
  const float *uinv, *vinv;
  const unsigned* epk; const float* gate;
  float* part;
  float* coef;
  const float* xres;
  const float* gate2;
  float* z;
  unsigned* ctr_u; unsigned* ctr_v;
};
constexpr int PCH = 64;
DI void cvt16_fp8(const u32x4& d, float (&f)[16]) {
  const unsigned w[4] = {d.x, d.y, d.z, d.w};
#pragma unroll
  for (int i = 0; i < 4; ++i) {
    const f32x2 lo = __builtin_amdgcn_cvt_pk_f32_fp8((int)w[i], false), hi = __builtin_amdgcn_cvt_pk_f32_fp8((int)w[i], true);
    f[i * 4] = lo.x; f[i * 4 + 1] = lo.y; f[i * 4 + 2] = hi.x; f[i * 4 + 3] = hi.y;
  }
}
template <bool VPHASE>
DI void peer_slice_phase(const PeerArgs& a, unsigned char* lds) {
  const int tq = opaque_v(threadIdx.x); const int lane = tq & 63, wv = tq >> 6, cc = lane & 7;
  volatile int* nxt = (volatile int*)lds;
  const unsigned xcc = xb_xcc_id() & 7u;
  unsigned* ctr = VPHASE ? a.ctr_v : a.ctr_u;
  for (int ks = 0; ks < 8; ++ks) {
    const int s = (int)((xcc + ks) & 7u);
    for (;;) {
      __syncthreads();
      if (tq == 0) *nxt = (int)atomicAdd(&ctr[s * 16], 1u);
      __syncthreads();
      const int chunk = *nxt;
      if (chunk >= T / PCH) break;
      for (int ti = 0; ti < PCH / 4; ++ti) {
        const int t = chunk * PCH + wv * (PCH / 4) + ti;
        const unsigned ep = a.epk[(size_t)t * 64 + lane];
        const unsigned char* tab = (VPHASE ? a.v8 : a.u8) + s * 128 + cc * 16;
        u32x4 data[16];
        float cv[16];
        float c_lo = 0.f, c_hi = 0.f;
        if (VPHASE) { c_lo = a.coef[(size_t)t * 128 + lane]; c_hi = a.coef[(size_t)t * 128 + 64 + lane]; }
#pragma unroll
        for (int i = 0; i < 16; ++i) {
          const int src = (lane & ~7) | (i & 7);
          const unsigned ev = (unsigned)__shfl((int)ep, src);
          const unsigned e = (i < 8) ? (ev & 0xffffu) : (ev >> 16);
          if (VPHASE) cv[i] = __shfl(i < 8 ? c_lo : c_hi, src);
          data[i] = *(const u32x4*)(tab + (size_t)e * D);
        }
        if (!VPHASE) {
          const u32x4 h0 = *(const u32x4*)(a.h2 + (size_t)t * D + s * 128 + cc * 16), h1 = *(const u32x4*)(a.h2 + (size_t)t * D + s * 128 + cc * 16 + 8);
          float hf[16];
          { const unsigned u[8] = {h0.x, h0.y, h0.z, h0.w, h1.x, h1.y, h1.z, h1.w};
#pragma unroll
            for (int q = 0; q < 8; ++q) { hf[2 * q] = bf_lo(u[q]); hf[2 * q + 1] = bf_hi(u[q]); } }
          float r_lo = 0.f, r_hi = 0.f;
#pragma unroll
          for (int i = 0; i < 16; ++i) {
            float f[16]; cvt16_fp8(data[i], f);
            float d = 0.f;
#pragma unroll
            for (int q = 0; q < 16; ++q) d += f[q] * hf[q];
            d += __builtin_bit_cast(float, __builtin_amdgcn_update_dpp(0, __builtin_bit_cast(int, d), 0xB1, 0xF, 0xF, true));
            d += __builtin_bit_cast(float, __builtin_amdgcn_update_dpp(0, __builtin_bit_cast(int, d), 0x4E, 0xF, 0xF, true));
            d += __builtin_bit_cast(float, __builtin_amdgcn_update_dpp(0, __builtin_bit_cast(int, d), 0x141, 0xF, 0xF, true));
            if ((i & 7) == cc) { if (i < 8) r_lo = d; else r_hi = d; }
          }
          float* pp = a.part + ((size_t)s * T + t) * 128;
          pp[lane] = r_lo; pp[64 + lane] = r_hi;
        } else {
          float acc[16];
#pragma unroll
          for (int q = 0; q < 16; ++q) acc[q] = 0.f;
#pragma unroll
          for (int i = 0; i < 16; ++i) {
            float f[16]; cvt16_fp8(data[i], f);
#pragma unroll
            for (int q = 0; q < 16; ++q) acc[q] += cv[i] * f[q];
          }
          float r8[8], r4[4], r2[2];
          { const bool up = (lane & 8) != 0;
#pragma unroll
            for (int q = 0; q < 8; ++q) { const float keep = up ? acc[8 + q] : acc[q], send = up ? acc[q] : acc[8 + q]; r8[q] = keep + __shfl_xor(send, 8); } }
          { const bool up = (lane & 16) != 0;
#pragma unroll
            for (int q = 0; q < 4; ++q) { const float keep = up ? r8[4 + q] : r8[q], send = up ? r8[q] : r8[4 + q]; r4[q] = keep + __shfl_xor(send, 16); } }
          { const bool up = (lane & 32) != 0;
#pragma unroll
            for (int q = 0; q < 2; ++q) { const float keep = up ? r4[2 + q] : r4[q], send = up ? r4[q] : r4[2 + q]; r2[q] = keep + __shfl_xor(send, 32); } }
          const int col = s * 128 + cc * 16 + ((lane >> 3) & 1) * 8 + ((lane >> 4) & 1) * 4 + ((lane >> 5) & 1) * 2;
          const int b = t / SEQ;
          const f32x2 xv = *(const f32x2*)(a.xres + (size_t)t * D + col), gt = *(const f32x2*)(a.gate2 + (size_t)b * 6144 + col);
          *(f32x2*)(a.z + (size_t)t * D + col) = (f32x2){ALPHA * xv.x + gt.x * r2[0], ALPHA * xv.y + gt.y * r2[1]};
        }
      }
    }
  }
  __syncthreads();
}
DI void peer_coef_phase(const PeerArgs& a, int bid, int nblk) {
  const int tq = opaque_v(threadIdx.x);
  for (int g4 = bid * 256 + tq; g4 < T * 32; g4 += nblk * 256) {
    const int t = g4 >> 5, j = (g4 & 31) * 4;
    const u32x4 ep = *(const u32x4*)(a.epk + (size_t)t * 64 + (j & 63));
    const int sh = (j < 64) ? 0 : 16;
    const unsigned e[4] = {(ep.x >> sh) & 0xffffu, (ep.y >> sh) & 0xffffu, (ep.z >> sh) & 0xffffu, (ep.w >> sh) & 0xffffu};
    float ui[4], vi[4];
#pragma unroll
    for (int q = 0; q < 4; ++q) { ui[q] = a.uinv[e[q]]; vi[q] = a.vinv[e[q]]; }
    f32x4 sum = {0.f, 0.f, 0.f, 0.f};
#pragma unroll
    for (int s8 = 0; s8 < 8; ++s8) sum += *(const f32x4*)(a.part + ((size_t)s8 * T + t) * 128 + j);
    const f32x4 gt = *(const f32x4*)(a.gate + (size_t)t * 128 + j);
    f32x4 o;
#pragma unroll
    for (int q = 0; q < 4; ++q) o[q] = gt[q] * gelu_exact(sum[q] * ui[q]) * vi[q];
    *(f32x4*)(a.coef + (size_t)t * 128 + j) = o;
  }
}

DI void pool_phase(const bf16_t* __restrict__ zin, bf16_t* __restrict__ pout, int bid, int nblk) {
  const int tq = opaque_v(threadIdx.x);
  constexpr int SEG = 32;
  for (int it = bid * 256 + tq; it < (T / SEG) * (D / 8); it += nblk * 256) {
    const int ch = it & 127, seg = it >> 7;
    const int d = ch * 8, win = 2 << (d / 256);
    const int t0 = seg * SEG, tp0 = t0 % SEQ;
    float s[8];
#pragma unroll
    for (int j = 0; j < 8; ++j) s[j] = 0.f;
    for (int w = 1; w < win; ++w) {
      if (tp0 - w < 0) break;
      const u32x4 v = *(const u32x4*)(zin + (size_t)(t0 - w) * D + d);
      const unsigned u[4] = {v.x, v.y, v.z, v.w};
#pragma unroll
      for (int j = 0; j < 4; ++j) { s[2 * j] += bf_lo(u[j]); s[2 * j + 1] += bf_hi(u[j]); }
    }
#pragma unroll 4
    for (int i = 0; i < SEG; ++i) {
      const int t = t0 + i, tp = tp0 + i;
      const u32x4 v = *(const u32x4*)(zin + (size_t)t * D + d);
      const unsigned u[4] = {v.x, v.y, v.z, v.w};
      float z0[8];
#pragma unroll
      for (int j = 0; j < 4; ++j) { z0[2 * j] = bf_lo(u[j]); z0[2 * j + 1] = bf_hi(u[j]); }
#pragma unroll
      for (int j = 0; j < 8; ++j) s[j] += z0[j];
      const int cnt = min(tp + 1, win);
      const float ic = 1.f / (float)cnt;
      float o[8];
#pragma unroll
      for (int j = 0; j < 8; ++j) o[j] = s[j] * ic - z0[j];
      *(u32x4*)(pout + (size_t)t * D + d) = (u32x4){cvt_pk_bf16(o[0], o[1]), cvt_pk_bf16(o[2], o[3]), cvt_pk_bf16(o[4], o[5]), cvt_pk_bf16(o[6], o[7])};
      if (tp + 1 >= win) {
        const u32x4 vo = *(const u32x4*)(zin + (size_t)(t - win + 1) * D + d);
        const unsigned uo[4] = {vo.x, vo.y, vo.z, vo.w};
#pragma unroll
        for (int j = 0; j < 4; ++j) { s[2 * j] -= bf_lo(uo[j]); s[2 * j + 1] -= bf_hi(uo[j]); }
      }
    }
  }
}

#define GRID_SYNC() xcd_barrier(xb)

__global__ void __launch_bounds__(256, 2) mega(Params p) {
  __shared__ __attribute__((aligned(16))) unsigned char lds[LDS_BYTES + 16];
  cg::grid_group grid = cg::this_grid();
  const int bid = blockIdx.x, nblk = gridDim.x;
  if (threadIdx.x == 0) { *(volatile LAS unsigned*)(lds + LDS_BYTES) = 0u; *(volatile LAS unsigned*)(lds + LDS_BYTES + 4) = 0u; }
  __syncthreads();
  const XcdBarrier xb = xcd_barrier_post(p.bar, (volatile LAS unsigned*)(lds + LDS_BYTES));
  const float* mod0 = p.mod; const float* mod1 = p.mod + (size_t)NB * 6144;
  bf16_t* S[7];
#pragma unroll
  for (int i = 0; i < 7; ++i) S[i] = (bf16_t*)p.slot[i];

  prologue_phase(p, lds, bid, nblk);
  grid.sync();
  bf16_t *h = S[0], *r = S[1], *k = S[2], *v = S[3], *lw = S[4], *av = S[5];
  bf16_t* tw = p.lora_tmp; bf16_t* ta = tw + (size_t)T * 64; bf16_t* tg = ta + (size_t)T * 64;
  modulate_phase(p.x, mod0, p.rw_mu, h, S[4], S[5], S[6], bid, nblk);
  for (int it = bid; it < 4 * 8 * 2; it += nblk) {
    const int nt = it & 1, mt = (it >> 1) & 7, g4 = it >> 4;
    gemm_tile(mk(p.PoutT + g4 * 256, D, p.WgrpS + (size_t)g4 * 256 * 256, 256, 256, 256, EPI_BF16, p.WcT + g4 * 256, D), mt * 128, nt * 128, lds);
  }
  for (int it = bid; it < 2 * 16 * 8; it += nblk) {
    const int nt = it & 7, gl = it >> 3;
    gemm_tile(mk(p.KeysB + (size_t)gl * 128 * 128, 128, p.WqB + (size_t)(gl >> 4) * D * 2048 + (gl & 15) * 128, 2048, D, 128, EPI_BF16, p.WeffT + (size_t)gl * 128 * D, D), 0, nt * 128, lds);
  }
  GRID_SYNC();
  for (int it = 0, nit = sched_iters(28, nblk); it < nit; ++it) {
    int mt, nt; if (!sched_mn(it, bid, nblk, 28, mt, nt)) continue;
    GemmArgs g; int n0;
    if (nt < 24) { const int j = nt >> 3; n0 = (nt & 7) * 128; g = mk(S[4 + j], D, p.WT_rkv + (size_t)j * D * D, D, D, D, EPI_BF16, j == 0 ? r : (j == 1 ? k : v), D); }
    else if (nt == 24) { n0 = 0; g = mk(h, D, p.W1T, D, 64, D, EPI_TANH, tw, 64, p.rw_mu + 3 * D); }
    else if (nt == 25) { n0 = 0; g = mk(h, D, p.A1T, D, 64, D, EPI_BF16, ta, 64, p.rw_mu + 4 * D); }
    else { n0 = (nt - 26) * 128; g = mk(h, D, p.G1T, D, 192, D, EPI_SIGMOID, tg, 192, p.rw_mu + 5 * D); }
    gemm_tile(g, mt * 128, n0, lds);
  }
  GRID_SYNC();
  for (int it = 0, nit = sched_iters(16, nblk); it < nit; ++it) {
    int mt, nt; if (!sched_mn(it, bid, nblk, 16, mt, nt)) continue;
    const int j = nt >> 3, n0 = (nt & 7) * 128;
    GemmArgs g;
    if (j == 0) g = mk(tw, 64, p.W2T, 64, D, 64, EPI_LW, lw, D, nullptr, p.rw_w0);
    else g = mk(ta, 64, p.A2T, 64, D, 64, EPI_ASIG, av, D, nullptr, p.rw_a0);
    gemm_tile(g, mt * 128, n0, lds);
  }
  GRID_SYNC();
  {
    ScanArgs s; s.r = r; s.k = k; s.v = v; s.lw = lw; s.a = av; s.k_k = p.rw_k_k; s.k_a = p.rw_k_a; s.r_k = p.rw_r_k; s.lnx_g = p.rw_lnx_g; s.lnx_b = p.rw_lnx_b;
    s.Pg = (bf16_t*)p.out; s.Qz0 = S[0]; s.Qz1 = S[6]; s.Gg = p.Gg;
    { ScanIn cur, nxt; if (bid < NB * NH * NCH) scan_fetch<false>(s, bid, cur);
      for (int it = bid; it < NB * NH * NCH; it += nblk) { if (it + nblk < NB * NH * NCH) scan_fetch<false>(s, it + nblk, nxt); scan_phaseA_item(s, it, cur, lds); cur = nxt; } }
    GRID_SYNC();
    for (int it = bid; it < NB * NH; it += nblk) scan_chain_block(s, it, lds);
    GRID_SYNC();
    { ScanIn cur, nxt; if (bid < NB * NH * NCH) scan_fetch<true>(s, bid, cur);
      for (int it = bid; it < NB * NH * NCH; it += nblk) { if (it + nblk < NB * NH * NCH) scan_fetch<true>(s, it + nblk, nxt); scan_phaseC_item(s, it, cur, lds); cur = nxt; } }
    GRID_SYNC();
  }
  for (int it = 0, nit = sched_iters(8, nblk); it < nit; ++it) {
    int mt, nt; if (!sched_mn(it, bid, nblk, 8, mt, nt)) continue;
    gemm_tile(mk(tg, 192, p.G2T, 192, D, 192, EPI_GATE, r, D), mt * 128, nt * 128, lds);
  }
  GRID_SYNC();
  h = r;
  float* z = (float*)p.slot[2];
  for (int it = 0, nit = sched_iters(8, nblk); it < nit; ++it) {
    int mt, nt; if (!sched_mn(it, bid, nblk, 8, mt, nt)) continue;
    gemm_tile(mk(h, D, p.WoT, D, D, D, EPI_Z, z, D, nullptr, p.x, mod0 + 2 * D), mt * 128, nt * 128, lds);
  }
  table_fp8_phase(p.pe_u, p.slot[6], p.tinv, NEXP, bid, nblk);
  table_fp8_phase(p.pe_v, p.slot[6] + ((size_t)16 << 20), p.tinv + NEXP, NEXP, bid, nblk);
  table_fp8_phase(p.pe_u + (size_t)NEXP * D, p.slot[6] + ((size_t)32 << 20), p.tinv + 2 * NEXP, NEXP, bid, nblk);
  table_fp8_phase(p.pe_v + (size_t)NEXP * D, p.slot[6] + ((size_t)48 << 20), p.tinv + 3 * NEXP, NEXP, bid, nblk);
  GRID_SYNC();
  ln_phase(z, p.ln_g + 0 * D, p.ln_b + 0 * D, (float*)p.slot[4], mod0, 3, 4, S[0], bid, nblk);
  GRID_SYNC();

#pragma unroll
  for (int layer = 0; layer < 2; ++layer) {
    const float* modl = layer == 0 ? mod0 : mod1;
    const bf16_t* hp = layer == 0 ? S[0] : S[3];
    unsigned char* lsl = layer == 0 ? p.slot[3] : p.slot[0];
    unsigned* lists = (unsigned*)lsl;
    unsigned* epk = (unsigned*)(lsl + ((size_t)32 << 20));
    float* gate = (float*)(lsl + ((size_t)40 << 20));
    for (int it = 0, nit = sched_iters(16, nblk); it < nit; ++it) {
      int mt, grp; if (!sched_mn(it, bid, nblk, 16, mt, grp)) continue;
      gemm_tile(mk(hp, D, p.WeffT + (size_t)layer * 2048 * D, D, 2048, D, EPI_TOPK, lists, 0), mt * 128, grp * 128, lds);
    }
    GRID_SYNC();
    combine_phase(lists, (unsigned short*)epk, gate, bid, nblk);
    GRID_SYNC();
    PeerArgs a; a.h2 = hp;
    a.u8 = p.slot[6] + ((size_t)(layer * 32) << 20); a.v8 = a.u8 + ((size_t)16 << 20);
    a.uinv = p.tinv + (layer * 2) * NEXP; a.vinv = a.uinv + NEXP;
    a.epk = epk; a.gate = gate; a.part = (float*)p.slot[1]; a.coef = (float*)lsl;
    a.xres = (const float*)p.slot[4]; a.gate2 = modl + 5 * D; a.z = (float*)p.slot[1];
    a.ctr_u = p.bar + XCD_BAR_WORDS + (layer * 2) * 128; a.ctr_v = a.ctr_u + 128;
    peer_slice_phase<false>(a, lds);
    GRID_SYNC();
    peer_coef_phase(a, bid, nblk);
    GRID_SYNC();
    peer_slice_phase<true>(a, lds);
    GRID_SYNC();
    if (layer == 1) { ln_phase(a.z, p.ln_g + 3 * D, p.ln_b + 3 * D, p.out, mod1, 0, 1, nullptr, bid, nblk); break; }
    ln_phase(a.z, p.ln_g + 1 * D, p.ln_b + 1 * D, (float*)p.slot[4], mod1, 0, 1, S[0], bid, nblk);
    GRID_SYNC();
    const float* x2 = (const float*)p.slot[4];
    bf16_t *hB = S[0], *zin = S[1], *pp = S[2];
    for (int it = 0, nit = sched_iters(8, nblk); it < nit; ++it) {
      int mt, nt; if (!sched_mn(it, bid, nblk, 8, mt, nt)) continue;
      gemm_tile(mk(hB, D, p.PinT, D, D, D, EPI_BF16, zin, D), mt * 128, nt * 128, lds);
    }
    GRID_SYNC();
    pool_phase(zin, pp, bid, nblk);
    GRID_SYNC();
    float* z1 = (float*)p.slot[0];
    for (int it = 0, nit = sched_iters(8, nblk); it < nit; ++it) {
      int mt, nt; if (!sched_mn(it, bid, nblk, 8, mt, nt)) continue;
      gemm_tile(mk(pp, D, p.WcT, D, D, D, EPI_Z, z1, D, nullptr, x2, mod1 + 2 * D), mt * 128, nt * 128, lds);
    }
    GRID_SYNC();
    ln_phase(z1, p.ln_g + 2 * D, p.ln_b + 2 * D, (float*)p.slot[4], mod1, 3, 4, S[3], bid, nblk);
    GRID_SYNC();
  }
}

extern "C" void kernel_launch(void* const* d_in, const int* in_sizes, int n_in, void* d_out, int out_size, void* d_ws, size_t ws_size, hipStream_t stream) {
  Params p{};
  const float** ip = (const float**)&p.x;
  for (int i = 0; i < 30; ++i) ip[i] = (const float*)d_in[i];
  p.out = (float*)d_out;
  unsigned char* w = (unsigned char*)d_ws; size_t off = 0;
  auto take = [&](size_t bytes) { unsigned char* r = w + off; off += (bytes + 255) & ~(size_t)255; return r; };
  p.bar = (unsigned*)take(16384);
  p.mod = (float*)take((size_t)2 * NB * 6144 * 4);
  p.WT_rkv = (bf16_t*)take((size_t)3 * D * D * 2);
  p.W1T = (bf16_t*)take((size_t)128 * D * 2); p.A1T = (bf16_t*)take((size_t)128 * D * 2); p.G1T = (bf16_t*)take((size_t)256 * D * 2);
  p.W2T = (bf16_t*)take((size_t)D * 64 * 2); p.A2T = (bf16_t*)take((size_t)D * 64 * 2); p.G2T = (bf16_t*)take((size_t)D * 192 * 2);
  p.WoT = (bf16_t*)take((size_t)D * D * 2); p.PinT = (bf16_t*)take((size_t)D * D * 2); p.PoutT = (bf16_t*)take((size_t)D * D * 2);
  p.WgrpS = (bf16_t*)take((size_t)4 * 256 * 256 * 2); p.WcT = (bf16_t*)take((size_t)D * D * 2); p.WqB = (bf16_t*)take((size_t)2 * 2048 * D * 2); p.WeffT = (bf16_t*)take((size_t)2 * 2048 * D * 2); p.KeysB = (bf16_t*)take((size_t)2 * 16 * 128 * 128 * 2);
  p.tinv = (float*)take((size_t)4 * NEXP * 4);
  p.lora_tmp = (bf16_t*)take((size_t)T * 320 * 2);
  p.Gg = (float*)take((size_t)16384 * 64 * 4);
  for (int i = 0; i < 7; ++i) p.slot[i] = take((size_t)64 << 20);
  if (off > ws_size) return;

  static int grid_blocks = 0;
  if (!grid_blocks) {
    int dev = 0, cus = 0, per_cu = 0;
    hipGetDevice(&dev);
    hipDeviceGetAttribute(&cus, hipDeviceAttributeMultiprocessorCount, dev);
    hipOccupancyMaxActiveBlocksPerMultiprocessor(&per_cu, mega, 256, 0);
    if (per_cu > 2) per_cu = 2;
    if (per_cu < 1) per_cu = 1;
    grid_blocks = cus * per_cu;
  }
  hipMemsetAsync(p.bar, 0, 16384, stream);
  void* args[] = {&p};
  hipLaunchCooperativeKernel((void*)mega, dim3(grid_blocks), dim3(256), args, 0, stream);
}
```

```cpp
#include <hip/hip_runtime.h>
#include <hip/hip_cooperative_groups.h>
#include <stdint.h>
#include <stddef.h>
namespace cg = cooperative_groups;

typedef unsigned short bf16_t;
typedef short bf16x8 __attribute__((ext_vector_type(8)));
typedef float f32x4 __attribute__((ext_vector_type(4)));
typedef float f32x2 __attribute__((ext_vector_type(2)));
typedef unsigned u32x4 __attribute__((ext_vector_type(4)));
typedef unsigned u32x2 __attribute__((ext_vector_type(2)));
#define DI __device__ __forceinline__

constexpr int D = 1024, NB = 8, SEQ = 4096, T = NB * SEQ;
constexpr int NH = 16, HS = 64;
constexpr int NEXP = 16384;
constexpr float ALPHA = 1.4142135623730951f;
constexpr float LN_EPS = 1e-5f, GN_EPS = 64e-5f;
constexpr int LDS_BYTES = 72 * 1024;

typedef __bf16 bf16x2_t __attribute__((ext_vector_type(2)));
DI unsigned cvt_pk_bf16(float lo, float hi) { const f32x2 v = {lo, hi}; return __builtin_bit_cast(unsigned, __builtin_convertvector(v, bf16x2_t)); }
DI float bf_lo(unsigned u) { return __uint_as_float(u << 16); }
DI float bf_hi(unsigned u) { return __uint_as_float(u & 0xffff0000u); }
DI bf16_t f2bf(float f) { unsigned u = __float_as_uint(f); u += 0x7fffu + ((u >> 16) & 1u); return (bf16_t)(u >> 16); }
DI float sigmoidf_(float x) { return 1.f / (1.f + __expf(-x)); }
DI float wave_sum(float v) {
#pragma unroll
  for (int o = 32; o >= 1; o >>= 1) v += __shfl_xor(v, o);
  return v;
}
DI int opaque_v(int x) { asm volatile("" : "+v"(x)); return x; }
DI float gelu_exact(float v) {
  const float av = fabsf(v), t = __builtin_amdgcn_rcpf(av * 0.2316418882f + 1.0f);
  float q = t * 0.5307027145f + (-0.7265760135f); q = q * t + 0.7107068705f; q = q * t + (-0.142248368f); q = q * t + 0.127414796f; q = q * t;
  const float m = v * (q * __builtin_amdgcn_exp2f((v * v) * (-0.72134752044f)));
  return v < 0.f ? m : v - m;
}

#define XB_TMO      128
#define XB_XCNT(j)  (256  + 64 * (j))
#define XB_XSUB(j)  (1280 + 64 * (j))
#define XB_XGEN(j)  (2304 + 64 * (j))
#define XB_TOP      3328
#define XB_TOPGEN   3392
#define XCD_BAR_WORDS 3456
#define XB_SPIN_CAP (1u << 22)
#define LAS __attribute__((address_space(3)))
DI unsigned xb_ld(unsigned* p)              { return __hip_atomic_load(p, __ATOMIC_RELAXED, __HIP_MEMORY_SCOPE_AGENT); }
DI unsigned xb_add(unsigned* p, unsigned v) { return __hip_atomic_fetch_add(p, v, __ATOMIC_RELAXED, __HIP_MEMORY_SCOPE_AGENT); }
DI unsigned xb_xcc_id() { return (unsigned)__builtin_amdgcn_s_getreg((3 << 11) | 20) & 0xFu; }
#define XB_SPIN(cond, bar) do { unsigned _sp = 0; while (cond) { __builtin_amdgcn_s_sleep(1); \
    if ((++_sp & 255u) == 0u) { if (xb_ld(&(bar)[XB_TMO])) break; if (_sp > XB_SPIN_CAP) { atomicAdd(&(bar)[XB_TMO], 1u); break; } } } } while (0)
struct XcdBarrier { unsigned* bar; unsigned x; volatile LAS unsigned* st; };
DI XcdBarrier xcd_barrier_post(unsigned* bar, volatile LAS unsigned* st) {
  XcdBarrier b; b.bar = bar; b.x = xb_xcc_id(); b.st = st;
  if (threadIdx.x == 0) (void)xb_add(&bar[XB_XCNT(b.x)], 1u);
  return b;
}
DI void xcd_barrier_complete(unsigned* bar, unsigned x, unsigned& nloc, unsigned& nx) {
  const unsigned G = gridDim.x * gridDim.y * gridDim.z;
  unsigned sum, cnt, mine, sp = 0u;
  for (;;) {
    sum = 0u; cnt = 0u; mine = 0u;
#pragma unroll
    for (unsigned j = 0; j < 16; ++j) { const unsigned c = xb_ld(&bar[XB_XCNT(j)]); sum += c; cnt += (c > 0u) ? 1u : 0u; mine = (j == x) ? c : mine; }
    if (sum == G) break;
    __builtin_amdgcn_s_sleep(1);
    if ((++sp & 255u) == 0u) { if (xb_ld(&bar[XB_TMO])) break; if (sp > XB_SPIN_CAP) { atomicAdd(&bar[XB_TMO], 1u); break; } }
  }
  nloc = mine > 0u ? mine : 1u; nx = cnt > 0u ? cnt : 1u;
}
DI void xcd_barrier(const XcdBarrier& b0) {
  XcdBarrier b = b0; { unsigned xx = b0.x; asm volatile("" : "+s"(xx)); b.x = xx; }
  asm volatile("s_waitcnt vmcnt(0)" ::: "memory");
  __syncthreads();
  if (threadIdx.x == 0) {
    unsigned* bar = b.bar;
    __builtin_amdgcn_s_waitcnt(0);
    unsigned nloc = b.st[0], nx = b.st[1];
    if (nloc == 0u) { xcd_barrier_complete(bar, b.x, nloc, nx); b.st[0] = nloc; b.st[1] = nx; }
    const unsigned old = xb_add(&bar[XB_XSUB(b.x)], 1u);
    const unsigned gen = old / nloc;
    if (old + 1u == (gen + 1u) * nloc) {
      __builtin_amdgcn_fence(__ATOMIC_RELEASE, "agent");
      asm volatile("s_waitcnt vmcnt(0)" ::: "memory");
      const unsigned og = xb_add(&bar[XB_TOP], 1u);
      const unsigned tg = og / nx;
      if (og + 1u == (tg + 1u) * nx) xb_add(&bar[XB_TOPGEN], 1u);
      else XB_SPIN(xb_ld(&bar[XB_TOPGEN]) == tg, bar);
      __builtin_amdgcn_fence(__ATOMIC_ACQUIRE, "agent");
      xb_add(&bar[XB_XGEN(b.x)], 1u);
      asm volatile("s_waitcnt vmcnt(0)" ::: "memory");
    } else {
      XB_SPIN(xb_ld(&bar[XB_XGEN(b.x)]) == gen, bar);
      __builtin_amdgcn_fence(__ATOMIC_ACQUIRE, "agent");
      asm volatile("s_waitcnt vmcnt(0)" ::: "memory");
    }
  }
  __syncthreads();
}

struct Params {
  const float *x, *c, *ada_w, *ada_b, *ln_g, *ln_b, *rw_mu, *rw_w_rkv, *rw_w0, *rw_w1, *rw_w2, *rw_a0, *rw_a1, *rw_a2, *rw_g1, *rw_g2,
      *rw_k_k, *rw_k_a, *rw_r_k, *rw_lnx_g, *rw_lnx_b, *rw_w_o, *pl_w_in, *pl_w_grp, *pl_scale, *pl_w_out, *pe_w_q, *pe_keys, *pe_u, *pe_v;
  float* out;
  float* mod;
  bf16_t *WT_rkv, *W1T, *A1T, *G1T, *W2T, *A2T, *G2T, *WoT, *PinT, *PoutT, *WgrpS, *WcT, *WqB, *WeffT, *KeysB;
  unsigned char* slot[7];
  float* tinv;
  bf16_t* lora_tmp;
  float* Gg;
  unsigned* bar;
};

DI void mod_item(const Params& p, int item, unsigned char* lds) {
  float* cond = (float*)lds;
  float (*red)[NB][32] = (float (*)[NB][32])(lds + 32768);
  const int tid = opaque_v(threadIdx.x);
  for (int i = tid; i < NB * D; i += 256) { float v = p.c[i]; cond[i] = v / (1.f + __expf(-v)); }
  __syncthreads();
  const int l = item / 192, cb = item % 192;
  const int col = cb * 32 + (tid & 31), kg = tid >> 5;
  const float* w = p.ada_w + (size_t)l * D * 6144 + col;
  float acc[NB];
#pragma unroll
  for (int b = 0; b < NB; ++b) acc[b] = 0.f;
  for (int k = kg * 128; k < kg * 128 + 128; k += 8) {
    float wv[8];
#pragma unroll
    for (int u = 0; u < 8; ++u) wv[u] = w[(size_t)(k + u) * 6144];
#pragma unroll
    for (int u = 0; u < 8; ++u)
#pragma unroll
      for (int b = 0; b < NB; ++b) acc[b] += cond[b * D + k + u] * wv[u];
  }
#pragma unroll
  for (int b = 0; b < NB; ++b) red[kg][b][tid & 31] = acc[b];
  __syncthreads();
  {
    const int b = tid >> 5, cc = tid & 31;
    float s = 0.f;
#pragma unroll
    for (int g = 0; g < 8; ++g) s += red[g][b][cc];
    const int n = cb * 32 + cc;
    p.mod[((size_t)l * NB + b) * 6144 + n] = s + p.ada_b[l * 6144 + n];
  }
  __syncthreads();
}

DI void transpose_item(const float* __restrict__ src, bf16_t* __restrict__ dst, int K, int N, int Kpad, int Npad, size_t sbs, size_t dbs, int item, unsigned char* lds) {
  float (*tile)[33] = (float (*)[33])lds;
  const int nb_n = Npad / 32, nb_k = Kpad / 32;
  const int per = nb_n * nb_k;
  const int bz = item / per, r = item % per;
  const int bk = r / nb_n, bn = r % nb_n;
  src += bz * sbs; dst += bz * dbs;
  const int tq = opaque_v(threadIdx.x); const int tx = tq & 31, ty = tq >> 5;
#pragma unroll
  for (int i = 0; i < 4; ++i) {
    const int k = bk * 32 + ty + i * 8, n = bn * 32 + tx;
    tile[ty + i * 8][tx] = (k < K && n < N) ? src[(size_t)k * N + n] : 0.f;
  }
  __syncthreads();
#pragma unroll
  for (int i = 0; i < 4; ++i) {
    const int n = bn * 32 + ty + i * 8, k = bk * 32 + tx;
    dst[(size_t)n * Kpad + k] = f2bf(tile[tx][ty + i * 8]);
  }
  __syncthreads();
}
DI void cvt_range(const float* __restrict__ src, bf16_t* __restrict__ dst, size_t n8, int bid, int nblk) {
  const int tq = opaque_v(threadIdx.x);
  for (size_t i = (size_t)bid * 256 + tq; i < n8; i += (size_t)nblk * 256) {
    const f32x4 a = *(const f32x4*)(src + i * 8), b = *(const f32x4*)(src + i * 8 + 4);
    u32x4 o; o.x = cvt_pk_bf16(a[0], a[1]); o.y = cvt_pk_bf16(a[2], a[3]); o.z = cvt_pk_bf16(b[0], b[1]); o.w = cvt_pk_bf16(b[2], b[3]);
    *(u32x4*)(dst + i * 8) = o;
  }
}
DI void prologue_phase(const Params& p, unsigned char* lds, int bid, int nblk) {
  constexpr int total = 384 + 3072 + 128 + 128 + 256 + 64 + 64 + 192 + 1024 + 1024 + 1024;
  for (int it = bid; it < total; it += nblk) {
    int r = it;
    if (r < 384) { mod_item(p, r, lds); continue; } r -= 384;
    if (r < 3072) { transpose_item(p.rw_w_rkv, p.WT_rkv, D, D, D, D, (size_t)D * D, (size_t)D * D, r, lds); continue; } r -= 3072;
    if (r < 128) { transpose_item(p.rw_w1, p.W1T, D, 64, D, 128, 0, 0, r, lds); continue; } r -= 128;
    if (r < 128) { transpose_item(p.rw_a1, p.A1T, D, 64, D, 128, 0, 0, r, lds); continue; } r -= 128;
    if (r < 256) { transpose_item(p.rw_g1, p.G1T, D, 160, D, 256, 0, 0, r, lds); continue; } r -= 256;
    if (r < 64) { transpose_item(p.rw_w2, p.W2T, 64, D, 64, D, 0, 0, r, lds); continue; } r -= 64;
    if (r < 64) { transpose_item(p.rw_a2, p.A2T, 64, D, 64, D, 0, 0, r, lds); continue; } r -= 64;
    if (r < 192) { transpose_item(p.rw_g2, p.G2T, 160, D, 192, D, 0, 0, r, lds); continue; } r -= 192;
    if (r < 1024) { transpose_item(p.rw_w_o, p.WoT, D, D, D, D, 0, 0, r, lds); continue; } r -= 1024;
    if (r < 1024) { transpose_item(p.pl_w_in, p.PinT, D, D, D, D, 0, 0, r, lds); continue; } r -= 1024;
    transpose_item(p.pl_w_out, p.PoutT, D, D, D, D, 0, 0, r, lds);
  }
  cvt_range(p.pe_keys, p.KeysB, (size_t)2 * 16 * 128 * 128 / 8, bid, nblk);
  cvt_range(p.pe_w_q, p.WqB, (size_t)2 * D * 2048 / 8, bid, nblk);
  {
    const int tq = opaque_v(threadIdx.x);
    for (int i = bid * 256 + tq; i < 4 * 256 * 256 / 8; i += nblk * 256) {
      const int e0 = (i * 8) & 255, g4 = (i * 8) >> 16;
      const f32x4 a0 = *(const f32x4*)(p.pl_w_grp + (size_t)i * 8), a1 = *(const f32x4*)(p.pl_w_grp + (size_t)i * 8 + 4);
      const f32x4 s0 = *(const f32x4*)(p.pl_scale + g4 * 256 + e0), s1 = *(const f32x4*)(p.pl_scale + g4 * 256 + e0 + 4);
      const f32x4 b0 = a0 * s0, b1 = a1 * s1;
      *(u32x4*)(p.WgrpS + (size_t)i * 8) = (u32x4){cvt_pk_bf16(b0[0], b0[1]), cvt_pk_bf16(b0[2], b0[3]), cvt_pk_bf16(b1[0], b1[1]), cvt_pk_bf16(b1[2], b1[3])};
    }
  }
}

DI void modulate_phase(const float* __restrict__ x, const float* __restrict__ mod_l, const float* __restrict__ mu, bf16_t* __restrict__ h, bf16_t* __restrict__ xr, bf16_t* __restrict__ xk,
                       bf16_t* __restrict__ xv, int bid, int nblk) {
  const size_t n8 = (size_t)T * D / 8; const int tq = opaque_v(threadIdx.x);
  for (size_t i = (size_t)bid * 256 + tq; i < n8; i += (size_t)nblk * 256) {
    const size_t e = i * 8; const int t = (int)(e / D), d = (int)(e % D), b = t / SEQ;
    const float* sh = mod_l + (size_t)b * 6144 + 0 * D + d; const float* sc = mod_l + (size_t)b * 6144 + 1 * D + d;
    float hv[8], pv[8];
    {
      const f32x4 a0 = *(const f32x4*)(x + e), a1 = *(const f32x4*)(x + e + 4);
      const f32x4 s0 = *(const f32x4*)sh, s1 = *(const f32x4*)(sh + 4), c0 = *(const f32x4*)sc, c1 = *(const f32x4*)(sc + 4);
      const f32x4 r0 = a0 * (c0 + 1.f) + s0, r1 = a1 * (c1 + 1.f) + s1;
      f32x4 q0 = {0.f, 0.f, 0.f, 0.f}, q1 = {0.f, 0.f, 0.f, 0.f};
      if ((t % SEQ) != 0) { const f32x4 b0 = *(const f32x4*)(x + e - D), b1 = *(const f32x4*)(x + e - D + 4); q0 = b0 * (c0 + 1.f) + s0; q1 = b1 * (c1 + 1.f) + s1; }
#pragma unroll
      for (int j = 0; j < 4; ++j) { hv[j] = r0[j]; hv[4 + j] = r1[j]; pv[j] = q0[j]; pv[4 + j] = q1[j]; }
    }
    u32x4 o; o.x = cvt_pk_bf16(hv[0], hv[1]); o.y = cvt_pk_bf16(hv[2], hv[3]); o.z = cvt_pk_bf16(hv[4], hv[5]); o.w = cvt_pk_bf16(hv[6], hv[7]);
    *(u32x4*)(h + e) = o;
#pragma unroll
    for (int n = 0; n < 3; ++n) {
      const f32x4 m0 = *(const f32x4*)(mu + n * D + d), m1 = *(const f32x4*)(mu + n * D + d + 4);
      float w[8];
#pragma unroll
      for (int j = 0; j < 8; ++j) { const float m = j < 4 ? m0[j] : m1[j - 4]; w[j] = hv[j] + (pv[j] - hv[j]) * m; }
      u32x4 q; q.x = cvt_pk_bf16(w[0], w[1]); q.y = cvt_pk_bf16(w[2], w[3]); q.z = cvt_pk_bf16(w[4], w[5]); q.w = cvt_pk_bf16(w[6], w[7]);
      *(u32x4*)((n == 0 ? xr : (n == 1 ? xk : xv)) + e) = q;
    }
  }
}

enum { EPI_BF16 = 0, EPI_TANH, EPI_SIGMOID, EPI_LW, EPI_ASIG, EPI_Z, EPI_SCALE, EPI_GATE, EPI_TOPK };
struct GemmArgs {
  const bf16_t* A; int lda;
  const bf16_t* Bt; int ldb;
  int N, K;
  const float* mu;
  int epi; void* out; int ldc;
  const float* v0; const float* v1;
};

DI int lds_off(int row, int chunk) { return row * 128 + ((chunk ^ (row & 7)) << 4); }

DI void gemm_load_a(const GemmArgs& g, int m0, int k0, int tid, u32x4 (&ra)[4]) {
#pragma unroll
  for (int i = 0; i < 4; ++i) {
    const int row = (tid >> 3) + i * 32, ch = tid & 7;
    const int m = m0 + row;
    const bf16_t* src = g.A + (size_t)m * g.lda + k0 + ch * 8;
    u32x4 v = *(const u32x4*)src;
    if (g.mu) {
      u32x4 pv = {0u, 0u, 0u, 0u};
      if ((m % SEQ) != 0) pv = *(const u32x4*)(src - g.lda);
      const f32x4 m0v = *(const f32x4*)(g.mu + k0 + ch * 8), m1v = *(const f32x4*)(g.mu + k0 + ch * 8 + 4);
      const unsigned hu[4] = {v.x, v.y, v.z, v.w}, pu[4] = {pv.x, pv.y, pv.z, pv.w};
      float o[8];
#pragma unroll
      for (int j = 0; j < 4; ++j) {
        const float h0 = bf_lo(hu[j]), h1 = bf_hi(hu[j]), p0 = bf_lo(pu[j]), p1 = bf_hi(pu[j]);
        const float mu0 = (2 * j < 4) ? m0v[(2 * j) & 3] : m1v[(2 * j) & 3], mu1 = (2 * j + 1 < 4) ? m0v[(2 * j + 1) & 3] : m1v[(2 * j + 1) & 3];
        o[2 * j] = h0 + (p0 - h0) * mu0; o[2 * j + 1] = h1 + (p1 - h1) * mu1;
      }
      v.x = cvt_pk_bf16(o[0], o[1]); v.y = cvt_pk_bf16(o[2], o[3]); v.z = cvt_pk_bf16(o[4], o[5]); v.w = cvt_pk_bf16(o[6], o[7]);
    }
    ra[i] = v;
  }
}
DI void gemm_load_b(const GemmArgs& g, int n0, int k0, int tid, u32x4 (&rb)[4]) {
#pragma unroll
  for (int i = 0; i < 4; ++i) {
    const int row = (tid >> 3) + i * 32, ch = tid & 7;
    rb[i] = *(const u32x4*)(g.Bt + (size_t)(n0 + row) * g.ldb + k0 + ch * 8);
  }
}
DI void gemm_store_lds(unsigned char* buf, int tid, const u32x4 (&r)[4]) {
#pragma unroll
  for (int i = 0; i < 4; ++i) {
    const int row = (tid >> 3) + i * 32, ch = tid & 7;
    *(u32x4*)(buf + lds_off(row, ch)) = r[i];
  }
}

DI unsigned f2key(float f) { unsigned u = __float_as_uint(f); return u ^ ((u >> 31) ? 0xffffffffu : 0x80000000u); }
DI float key2f(unsigned k) { unsigned u = (k >> 31) ? (k ^ 0x80000000u) : ~k; return __uint_as_float(u); }
#define CE_DESC(a, b) { const unsigned _mx = max(a, b), _mn = min(a, b); a = _mx; b = _mn; }
DI void sort16_desc(unsigned (&x)[16]) {
#pragma unroll
  for (int k = 2; k <= 16; k <<= 1) {
#pragma unroll
    for (int j = k >> 1; j > 0; j >>= 1) {
#pragma unroll
      for (int i = 0; i < 16; ++i) {
        const int l = i ^ j;
        if (l > i) {
          if ((i & k) == 0) { CE_DESC(x[i], x[l]); } else { CE_DESC(x[l], x[i]); }
        }
      }
    }
  }
}
DI void merge16_desc(unsigned (&x)[16]) {
#pragma unroll
  for (int j = 8; j > 0; j >>= 1) {
#pragma unroll
    for (int i = 0; i < 16; ++i) { const int l = i ^ j; if (l > i) { CE_DESC(x[i], x[l]); } }
  }
}

DI void peer_combine(const unsigned* la, const unsigned* lb, const unsigned (&s2k)[16], unsigned short* __restrict__ epk_row, float* __restrict__ gate_row) {
  float s1[16], s2[16];
#pragma unroll
  for (int i = 0; i < 4; ++i) {
    const u32x4 a = *(const u32x4*)(la + i * 4);
    s1[i * 4] = key2f(a.x & ~127u); s1[i * 4 + 1] = key2f(a.y & ~127u); s1[i * 4 + 2] = key2f(a.z & ~127u); s1[i * 4 + 3] = key2f(a.w & ~127u);
  }
#pragma unroll
  for (int i = 0; i < 16; ++i) s2[i] = key2f(s2k[i] & ~127u);
  unsigned c[4][16];
  {
    int n = 0;
#pragma unroll
    for (int a = 0; a < 16; ++a)
#pragma unroll
      for (int b = 0; b < 16; ++b)
        if ((a + 1) * (b + 1) <= 16) { c[n >> 4][n & 15] = (f2key(s1[a] + s2[b]) & ~255u) | (unsigned)(255 - (a * 16 + b)); ++n; }
#pragma unroll
    for (int q = 50; q < 64; ++q) c[q >> 4][q & 15] = 0u;
  }
  sort16_desc(c[0]); sort16_desc(c[1]); sort16_desc(c[2]); sort16_desc(c[3]);
#pragma unroll
  for (int e = 0; e < 16; ++e) { c[0][e] = max(c[0][e], c[1][15 - e]); c[2][e] = max(c[2][e], c[3][15 - e]); }
  merge16_desc(c[0]); merge16_desc(c[2]);
#pragma unroll
  for (int e = 0; e < 16; ++e) c[0][e] = max(c[0][e], c[2][15 - e]);
  merge16_desc(c[0]);
  float best[16], den = 0.f;
  const float mx = key2f(c[0][0] & ~255u);
#pragma unroll
  for (int e = 0; e < 16; ++e) { best[e] = __expf(key2f(c[0][e] & ~255u) - mx); den += best[e]; }
  const float inv = 1.f / den;
  unsigned idw[8];
#pragma unroll
  for (int e = 0; e < 16; ++e) {
    const int pos = 255 - (int)(c[0][e] & 255u), a = pos >> 4, b = pos & 15;
    const unsigned i1 = 127u - (la[a] & 127u), i2 = 127u - (lb[b] & 127u);
    const unsigned id = i1 * 128u + i2;
    if (e & 1) idw[e >> 1] |= id << 16; else idw[e >> 1] = id;
    best[e] *= inv;
  }
  ((u32x4*)epk_row)[0] = (u32x4){idw[0], idw[1], idw[2], idw[3]}; ((u32x4*)epk_row)[1] = (u32x4){idw[4], idw[5], idw[6], idw[7]};
#pragma unroll
  for (int q = 0; q < 4; ++q) ((f32x4*)gate_row)[q] = (f32x4){best[q * 4], best[q * 4 + 1], best[q * 4 + 2], best[q * 4 + 3]};
}

DI void gemm_glds(const bf16_t* __restrict__ base, int ld, int r0, int k0, unsigned char* buf, int wid, int lane) {
  const bf16_t* src = base + (size_t)(r0 + wid * 8 + (lane >> 3)) * ld + k0 + (((lane & 7) ^ (lane >> 3)) << 3);
#pragma unroll
  for (int j = 0; j < 4; ++j)
    __builtin_amdgcn_global_load_lds((const unsigned*)(src + (size_t)j * 32 * ld), (unsigned*)(buf + (j * 4 + wid) * 1024), 16, 0, 0);
}
DI void gemm_tile(const GemmArgs& g, int m0, int n0, unsigned char* lds) {
  constexpr int WM = 2, WN = 4 / WM, TM = 128 / WM, TN = 128 / WN, MI = TM / 16, NI = TN / 16;
  const int tid = opaque_v(threadIdx.x), lane = tid & 63, wid = tid >> 6;
  const int wm = wid / WN, wn = wid % WN;
  const int nk = g.K / 64;
  const bool lerp = g.mu != nullptr;
  f32x4 acc[MI][NI];
#pragma unroll
  for (int i = 0; i < MI; ++i)
#pragma unroll
    for (int j = 0; j < NI; ++j) acc[i][j] = (f32x4){0.f, 0.f, 0.f, 0.f};
  u32x4 ra[4];
  if (lerp) { gemm_load_a(g, m0, 0, tid, ra); gemm_store_lds(lds, tid, ra); } else gemm_glds(g.A, g.lda, m0, 0, lds, wid, lane);
  gemm_glds(g.Bt, g.ldb, n0, 0, lds + 16384, wid, lane);
  asm volatile("s_waitcnt vmcnt(0)" ::: "memory");
  __syncthreads();
  const int fr = lane & 15, fq = lane >> 4;
  for (int kt = 0; kt < nk; ++kt) {
    unsigned char* cur = lds + (kt & 1) * 32768;
    unsigned char* nxt = lds + ((kt + 1) & 1) * 32768;
    if (kt + 1 < nk) {
      if (lerp) gemm_load_a(g, m0, (kt + 1) * 64, tid, ra); else gemm_glds(g.A, g.lda, m0, (kt + 1) * 64, nxt, wid, lane);
      gemm_glds(g.Bt, g.ldb, n0, (kt + 1) * 64, nxt + 16384, wid, lane);
    }
    {
      bf16x8 af[2][MI], bfr[2][NI];
#pragma unroll
      for (int ks = 0; ks < 2; ++ks) {
#pragma unroll
        for (int i = 0; i < MI; ++i) af[ks][i] = *(const bf16x8*)(cur + lds_off(wm * TM + i * 16 + fr, ks * 4 + fq));
#pragma unroll
        for (int j = 0; j < NI; ++j) bfr[ks][j] = *(const bf16x8*)(cur + 16384 + lds_off(wn * TN + j * 16 + fr, ks * 4 + fq));
      }
      __builtin_amdgcn_sched_barrier(0);
#pragma unroll
      for (int ks = 0; ks < 2; ++ks)
#pragma unroll
        for (int i = 0; i < MI; ++i)
#pragma unroll
          for (int j = 0; j < NI; ++j) acc[i][j] = __builtin_amdgcn_mfma_f32_16x16x32_bf16(bfr[ks][j], af[ks][i], acc[i][j], 0, 0, 0);
      __builtin_amdgcn_sched_barrier(0);
    }
    if (lerp && kt + 1 < nk) gemm_store_lds(nxt, tid, ra);
    asm volatile("s_waitcnt vmcnt(0)" ::: "memory");
    __syncthreads();
  }
  if (g.epi == EPI_TOPK) {
    const int grp = n0 >> 7, head = grp >> 1, half = grp & 1;
#pragma unroll
    for (int i = 0; i < MI; ++i)
#pragma unroll
      for (int j = 0; j < NI; ++j) {
        const int ml = wm * TM + i * 16 + fr, c = wn * 16 + j * 4 + fq;
        u32x4 kv;
        kv.x = (f2key(acc[i][j][0]) & ~127u) | (unsigned)(127 - (c * 4 + 0)); kv.y = (f2key(acc[i][j][1]) & ~127u) | (unsigned)(127 - (c * 4 + 1));
        kv.z = (f2key(acc[i][j][2]) & ~127u) | (unsigned)(127 - (c * 4 + 2)); kv.w = (f2key(acc[i][j][3]) & ~127u) | (unsigned)(127 - (c * 4 + 3));
        *(u32x4*)(lds + ml * 512 + ((c ^ (ml & 31)) << 4)) = kv;
      }
    __syncthreads();
    {
      const int ml = wid * 32 + (lane & 31), hf = lane >> 5;
      unsigned a[16], b[16];
#pragma unroll
      for (int ch = 0; ch < 4; ++ch) {
#pragma unroll
        for (int cc = 0; cc < 4; ++cc) {
          const int c = hf * 16 + ch * 4 + cc;
          const u32x4 kv = *(const u32x4*)(lds + ml * 512 + ((c ^ (ml & 31)) << 4));
          b[cc * 4] = kv.x; b[cc * 4 + 1] = kv.y; b[cc * 4 + 2] = kv.z; b[cc * 4 + 3] = kv.w;
        }
        sort16_desc(b);
        if (ch == 0) {
#pragma unroll
          for (int e = 0; e < 16; ++e) a[e] = b[e];
        } else {
#pragma unroll
          for (int e = 0; e < 16; ++e) a[e] = max(a[e], b[15 - e]);
          merge16_desc(a);
        }
      }
#pragma unroll
      for (int e = 0; e < 16; ++e) b[e] = (unsigned)__shfl_xor((int)a[e], 32);
#pragma unroll
      for (int e = 0; e < 16; ++e) a[e] = max(a[e], b[15 - e]);
      merge16_desc(a);
      if (hf == 0) {
        unsigned* park = (unsigned*)(lds + (half == 0 ? 65536 + ml * 64 : ml * 512));
        ((u32x4*)park)[0] = (u32x4){a[0], a[1], a[2], a[3]}; ((u32x4*)park)[1] = (u32x4){a[4], a[5], a[6], a[7]};
        ((u32x4*)park)[2] = (u32x4){a[8], a[9], a[10], a[11]}; ((u32x4*)park)[3] = (u32x4){a[12], a[13], a[14], a[15]};
        if (half == 1) {
          const size_t m = (size_t)(m0 + ml);
          peer_combine((const unsigned*)(lds + 65536 + ml * 64), park, a, (unsigned short*)g.out + m * 128 + head * 16, (float*)g.v0 + m * 128 + head * 16);
        }
      }
    }
    __syncthreads();
    return;
  }
#pragma unroll
  for (int i = 0; i < MI; ++i) {
    const int m = m0 + wm * TM + i * 16 + fr;
#pragma unroll
    for (int j = 0; j < NI; ++j) {
      const int n = n0 + wn * TN + j * 16 + fq * 4;
      if (n >= g.N) continue;
      const f32x4 v = acc[i][j];
      bf16_t* ob = (bf16_t*)g.out + (size_t)m * g.ldc + n;
      switch (g.epi) {
        case EPI_BF16: *(u32x2*)ob = (u32x2){cvt_pk_bf16(v[0], v[1]), cvt_pk_bf16(v[2], v[3])}; break;
        case EPI_TANH: *(u32x2*)ob = (u32x2){cvt_pk_bf16(tanhf(v[0]), tanhf(v[1])), cvt_pk_bf16(tanhf(v[2]), tanhf(v[3]))}; break;
        case EPI_SIGMOID: *(u32x2*)ob = (u32x2){cvt_pk_bf16(sigmoidf_(v[0]), sigmoidf_(v[1])), cvt_pk_bf16(sigmoidf_(v[2]), sigmoidf_(v[3]))}; break;
        case EPI_LW: {
          const f32x4 w0 = *(const f32x4*)(g.v0 + n); float o[4];
#pragma unroll
          for (int q = 0; q < 4; ++q) { const float xx = -(w0[q] + v[q]); const float sp = fmaxf(xx, 0.f) + __logf(1.f + __expf(-fabsf(xx))); o[q] = -__expf(-sp - 0.5f); }
          *(u32x2*)ob = (u32x2){cvt_pk_bf16(o[0], o[1]), cvt_pk_bf16(o[2], o[3])};
        } break;
        case EPI_ASIG: {
          const f32x4 a0 = *(const f32x4*)(g.v0 + n);
          *(u32x2*)ob = (u32x2){cvt_pk_bf16(sigmoidf_(a0[0] + v[0]), sigmoidf_(a0[1] + v[1])), cvt_pk_bf16(sigmoidf_(a0[2] + v[2]), sigmoidf_(a0[3] + v[3]))};
        } break;
        case EPI_Z: {
          const int b = m / SEQ;
          const f32x4 xv = *(const f32x4*)(g.v0 + (size_t)m * D + n), gt = *(const f32x4*)(g.v1 + (size_t)b * 6144 + n);
          *(f32x4*)((float*)g.out + (size_t)m * g.ldc + n) = xv * ALPHA + gt * v;
        } break;
        case EPI_GATE: {
          const u32x2 yv = *(const u32x2*)ob;
          *(u32x2*)ob = (u32x2){cvt_pk_bf16(bf_lo(yv.x) * v[0], bf_hi(yv.x) * v[1]), cvt_pk_bf16(bf_lo(yv.y) * v[2], bf_hi(yv.y) * v[3])};
        } break;
        default: {
          const f32x4 sc = *(const f32x4*)(g.v0 + n);
          *(u32x2*)ob = (u32x2){cvt_pk_bf16(v[0] * sc[0], v[1] * sc[1]), cvt_pk_bf16(v[2] * sc[2], v[3] * sc[3])};
        } break;
      }
    }
  }
}

DI int lds_off32(int row, int chunk) { return row * 64 + ((chunk ^ (((row >> 3) & 1) << 1)) << 4); }
DI void gemm256_issue(const GemmArgs& g, int m0, int n0, int k0, unsigned char* buf, int wid, int lane) {
  const int lr = lane >> 2, gc = ((lane & 3) ^ ((lane >> 5) << 1)) << 3;
  const bf16_t* sa = g.A + (size_t)(m0 + wid * 16 + lr) * g.lda + k0 + gc;
#pragma unroll
  for (int j = 0; j < 4; ++j) __builtin_amdgcn_global_load_lds((const unsigned*)(sa + (size_t)j * 64 * g.lda), (unsigned*)(buf + (j * 4 + wid) * 1024), 16, 0, 0);
  const bf16_t* sb = g.Bt + (size_t)(n0 + wid * 16 + lr) * g.ldb + k0 + gc;
#pragma unroll
  for (int j = 0; j < 2; ++j) __builtin_amdgcn_global_load_lds((const unsigned*)(sb + (size_t)j * 64 * g.ldb), (unsigned*)(buf + 16384 + (j * 4 + wid) * 1024), 16, 0, 0);
}
DI void gemm_tile256(const GemmArgs& g, int m0, int n0, unsigned char* lds) {
  constexpr int MI = 8, NI = 4, STG = 24576;
  const int tid = opaque_v(threadIdx.x), lane = tid & 63, wid = tid >> 6, wm = wid >> 1, wn = wid & 1, fr = lane & 15, fq = lane >> 4;
  const int nk = g.K / 32;
  f32x4 acc[MI][NI];
#pragma unroll
  for (int i = 0; i < MI; ++i)
#pragma unroll
    for (int j = 0; j < NI; ++j) acc[i][j] = (f32x4){0.f, 0.f, 0.f, 0.f};
  __syncthreads();
  gemm256_issue(g, m0, n0, 0, lds, wid, lane);
  if (nk > 1) gemm256_issue(g, m0, n0, 32, lds + STG, wid, lane);
  int sc = 0, sn = 2;
  for (int kt = 0; kt < nk; ++kt) {
    if (kt + 1 < nk) asm volatile("s_waitcnt vmcnt(6)" ::: "memory"); else asm volatile("s_waitcnt vmcnt(0)" ::: "memory");
    __builtin_amdgcn_s_barrier();
    if (kt + 2 < nk) gemm256_issue(g, m0, n0, (kt + 2) * 32, lds + sn * STG, wid, lane);
    const unsigned char* cur = lds + sc * STG;
    bf16x8 af[MI], bfr[NI];
#pragma unroll
    for (int i = 0; i < MI; ++i) af[i] = *(const bf16x8*)(cur + lds_off32(wm * 128 + i * 16 + fr, fq));
#pragma unroll
    for (int j = 0; j < NI; ++j) bfr[j] = *(const bf16x8*)(cur + 16384 + lds_off32(wn * 64 + j * 16 + fr, fq));
#pragma unroll
    for (int i = 0; i < MI; ++i)
#pragma unroll
      for (int j = 0; j < NI; ++j) acc[i][j] = __builtin_amdgcn_mfma_f32_16x16x32_bf16(bfr[j], af[i], acc[i][j], 0, 0, 0);
    sc = (sc == 2) ? 0 : sc + 1; sn = (sn == 2) ? 0 : sn + 1;
  }
  if (g.epi == EPI_TOPK) {
    const int grp = n0 >> 7, head = grp >> 1, half = grp & 1;
    unsigned* parkg = (unsigned*)g.v1;
#pragma unroll 1
    for (int hb = 0; hb < 2; ++hb) {
      __syncthreads();
      if (wm == hb) {
#pragma unroll
        for (int i = 0; i < MI; ++i)
#pragma unroll
          for (int j = 0; j < NI; ++j) {
            const int ml = i * 16 + fr, c = wn * 16 + j * 4 + fq;
            u32x4 kv;
            kv.x = (f2key(acc[i][j][0]) & ~127u) | (unsigned)(127 - (c * 4 + 0)); kv.y = (f2key(acc[i][j][1]) & ~127u) | (unsigned)(127 - (c * 4 + 1));
            kv.z = (f2key(acc[i][j][2]) & ~127u) | (unsigned)(127 - (c * 4 + 2)); kv.w = (f2key(acc[i][j][3]) & ~127u) | (unsigned)(127 - (c * 4 + 3));
            *(u32x4*)(lds + ml * 512 + ((c ^ (ml & 31)) << 4)) = kv;
          }
      }
      __syncthreads();
      const int ml = wid * 32 + (lane & 31), hf = lane >> 5;
      unsigned a[16], b[16];
#pragma unroll 1
      for (int ch = 0; ch < 4; ++ch) {
#pragma unroll
        for (int cc = 0; cc < 4; ++cc) {
          const int c = hf * 16 + ch * 4 + cc;
          const u32x4 kv = *(const u32x4*)(lds + ml * 512 + ((c ^ (ml & 31)) << 4));
          b[cc * 4] = kv.x; b[cc * 4 + 1] = kv.y; b[cc * 4 + 2] = kv.z; b[cc * 4 + 3] = kv.w;
        }
        sort16_desc(b);
        if (ch == 0) {
#pragma unroll
          for (int e = 0; e < 16; ++e) a[e] = b[e];
        } else {
#pragma unroll
          for (int e = 0; e < 16; ++e) a[e] = max(a[e], b[15 - e]);
          merge16_desc(a);
        }
      }
#pragma unroll
      for (int e = 0; e < 16; ++e) b[e] = (unsigned)__shfl_xor((int)a[e], 32);
#pragma unroll
      for (int e = 0; e < 16; ++e) a[e] = max(a[e], b[15 - e]);
      merge16_desc(a);
      if (hf == 0) {
        unsigned* pg = parkg + (hb * 128 + ml) * 16;
        if (half == 0) {
          ((u32x4*)pg)[0] = (u32x4){a[0], a[1], a[2], a[3]}; ((u32x4*)pg)[1] = (u32x4){a[4], a[5], a[6], a[7]};
          ((u32x4*)pg)[2] = (u32x4){a[8], a[9], a[10], a[11]}; ((u32x4*)pg)[3] = (u32x4){a[12], a[13], a[14], a[15]};
        } else {
          unsigned* row = (unsigned*)(lds + ml * 512);
          ((u32x4*)row)[0] = (u32x4){a[0], a[1], a[2], a[3]}; ((u32x4*)row)[1] = (u32x4){a[4], a[5], a[6], a[7]};
          ((u32x4*)row)[2] = (u32x4){a[8], a[9], a[10], a[11]}; ((u32x4*)row)[3] = (u32x4){a[12], a[13], a[14], a[15]};
#pragma unroll
          for (int e = 0; e < 16; ++e) row[16 + e] = __hip_atomic_load(pg + e, __ATOMIC_RELAXED, __HIP_MEMORY_SCOPE_AGENT);
          const size_t m = (size_t)(m0 + hb * 128 + ml);
          peer_combine(row + 16, row, a, (unsigned short*)g.out + m * 128 + head * 16, (float*)g.v0 + m * 128 + head * 16);
        }
      }
    }
    __syncthreads();
    return;
  }
#pragma unroll
  for (int i = 0; i < MI; ++i) {
    const int m = m0 + wm * 128 + i * 16 + fr;
#pragma unroll
    for (int j = 0; j < NI; ++j) {
      const int n = n0 + wn * 64 + j * 16 + fq * 4;
      const f32x4 v = acc[i][j];
      if (g.epi == EPI_Z) {
        const int b = m / SEQ;
        const f32x4 xv = *(const f32x4*)(g.v0 + (size_t)m * D + n), gt = *(const f32x4*)(g.v1 + (size_t)b * 6144 + n);
        *(f32x4*)((float*)g.out + (size_t)m * g.ldc + n) = xv * ALPHA + gt * v;
      } else {
        *(u32x2*)((bf16_t*)g.out + (size_t)m * g.ldc + n) = (u32x2){cvt_pk_bf16(v[0], v[1]), cvt_pk_bf16(v[2], v[3])};
      }
    }
  }
}

DI GemmArgs mk(const bf16_t* A, int lda, const bf16_t* Bt, int ldb, int N, int K, int epi, void* out, int ldc,
               const float* mu = nullptr, const float* v0 = nullptr, const float* v1 = nullptr) {
  GemmArgs g; g.A = A; g.lda = lda; g.Bt = Bt; g.ldb = ldb; g.N = N; g.K = K; g.mu = mu; g.epi = epi; g.out = out; g.ldc = ldc; g.v0 = v0; g.v1 = v1; return g;
}
DI int sched_iters(int ntn, int nblk, int nmt = 256) {
  const int LB = nblk >> 3; int it = 0;
  for (int n0 = 0; n0 < ntn;) { int NT = min(8, ntn - n0); while (LB % NT) --NT; const int MT = LB / NT; it += (nmt + 8 * MT - 1) / (8 * MT); n0 += NT; }
  return it;
}
DI bool sched_mn(int i, int bid, int nblk, int ntn, int& mt, int& nt, int nmt = 256) {
  const int x = bid & 7, l = bid >> 3, LB = nblk >> 3; int base = 0;
  for (int n0 = 0; n0 < ntn;) {
    int NT = min(8, ntn - n0); while (LB % NT) --NT;
    const int MT = LB / NT, rounds = (nmt + 8 * MT - 1) / (8 * MT);
    if (i < base + rounds) { mt = (i - base) * 8 * MT + x * MT + (l % MT); nt = n0 + l / MT; return mt < nmt; }
    base += rounds; n0 += NT;
  }
  return false;
}

constexpr int CL = 32;
constexpr int NCH = SEQ / CL;
constexpr int SN = 144, ST = 80;
struct ScanArgs {
  bf16_t* r; const bf16_t *k, *v, *lw, *a;
  const float *k_k, *k_a, *r_k, *lnx_g, *lnx_b;
  bf16_t* Pg;
  bf16_t *Qz0, *Qz1;
  float* Gg;
};
DI int tr_off(int row, int tok) { return row * ST + ((((tok >> 3) ^ ((row >> 3) & 3)) << 4) | ((tok & 7) << 1)); }
template <bool PT, bool QT>
DI f32x4 tile_mm(const unsigned char* P, int ps, const unsigned char* Q, int qs, int i0, int j0, int nks, f32x4 acc, int lane) {
  const int fr = lane & 15, fq = lane >> 4;
  for (int ks = 0; ks < nks; ++ks) {
    const bf16x8 pa = *(const bf16x8*)(PT ? P + tr_off(i0 + fr, fq * 8) : P + (i0 + fr) * ps + ks * 64 + fq * 16);
    const bf16x8 qb = *(const bf16x8*)(QT ? Q + tr_off(j0 + fr, fq * 8) : Q + (j0 + fr) * qs + ks * 64 + fq * 16);
    acc = __builtin_amdgcn_mfma_f32_16x16x32_bf16(pa, qb, acc, 0, 0, 0);
  }
  return acc;
}
DI bf16_t* qz_ptr(const ScanArgs& s, int ch) { return ((ch >> 13) ? s.Qz1 : s.Qz0) + (size_t)(ch & 8191) * 4096; }
DI void st_bf16x4(unsigned char* p, const f32x4& v) { *(u32x2*)p = (u32x2){cvt_pk_bf16(v[0], v[1]), cvt_pk_bf16(v[2], v[3])}; }

struct ScanIn { u32x4 r, k, v, w, a, z0, z1; f32x4 kk0, kk1, ka0, ka1, rk0, rk1; };
template <bool PHASE_C>
DI void scan_fetch(const ScanArgs& s, int item, ScanIn& in) {
  const int c = item & (NCH - 1), h = (item >> 7) & 15, b = item >> 11;
  const int tid = opaque_v(threadIdx.x), tt = tid >> 3, c0 = (tid & 7) * 8;
  const size_t off = ((size_t)b * SEQ + (size_t)c * CL + tt) * D + h * HS + c0;
  in.k = *(const u32x4*)(s.k + off); in.v = *(const u32x4*)(s.v + off); in.w = *(const u32x4*)(s.lw + off); in.a = *(const u32x4*)(s.a + off);
  { const int ch = h * HS + c0;
    in.kk0 = *(const f32x4*)(s.k_k + ch); in.kk1 = *(const f32x4*)(s.k_k + ch + 4); in.ka0 = *(const f32x4*)(s.k_a + ch); in.ka1 = *(const f32x4*)(s.k_a + ch + 4);
    if (PHASE_C) { in.rk0 = *(const f32x4*)(s.r_k + ch); in.rk1 = *(const f32x4*)(s.r_k + ch + 4); } }
  if (PHASE_C) {
    in.r = *(const u32x4*)(s.r + off);
    const bf16_t* Zg = qz_ptr(s, item);
    in.z0 = *(const u32x4*)(Zg + tid * 8); in.z1 = *(const u32x4*)(Zg + (tid + 256) * 8);
  }
}
template <bool PHASE_C>
DI void scan_load(const ScanArgs& s, const ScanIn& in, int h, float* lwbuf, unsigned char* At, unsigned char* Bt, unsigned char* Kt, unsigned char* Rt,
                  unsigned char* AtT, unsigned char* BhT, unsigned char* KhT, unsigned char* VT, float& bonus, float (&vout)[8], float* Gout) {
  const int tid = opaque_v(threadIdx.x), tt = tid >> 3, c0 = (tid & 7) * 8;
  const u32x4 vk = in.k, vv = in.v, vw = in.w, va = in.a;
  u32x4 vr = {0u, 0u, 0u, 0u};
  if (PHASE_C) vr = in.r;
  float fr_[8], fk[8], fv[8], fw[8], fa[8];
  { const unsigned ur[4] = {vr.x, vr.y, vr.z, vr.w}, uk[4] = {vk.x, vk.y, vk.z, vk.w}, uv[4] = {vv.x, vv.y, vv.z, vv.w}, uw[4] = {vw.x, vw.y, vw.z, vw.w}, ua[4] = {va.x, va.y, va.z, va.w};
#pragma unroll
    for (int j = 0; j < 4; ++j) {
      fr_[2 * j] = bf_lo(ur[j]); fr_[2 * j + 1] = bf_hi(ur[j]); fk[2 * j] = bf_lo(uk[j]); fk[2 * j + 1] = bf_hi(uk[j]);
      fv[2 * j] = bf_lo(uv[j]); fv[2 * j + 1] = bf_hi(uv[j]); fw[2 * j] = bf_lo(uw[j]); fw[2 * j + 1] = bf_hi(uw[j]);
      fa[2 * j] = bf_lo(ua[j]); fa[2 * j + 1] = bf_hi(ua[j]);
    } }
  *(f32x4*)(lwbuf + tt * 64 + c0) = (f32x4){fw[0], fw[1], fw[2], fw[3]}; *(f32x4*)(lwbuf + tt * 64 + c0 + 4) = (f32x4){fw[4], fw[5], fw[6], fw[7]};
  float kkr[8], nrm = 0.f, bon = 0.f, kp[8];
#pragma unroll
  for (int j = 0; j < 8; ++j) {
    const float pkk = j < 4 ? in.kk0[j & 3] : in.kk1[j & 3], pka = j < 4 ? in.ka0[j & 3] : in.ka1[j & 3];
    kkr[j] = fk[j] * pkk; nrm += kkr[j] * kkr[j];
    kp[j] = fk[j] * (1.f + (fa[j] - 1.f) * pka);
    if (PHASE_C) bon += fr_[j] * kp[j] * (j < 4 ? in.rk0[j & 3] : in.rk1[j & 3]);
  }
  nrm += __shfl_xor(nrm, 1); nrm += __shfl_xor(nrm, 2); nrm += __shfl_xor(nrm, 4);
  if (PHASE_C) { bon += __shfl_xor(bon, 1); bon += __shfl_xor(bon, 2); bon += __shfl_xor(bon, 4); }
  bonus = bon;
  const float inv = rsqrtf(fmaxf(nrm, 1e-24f));
  __syncthreads();
  {
    const int c = tid & 63, sg = tid >> 6;
    float w8[8];
#pragma unroll
    for (int i = 0; i < 8; ++i) w8[i] = lwbuf[(sg * 8 + i) * 64 + c];
    float run = 0.f;
#pragma unroll
    for (int i = 0; i < 8; ++i) { run += w8[i]; lwbuf[(sg * 8 + i) * 64 + c] = run; }
  }
  __syncthreads();
  float cum[8], cl[8];
  {
    const int sg = tt >> 3;
#pragma unroll
    for (int hh = 0; hh < 2; ++hh) {
      const f32x4 me = *(const f32x4*)(lwbuf + tt * 64 + c0 + hh * 4);
      const f32x4 s0 = *(const f32x4*)(lwbuf + 7 * 64 + c0 + hh * 4), s1 = *(const f32x4*)(lwbuf + 15 * 64 + c0 + hh * 4),
                  s2 = *(const f32x4*)(lwbuf + 23 * 64 + c0 + hh * 4), s3 = *(const f32x4*)(lwbuf + 31 * 64 + c0 + hh * 4);
#pragma unroll
      for (int q = 0; q < 4; ++q) {
        const float pre = (sg > 0 ? s0[q] : 0.f) + (sg > 1 ? s1[q] : 0.f) + (sg > 2 ? s2[q] : 0.f);
        cum[hh * 4 + q] = me[q] + pre; cl[hh * 4 + q] = (s0[q] + s1[q]) + (s2[q] + s3[q]);
      }
    }
  }
  float at[8], bt[8], kt[8], rt[8], bh[8], kh[8];
#pragma unroll
  for (int j = 0; j < 8; ++j) {
    const float kk = kkr[j] * inv, bb = kk * fa[j];
    const float ein = __expf(cum[j]), eneg = __expf(-cum[j]), eex = __expf(cum[j] - fw[j]), eend = __expf(cl[j] - cum[j]);
    at[j] = -kk * eex; bt[j] = bb * eneg; kt[j] = kp[j] * eneg; rt[j] = fr_[j] * ein; bh[j] = bb * eend; kh[j] = kp[j] * eend;
    vout[j] = fv[j];
  }
  *(u32x4*)(At + tt * SN + c0 * 2) = (u32x4){cvt_pk_bf16(at[0], at[1]), cvt_pk_bf16(at[2], at[3]), cvt_pk_bf16(at[4], at[5]), cvt_pk_bf16(at[6], at[7])};
  *(u32x4*)(Bt + tt * SN + c0 * 2) = (u32x4){cvt_pk_bf16(bt[0], bt[1]), cvt_pk_bf16(bt[2], bt[3]), cvt_pk_bf16(bt[4], bt[5]), cvt_pk_bf16(bt[6], bt[7])};
  *(u32x4*)(Kt + tt * SN + c0 * 2) = (u32x4){cvt_pk_bf16(kt[0], kt[1]), cvt_pk_bf16(kt[2], kt[3]), cvt_pk_bf16(kt[4], kt[5]), cvt_pk_bf16(kt[6], kt[7])};
  if (PHASE_C) *(u32x4*)(Rt + tt * SN + c0 * 2) = (u32x4){cvt_pk_bf16(rt[0], rt[1]), cvt_pk_bf16(rt[2], rt[3]), cvt_pk_bf16(rt[4], rt[5]), cvt_pk_bf16(rt[6], rt[7])};
#pragma unroll
  for (int j = 0; j < 8; ++j) {
    *(bf16_t*)(VT + tr_off(c0 + j, tt)) = f2bf(fv[j]);
    if (!PHASE_C) {
      *(bf16_t*)(AtT + tr_off(c0 + j, tt)) = f2bf(at[j]);
      *(bf16_t*)(BhT + tr_off(c0 + j, tt)) = f2bf(bh[j]);
      *(bf16_t*)(KhT + tr_off(c0 + j, tt)) = f2bf(kh[j]);
    }
  }
  if (!PHASE_C && tt == 0 && Gout) {
#pragma unroll
    for (int j = 0; j < 8; ++j) Gout[c0 + j] = __expf(cl[j]);
  }
}
DI void scan_tinv(const float* A32, unsigned char* Tm, int lane) {
  const int c = lane & 31;
  float Tc[32];
#pragma unroll
  for (int i = 0; i < 32; ++i) {
    float s0 = (i == c) ? 1.f : 0.f, s1 = 0.f, s2 = 0.f, s3 = 0.f;
#pragma unroll
    for (int j4 = 0; j4 < (i + 3) / 4; ++j4) {
      const f32x4 a4 = *(const f32x4*)(A32 + i * 36 + j4 * 4);
      if (j4 * 4 + 0 < i) s0 += a4[0] * Tc[j4 * 4 + 0];
      if (j4 * 4 + 1 < i) s1 += a4[1] * Tc[j4 * 4 + 1];
      if (j4 * 4 + 2 < i) s2 += a4[2] * Tc[j4 * 4 + 2];
      if (j4 * 4 + 3 < i) s3 += a4[3] * Tc[j4 * 4 + 3];
    }
    Tc[i] = (s0 + s1) + (s2 + s3);
  }
  if (lane < 32) {
#pragma unroll
    for (int i = 0; i < 32; ++i) *(bf16_t*)(Tm + i * ST + c * 2) = f2bf(Tc[i]);
  }
}

DI void scan_phaseA_item(const ScanArgs& s, int item, const ScanIn& in, unsigned char* lds) {
  const int c = item & (NCH - 1), h = (item >> 7) & 15, b = item >> 11;
  const int tid = opaque_v(threadIdx.x), lane = tid & 63, wv = tid >> 6, fr = lane & 15, fq = lane >> 4;
  unsigned char* At = lds; unsigned char* Bt = At + 32 * SN; unsigned char* Kt = Bt + 32 * SN;
  unsigned char* AtT = Kt + 32 * SN; unsigned char* BhT = AtT + 64 * ST; unsigned char* KhT = BhT + 64 * ST; unsigned char* VT = KhT + 64 * ST;
  unsigned char* Tm = VT + 64 * ST; unsigned char* Aak = Tm + 32 * ST;
  float* A32 = (float*)(Aak + 32 * ST);
  unsigned char* W1T = (unsigned char*)A32 + 4608; unsigned char* M2T = W1T + 64 * ST; unsigned char* UlT = M2T + 64 * ST;
  float* lwbuf = (float*)W1T;
  const size_t gbase = ((size_t)b * SEQ + (size_t)c * CL) * D + h * HS;
  float bonus; float vv8[8];
  scan_load<false>(s, in, h, lwbuf, At, Bt, Kt, nullptr, AtT, BhT, KhT, VT, bonus, vv8, s.Gg + (size_t)item * 64);
  __syncthreads();
  {
    const int mat = wv >> 1, ti = wv & 1;
#pragma unroll
    for (int tj = 0; tj < 2; ++tj) {
      const f32x4 x = tile_mm<false, false>(At, SN, mat ? Kt : Bt, SN, ti * 16, tj * 16, 2, (f32x4){0.f, 0.f, 0.f, 0.f}, lane);
#pragma unroll
      for (int q = 0; q < 4; ++q) {
        const int i = ti * 16 + fq * 4 + q, j = tj * 16 + fr;
        const float val = (j < i) ? x[q] : 0.f;
        if (mat == 0) A32[i * 36 + j] = val; else *(bf16_t*)(Aak + i * ST + j * 2) = f2bf(val);
      }
    }
  }
  __syncthreads();
  if (wv == 0) scan_tinv(A32, Tm, lane);
  else {
    for (int tile = wv - 1; tile < 8; tile += 3) {
      const int ti = tile >> 2, tv = tile & 3;
      const f32x4 x = tile_mm<false, true>(Aak, ST, VT, ST, ti * 16, tv * 16, 1, (f32x4){0.f, 0.f, 0.f, 0.f}, lane);
      st_bf16x4(M2T + tr_off(tv * 16 + fr, ti * 16 + fq * 4), x);
    }
  }
  __syncthreads();
#pragma unroll
  for (int u = 0; u < 4; ++u) {
    const int tile = wv * 4 + u, which = tile >> 3, ti = (tile >> 2) & 1, tn = tile & 3;
    const f32x4 x = tile_mm<false, true>(Tm, ST, which ? M2T : AtT, ST, ti * 16, tn * 16, 1, (f32x4){0.f, 0.f, 0.f, 0.f}, lane);
    st_bf16x4((which ? UlT : W1T) + tr_off(tn * 16 + fr, ti * 16 + fq * 4), x);
  }
  __syncthreads();
  bf16_t* Pg = s.Pg + (size_t)item * 4096; bf16_t* Qg = qz_ptr(s, item);
#pragma unroll
  for (int u = 0; u < 4; ++u) {
    const int tile = wv * 4 + u, tk = tile >> 2, tn = tile & 3;
    const f32x4 xp = tile_mm<true, true>(W1T, ST, BhT, ST, tk * 16, tn * 16, 1, (f32x4){0.f, 0.f, 0.f, 0.f}, lane);
    *(u32x2*)(Pg + (tn * 16 + fr) * 64 + tk * 16 + fq * 4) = (u32x2){cvt_pk_bf16(xp[0], xp[1]), cvt_pk_bf16(xp[2], xp[3])};
    f32x4 xq = tile_mm<true, true>(BhT, ST, UlT, ST, tk * 16, tn * 16, 1, (f32x4){0.f, 0.f, 0.f, 0.f}, lane);
    xq = tile_mm<true, true>(KhT, ST, VT, ST, tk * 16, tn * 16, 1, xq, lane);
    __hip_atomic_store((unsigned long long*)(Qg + ((tk * 4 + tn) * 64 + lane) * 4), (unsigned long long)cvt_pk_bf16(xq[0], xq[1]) | ((unsigned long long)cvt_pk_bf16(xq[2], xq[3]) << 32), __ATOMIC_RELAXED, __HIP_MEMORY_SCOPE_AGENT);
  }
  __syncthreads();
}

constexpr int PSTR = 144;
constexpr int RSLOT = 64 * PSTR + 8192 + 256;
DI void scan_chain_block(const ScanArgs& s, int bh, unsigned char* lds) {
  const int tid = opaque_v(threadIdx.x), lane = tid & 63, tv = tid >> 6, fr = lane & 15, fq = lane >> 4;
  const int ch0 = bh * NCH;
  u32x4 pr[5];
  auto issue = [&](int c) {
    const bf16_t* Pg = s.Pg + (size_t)(ch0 + c) * 4096; const bf16_t* Qg = qz_ptr(s, ch0 + c);
    pr[0] = *(const u32x4*)(Pg + (size_t)tid * 8); pr[1] = *(const u32x4*)(Pg + (size_t)(tid + 256) * 8);
    pr[2] = *(const u32x4*)(Qg + (size_t)tid * 8); pr[3] = *(const u32x4*)(Qg + (size_t)(tid + 256) * 8);
    if (tid < 16) pr[4] = *(const u32x4*)(s.Gg + (size_t)(ch0 + c) * 64 + tid * 4);
  };
  auto commit = [&](int c) {
    unsigned char* sl = lds + (c & 3) * RSLOT;
    *(u32x4*)(sl + (tid >> 3) * PSTR + (tid & 7) * 16) = pr[0]; *(u32x4*)(sl + ((tid + 256) >> 3) * PSTR + (tid & 7) * 16) = pr[1];
    *(u32x4*)(sl + 64 * PSTR + tid * 16) = pr[2]; *(u32x4*)(sl + 64 * PSTR + (tid + 256) * 16) = pr[3];
    if (tid < 16) *(u32x4*)(sl + 64 * PSTR + 8192 + tid * 16) = pr[4];
  };
  issue(0); commit(0); issue(1); commit(1); issue(2); commit(2);
  __syncthreads();
  f32x4 Z[4];
#pragma unroll
  for (int t = 0; t < 4; ++t) Z[t] = (f32x4){0.f, 0.f, 0.f, 0.f};
  for (int c = 0; c < NCH; ++c) {
    if (c + 3 < NCH) issue(c + 3);
    const unsigned char* sl = lds + (c & 3) * RSLOT;
    bf16_t* Zo = qz_ptr(s, ch0 + c) + (tv * 16 + fr) * 64;
    unsigned zp[4][2];
#pragma unroll
    for (int t = 0; t < 4; ++t) { zp[t][0] = cvt_pk_bf16(Z[t][0], Z[t][1]); zp[t][1] = cvt_pk_bf16(Z[t][2], Z[t][3]); *(u32x2*)(Zo + t * 16 + fq * 4) = (u32x2){zp[t][0], zp[t][1]}; }
    bf16x8 zb[2];
#pragma unroll
    for (int ks = 0; ks < 2; ++ks) { const u32x4 w = {zp[2 * ks][0], zp[2 * ks][1], zp[2 * ks + 1][0], zp[2 * ks + 1][1]}; zb[ks] = __builtin_bit_cast(bf16x8, w); }
#pragma unroll
    for (int t = 0; t < 4; ++t) {
      const u32x2 qv = *(const u32x2*)(sl + 64 * PSTR + ((t * 4 + tv) * 64 + lane) * 8);
      const f32x4 g4 = *(const f32x4*)(sl + 64 * PSTR + 8192 + (t * 16 + fq * 4) * 4);
      f32x4 acc = (f32x4){bf_lo(qv.x) + g4[0] * Z[t][0], bf_hi(qv.x) + g4[1] * Z[t][1], bf_lo(qv.y) + g4[2] * Z[t][2], bf_hi(qv.y) + g4[3] * Z[t][3]};
#pragma unroll
      for (int ks = 0; ks < 2; ++ks) {
        const unsigned char* prow = sl + (t * 16 + fr) * PSTR + ks * 64 + fq * 8;
        const u32x2 p0 = *(const u32x2*)prow, p1 = *(const u32x2*)(prow + 32);
        const u32x4 w = {p0.x, p0.y, p1.x, p1.y};
        acc = __builtin_amdgcn_mfma_f32_16x16x32_bf16(__builtin_bit_cast(bf16x8, w), zb[ks], acc, 0, 0, 0);
      }
      Z[t] = acc;
    }
    if (c + 3 < NCH) commit(c + 3);
    __syncthreads();
  }
}

DI void scan_phaseC_item(const ScanArgs& s, int item, const ScanIn& in, unsigned char* lds) {
  const int c = item & (NCH - 1), h = (item >> 7) & 15, b = item >> 11;
  const int tid = opaque_v(threadIdx.x), lane = tid & 63, wv = tid >> 6, fr = lane & 15, fq = lane >> 4;
  unsigned char* At = lds; unsigned char* Bt = At + 32 * SN; unsigned char* Kt = Bt + 32 * SN; unsigned char* Rt = Kt + 32 * SN;
  unsigned char* VT = Rt + 32 * SN;
  unsigned char* Tm = VT + 64 * ST; unsigned char* Aak = Tm + 32 * ST; unsigned char* Arb = Aak + 32 * ST; unsigned char* Ark = Arb + 32 * ST;
  float* A32 = (float*)(Ark + 32 * ST);
  unsigned char* S0 = (unsigned char*)A32 + 4608;
  unsigned char* X1T = S0 + 64 * SN; unsigned char* UT = X1T + 64 * ST;
  float* Yb = (float*)(UT + 64 * ST);
  float* lwbuf = Yb;
  const size_t gbase = ((size_t)b * SEQ + (size_t)c * CL) * D + h * HS;
  float bonus; float vv8[8];
  { const int e0 = tid * 8, e1 = (tid + 256) * 8;
    *(u32x4*)(S0 + (e0 >> 6) * SN + (e0 & 63) * 2) = in.z0; *(u32x4*)(S0 + (e1 >> 6) * SN + (e1 & 63) * 2) = in.z1; }
  scan_load<true>(s, in, h, lwbuf, At, Bt, Kt, Rt, nullptr, nullptr, nullptr, VT, bonus, vv8, nullptr);
  __syncthreads();
  {
    const unsigned char* Pm = (wv < 2) ? At : Rt; const unsigned char* Qm = (wv & 1) ? Kt : Bt;
    unsigned char* dst = (wv == 1) ? Aak : (wv == 2 ? Arb : Ark);
#pragma unroll
    for (int t4 = 0; t4 < 4; ++t4) {
      const int ti = t4 >> 1, tj = t4 & 1;
      const f32x4 x = tile_mm<false, false>(Pm, SN, Qm, SN, ti * 16, tj * 16, 2, (f32x4){0.f, 0.f, 0.f, 0.f}, lane);
#pragma unroll
      for (int q = 0; q < 4; ++q) {
        const int i = ti * 16 + fq * 4 + q, j = tj * 16 + fr;
        const bool keep = (wv < 2) ? (j < i) : (j <= i);
        const float val = keep ? x[q] : 0.f;
        if (wv == 0) A32[i * 36 + j] = val; else *(bf16_t*)(dst + i * ST + j * 2) = f2bf(val);
      }
    }
  }
  __syncthreads();
  if (wv == 0) scan_tinv(A32, Tm, lane);
  else {
    for (int tile = wv - 1; tile < 8; tile += 3) {
      const int ti = tile >> 2, tv = tile & 3;
      f32x4 x = tile_mm<false, false>(At, SN, S0, SN, ti * 16, tv * 16, 2, (f32x4){0.f, 0.f, 0.f, 0.f}, lane);
      x = tile_mm<false, true>(Aak, ST, VT, ST, ti * 16, tv * 16, 1, x, lane);
      st_bf16x4(X1T + tr_off(tv * 16 + fr, ti * 16 + fq * 4), x);
    }
  }
  __syncthreads();
#pragma unroll
  for (int u = 0; u < 2; ++u) {
    const int tile = wv * 2 + u, ti = tile >> 2, tv = tile & 3;
    const f32x4 x = tile_mm<false, true>(Tm, ST, X1T, ST, ti * 16, tv * 16, 1, (f32x4){0.f, 0.f, 0.f, 0.f}, lane);
    st_bf16x4(UT + tr_off(tv * 16 + fr, ti * 16 + fq * 4), x);
  }
  __syncthreads();
#pragma unroll
  for (int u = 0; u < 2; ++u) {
    const int tile = wv * 2 + u, ti = tile >> 2, tv = tile & 3;
    f32x4 x = tile_mm<false, false>(Rt, SN, S0, SN, ti * 16, tv * 16, 2, (f32x4){0.f, 0.f, 0.f, 0.f}, lane);
    x = tile_mm<false, true>(Arb, ST, UT, ST, ti * 16, tv * 16, 1, x, lane);
    x = tile_mm<false, true>(Ark, ST, VT, ST, ti * 16, tv * 16, 1, x, lane);
#pragma unroll
    for (int q = 0; q < 4; ++q) Yb[(ti * 16 + fq * 4 + q) * 68 + tv * 16 + fr] = x[q];
  }
  __syncthreads();
  {
    const int tt = tid >> 3, c0 = (tid & 7) * 8;
    float yv[8], sum = 0.f;
#pragma unroll
    for (int j = 0; j < 8; ++j) { yv[j] = Yb[tt * 68 + c0 + j]; sum += yv[j]; }
    sum += __shfl_xor(sum, 1); sum += __shfl_xor(sum, 2); sum += __shfl_xor(sum, 4);
    const float mean = sum * (1.f / 64.f);
    float var = 0.f;
#pragma unroll
    for (int j = 0; j < 8; ++j) { const float d = yv[j] - mean; var += d * d; }
    var += __shfl_xor(var, 1); var += __shfl_xor(var, 2); var += __shfl_xor(var, 4);
    const float rstd = rsqrtf(var * (1.f / 64.f) + GN_EPS);
    const size_t off = gbase + (size_t)tt * D + c0;
    float o[8];
#pragma unroll
    for (int j = 0; j < 8; ++j) {
      const int chn = h * HS + c0 + j;
      o[j] = (yv[j] - mean) * rstd * s.lnx_g[chn] + s.lnx_b[chn] + bonus * vv8[j];
    }
    *(u32x4*)(s.r + off) = (u32x4){cvt_pk_bf16(o[0], o[1]), cvt_pk_bf16(o[2], o[3]), cvt_pk_bf16(o[4], o[5]), cvt_pk_bf16(o[6], o[7])};
  }
  __syncthreads();
}

DI void ln_phase(const float* __restrict__ z, const float* __restrict__ lg, const float* __restrict__ lb, float* __restrict__ xo,
                 const float* __restrict__ mod_l, int shift_idx, int scale_idx, bf16_t* __restrict__ ho, int bid, int nblk) {
  const int tq = opaque_v(threadIdx.x); const int lane = tq & 63, wv = tq >> 6;
  constexpr int RW = 4;
  for (int row0 = (bid * 4 + wv) * RW; row0 < T; row0 += nblk * 4 * RW) {
    f32x4 v[RW][4];
#pragma unroll
    for (int r = 0; r < RW; ++r)
#pragma unroll
      for (int i = 0; i < 4; ++i) v[r][i] = *(const f32x4*)(z + (size_t)(row0 + r) * D + i * 256 + lane * 4);
    const int b = row0 / SEQ;
#pragma unroll
    for (int r = 0; r < RW; ++r) {
      float s = 0.f;
#pragma unroll
      for (int i = 0; i < 4; ++i) s += (v[r][i][0] + v[r][i][1]) + (v[r][i][2] + v[r][i][3]);
      const float mean = wave_sum(s) * (1.f / D);
      float q = 0.f;
#pragma unroll
      for (int i = 0; i < 4; ++i) { const f32x4 d = v[r][i] - mean; q += (d[0] * d[0] + d[1] * d[1]) + (d[2] * d[2] + d[3] * d[3]); }
      const float rstd = rsqrtf(wave_sum(q) * (1.f / D) + LN_EPS);
      const int row = row0 + r;
#pragma unroll
      for (int i = 0; i < 4; ++i) {
        const int d = i * 256 + lane * 4;
        const f32x4 o = (v[r][i] - mean) * rstd * *(const f32x4*)(lg + d) + *(const f32x4*)(lb + d);
        *(f32x4*)(xo + (size_t)row * D + d) = o;
        if (!ho) continue;
        const f32x4 sh = *(const f32x4*)(mod_l + (size_t)b * 6144 + shift_idx * D + d), sc = *(const f32x4*)(mod_l + (size_t)b * 6144 + scale_idx * D + d);
        const f32x4 hh = o * (sc + 1.f) + sh;
        *(u32x2*)(ho + (size_t)row * D + d) = (u32x2){cvt_pk_bf16(hh[0], hh[1]), cvt_pk_bf16(hh[2], hh[3])};
      }
    }
  }
}

DI void table_fp8_phase(const float* __restrict__ src, unsigned char* __restrict__ dst, float* __restrict__ inv, int rows, int bid, int nblk) {
  const int tq = opaque_v(threadIdx.x); const int lane = tq & 63, wv = tq >> 6;
  for (int r0 = (bid * 4 + wv) * 4; r0 < rows; r0 += nblk * 16) {
    f32x4 v[4][4];
#pragma unroll
    for (int rr = 0; rr < 4; ++rr)
#pragma unroll
      for (int i = 0; i < 4; ++i) v[rr][i] = __builtin_nontemporal_load((const f32x4*)(src + (size_t)(r0 + rr) * D + lane * 16 + i * 4));
#pragma unroll
    for (int rr = 0; rr < 4; ++rr) {
      float mx = 0.f;
#pragma unroll
      for (int i = 0; i < 4; ++i) mx = fmaxf(mx, fmaxf(fmaxf(fabsf(v[rr][i][0]), fabsf(v[rr][i][1])), fmaxf(fabsf(v[rr][i][2]), fabsf(v[rr][i][3]))));
#pragma unroll
      for (int o = 32; o >= 1; o >>= 1) mx = fmaxf(mx, __shfl_xor(mx, o));
      const float sc = mx > 0.f ? exp2f(floorf(log2f(384.f / mx))) : 1.f;
      unsigned w[4];
#pragma unroll
      for (int i = 0; i < 4; ++i) {
        int pk = 0;
        pk = __builtin_amdgcn_cvt_pk_fp8_f32(v[rr][i][0] * sc, v[rr][i][1] * sc, pk, false);
        pk = __builtin_amdgcn_cvt_pk_fp8_f32(v[rr][i][2] * sc, v[rr][i][3] * sc, pk, true);
        w[i] = (unsigned)pk;
      }
      *(u32x4*)(dst + (size_t)(r0 + rr) * D + lane * 16) = (u32x4){w[0], w[1], w[2], w[3]};
      if (lane == 0) inv[r0 + rr] = 1.f / sc;
    }
  }
}

struct PeerArgs {
  const bf16_t* h2;
  const unsigned char *u8, *v8;
  const float *uinv, *vinv;
  const unsigned short* epk; const float* gate;
  float* part;
  float* coef;
  const float* xres;
  const float* gate2;
  float* z;
  unsigned* ctr_u; unsigned* ctr_v;
};
constexpr int PCH = 64;
DI void cvt16_fp8(const u32x4& d, float (&f)[16]) {
  const unsigned w[4] = {d.x, d.y, d.z, d.w};
#pragma unroll
  for (int i = 0; i < 4; ++i) {
    const f32x2 lo = __builtin_amdgcn_cvt_pk_f32_fp8((int)w[i], false), hi = __builtin_amdgcn_cvt_pk_f32_fp8((int)w[i], true);
    f[i * 4] = lo.x; f[i * 4 + 1] = lo.y; f[i * 4 + 2] = hi.x; f[i * 4 + 3] = hi.y;
  }
}
template <bool VPHASE>
DI void peer_slice_phase(const PeerArgs& a, unsigned char* lds) {
  const int tq = opaque_v(threadIdx.x); const int lane = tq & 63, wv = tq >> 6, cc = lane & 7;
  volatile int* nxt = (volatile int*)lds;
  const unsigned xcc = xb_xcc_id() & 7u;
  unsigned* ctr = VPHASE ? a.ctr_v : a.ctr_u;
  for (int ks = 0; ks < 8; ++ks) {
    const int s = (int)((xcc + ks) & 7u);
    for (;;) {
      __syncthreads();
      if (tq == 0) *nxt = (int)atomicAdd(&ctr[s * 16], 1u);
      __syncthreads();
      const int chunk = *nxt;
      if (chunk >= T / PCH) break;
      for (int ti = 0; ti < PCH / 4; ++ti) {
        const int t = chunk * PCH + wv * (PCH / 4) + ti;
        const unsigned ep = (unsigned)a.epk[(size_t)t * 128 + lane] | ((unsigned)a.epk[(size_t)t * 128 + 64 + lane] << 16);
        const unsigned char* tab = (VPHASE ? a.v8 : a.u8) + s * 128 + cc * 16;
        u32x4 data[16];
        float cv[16];
        float c_lo = 0.f, c_hi = 0.f;
        if (VPHASE) { c_lo = a.coef[(size_t)t * 128 + lane]; c_hi = a.coef[(size_t)t * 128 + 64 + lane]; }
#pragma unroll
        for (int i = 0; i < 16; ++i) {
          const int src = (lane & ~7) | (i & 7);
          const unsigned ev = (unsigned)__shfl((int)ep, src);
          const unsigned e = (i < 8) ? (ev & 0xffffu) : (ev >> 16);
          if (VPHASE) cv[i] = __shfl(i < 8 ? c_lo : c_hi, src);
          data[i] = *(const u32x4*)(tab + (size_t)e * D);
        }
        if (!VPHASE) {
          const u32x4 h0 = *(const u32x4*)(a.h2 + (size_t)t * D + s * 128 + cc * 16), h1 = *(const u32x4*)(a.h2 + (size_t)t * D + s * 128 + cc * 16 + 8);
          float hf[16];
          { const unsigned u[8] = {h0.x, h0.y, h0.z, h0.w, h1.x, h1.y, h1.z, h1.w};
#pragma unroll
            for (int q = 0; q < 8; ++q) { hf[2 * q] = bf_lo(u[q]); hf[2 * q + 1] = bf_hi(u[q]); } }
          float r_lo = 0.f, r_hi = 0.f;
#pragma unroll
          for (int i = 0; i < 16; ++i) {
            float f[16]; cvt16_fp8(data[i], f);
            float d = 0.f;
#pragma unroll
            for (int q = 0; q < 16; ++q) d += f[q] * hf[q];
            d += __builtin_bit_cast(float, __builtin_amdgcn_update_dpp(0, __builtin_bit_cast(int, d), 0xB1, 0xF, 0xF, true));
            d += __builtin_bit_cast(float, __builtin_amdgcn_update_dpp(0, __builtin_bit_cast(int, d), 0x4E, 0xF, 0xF, true));
            d += __builtin_bit_cast(float, __builtin_amdgcn_update_dpp(0, __builtin_bit_cast(int, d), 0x141, 0xF, 0xF, true));
            if ((i & 7) == cc) { if (i < 8) r_lo = d; else r_hi = d; }
          }
          float* pp = a.part + ((size_t)s * T + t) * 128;
          pp[lane] = r_lo; pp[64 + lane] = r_hi;
        } else {
          float acc[16];
#pragma unroll
          for (int q = 0; q < 16; ++q) acc[q] = 0.f;
#pragma unroll
          for (int i = 0; i < 16; ++i) {
            float f[16]; cvt16_fp8(data[i], f);
#pragma unroll
            for (int q = 0; q < 16; ++q) acc[q] += cv[i] * f[q];
          }
          float r8[8], r4[4], r2[2];
          { const bool up = (lane & 8) != 0;
#pragma unroll
            for (int q = 0; q < 8; ++q) { const float keep = up ? acc[8 + q] : acc[q], send = up ? acc[q] : acc[8 + q]; r8[q] = keep + __shfl_xor(send, 8); } }
          { const bool up = (lane & 16) != 0;
#pragma unroll
            for (int q = 0; q < 4; ++q) { const float keep = up ? r8[4 + q] : r8[q], send = up ? r8[q] : r8[4 + q]; r4[q] = keep + __shfl_xor(send, 16); } }
          { const bool up = (lane & 32) != 0;
#pragma unroll
            for (int q = 0; q < 2; ++q) { const float keep = up ? r4[2 + q] : r4[q], send = up ? r4[q] : r4[2 + q]; r2[q] = keep + __shfl_xor(send, 32); } }
          const int col = s * 128 + cc * 16 + ((lane >> 3) & 1) * 8 + ((lane >> 4) & 1) * 4 + ((lane >> 5) & 1) * 2;
          const int b = t / SEQ;
          const f32x2 xv = *(const f32x2*)(a.xres + (size_t)t * D + col), gt = *(const f32x2*)(a.gate2 + (size_t)b * 6144 + col);
          *(f32x2*)(a.z + (size_t)t * D + col) = (f32x2){ALPHA * xv.x + gt.x * r2[0], ALPHA * xv.y + gt.y * r2[1]};
        }
      }
    }
  }
  __syncthreads();
}
DI void peer_coef_phase(const PeerArgs& a, int bid, int nblk) {
  const int tq = opaque_v(threadIdx.x);
  for (int g4 = bid * 256 + tq; g4 < T * 32; g4 += nblk * 256) {
    const int t = g4 >> 5, j = (g4 & 31) * 4;
    const u32x2 ep = *(const u32x2*)(a.epk + (size_t)t * 128 + j);
    const unsigned e[4] = {ep.x & 0xffffu, ep.x >> 16, ep.y & 0xffffu, ep.y >> 16};
    float ui[4], vi[4];
#pragma unroll
    for (int q = 0; q < 4; ++q) { ui[q] = a.uinv[e[q]]; vi[q] = a.vinv[e[q]]; }
    f32x4 sum = {0.f, 0.f, 0.f, 0.f};
#pragma unroll
    for (int s8 = 0; s8 < 8; ++s8) sum += *(const f32x4*)(a.part + ((size_t)s8 * T + t) * 128 + j);
    const f32x4 gt = *(const f32x4*)(a.gate + (size_t)t * 128 + j);
    f32x4 o;
#pragma unroll
    for (int q = 0; q < 4; ++q) o[q] = gt[q] * gelu_exact(sum[q] * ui[q]) * vi[q];
    *(f32x4*)(a.coef + (size_t)t * 128 + j) = o;
  }
}

DI void pool_phase(const bf16_t* __restrict__ zin, bf16_t* __restrict__ pout, int bid, int nblk) {
  const int tq = opaque_v(threadIdx.x);
  constexpr int SEG = 32;
  for (int it = bid * 256 + tq; it < (T / SEG) * (D / 8); it += nblk * 256) {
    const int ch = it & 127, seg = it >> 7;
    const int d = ch * 8, win = 2 << (d / 256);
    const int t0 = seg * SEG, tp0 = t0 % SEQ;
    float s[8];
#pragma unroll
    for (int j = 0; j < 8; ++j) s[j] = 0.f;
    for (int w = 1; w < win; ++w) {
      if (tp0 - w < 0) break;
      const u32x4 v = *(const u32x4*)(zin + (size_t)(t0 - w) * D + d);
      const unsigned u[4] = {v.x, v.y, v.z, v.w};
#pragma unroll
      for (int j = 0; j < 4; ++j) { s[2 * j] += bf_lo(u[j]); s[2 * j + 1] += bf_hi(u[j]); }
    }
#pragma unroll 4
    for (int i = 0; i < SEG; ++i) {
      const int t = t0 + i, tp = tp0 + i;
      const u32x4 v = *(const u32x4*)(zin + (size_t)t * D + d);
      const unsigned u[4] = {v.x, v.y, v.z, v.w};
      float z0[8];
#pragma unroll
      for (int j = 0; j < 4; ++j) { z0[2 * j] = bf_lo(u[j]); z0[2 * j + 1] = bf_hi(u[j]); }
#pragma unroll
      for (int j = 0; j < 8; ++j) s[j] += z0[j];
      const int cnt = min(tp + 1, win);
      const float ic = 1.f / (float)cnt;
      float o[8];
#pragma unroll
      for (int j = 0; j < 8; ++j) o[j] = s[j] * ic - z0[j];
      *(u32x4*)(pout + (size_t)t * D + d) = (u32x4){cvt_pk_bf16(o[0], o[1]), cvt_pk_bf16(o[2], o[3]), cvt_pk_bf16(o[4], o[5]), cvt_pk_bf16(o[6], o[7])};
      if (tp + 1 >= win) {
        const u32x4 vo = *(const u32x4*)(zin + (size_t)(t - win + 1) * D + d);
        const unsigned uo[4] = {vo.x, vo.y, vo.z, vo.w};
#pragma unroll
        for (int j = 0; j < 4; ++j) { s[2 * j] -= bf_lo(uo[j]); s[2 * j + 1] -= bf_hi(uo[j]); }
      }
    }
  }
}

#define GRID_SYNC() xcd_barrier(xb)

__global__ void __launch_bounds__(256, 2) mega(Params p) {
  __shared__ __attribute__((aligned(16))) unsigned char lds[LDS_BYTES + 16];
  cg::grid_group grid = cg::this_grid();
  const int bid = blockIdx.x, nblk = gridDim.x;
  if (threadIdx.x == 0) { *(volatile LAS unsigned*)(lds + LDS_BYTES) = 0u; *(volatile LAS unsigned*)(lds + LDS_BYTES + 4) = 0u; }
  __syncthreads();
  const XcdBarrier xb = xcd_barrier_post(p.bar, (volatile LAS unsigned*)(lds + LDS_BYTES));
  const float* mod0 = p.mod; const float* mod1 = p.mod + (size_t)NB * 6144;
  bf16_t* S[7];
#pragma unroll
  for (int i = 0; i < 7; ++i) S[i] = (bf16_t*)p.slot[i];

  prologue_phase(p, lds, bid, nblk);
  grid.sync();
  bf16_t *h = S[0], *r = S[1], *k = S[2], *v = S[3], *lw = S[4], *av = S[5];
  bf16_t* tw = p.lora_tmp; bf16_t* ta = tw + (size_t)T * 64; bf16_t* tg = ta + (size_t)T * 64;
  modulate_phase(p.x, mod0, p.rw_mu, h, S[4], S[5], S[6], bid, nblk);
  for (int it = bid; it < 4 * 8 * 2; it += nblk) {
    const int nt = it & 1, mt = (it >> 1) & 7, g4 = it >> 4;
    gemm_tile(mk(p.PoutT + g4 * 256, D, p.WgrpS + (size_t)g4 * 256 * 256, 256, 256, 256, EPI_BF16, p.WcT + g4 * 256, D), mt * 128, nt * 128, lds);
  }
  for (int it = bid; it < 2 * 16 * 8; it += nblk) {
    const int nt = it & 7, gl = it >> 3;
    gemm_tile(mk(p.KeysB + (size_t)gl * 128 * 128, 128, p.WqB + (size_t)(gl >> 4) * D * 2048 + (gl & 15) * 128, 2048, D, 128, EPI_BF16, p.WeffT + (size_t)gl * 128 * D, D), 0, nt * 128, lds);
  }
  GRID_SYNC();
  for (int it = 0, nit = sched_iters(28, nblk); it < nit; ++it) {
    int mt, nt; if (!sched_mn(it, bid, nblk, 28, mt, nt)) continue;
    GemmArgs g; int n0;
    if (nt < 24) { const int j = nt >> 3; n0 = (nt & 7) * 128; g = mk(S[4 + j], D, p.WT_rkv + (size_t)j * D * D, D, D, D, EPI_BF16, j == 0 ? r : (j == 1 ? k : v), D); }
    else if (nt == 24) { n0 = 0; g = mk(h, D, p.W1T, D, 64, D, EPI_TANH, tw, 64, p.rw_mu + 3 * D); }
    else if (nt == 25) { n0 = 0; g = mk(h, D, p.A1T, D, 64, D, EPI_BF16, ta, 64, p.rw_mu + 4 * D); }
    else { n0 = (nt - 26) * 128; g = mk(h, D, p.G1T, D, 192, D, EPI_SIGMOID, tg, 192, p.rw_mu + 5 * D); }
    gemm_tile(g, mt * 128, n0, lds);
  }
  GRID_SYNC();
  for (int it = 0, nit = sched_iters(16, nblk); it < nit; ++it) {
    int mt, nt; if (!sched_mn(it, bid, nblk, 16, mt, nt)) continue;
    const int j = nt >> 3, n0 = (nt & 7) * 128;
    GemmArgs g;
    if (j == 0) g = mk(tw, 64, p.W2T, 64, D, 64, EPI_LW, lw, D, nullptr, p.rw_w0);
    else g = mk(ta, 64, p.A2T, 64, D, 64, EPI_ASIG, av, D, nullptr, p.rw_a0);
    gemm_tile(g, mt * 128, n0, lds);
  }
  GRID_SYNC();
  {
    ScanArgs s; s.r = r; s.k = k; s.v = v; s.lw = lw; s.a = av; s.k_k = p.rw_k_k; s.k_a = p.rw_k_a; s.r_k = p.rw_r_k; s.lnx_g = p.rw_lnx_g; s.lnx_b = p.rw_lnx_b;
    s.Pg = (bf16_t*)p.out; s.Qz0 = S[0]; s.Qz1 = S[6]; s.Gg = p.Gg;
    { ScanIn cur, nxt; if (bid < NB * NH * NCH) scan_fetch<false>(s, bid, cur);
      for (int it = bid; it < NB * NH * NCH; it += nblk) { if (it + nblk < NB * NH * NCH) scan_fetch<false>(s, it + nblk, nxt); scan_phaseA_item(s, it, cur, lds); cur = nxt; } }
    GRID_SYNC();
    for (int it = bid; it < NB * NH; it += nblk) scan_chain_block(s, it, lds);
    GRID_SYNC();
    { ScanIn cur, nxt; if (bid < NB * NH * NCH) scan_fetch<true>(s, bid, cur);
      for (int it = bid; it < NB * NH * NCH; it += nblk) { if (it + nblk < NB * NH * NCH) scan_fetch<true>(s, it + nblk, nxt); scan_phaseC_item(s, it, cur, lds); cur = nxt; } }
    GRID_SYNC();
  }
  for (int it = 0, nit = sched_iters(8, nblk); it < nit; ++it) {
    int mt, nt; if (!sched_mn(it, bid, nblk, 8, mt, nt)) continue;
    gemm_tile(mk(tg, 192, p.G2T, 192, D, 192, EPI_GATE, r, D), mt * 128, nt * 128, lds);
  }
  GRID_SYNC();
  h = r;
  float* z = (float*)p.slot[2];
  for (int it = 0, nit = sched_iters(8, nblk, 128); it < nit; ++it) {
    int mt, nt; if (!sched_mn(it, bid, nblk, 8, mt, nt, 128)) continue;
    gemm_tile256(mk(h, D, p.WoT, D, D, D, EPI_Z, z, D, nullptr, p.x, mod0 + 2 * D), mt * 256, nt * 128, lds);
  }
  table_fp8_phase(p.pe_u, p.slot[6], p.tinv, NEXP, bid, nblk);
  table_fp8_phase(p.pe_v, p.slot[6] + ((size_t)16 << 20), p.tinv + NEXP, NEXP, bid, nblk);
  table_fp8_phase(p.pe_u + (size_t)NEXP * D, p.slot[6] + ((size_t)32 << 20), p.tinv + 2 * NEXP, NEXP, bid, nblk);
  table_fp8_phase(p.pe_v + (size_t)NEXP * D, p.slot[6] + ((size_t)48 << 20), p.tinv + 3 * NEXP, NEXP, bid, nblk);
  GRID_SYNC();
  ln_phase(z, p.ln_g + 0 * D, p.ln_b + 0 * D, (float*)p.slot[4], mod0, 3, 4, S[0], bid, nblk);
  GRID_SYNC();

#pragma unroll
  for (int layer = 0; layer < 2; ++layer) {
    const float* modl = layer == 0 ? mod0 : mod1;
    const bf16_t* hp = layer == 0 ? S[0] : S[3];
    unsigned char* lsl = layer == 0 ? p.slot[3] : p.slot[0];
    unsigned* epk = (unsigned*)(lsl + ((size_t)32 << 20));
    float* gate = (float*)(lsl + ((size_t)40 << 20));
    for (int it = 0, nit = sched_iters(8, nblk); it < nit; ++it) {
      int mt, hd; if (!sched_mn(it, bid, nblk, 8, mt, hd)) continue;
      gemm_tile(mk(hp, D, p.WeffT + (size_t)layer * 2048 * D, D, 2048, D, EPI_TOPK, epk, 0, nullptr, gate), mt * 128, (hd * 2 + 0) * 128, lds);
      gemm_tile(mk(hp, D, p.WeffT + (size_t)layer * 2048 * D, D, 2048, D, EPI_TOPK, epk, 0, nullptr, gate), mt * 128, (hd * 2 + 1) * 128, lds);
    }
    GRID_SYNC();
    PeerArgs a; a.h2 = hp;
    a.u8 = p.slot[6] + ((size_t)(layer * 32) << 20); a.v8 = a.u8 + ((size_t)16 << 20);
    a.uinv = p.tinv + (layer * 2) * NEXP; a.vinv = a.uinv + NEXP;
    a.epk = (const unsigned short*)epk; a.gate = gate; a.part = (float*)p.slot[1]; a.coef = (float*)lsl;
    a.xres = (const float*)p.slot[4]; a.gate2 = modl + 5 * D; a.z = (float*)p.slot[1];
    a.ctr_u = p.bar + XCD_BAR_WORDS + (layer * 2) * 128; a.ctr_v = a.ctr_u + 128;
    peer_slice_phase<false>(a, lds);
    GRID_SYNC();
    peer_coef_phase(a, bid, nblk);
    GRID_SYNC();
    peer_slice_phase<true>(a, lds);
    GRID_SYNC();
    if (layer == 1) { ln_phase(a.z, p.ln_g + 3 * D, p.ln_b + 3 * D, p.out, mod1, 0, 1, nullptr, bid, nblk); break; }
    ln_phase(a.z, p.ln_g + 1 * D, p.ln_b + 1 * D, (float*)p.slot[4], mod1, 0, 1, S[0], bid, nblk);
    GRID_SYNC();
    const float* x2 = (const float*)p.slot[4];
    bf16_t *hB = S[0], *zin = S[1], *pp = S[2];
    for (int it = 0, nit = sched_iters(8, nblk, 128); it < nit; ++it) {
      int mt, nt; if (!sched_mn(it, bid, nblk, 8, mt, nt, 128)) continue;
      gemm_tile256(mk(hB, D, p.PinT, D, D, D, EPI_BF16, zin, D), mt * 256, nt * 128, lds);
    }
    GRID_SYNC();
    pool_phase(zin, pp, bid, nblk);
    GRID_SYNC();
    float* z1 = (float*)p.slot[0];
    for (int it = 0, nit = sched_iters(8, nblk, 128); it < nit; ++it) {
      int mt, nt; if (!sched_mn(it, bid, nblk, 8, mt, nt, 128)) continue;
      gemm_tile256(mk(pp, D, p.WcT, D, D, D, EPI_Z, z1, D, nullptr, x2, mod1 + 2 * D), mt * 256, nt * 128, lds);
    }
    GRID_SYNC();
    ln_phase(z1, p.ln_g + 2 * D, p.ln_b + 2 * D, (float*)p.slot[4], mod1, 3, 4, S[3], bid, nblk);
    GRID_SYNC();
  }
}

extern "C" void kernel_launch(void* const* d_in, const int* in_sizes, int n_in, void* d_out, int out_size, void* d_ws, size_t ws_size, hipStream_t stream) {
  Params p{};
  const float** ip = (const float**)&p.x;
  for (int i = 0; i < 30; ++i) ip[i] = (const float*)d_in[i];
  p.out = (float*)d_out;
  unsigned char* w = (unsigned char*)d_ws; size_t off = 0;
  auto take = [&](size_t bytes) { unsigned char* r = w + off; off += (bytes + 255) & ~(size_t)255; return r; };
  p.bar = (unsigned*)take(16384);
  p.mod = (float*)take((size_t)2 * NB * 6144 * 4);
  p.WT_rkv = (bf16_t*)take((size_t)3 * D * D * 2);
  p.W1T = (bf16_t*)take((size_t)128 * D * 2); p.A1T = (bf16_t*)take((size_t)128 * D * 2); p.G1T = (bf16_t*)take((size_t)256 * D * 2);
  p.W2T = (bf16_t*)take((size_t)D * 64 * 2); p.A2T = (bf16_t*)take((size_t)D * 64 * 2); p.G2T = (bf16_t*)take((size_t)D * 192 * 2);
  p.WoT = (bf16_t*)take((size_t)D * D * 2); p.PinT = (bf16_t*)take((size_t)D * D * 2); p.PoutT = (bf16_t*)take((size_t)D * D * 2);
  p.WgrpS = (bf16_t*)take((size_t)4 * 256 * 256 * 2); p.WcT = (bf16_t*)take((size_t)D * D * 2); p.WqB = (bf16_t*)take((size_t)2 * 2048 * D * 2); p.WeffT = (bf16_t*)take((size_t)2 * 2048 * D * 2); p.KeysB = (bf16_t*)take((size_t)2 * 16 * 128 * 128 * 2);
  p.tinv = (float*)take((size_t)4 * NEXP * 4);
  p.lora_tmp = (bf16_t*)take((size_t)T * 320 * 2);
  p.Gg = (float*)take((size_t)16384 * 64 * 4);
  for (int i = 0; i < 7; ++i) p.slot[i] = take((size_t)64 << 20);
  if (off > ws_size) return;

  static int grid_blocks = 0;
  if (!grid_blocks) {
    int dev = 0, cus = 0, per_cu = 0;
    hipGetDevice(&dev);
    hipDeviceGetAttribute(&cus, hipDeviceAttributeMultiprocessorCount, dev);
    hipOccupancyMaxActiveBlocksPerMultiprocessor(&per_cu, mega, 256, 0);
    if (per_cu > 2) per_cu = 2;
    if (per_cu < 1) per_cu = 1;
    grid_blocks = cus * per_cu;
  }
  hipMemsetAsync(p.bar, 0, 16384, stream);
  void* args[] = {&p};
  hipLaunchCooperativeKernel((void*)mega, dim3(grid_blocks), dim3(256), args, 0, stream);
}
```

```cpp
#include <hip/hip_runtime.h>
#include <hip/hip_cooperative_groups.h>
#include <stdint.h>
#include <stddef.h>
namespace cg = cooperative_groups;

typedef unsigned short bf16_t;
typedef short bf16x8 __attribute__((ext_vector_type(8)));
typedef float f32x4 __attribute__((ext_vector_type(4)));
typedef float f32x2 __attribute__((ext_vector_type(2)));
typedef unsigned u32x4 __attribute__((ext_vector_type(4)));
typedef unsigned u32x2 __attribute__((ext_vector_type(2)));
#define DI __device__ __forceinline__

constexpr int D = 1024, NB = 8, SEQ = 4096, T = NB * SEQ;
constexpr int NH = 16, HS = 64;
constexpr int NEXP = 16384;
constexpr float ALPHA = 1.4142135623730951f;
constexpr float LN_EPS = 1e-5f, GN_EPS = 64e-5f;
constexpr int LDS_BYTES = 72 * 1024;

typedef __bf16 bf16x2_t __attribute__((ext_vector_type(2)));
DI unsigned cvt_pk_bf16(float lo, float hi) { const f32x2 v = {lo, hi}; return __builtin_bit_cast(unsigned, __builtin_convertvector(v, bf16x2_t)); }
DI float bf_lo(unsigned u) { return __uint_as_float(u << 16); }
DI float bf_hi(unsigned u) { return __uint_as_float(u & 0xffff0000u); }
DI bf16_t f2bf(float f) { unsigned u = __float_as_uint(f); u += 0x7fffu + ((u >> 16) & 1u); return (bf16_t)(u >> 16); }
DI float sigmoidf_(float x) { return 1.f / (1.f + __expf(-x)); }
DI float wave_sum(float v) {
#pragma unroll
  for (int o = 32; o >= 1; o >>= 1) v += __shfl_xor(v, o);
  return v;
}
DI int opaque_v(int x) { asm volatile("" : "+v"(x)); return x; }
DI float gelu_exact(float v) {
  const float av = fabsf(v), t = __builtin_amdgcn_rcpf(av * 0.2316418882f + 1.0f);
  float q = t * 0.5307027145f + (-0.7265760135f); q = q * t + 0.7107068705f; q = q * t + (-0.142248368f); q = q * t + 0.127414796f; q = q * t;
  const float m = v * (q * __builtin_amdgcn_exp2f((v * v) * (-0.72134752044f)));
  return v < 0.f ? m : v - m;
}

#define XB_TMO      128
#define XB_XCNT(j)  (256  + 64 * (j))
#define XB_XSUB(j)  (1280 + 64 * (j))
#define XB_XGEN(j)  (2304 + 64 * (j))
#define XB_TOP      3328
#define XB_TOPGEN   3392
#define XCD_BAR_WORDS 3456
#define XB_SPIN_CAP (1u << 22)
#define LAS __attribute__((address_space(3)))
DI unsigned xb_ld(unsigned* p)              { return __hip_atomic_load(p, __ATOMIC_RELAXED, __HIP_MEMORY_SCOPE_AGENT); }
DI unsigned xb_add(unsigned* p, unsigned v) { return __hip_atomic_fetch_add(p, v, __ATOMIC_RELAXED, __HIP_MEMORY_SCOPE_AGENT); }
DI unsigned xb_xcc_id() { return (unsigned)__builtin_amdgcn_s_getreg((3 << 11) | 20) & 0xFu; }
#define XB_SPIN(cond, bar) do { unsigned _sp = 0; while (cond) { __builtin_amdgcn_s_sleep(1); \
    if ((++_sp & 255u) == 0u) { if (xb_ld(&(bar)[XB_TMO])) break; if (_sp > XB_SPIN_CAP) { atomicAdd(&(bar)[XB_TMO], 1u); break; } } } } while (0)
struct XcdBarrier { unsigned* bar; unsigned x; volatile LAS unsigned* st; };
DI XcdBarrier xcd_barrier_post(unsigned* bar, volatile LAS unsigned* st) {
  XcdBarrier b; b.bar = bar; b.x = xb_xcc_id(); b.st = st;
  if (threadIdx.x == 0) (void)xb_add(&bar[XB_XCNT(b.x)], 1u);
  return b;
}
DI void xcd_barrier_complete(unsigned* bar, unsigned x, unsigned& nloc, unsigned& nx) {
  const unsigned G = gridDim.x * gridDim.y * gridDim.z;
  unsigned sum, cnt, mine, sp = 0u;
  for (;;) {
    sum = 0u; cnt = 0u; mine = 0u;
#pragma unroll
    for (unsigned j = 0; j < 16; ++j) { const unsigned c = xb_ld(&bar[XB_XCNT(j)]); sum += c; cnt += (c > 0u) ? 1u : 0u; mine = (j == x) ? c : mine; }
    if (sum == G) break;
    __builtin_amdgcn_s_sleep(1);
    if ((++sp & 255u) == 0u) { if (xb_ld(&bar[XB_TMO])) break; if (sp > XB_SPIN_CAP) { atomicAdd(&bar[XB_TMO], 1u); break; } }
  }
  nloc = mine > 0u ? mine : 1u; nx = cnt > 0u ? cnt : 1u;
}
DI void xcd_barrier(const XcdBarrier& b0) {
  XcdBarrier b = b0; { unsigned xx = b0.x; asm volatile("" : "+s"(xx)); b.x = xx; }
  asm volatile("s_waitcnt vmcnt(0)" ::: "memory");
  __syncthreads();
  if (threadIdx.x == 0) {
    unsigned* bar = b.bar;
    __builtin_amdgcn_s_waitcnt(0);
    unsigned nloc = b.st[0], nx = b.st[1];
    if (nloc == 0u) { xcd_barrier_complete(bar, b.x, nloc, nx); b.st[0] = nloc; b.st[1] = nx; }
    const unsigned old = xb_add(&bar[XB_XSUB(b.x)], 1u);
    const unsigned gen = old / nloc;
    if (old + 1u == (gen + 1u) * nloc) {
      __builtin_amdgcn_fence(__ATOMIC_RELEASE, "agent");
      asm volatile("s_waitcnt vmcnt(0)" ::: "memory");
      const unsigned og = xb_add(&bar[XB_TOP], 1u);
      const unsigned tg = og / nx;
      if (og + 1u == (tg + 1u) * nx) xb_add(&bar[XB_TOPGEN], 1u);
      else XB_SPIN(xb_ld(&bar[XB_TOPGEN]) == tg, bar);
      __builtin_amdgcn_fence(__ATOMIC_ACQUIRE, "agent");
      xb_add(&bar[XB_XGEN(b.x)], 1u);
      asm volatile("s_waitcnt vmcnt(0)" ::: "memory");
    } else {
      XB_SPIN(xb_ld(&bar[XB_XGEN(b.x)]) == gen, bar);
      __builtin_amdgcn_fence(__ATOMIC_ACQUIRE, "agent");
      asm volatile("s_waitcnt vmcnt(0)" ::: "memory");
    }
  }
  __syncthreads();
}

struct Params {
  const float *x, *c, *ada_w, *ada_b, *ln_g, *ln_b, *rw_mu, *rw_w_rkv, *rw_w0, *rw_w1, *rw_w2, *rw_a0, *rw_a1, *rw_a2, *rw_g1, *rw_g2,
      *rw_k_k, *rw_k_a, *rw_r_k, *rw_lnx_g, *rw_lnx_b, *rw_w_o, *pl_w_in, *pl_w_grp, *pl_scale, *pl_w_out, *pe_w_q, *pe_keys, *pe_u, *pe_v;
  float* out;
  float* mod;
  bf16_t *WT_rkv, *W1T, *A1T, *G1T, *W2T, *A2T, *G2T, *WoT, *PinT, *PoutT, *WgrpS, *WcT, *WqB, *WeffT, *KeysB;
  unsigned char* slot[7];
  float* tinv;
  bf16_t* lora_tmp;
  float* Gg;
  unsigned* bar;
};

DI void mod_item(const Params& p, int item, unsigned char* lds) {
  float* cond = (float*)lds;
  float (*red)[NB][32] = (float (*)[NB][32])(lds + 32768);
  const int tid = opaque_v(threadIdx.x);
  for (int i = tid; i < NB * D; i += 256) { float v = p.c[i]; cond[i] = v / (1.f + __expf(-v)); }
  __syncthreads();
  const int l = item / 192, cb = item % 192;
  const int col = cb * 32 + (tid & 31), kg = tid >> 5;
  const float* w = p.ada_w + (size_t)l * D * 6144 + col;
  float acc[NB];
#pragma unroll
  for (int b = 0; b < NB; ++b) acc[b] = 0.f;
  for (int k = kg * 128; k < kg * 128 + 128; k += 8) {
    float wv[8];
#pragma unroll
    for (int u = 0; u < 8; ++u) wv[u] = w[(size_t)(k + u) * 6144];
#pragma unroll
    for (int u = 0; u < 8; ++u)
#pragma unroll
      for (int b = 0; b < NB; ++b) acc[b] += cond[b * D + k + u] * wv[u];
  }
#pragma unroll
  for (int b = 0; b < NB; ++b) red[kg][b][tid & 31] = acc[b];
  __syncthreads();
  {
    const int b = tid >> 5, cc = tid & 31;
    float s = 0.f;
#pragma unroll
    for (int g = 0; g < 8; ++g) s += red[g][b][cc];
    const int n = cb * 32 + cc;
    p.mod[((size_t)l * NB + b) * 6144 + n] = s + p.ada_b[l * 6144 + n];
  }
  __syncthreads();
}

DI void transpose_item(const float* __restrict__ src, bf16_t* __restrict__ dst, int K, int N, int Kpad, int Npad, size_t sbs, size_t dbs, int item, unsigned char* lds) {
  float (*tile)[33] = (float (*)[33])lds;
  const int nb_n = Npad / 32, nb_k = Kpad / 32;
  const int per = nb_n * nb_k;
  const int bz = item / per, r = item % per;
  const int bk = r / nb_n, bn = r % nb_n;
  src += bz * sbs; dst += bz * dbs;
  const int tq = opaque_v(threadIdx.x); const int tx = tq & 31, ty = tq >> 5;
#pragma unroll
  for (int i = 0; i < 4; ++i) {
    const int k = bk * 32 + ty + i * 8, n = bn * 32 + tx;
    tile[ty + i * 8][tx] = (k < K && n < N) ? src[(size_t)k * N + n] : 0.f;
  }
  __syncthreads();
#pragma unroll
  for (int i = 0; i < 4; ++i) {
    const int n = bn * 32 + ty + i * 8, k = bk * 32 + tx;
    dst[(size_t)n * Kpad + k] = f2bf(tile[tx][ty + i * 8]);
  }
  __syncthreads();
}
DI void cvt_range(const float* __restrict__ src, bf16_t* __restrict__ dst, size_t n8, int bid, int nblk) {
  const int tq = opaque_v(threadIdx.x);
  for (size_t i = (size_t)bid * 256 + tq; i < n8; i += (size_t)nblk * 256) {
    const f32x4 a = *(const f32x4*)(src + i * 8), b = *(const f32x4*)(src + i * 8 + 4);
    u32x4 o; o.x = cvt_pk_bf16(a[0], a[1]); o.y = cvt_pk_bf16(a[2], a[3]); o.z = cvt_pk_bf16(b[0], b[1]); o.w = cvt_pk_bf16(b[2], b[3]);
    *(u32x4*)(dst + i * 8) = o;
  }
}
DI void prologue_phase(const Params& p, unsigned char* lds, int bid, int nblk) {
  constexpr int total = 384 + 3072 + 128 + 128 + 256 + 64 + 64 + 192 + 1024 + 1024 + 1024;
  for (int it = bid; it < total; it += nblk) {
    int r = it;
    if (r < 384) { mod_item(p, r, lds); continue; } r -= 384;
    if (r < 3072) { transpose_item(p.rw_w_rkv, p.WT_rkv, D, D, D, D, (size_t)D * D, (size_t)D * D, r, lds); continue; } r -= 3072;
    if (r < 128) { transpose_item(p.rw_w1, p.W1T, D, 64, D, 128, 0, 0, r, lds); continue; } r -= 128;
    if (r < 128) { transpose_item(p.rw_a1, p.A1T, D, 64, D, 128, 0, 0, r, lds); continue; } r -= 128;
    if (r < 256) { transpose_item(p.rw_g1, p.G1T, D, 160, D, 256, 0, 0, r, lds); continue; } r -= 256;
    if (r < 64) { transpose_item(p.rw_w2, p.W2T, 64, D, 64, D, 0, 0, r, lds); continue; } r -= 64;
    if (r < 64) { transpose_item(p.rw_a2, p.A2T, 64, D, 64, D, 0, 0, r, lds); continue; } r -= 64;
    if (r < 192) { transpose_item(p.rw_g2, p.G2T, 160, D, 192, D, 0, 0, r, lds); continue; } r -= 192;
    if (r < 1024) { transpose_item(p.rw_w_o, p.WoT, D, D, D, D, 0, 0, r, lds); continue; } r -= 1024;
    if (r < 1024) { transpose_item(p.pl_w_in, p.PinT, D, D, D, D, 0, 0, r, lds); continue; } r -= 1024;
    transpose_item(p.pl_w_out, p.PoutT, D, D, D, D, 0, 0, r, lds);
  }
  cvt_range(p.pe_keys, p.KeysB, (size_t)2 * 16 * 128 * 128 / 8, bid, nblk);
  cvt_range(p.pe_w_q, p.WqB, (size_t)2 * D * 2048 / 8, bid, nblk);
  {
    const int tq = opaque_v(threadIdx.x);
    for (int i = bid * 256 + tq; i < 4 * 256 * 256 / 8; i += nblk * 256) {
      const int e0 = (i * 8) & 255, g4 = (i * 8) >> 16;
      const f32x4 a0 = *(const f32x4*)(p.pl_w_grp + (size_t)i * 8), a1 = *(const f32x4*)(p.pl_w_grp + (size_t)i * 8 + 4);
      const f32x4 s0 = *(const f32x4*)(p.pl_scale + g4 * 256 + e0), s1 = *(const f32x4*)(p.pl_scale + g4 * 256 + e0 + 4);
      const f32x4 b0 = a0 * s0, b1 = a1 * s1;
      *(u32x4*)(p.WgrpS + (size_t)i * 8) = (u32x4){cvt_pk_bf16(b0[0], b0[1]), cvt_pk_bf16(b0[2], b0[3]), cvt_pk_bf16(b1[0], b1[1]), cvt_pk_bf16(b1[2], b1[3])};
    }
  }
}

DI void modulate_phase(const float* __restrict__ x, const float* __restrict__ mod_l, const float* __restrict__ mu, bf16_t* __restrict__ h, bf16_t* __restrict__ xr, bf16_t* __restrict__ xk,
                       bf16_t* __restrict__ xv, int bid, int nblk) {
  const size_t n8 = (size_t)T * D / 8; const int tq = opaque_v(threadIdx.x);
  for (size_t i = (size_t)bid * 256 + tq; i < n8; i += (size_t)nblk * 256) {
    const size_t e = i * 8; const int t = (int)(e / D), d = (int)(e % D), b = t / SEQ;
    const float* sh = mod_l + (size_t)b * 6144 + 0 * D + d; const float* sc = mod_l + (size_t)b * 6144 + 1 * D + d;
    float hv[8], pv[8];
    {
      const f32x4 a0 = *(const f32x4*)(x + e), a1 = *(const f32x4*)(x + e + 4);
      const f32x4 s0 = *(const f32x4*)sh, s1 = *(const f32x4*)(sh + 4), c0 = *(const f32x4*)sc, c1 = *(const f32x4*)(sc + 4);
      const f32x4 r0 = a0 * (c0 + 1.f) + s0, r1 = a1 * (c1 + 1.f) + s1;
      f32x4 q0 = {0.f, 0.f, 0.f, 0.f}, q1 = {0.f, 0.f, 0.f, 0.f};
      if ((t % SEQ) != 0) { const f32x4 b0 = *(const f32x4*)(x + e - D), b1 = *(const f32x4*)(x + e - D + 4); q0 = b0 * (c0 + 1.f) + s0; q1 = b1 * (c1 + 1.f) + s1; }
#pragma unroll
      for (int j = 0; j < 4; ++j) { hv[j] = r0[j]; hv[4 + j] = r1[j]; pv[j] = q0[j]; pv[4 + j] = q1[j]; }
    }
    u32x4 o; o.x = cvt_pk_bf16(hv[0], hv[1]); o.y = cvt_pk_bf16(hv[2], hv[3]); o.z = cvt_pk_bf16(hv[4], hv[5]); o.w = cvt_pk_bf16(hv[6], hv[7]);
    *(u32x4*)(h + e) = o;
#pragma unroll
    for (int n = 0; n < 3; ++n) {
      const f32x4 m0 = *(const f32x4*)(mu + n * D + d), m1 = *(const f32x4*)(mu + n * D + d + 4);
      float w[8];
#pragma unroll
      for (int j = 0; j < 8; ++j) { const float m = j < 4 ? m0[j] : m1[j - 4]; w[j] = hv[j] + (pv[j] - hv[j]) * m; }
      u32x4 q; q.x = cvt_pk_bf16(w[0], w[1]); q.y = cvt_pk_bf16(w[2], w[3]); q.z = cvt_pk_bf16(w[4], w[5]); q.w = cvt_pk_bf16(w[6], w[7]);
      *(u32x4*)((n == 0 ? xr : (n == 1 ? xk : xv)) + e) = q;
    }
  }
}

enum { EPI_BF16 = 0, EPI_TANH, EPI_SIGMOID, EPI_LW, EPI_ASIG, EPI_Z, EPI_SCALE, EPI_GATE, EPI_TOPK, EPI_ZB };
struct GemmArgs {
  const bf16_t* A; int lda;
  const bf16_t* Bt; int ldb;
  int N, K;
  const float* mu;
  int epi; void* out; int ldc;
  const float* v0; const float* v1;
};

DI int lds_off(int row, int chunk) { return row * 128 + ((chunk ^ (row & 7)) << 4); }

DI void gemm_load_a(const GemmArgs& g, int m0, int k0, int tid, u32x4 (&ra)[4]) {
#pragma unroll
  for (int i = 0; i < 4; ++i) {
    const int row = (tid >> 3) + i * 32, ch = tid & 7;
    const int m = m0 + row;
    const bf16_t* src = g.A + (size_t)m * g.lda + k0 + ch * 8;
    u32x4 v = *(const u32x4*)src;
    if (g.mu) {
      u32x4 pv = {0u, 0u, 0u, 0u};
      if ((m % SEQ) != 0) pv = *(const u32x4*)(src - g.lda);
      const f32x4 m0v = *(const f32x4*)(g.mu + k0 + ch * 8), m1v = *(const f32x4*)(g.mu + k0 + ch * 8 + 4);
      const unsigned hu[4] = {v.x, v.y, v.z, v.w}, pu[4] = {pv.x, pv.y, pv.z, pv.w};
      float o[8];
#pragma unroll
      for (int j = 0; j < 4; ++j) {
        const float h0 = bf_lo(hu[j]), h1 = bf_hi(hu[j]), p0 = bf_lo(pu[j]), p1 = bf_hi(pu[j]);
        const float mu0 = (2 * j < 4) ? m0v[(2 * j) & 3] : m1v[(2 * j) & 3], mu1 = (2 * j + 1 < 4) ? m0v[(2 * j + 1) & 3] : m1v[(2 * j + 1) & 3];
        o[2 * j] = h0 + (p0 - h0) * mu0; o[2 * j + 1] = h1 + (p1 - h1) * mu1;
      }
      v.x = cvt_pk_bf16(o[0], o[1]); v.y = cvt_pk_bf16(o[2], o[3]); v.z = cvt_pk_bf16(o[4], o[5]); v.w = cvt_pk_bf16(o[6], o[7]);
    }
    ra[i] = v;
  }
}
DI void gemm_load_b(const GemmArgs& g, int n0, int k0, int tid, u32x4 (&rb)[4]) {
#pragma unroll
  for (int i = 0; i < 4; ++i) {
    const int row = (tid >> 3) + i * 32, ch = tid & 7;
    rb[i] = *(const u32x4*)(g.Bt + (size_t)(n0 + row) * g.ldb + k0 + ch * 8);
  }
}
DI void gemm_store_lds(unsigned char* buf, int tid, const u32x4 (&r)[4]) {
#pragma unroll
  for (int i = 0; i < 4; ++i) {
    const int row = (tid >> 3) + i * 32, ch = tid & 7;
    *(u32x4*)(buf + lds_off(row, ch)) = r[i];
  }
}

DI unsigned f2key(float f) { unsigned u = __float_as_uint(f); return u ^ ((u >> 31) ? 0xffffffffu : 0x80000000u); }
DI float key2f(unsigned k) { unsigned u = (k >> 31) ? (k ^ 0x80000000u) : ~k; return __uint_as_float(u); }
#define CE_DESC(a, b) { const unsigned _mx = max(a, b), _mn = min(a, b); a = _mx; b = _mn; }
DI void sort16_desc(unsigned (&x)[16]) {
#pragma unroll
  for (int k = 2; k <= 16; k <<= 1) {
#pragma unroll
    for (int j = k >> 1; j > 0; j >>= 1) {
#pragma unroll
      for (int i = 0; i < 16; ++i) {
        const int l = i ^ j;
        if (l > i) {
          if ((i & k) == 0) { CE_DESC(x[i], x[l]); } else { CE_DESC(x[l], x[i]); }
        }
      }
    }
  }
}
DI void merge16_desc(unsigned (&x)[16]) {
#pragma unroll
  for (int j = 8; j > 0; j >>= 1) {
#pragma unroll
    for (int i = 0; i < 16; ++i) { const int l = i ^ j; if (l > i) { CE_DESC(x[i], x[l]); } }
  }
}

DI void peer_combine(const unsigned* la, const unsigned* lb, const unsigned (&s2k)[16], unsigned short* __restrict__ epk_row, float* __restrict__ gate_row) {
  float s1[16], s2[16];
#pragma unroll
  for (int i = 0; i < 4; ++i) {
    const u32x4 a = *(const u32x4*)(la + i * 4);
    s1[i * 4] = key2f(a.x & ~127u); s1[i * 4 + 1] = key2f(a.y & ~127u); s1[i * 4 + 2] = key2f(a.z & ~127u); s1[i * 4 + 3] = key2f(a.w & ~127u);
  }
#pragma unroll
  for (int i = 0; i < 16; ++i) s2[i] = key2f(s2k[i] & ~127u);
  unsigned c[4][16];
  {
    int n = 0;
#pragma unroll
    for (int a = 0; a < 16; ++a)
#pragma unroll
      for (int b = 0; b < 16; ++b)
        if ((a + 1) * (b + 1) <= 16) { c[n >> 4][n & 15] = (f2key(s1[a] + s2[b]) & ~255u) | (unsigned)(255 - (a * 16 + b)); ++n; }
#pragma unroll
    for (int q = 50; q < 64; ++q) c[q >> 4][q & 15] = 0u;
  }
  sort16_desc(c[0]); sort16_desc(c[1]); sort16_desc(c[2]); sort16_desc(c[3]);
#pragma unroll
  for (int e = 0; e < 16; ++e) { c[0][e] = max(c[0][e], c[1][15 - e]); c[2][e] = max(c[2][e], c[3][15 - e]); }
  merge16_desc(c[0]); merge16_desc(c[2]);
#pragma unroll
  for (int e = 0; e < 16; ++e) c[0][e] = max(c[0][e], c[2][15 - e]);
  merge16_desc(c[0]);
  float best[16], den = 0.f;
  const float mx = key2f(c[0][0] & ~255u);
#pragma unroll
  for (int e = 0; e < 16; ++e) { best[e] = __expf(key2f(c[0][e] & ~255u) - mx); den += best[e]; }
  const float inv = 1.f / den;
  unsigned idw[8];
#pragma unroll
  for (int e = 0; e < 16; ++e) {
    const int pos = 255 - (int)(c[0][e] & 255u), a = pos >> 4, b = pos & 15;
    const unsigned i1 = 127u - (la[a] & 127u), i2 = 127u - (lb[b] & 127u);
    const unsigned id = i1 * 128u + i2;
    if (e & 1) idw[e >> 1] |= id << 16; else idw[e >> 1] = id;
    best[e] *= inv;
  }
  ((u32x4*)epk_row)[0] = (u32x4){idw[0], idw[1], idw[2], idw[3]}; ((u32x4*)epk_row)[1] = (u32x4){idw[4], idw[5], idw[6], idw[7]};
#pragma unroll
  for (int q = 0; q < 4; ++q) ((f32x4*)gate_row)[q] = (f32x4){best[q * 4], best[q * 4 + 1], best[q * 4 + 2], best[q * 4 + 3]};
}

DI void gemm_glds(const bf16_t* __restrict__ base, int ld, int r0, int k0, unsigned char* buf, int wid, int lane) {
  const bf16_t* src = base + (size_t)(r0 + wid * 8 + (lane >> 3)) * ld + k0 + (((lane & 7) ^ (lane >> 3)) << 3);
#pragma unroll
  for (int j = 0; j < 4; ++j)
    __builtin_amdgcn_global_load_lds((const unsigned*)(src + (size_t)j * 32 * ld), (unsigned*)(buf + (j * 4 + wid) * 1024), 16, 0, 0);
}
DI void gemm_tile(const GemmArgs& g, int m0, int n0, unsigned char* lds) {
  constexpr int WM = 2, WN = 4 / WM, TM = 128 / WM, TN = 128 / WN, MI = TM / 16, NI = TN / 16;
  const int tid = opaque_v(threadIdx.x), lane = tid & 63, wid = tid >> 6;
  const int wm = wid / WN, wn = wid % WN;
  const int nk = g.K / 64;
  const bool lerp = g.mu != nullptr;
  f32x4 acc[MI][NI];
#pragma unroll
  for (int i = 0; i < MI; ++i)
#pragma unroll
    for (int j = 0; j < NI; ++j) acc[i][j] = (f32x4){0.f, 0.f, 0.f, 0.f};
  u32x4 ra[4];
  if (lerp) { gemm_load_a(g, m0, 0, tid, ra); gemm_store_lds(lds, tid, ra); } else gemm_glds(g.A, g.lda, m0, 0, lds, wid, lane);
  gemm_glds(g.Bt, g.ldb, n0, 0, lds + 16384, wid, lane);
  asm volatile("s_waitcnt vmcnt(0)" ::: "memory");
  __syncthreads();
  const int fr = lane & 15, fq = lane >> 4;
  for (int kt = 0; kt < nk; ++kt) {
    unsigned char* cur = lds + (kt & 1) * 32768;
    unsigned char* nxt = lds + ((kt + 1) & 1) * 32768;
    if (kt + 1 < nk) {
      if (lerp) gemm_load_a(g, m0, (kt + 1) * 64, tid, ra); else gemm_glds(g.A, g.lda, m0, (kt + 1) * 64, nxt, wid, lane);
      gemm_glds(g.Bt, g.ldb, n0, (kt + 1) * 64, nxt + 16384, wid, lane);
    }
    {
      bf16x8 af[2][MI], bfr[2][NI];
#pragma unroll
      for (int ks = 0; ks < 2; ++ks) {
#pragma unroll
        for (int i = 0; i < MI; ++i) af[ks][i] = *(const bf16x8*)(cur + lds_off(wm * TM + i * 16 + fr, ks * 4 + fq));
#pragma unroll
        for (int j = 0; j < NI; ++j) bfr[ks][j] = *(const bf16x8*)(cur + 16384 + lds_off(wn * TN + j * 16 + fr, ks * 4 + fq));
      }
      __builtin_amdgcn_sched_barrier(0);
#pragma unroll
      for (int ks = 0; ks < 2; ++ks)
#pragma unroll
        for (int i = 0; i < MI; ++i)
#pragma unroll
          for (int j = 0; j < NI; ++j) acc[i][j] = __builtin_amdgcn_mfma_f32_16x16x32_bf16(bfr[ks][j], af[ks][i], acc[i][j], 0, 0, 0);
      __builtin_amdgcn_sched_barrier(0);
    }
    if (lerp && kt + 1 < nk) gemm_store_lds(nxt, tid, ra);
    asm volatile("s_waitcnt vmcnt(0)" ::: "memory");
    __syncthreads();
  }
  if (g.epi == EPI_TOPK) {
    const int grp = n0 >> 7, head = grp >> 1, half = grp & 1;
#pragma unroll
    for (int i = 0; i < MI; ++i)
#pragma unroll
      for (int j = 0; j < NI; ++j) {
        const int ml = wm * TM + i * 16 + fr, c = wn * 16 + j * 4 + fq;
        u32x4 kv;
        kv.x = (f2key(acc[i][j][0]) & ~127u) | (unsigned)(127 - (c * 4 + 0)); kv.y = (f2key(acc[i][j][1]) & ~127u) | (unsigned)(127 - (c * 4 + 1));
        kv.z = (f2key(acc[i][j][2]) & ~127u) | (unsigned)(127 - (c * 4 + 2)); kv.w = (f2key(acc[i][j][3]) & ~127u) | (unsigned)(127 - (c * 4 + 3));
        *(u32x4*)(lds + ml * 512 + ((c ^ (ml & 31)) << 4)) = kv;
      }
    __syncthreads();
    {
      const int ml = wid * 32 + (lane & 31), hf = lane >> 5;
      unsigned a[16], b[16];
#pragma unroll
      for (int ch = 0; ch < 4; ++ch) {
#pragma unroll
        for (int cc = 0; cc < 4; ++cc) {
          const int c = hf * 16 + ch * 4 + cc;
          const u32x4 kv = *(const u32x4*)(lds + ml * 512 + ((c ^ (ml & 31)) << 4));
          b[cc * 4] = kv.x; b[cc * 4 + 1] = kv.y; b[cc * 4 + 2] = kv.z; b[cc * 4 + 3] = kv.w;
        }
        sort16_desc(b);
        if (ch == 0) {
#pragma unroll
          for (int e = 0; e < 16; ++e) a[e] = b[e];
        } else {
#pragma unroll
          for (int e = 0; e < 16; ++e) a[e] = max(a[e], b[15 - e]);
          merge16_desc(a);
        }
      }
#pragma unroll
      for (int e = 0; e < 16; ++e) b[e] = (unsigned)__shfl_xor((int)a[e], 32);
#pragma unroll
      for (int e = 0; e < 16; ++e) a[e] = max(a[e], b[15 - e]);
      merge16_desc(a);
      if (hf == 0) {
        unsigned* park = (unsigned*)(lds + (half == 0 ? 65536 + ml * 64 : ml * 512));
        ((u32x4*)park)[0] = (u32x4){a[0], a[1], a[2], a[3]}; ((u32x4*)park)[1] = (u32x4){a[4], a[5], a[6], a[7]};
        ((u32x4*)park)[2] = (u32x4){a[8], a[9], a[10], a[11]}; ((u32x4*)park)[3] = (u32x4){a[12], a[13], a[14], a[15]};
        if (half == 1) {
          const size_t m = (size_t)(m0 + ml);
          peer_combine((const unsigned*)(lds + 65536 + ml * 64), park, a, (unsigned short*)g.out + m * 128 + head * 16, (float*)g.v0 + m * 128 + head * 16);
        }
      }
    }
    __syncthreads();
    return;
  }
#pragma unroll
  for (int i = 0; i < MI; ++i) {
    const int m = m0 + wm * TM + i * 16 + fr;
#pragma unroll
    for (int j = 0; j < NI; ++j) {
      const int n = n0 + wn * TN + j * 16 + fq * 4;
      if (n >= g.N) continue;
      const f32x4 v = acc[i][j];
      bf16_t* ob = (bf16_t*)g.out + (size_t)m * g.ldc + n;
      switch (g.epi) {
        case EPI_BF16: *(u32x2*)ob = (u32x2){cvt_pk_bf16(v[0], v[1]), cvt_pk_bf16(v[2], v[3])}; break;
        case EPI_TANH: *(u32x2*)ob = (u32x2){cvt_pk_bf16(tanhf(v[0]), tanhf(v[1])), cvt_pk_bf16(tanhf(v[2]), tanhf(v[3]))}; break;
        case EPI_SIGMOID: *(u32x2*)ob = (u32x2){cvt_pk_bf16(sigmoidf_(v[0]), sigmoidf_(v[1])), cvt_pk_bf16(sigmoidf_(v[2]), sigmoidf_(v[3]))}; break;
        case EPI_LW: {
          const f32x4 w0 = *(const f32x4*)(g.v0 + n); float o[4];
#pragma unroll
          for (int q = 0; q < 4; ++q) { const float xx = -(w0[q] + v[q]); const float sp = fmaxf(xx, 0.f) + __logf(1.f + __expf(-fabsf(xx))); o[q] = -__expf(-sp - 0.5f); }
          *(u32x2*)ob = (u32x2){cvt_pk_bf16(o[0], o[1]), cvt_pk_bf16(o[2], o[3])};
        } break;
        case EPI_ASIG: {
          const f32x4 a0 = *(const f32x4*)(g.v0 + n);
          *(u32x2*)ob = (u32x2){cvt_pk_bf16(sigmoidf_(a0[0] + v[0]), sigmoidf_(a0[1] + v[1])), cvt_pk_bf16(sigmoidf_(a0[2] + v[2]), sigmoidf_(a0[3] + v[3]))};
        } break;
        case EPI_Z: {
          const int b = m / SEQ;
          const f32x4 xv = *(const f32x4*)(g.v0 + (size_t)m * D + n), gt = *(const f32x4*)(g.v1 + (size_t)b * 6144 + n);
          const f32x4 zz = xv * ALPHA + gt * v;
          *(u32x2*)ob = (u32x2){cvt_pk_bf16(zz[0], zz[1]), cvt_pk_bf16(zz[2], zz[3])};
        } break;
        case EPI_GATE: {
          const u32x2 yv = *(const u32x2*)ob;
          *(u32x2*)ob = (u32x2){cvt_pk_bf16(bf_lo(yv.x) * v[0], bf_hi(yv.x) * v[1]), cvt_pk_bf16(bf_lo(yv.y) * v[2], bf_hi(yv.y) * v[3])};
        } break;
        default: {
          const f32x4 sc = *(const f32x4*)(g.v0 + n);
          *(u32x2*)ob = (u32x2){cvt_pk_bf16(v[0] * sc[0], v[1] * sc[1]), cvt_pk_bf16(v[2] * sc[2], v[3] * sc[3])};
        } break;
      }
    }
  }
}

DI int lds_off32(int row, int chunk) { return row * 64 + ((chunk ^ (((row >> 3) & 1) << 1)) << 4); }
DI void gemm256_issue(const GemmArgs& g, int m0, int n0, int k0, unsigned char* buf, int wid, int lane) {
  const int lr = lane >> 2, gc = ((lane & 3) ^ ((lane >> 5) << 1)) << 3;
  const bf16_t* sa = g.A + (size_t)(m0 + wid * 16 + lr) * g.lda + k0 + gc;
#pragma unroll
  for (int j = 0; j < 4; ++j) __builtin_amdgcn_global_load_lds((const unsigned*)(sa + (size_t)j * 64 * g.lda), (unsigned*)(buf + (j * 4 + wid) * 1024), 16, 0, 0);
  const bf16_t* sb = g.Bt + (size_t)(n0 + wid * 16 + lr) * g.ldb + k0 + gc;
#pragma unroll
  for (int j = 0; j < 2; ++j) __builtin_amdgcn_global_load_lds((const unsigned*)(sb + (size_t)j * 64 * g.ldb), (unsigned*)(buf + 16384 + (j * 4 + wid) * 1024), 16, 0, 0);
}
DI void gemm_tile256(const GemmArgs& g, int m0, int n0, unsigned char* lds) {
  constexpr int MI = 8, NI = 4, STG = 24576;
  const int tid = opaque_v(threadIdx.x), lane = tid & 63, wid = tid >> 6, wm = wid >> 1, wn = wid & 1, fr = lane & 15, fq = lane >> 4;
  const int nk = g.K / 32;
  f32x4 acc[MI][NI];
#pragma unroll
  for (int i = 0; i < MI; ++i)
#pragma unroll
    for (int j = 0; j < NI; ++j) acc[i][j] = (f32x4){0.f, 0.f, 0.f, 0.f};
  __syncthreads();
  gemm256_issue(g, m0, n0, 0, lds, wid, lane);
  if (nk > 1) gemm256_issue(g, m0, n0, 32, lds + STG, wid, lane);
  int sc = 0, sn = 2;
  for (int kt = 0; kt < nk; ++kt) {
    if (kt + 1 < nk) asm volatile("s_waitcnt vmcnt(6)" ::: "memory"); else asm volatile("s_waitcnt vmcnt(0)" ::: "memory");
    __builtin_amdgcn_s_barrier();
    if (kt + 2 < nk) gemm256_issue(g, m0, n0, (kt + 2) * 32, lds + sn * STG, wid, lane);
    const unsigned char* cur = lds + sc * STG;
    bf16x8 af[MI], bfr[NI];
#pragma unroll
    for (int i = 0; i < MI; ++i) af[i] = *(const bf16x8*)(cur + lds_off32(wm * 128 + i * 16 + fr, fq));
#pragma unroll
    for (int j = 0; j < NI; ++j) bfr[j] = *(const bf16x8*)(cur + 16384 + lds_off32(wn * 64 + j * 16 + fr, fq));
#pragma unroll
    for (int i = 0; i < MI; ++i)
#pragma unroll
      for (int j = 0; j < NI; ++j) acc[i][j] = __builtin_amdgcn_mfma_f32_16x16x32_bf16(bfr[j], af[i], acc[i][j], 0, 0, 0);
    sc = (sc == 2) ? 0 : sc + 1; sn = (sn == 2) ? 0 : sn + 1;
  }
  if (g.epi == EPI_TOPK) {
    const int grp = n0 >> 7, head = grp >> 1, half = grp & 1;
    unsigned* parkg = (unsigned*)g.v1;
#pragma unroll 1
    for (int hb = 0; hb < 2; ++hb) {
      __syncthreads();
      if (wm == hb) {
#pragma unroll
        for (int i = 0; i < MI; ++i)
#pragma unroll
          for (int j = 0; j < NI; ++j) {
            const int ml = i * 16 + fr, c = wn * 16 + j * 4 + fq;
            u32x4 kv;
            kv.x = (f2key(acc[i][j][0]) & ~127u) | (unsigned)(127 - (c * 4 + 0)); kv.y = (f2key(acc[i][j][1]) & ~127u) | (unsigned)(127 - (c * 4 + 1));
            kv.z = (f2key(acc[i][j][2]) & ~127u) | (unsigned)(127 - (c * 4 + 2)); kv.w = (f2key(acc[i][j][3]) & ~127u) | (unsigned)(127 - (c * 4 + 3));
            *(u32x4*)(lds + ml * 512 + ((c ^ (ml & 31)) << 4)) = kv;
          }
      }
      __syncthreads();
      const int ml = wid * 32 + (lane & 31), hf = lane >> 5;
      unsigned a[16], b[16];
#pragma unroll 1
      for (int ch = 0; ch < 4; ++ch) {
#pragma unroll
        for (int cc = 0; cc < 4; ++cc) {
          const int c = hf * 16 + ch * 4 + cc;
          const u32x4 kv = *(const u32x4*)(lds + ml * 512 + ((c ^ (ml & 31)) << 4));
          b[cc * 4] = kv.x; b[cc * 4 + 1] = kv.y; b[cc * 4 + 2] = kv.z; b[cc * 4 + 3] = kv.w;
        }
        sort16_desc(b);
        if (ch == 0) {
#pragma unroll
          for (int e = 0; e < 16; ++e) a[e] = b[e];
        } else {
#pragma unroll
          for (int e = 0; e < 16; ++e) a[e] = max(a[e], b[15 - e]);
          merge16_desc(a);
        }
      }
#pragma unroll
      for (int e = 0; e < 16; ++e) b[e] = (unsigned)__shfl_xor((int)a[e], 32);
#pragma unroll
      for (int e = 0; e < 16; ++e) a[e] = max(a[e], b[15 - e]);
      merge16_desc(a);
      if (hf == 0) {
        unsigned* pg = parkg + (hb * 128 + ml) * 16;
        if (half == 0) {
          ((u32x4*)pg)[0] = (u32x4){a[0], a[1], a[2], a[3]}; ((u32x4*)pg)[1] = (u32x4){a[4], a[5], a[6], a[7]};
          ((u32x4*)pg)[2] = (u32x4){a[8], a[9], a[10], a[11]}; ((u32x4*)pg)[3] = (u32x4){a[12], a[13], a[14], a[15]};
        } else {
          unsigned* row = (unsigned*)(lds + ml * 512);
          ((u32x4*)row)[0] = (u32x4){a[0], a[1], a[2], a[3]}; ((u32x4*)row)[1] = (u32x4){a[4], a[5], a[6], a[7]};
          ((u32x4*)row)[2] = (u32x4){a[8], a[9], a[10], a[11]}; ((u32x4*)row)[3] = (u32x4){a[12], a[13], a[14], a[15]};
#pragma unroll
          for (int e = 0; e < 16; ++e) row[16 + e] = __hip_atomic_load(pg + e, __ATOMIC_RELAXED, __HIP_MEMORY_SCOPE_AGENT);
          const size_t m = (size_t)(m0 + hb * 128 + ml);
          peer_combine(row + 16, row, a, (unsigned short*)g.out + m * 128 + head * 16, (float*)g.v0 + m * 128 + head * 16);
        }
      }
    }
    __syncthreads();
    return;
  }
#pragma unroll
  for (int i = 0; i < MI; ++i) {
    const int m = m0 + wm * 128 + i * 16 + fr;
#pragma unroll
    for (int j = 0; j < NI; ++j) {
      const int n = n0 + wn * 64 + j * 16 + fq * 4;
      const f32x4 v = acc[i][j];
      if (g.epi == EPI_Z || g.epi == EPI_ZB) {
        const int b = m / SEQ;
        f32x4 xv;
        if (g.epi == EPI_Z) xv = *(const f32x4*)(g.v0 + (size_t)m * D + n);
        else { const u32x2 xb = *(const u32x2*)((const bf16_t*)g.v0 + (size_t)m * D + n); xv = (f32x4){bf_lo(xb.x), bf_hi(xb.x), bf_lo(xb.y), bf_hi(xb.y)}; }
        const f32x4 gt = *(const f32x4*)(g.v1 + (size_t)b * 6144 + n);
        const f32x4 zz = xv * ALPHA + gt * v;
        *(u32x2*)((bf16_t*)g.out + (size_t)m * g.ldc + n) = (u32x2){cvt_pk_bf16(zz[0], zz[1]), cvt_pk_bf16(zz[2], zz[3])};
      } else {
        *(u32x2*)((bf16_t*)g.out + (size_t)m * g.ldc + n) = (u32x2){cvt_pk_bf16(v[0], v[1]), cvt_pk_bf16(v[2], v[3])};
      }
    }
  }
}

DI GemmArgs mk(const bf16_t* A, int lda, const bf16_t* Bt, int ldb, int N, int K, int epi, void* out, int ldc,
               const float* mu = nullptr, const float* v0 = nullptr, const float* v1 = nullptr) {
  GemmArgs g; g.A = A; g.lda = lda; g.Bt = Bt; g.ldb = ldb; g.N = N; g.K = K; g.mu = mu; g.epi = epi; g.out = out; g.ldc = ldc; g.v0 = v0; g.v1 = v1; return g;
}
DI int sched_iters(int ntn, int nblk, int nmt = 256) {
  const int LB = nblk >> 3; int it = 0;
  for (int n0 = 0; n0 < ntn;) { int NT = min(8, ntn - n0); while (LB % NT) --NT; const int MT = LB / NT; it += (nmt + 8 * MT - 1) / (8 * MT); n0 += NT; }
  return it;
}
DI bool sched_mn(int i, int bid, int nblk, int ntn, int& mt, int& nt, int nmt = 256) {
  const int x = bid & 7, l = bid >> 3, LB = nblk >> 3; int base = 0;
  for (int n0 = 0; n0 < ntn;) {
    int NT = min(8, ntn - n0); while (LB % NT) --NT;
    const int MT = LB / NT, rounds = (nmt + 8 * MT - 1) / (8 * MT);
    if (i < base + rounds) { mt = (i - base) * 8 * MT + x * MT + (l % MT); nt = n0 + l / MT; return mt < nmt; }
    base += rounds; n0 += NT;
  }
  return false;
}

constexpr int CL = 32;
constexpr int NCH = SEQ / CL;
constexpr int SN = 144, ST = 80;
struct ScanArgs {
  bf16_t* r; const bf16_t *k, *v, *lw, *a;
  const float *k_k, *k_a, *r_k, *lnx_g, *lnx_b;
  bf16_t* Pg;
  bf16_t *Qz0, *Qz1;
  float* Gg;
};
DI int tr_off(int row, int tok) { return row * ST + ((((tok >> 3) ^ ((row >> 3) & 3)) << 4) | ((tok & 7) << 1)); }
template <bool PT, bool QT>
DI f32x4 tile_mm(const unsigned char* P, int ps, const unsigned char* Q, int qs, int i0, int j0, int nks, f32x4 acc, int lane) {
  const int fr = lane & 15, fq = lane >> 4;
  for (int ks = 0; ks < nks; ++ks) {
    const bf16x8 pa = *(const bf16x8*)(PT ? P + tr_off(i0 + fr, fq * 8) : P + (i0 + fr) * ps + ks * 64 + fq * 16);
    const bf16x8 qb = *(const bf16x8*)(QT ? Q + tr_off(j0 + fr, fq * 8) : Q + (j0 + fr) * qs + ks * 64 + fq * 16);
    acc = __builtin_amdgcn_mfma_f32_16x16x32_bf16(pa, qb, acc, 0, 0, 0);
  }
  return acc;
}
DI bf16_t* qz_ptr(const ScanArgs& s, int ch) { return ((ch >> 13) ? s.Qz1 : s.Qz0) + (size_t)(ch & 8191) * 4096; }
DI void st_bf16x4(unsigned char* p, const f32x4& v) { *(u32x2*)p = (u32x2){cvt_pk_bf16(v[0], v[1]), cvt_pk_bf16(v[2], v[3])}; }

struct ScanIn { u32x4 r, k, v, w, a, z0, z1; f32x4 kk0, kk1, ka0, ka1, rk0, rk1; };
template <bool PHASE_C>
DI void scan_fetch(const ScanArgs& s, int item, ScanIn& in) {
  const int c = item & (NCH - 1), h = (item >> 7) & 15, b = item >> 11;
  const int tid = opaque_v(threadIdx.x), tt = tid >> 3, c0 = (tid & 7) * 8;
  const size_t off = ((size_t)b * SEQ + (size_t)c * CL + tt) * D + h * HS + c0;
  in.k = *(const u32x4*)(s.k + off); in.v = *(const u32x4*)(s.v + off); in.w = *(const u32x4*)(s.lw + off); in.a = *(const u32x4*)(s.a + off);
  { const int ch = h * HS + c0;
    in.kk0 = *(const f32x4*)(s.k_k + ch); in.kk1 = *(const f32x4*)(s.k_k + ch + 4); in.ka0 = *(const f32x4*)(s.k_a + ch); in.ka1 = *(const f32x4*)(s.k_a + ch + 4);
    if (PHASE_C) { in.rk0 = *(const f32x4*)(s.r_k + ch); in.rk1 = *(const f32x4*)(s.r_k + ch + 4); } }
  if (PHASE_C) {
    in.r = *(const u32x4*)(s.r + off);
    const bf16_t* Zg = qz_ptr(s, item);
    in.z0 = *(const u32x4*)(Zg + tid * 8); in.z1 = *(const u32x4*)(Zg + (tid + 256) * 8);
  }
}
template <bool PHASE_C>
DI void scan_load(const ScanArgs& s, const ScanIn& in, int h, float* lwbuf, unsigned char* At, unsigned char* Bt, unsigned char* Kt, unsigned char* Rt,
                  unsigned char* AtT, unsigned char* BhT, unsigned char* KhT, unsigned char* VT, float& bonus, float (&vout)[8], float* Gout) {
  const int tid = opaque_v(threadIdx.x), tt = tid >> 3, c0 = (tid & 7) * 8;
  const u32x4 vk = in.k, vv = in.v, vw = in.w, va = in.a;
  u32x4 vr = {0u, 0u, 0u, 0u};
  if (PHASE_C) vr = in.r;
  float fr_[8], fk[8], fv[8], fw[8], fa[8];
  { const unsigned ur[4] = {vr.x, vr.y, vr.z, vr.w}, uk[4] = {vk.x, vk.y, vk.z, vk.w}, uv[4] = {vv.x, vv.y, vv.z, vv.w}, uw[4] = {vw.x, vw.y, vw.z, vw.w}, ua[4] = {va.x, va.y, va.z, va.w};
#pragma unroll
    for (int j = 0; j < 4; ++j) {
      fr_[2 * j] = bf_lo(ur[j]); fr_[2 * j + 1] = bf_hi(ur[j]); fk[2 * j] = bf_lo(uk[j]); fk[2 * j + 1] = bf_hi(uk[j]);
      fv[2 * j] = bf_lo(uv[j]); fv[2 * j + 1] = bf_hi(uv[j]); fw[2 * j] = bf_lo(uw[j]); fw[2 * j + 1] = bf_hi(uw[j]);
      fa[2 * j] = bf_lo(ua[j]); fa[2 * j + 1] = bf_hi(ua[j]);
    } }
  *(f32x4*)(lwbuf + tt * 64 + c0) = (f32x4){fw[0], fw[1], fw[2], fw[3]}; *(f32x4*)(lwbuf + tt * 64 + c0 + 4) = (f32x4){fw[4], fw[5], fw[6], fw[7]};
  float kkr[8], nrm = 0.f, bon = 0.f, kp[8];
#pragma unroll
  for (int j = 0; j < 8; ++j) {
    const float pkk = j < 4 ? in.kk0[j & 3] : in.kk1[j & 3], pka = j < 4 ? in.ka0[j & 3] : in.ka1[j & 3];
    kkr[j] = fk[j] * pkk; nrm += kkr[j] * kkr[j];
    kp[j] = fk[j] * (1.f + (fa[j] - 1.f) * pka);
    if (PHASE_C) bon += fr_[j] * kp[j] * (j < 4 ? in.rk0[j & 3] : in.rk1[j & 3]);
  }
  nrm += __shfl_xor(nrm, 1); nrm += __shfl_xor(nrm, 2); nrm += __shfl_xor(nrm, 4);
  if (PHASE_C) { bon += __shfl_xor(bon, 1); bon += __shfl_xor(bon, 2); bon += __shfl_xor(bon, 4); }
  bonus = bon;
  const float inv = rsqrtf(fmaxf(nrm, 1e-24f));
  __syncthreads();
  {
    const int c = tid & 63, sg = tid >> 6;
    float w8[8];
#pragma unroll
    for (int i = 0; i < 8; ++i) w8[i] = lwbuf[(sg * 8 + i) * 64 + c];
    float run = 0.f;
#pragma unroll
    for (int i = 0; i < 8; ++i) { run += w8[i]; lwbuf[(sg * 8 + i) * 64 + c] = run; }
  }
  __syncthreads();
  float cum[8], cl[8];
  {
    const int sg = tt >> 3;
#pragma unroll
    for (int hh = 0; hh < 2; ++hh) {
      const f32x4 me = *(const f32x4*)(lwbuf + tt * 64 + c0 + hh * 4);
      const f32x4 s0 = *(const f32x4*)(lwbuf + 7 * 64 + c0 + hh * 4), s1 = *(const f32x4*)(lwbuf + 15 * 64 + c0 + hh * 4),
                  s2 = *(const f32x4*)(lwbuf + 23 * 64 + c0 + hh * 4), s3 = *(const f32x4*)(lwbuf + 31 * 64 + c0 + hh * 4);
#pragma unroll
      for (int q = 0; q < 4; ++q) {
        const float pre = (sg > 0 ? s0[q] : 0.f) + (sg > 1 ? s1[q] : 0.f) + (sg > 2 ? s2[q] : 0.f);
        cum[hh * 4 + q] = me[q] + pre; cl[hh * 4 + q] = (s0[q] + s1[q]) + (s2[q] + s3[q]);
      }
    }
  }
  float at[8], bt[8], kt[8], rt[8], bh[8], kh[8];
#pragma unroll
  for (int j = 0; j < 8; ++j) {
    const float kk = kkr[j] * inv, bb = kk * fa[j];
    const float ein = __expf(cum[j]), eneg = __expf(-cum[j]), eex = __expf(cum[j] - fw[j]), eend = __expf(cl[j] - cum[j]);
    at[j] = -kk * eex; bt[j] = bb * eneg; kt[j] = kp[j] * eneg; rt[j] = fr_[j] * ein; bh[j] = bb * eend; kh[j] = kp[j] * eend;
    vout[j] = fv[j];
  }
  *(u32x4*)(At + tt * SN + c0 * 2) = (u32x4){cvt_pk_bf16(at[0], at[1]), cvt_pk_bf16(at[2], at[3]), cvt_pk_bf16(at[4], at[5]), cvt_pk_bf16(at[6], at[7])};
  *(u32x4*)(Bt + tt * SN + c0 * 2) = (u32x4){cvt_pk_bf16(bt[0], bt[1]), cvt_pk_bf16(bt[2], bt[3]), cvt_pk_bf16(bt[4], bt[5]), cvt_pk_bf16(bt[6], bt[7])};
  *(u32x4*)(Kt + tt * SN + c0 * 2) = (u32x4){cvt_pk_bf16(kt[0], kt[1]), cvt_pk_bf16(kt[2], kt[3]), cvt_pk_bf16(kt[4], kt[5]), cvt_pk_bf16(kt[6], kt[7])};
  if (PHASE_C) *(u32x4*)(Rt + tt * SN + c0 * 2) = (u32x4){cvt_pk_bf16(rt[0], rt[1]), cvt_pk_bf16(rt[2], rt[3]), cvt_pk_bf16(rt[4], rt[5]), cvt_pk_bf16(rt[6], rt[7])};
#pragma unroll
  for (int j = 0; j < 8; ++j) {
    *(bf16_t*)(VT + tr_off(c0 + j, tt)) = f2bf(fv[j]);
    if (!PHASE_C) {
      *(bf16_t*)(AtT + tr_off(c0 + j, tt)) = f2bf(at[j]);
      *(bf16_t*)(BhT + tr_off(c0 + j, tt)) = f2bf(bh[j]);
      *(bf16_t*)(KhT + tr_off(c0 + j, tt)) = f2bf(kh[j]);
    }
  }
  if (!PHASE_C && tt == 0 && Gout) {
#pragma unroll
    for (int j = 0; j < 8; ++j) Gout[c0 + j] = __expf(cl[j]);
  }
}
DI void scan_tinv(const float* A32, unsigned char* Tm, int lane) {
  const int c = lane & 31;
  float Tc[32];
#pragma unroll
  for (int i = 0; i < 32; ++i) {
    float s0 = (i == c) ? 1.f : 0.f, s1 = 0.f, s2 = 0.f, s3 = 0.f;
#pragma unroll
    for (int j4 = 0; j4 < (i + 3) / 4; ++j4) {
      const f32x4 a4 = *(const f32x4*)(A32 + i * 36 + j4 * 4);
      if (j4 * 4 + 0 < i) s0 += a4[0] * Tc[j4 * 4 + 0];
      if (j4 * 4 + 1 < i) s1 += a4[1] * Tc[j4 * 4 + 1];
      if (j4 * 4 + 2 < i) s2 += a4[2] * Tc[j4 * 4 + 2];
      if (j4 * 4 + 3 < i) s3 += a4[3] * Tc[j4 * 4 + 3];
    }
    Tc[i] = (s0 + s1) + (s2 + s3);
  }
  if (lane < 32) {
#pragma unroll
    for (int i = 0; i < 32; ++i) *(bf16_t*)(Tm + i * ST + c * 2) = f2bf(Tc[i]);
  }
}

DI void scan_phaseA_item(const ScanArgs& s, int item, const ScanIn& in, unsigned char* lds) {
  const int c = item & (NCH - 1), h = (item >> 7) & 15, b = item >> 11;
  const int tid = opaque_v(threadIdx.x), lane = tid & 63, wv = tid >> 6, fr = lane & 15, fq = lane >> 4;
  unsigned char* At = lds; unsigned char* Bt = At + 32 * SN; unsigned char* Kt = Bt + 32 * SN;
  unsigned char* AtT = Kt + 32 * SN; unsigned char* BhT = AtT + 64 * ST; unsigned char* KhT = BhT + 64 * ST; unsigned char* VT = KhT + 64 * ST;
  unsigned char* Tm = VT + 64 * ST; unsigned char* Aak = Tm + 32 * ST;
  float* A32 = (float*)(Aak + 32 * ST);
  unsigned char* W1T = (unsigned char*)A32 + 4608; unsigned char* M2T = W1T + 64 * ST; unsigned char* UlT = M2T + 64 * ST;
  float* lwbuf = (float*)W1T;
  const size_t gbase = ((size_t)b * SEQ + (size_t)c * CL) * D + h * HS;
  float bonus; float vv8[8];
  scan_load<false>(s, in, h, lwbuf, At, Bt, Kt, nullptr, AtT, BhT, KhT, VT, bonus, vv8, s.Gg + (size_t)item * 64);
  __syncthreads();
  {
    const int mat = wv >> 1, ti = wv & 1;
#pragma unroll
    for (int tj = 0; tj < 2; ++tj) {
      const f32x4 x = tile_mm<false, false>(At, SN, mat ? Kt : Bt, SN, ti * 16, tj * 16, 2, (f32x4){0.f, 0.f, 0.f, 0.f}, lane);
#pragma unroll
      for (int q = 0; q < 4; ++q) {
        const int i = ti * 16 + fq * 4 + q, j = tj * 16 + fr;
        const float val = (j < i) ? x[q] : 0.f;
        if (mat == 0) A32[i * 36 + j] = val; else *(bf16_t*)(Aak + i * ST + j * 2) = f2bf(val);
      }
    }
  }
  __syncthreads();
  if (wv == 0) scan_tinv(A32, Tm, lane);
  else {
    for (int tile = wv - 1; tile < 8; tile += 3) {
      const int ti = tile >> 2, tv = tile & 3;
      const f32x4 x = tile_mm<false, true>(Aak, ST, VT, ST, ti * 16, tv * 16, 1, (f32x4){0.f, 0.f, 0.f, 0.f}, lane);
      st_bf16x4(M2T + tr_off(tv * 16 + fr, ti * 16 + fq * 4), x);
    }
  }
  __syncthreads();
#pragma unroll
  for (int u = 0; u < 4; ++u) {
    const int tile = wv * 4 + u, which = tile >> 3, ti = (tile >> 2) & 1, tn = tile & 3;
    const f32x4 x = tile_mm<false, true>(Tm, ST, which ? M2T : AtT, ST, ti * 16, tn * 16, 1, (f32x4){0.f, 0.f, 0.f, 0.f}, lane);
    st_bf16x4((which ? UlT : W1T) + tr_off(tn * 16 + fr, ti * 16 + fq * 4), x);
  }
  __syncthreads();
  bf16_t* Pg = s.Pg + (size_t)item * 4096; bf16_t* Qg = qz_ptr(s, item);
#pragma unroll
  for (int u = 0; u < 4; ++u) {
    const int tile = wv * 4 + u, tk = tile >> 2, tn = tile & 3;
    const f32x4 xp = tile_mm<true, true>(W1T, ST, BhT, ST, tk * 16, tn * 16, 1, (f32x4){0.f, 0.f, 0.f, 0.f}, lane);
    *(u32x2*)(Pg + (tn * 16 + fr) * 64 + tk * 16 + fq * 4) = (u32x2){cvt_pk_bf16(xp[0], xp[1]), cvt_pk_bf16(xp[2], xp[3])};
    f32x4 xq = tile_mm<true, true>(BhT, ST, UlT, ST, tk * 16, tn * 16, 1, (f32x4){0.f, 0.f, 0.f, 0.f}, lane);
    xq = tile_mm<true, true>(KhT, ST, VT, ST, tk * 16, tn * 16, 1, xq, lane);
    __hip_atomic_store((unsigned long long*)(Qg + ((tk * 4 + tn) * 64 + lane) * 4), (unsigned long long)cvt_pk_bf16(xq[0], xq[1]) | ((unsigned long long)cvt_pk_bf16(xq[2], xq[3]) << 32), __ATOMIC_RELAXED, __HIP_MEMORY_SCOPE_AGENT);
  }
  __syncthreads();
}

constexpr int PSTR = 144;
constexpr int RSLOT = 64 * PSTR + 8192 + 256;
DI void scan_chain_block(const ScanArgs& s, int bh, unsigned char* lds) {
  const int tid = opaque_v(threadIdx.x), lane = tid & 63, tv = tid >> 6, fr = lane & 15, fq = lane >> 4;
  const int ch0 = bh * NCH;
  u32x4 pr[5];
  auto issue = [&](int c) {
    const bf16_t* Pg = s.Pg + (size_t)(ch0 + c) * 4096; const bf16_t* Qg = qz_ptr(s, ch0 + c);
    pr[0] = *(const u32x4*)(Pg + (size_t)tid * 8); pr[1] = *(const u32x4*)(Pg + (size_t)(tid + 256) * 8);
    pr[2] = *(const u32x4*)(Qg + (size_t)tid * 8); pr[3] = *(const u32x4*)(Qg + (size_t)(tid + 256) * 8);
    if (tid < 16) pr[4] = *(const u32x4*)(s.Gg + (size_t)(ch0 + c) * 64 + tid * 4);
  };
  auto commit = [&](int c) {
    unsigned char* sl = lds + (c & 3) * RSLOT;
    *(u32x4*)(sl + (tid >> 3) * PSTR + (tid & 7) * 16) = pr[0]; *(u32x4*)(sl + ((tid + 256) >> 3) * PSTR + (tid & 7) * 16) = pr[1];
    *(u32x4*)(sl + 64 * PSTR + tid * 16) = pr[2]; *(u32x4*)(sl + 64 * PSTR + (tid + 256) * 16) = pr[3];
    if (tid < 16) *(u32x4*)(sl + 64 * PSTR + 8192 + tid * 16) = pr[4];
  };
  issue(0); commit(0); issue(1); commit(1); issue(2); commit(2);
  __syncthreads();
  f32x4 Z[4];
#pragma unroll
  for (int t = 0; t < 4; ++t) Z[t] = (f32x4){0.f, 0.f, 0.f, 0.f};
  for (int c = 0; c < NCH; ++c) {
    if (c + 3 < NCH) issue(c + 3);
    const unsigned char* sl = lds + (c & 3) * RSLOT;
    bf16_t* Zo = qz_ptr(s, ch0 + c) + (tv * 16 + fr) * 64;
    unsigned zp[4][2];
#pragma unroll
    for (int t = 0; t < 4; ++t) { zp[t][0] = cvt_pk_bf16(Z[t][0], Z[t][1]); zp[t][1] = cvt_pk_bf16(Z[t][2], Z[t][3]); *(u32x2*)(Zo + t * 16 + fq * 4) = (u32x2){zp[t][0], zp[t][1]}; }
    bf16x8 zb[2];
#pragma unroll
    for (int ks = 0; ks < 2; ++ks) { const u32x4 w = {zp[2 * ks][0], zp[2 * ks][1], zp[2 * ks + 1][0], zp[2 * ks + 1][1]}; zb[ks] = __builtin_bit_cast(bf16x8, w); }
#pragma unroll
    for (int t = 0; t < 4; ++t) {
      const u32x2 qv = *(const u32x2*)(sl + 64 * PSTR + ((t * 4 + tv) * 64 + lane) * 8);
      const f32x4 g4 = *(const f32x4*)(sl + 64 * PSTR + 8192 + (t * 16 + fq * 4) * 4);
      f32x4 acc = (f32x4){bf_lo(qv.x) + g4[0] * Z[t][0], bf_hi(qv.x) + g4[1] * Z[t][1], bf_lo(qv.y) + g4[2] * Z[t][2], bf_hi(qv.y) + g4[3] * Z[t][3]};
#pragma unroll
      for (int ks = 0; ks < 2; ++ks) {
        const unsigned char* prow = sl + (t * 16 + fr) * PSTR + ks * 64 + fq * 8;
        const u32x2 p0 = *(const u32x2*)prow, p1 = *(const u32x2*)(prow + 32);
        const u32x4 w = {p0.x, p0.y, p1.x, p1.y};
        acc = __builtin_amdgcn_mfma_f32_16x16x32_bf16(__builtin_bit_cast(bf16x8, w), zb[ks], acc, 0, 0, 0);
      }
      Z[t] = acc;
    }
    if (c + 3 < NCH) commit(c + 3);
    __syncthreads();
  }
}

DI void scan_phaseC_item(const ScanArgs& s, int item, const ScanIn& in, unsigned char* lds) {
  const int c = item & (NCH - 1), h = (item >> 7) & 15, b = item >> 11;
  const int tid = opaque_v(threadIdx.x), lane = tid & 63, wv = tid >> 6, fr = lane & 15, fq = lane >> 4;
  unsigned char* At = lds; unsigned char* Bt = At + 32 * SN; unsigned char* Kt = Bt + 32 * SN; unsigned char* Rt = Kt + 32 * SN;
  unsigned char* VT = Rt + 32 * SN;
  unsigned char* Tm = VT + 64 * ST; unsigned char* Aak = Tm + 32 * ST; unsigned char* Arb = Aak + 32 * ST; unsigned char* Ark = Arb + 32 * ST;
  float* A32 = (float*)(Ark + 32 * ST);
  unsigned char* S0 = (unsigned char*)A32 + 4608;
  unsigned char* X1T = S0 + 64 * SN; unsigned char* UT = X1T + 64 * ST;
  float* Yb = (float*)(UT + 64 * ST);
  float* lwbuf = Yb;
  const size_t gbase = ((size_t)b * SEQ + (size_t)c * CL) * D + h * HS;
  float bonus; float vv8[8];
  { const int e0 = tid * 8, e1 = (tid + 256) * 8;
    *(u32x4*)(S0 + (e0 >> 6) * SN + (e0 & 63) * 2) = in.z0; *(u32x4*)(S0 + (e1 >> 6) * SN + (e1 & 63) * 2) = in.z1; }
  scan_load<true>(s, in, h, lwbuf, At, Bt, Kt, Rt, nullptr, nullptr, nullptr, VT, bonus, vv8, nullptr);
  __syncthreads();
  {
    const unsigned char* Pm = (wv < 2) ? At : Rt; const unsigned char* Qm = (wv & 1) ? Kt : Bt;
    unsigned char* dst = (wv == 1) ? Aak : (wv == 2 ? Arb : Ark);
#pragma unroll
    for (int t4 = 0; t4 < 4; ++t4) {
      const int ti = t4 >> 1, tj = t4 & 1;
      const f32x4 x = tile_mm<false, false>(Pm, SN, Qm, SN, ti * 16, tj * 16, 2, (f32x4){0.f, 0.f, 0.f, 0.f}, lane);
#pragma unroll
      for (int q = 0; q < 4; ++q) {
        const int i = ti * 16 + fq * 4 + q, j = tj * 16 + fr;
        const bool keep = (wv < 2) ? (j < i) : (j <= i);
        const float val = keep ? x[q] : 0.f;
        if (wv == 0) A32[i * 36 + j] = val; else *(bf16_t*)(dst + i * ST + j * 2) = f2bf(val);
      }
    }
  }
  __syncthreads();
  if (wv == 0) scan_tinv(A32, Tm, lane);
  else {
    for (int tile = wv - 1; tile < 8; tile += 3) {
      const int ti = tile >> 2, tv = tile & 3;
      f32x4 x = tile_mm<false, false>(At, SN, S0, SN, ti * 16, tv * 16, 2, (f32x4){0.f, 0.f, 0.f, 0.f}, lane);
      x = tile_mm<false, true>(Aak, ST, VT, ST, ti * 16, tv * 16, 1, x, lane);
      st_bf16x4(X1T + tr_off(tv * 16 + fr, ti * 16 + fq * 4), x);
    }
  }
  __syncthreads();
#pragma unroll
  for (int u = 0; u < 2; ++u) {
    const int tile = wv * 2 + u, ti = tile >> 2, tv = tile & 3;
    const f32x4 x = tile_mm<false, true>(Tm, ST, X1T, ST, ti * 16, tv * 16, 1, (f32x4){0.f, 0.f, 0.f, 0.f}, lane);
    st_bf16x4(UT + tr_off(tv * 16 + fr, ti * 16 + fq * 4), x);
  }
  __syncthreads();
#pragma unroll
  for (int u = 0; u < 2; ++u) {
    const int tile = wv * 2 + u, ti = tile >> 2, tv = tile & 3;
    f32x4 x = tile_mm<false, false>(Rt, SN, S0, SN, ti * 16, tv * 16, 2, (f32x4){0.f, 0.f, 0.f, 0.f}, lane);
    x = tile_mm<false, true>(Arb, ST, UT, ST, ti * 16, tv * 16, 1, x, lane);
    x = tile_mm<false, true>(Ark, ST, VT, ST, ti * 16, tv * 16, 1, x, lane);
#pragma unroll
    for (int q = 0; q < 4; ++q) Yb[(ti * 16 + fq * 4 + q) * 68 + tv * 16 + fr] = x[q];
  }
  __syncthreads();
  {
    const int tt = tid >> 3, c0 = (tid & 7) * 8;
    float yv[8], sum = 0.f;
#pragma unroll
    for (int j = 0; j < 8; ++j) { yv[j] = Yb[tt * 68 + c0 + j]; sum += yv[j]; }
    sum += __shfl_xor(sum, 1); sum += __shfl_xor(sum, 2); sum += __shfl_xor(sum, 4);
    const float mean = sum * (1.f / 64.f);
    float var = 0.f;
#pragma unroll
    for (int j = 0; j < 8; ++j) { const float d = yv[j] - mean; var += d * d; }
    var += __shfl_xor(var, 1); var += __shfl_xor(var, 2); var += __shfl_xor(var, 4);
    const float rstd = rsqrtf(var * (1.f / 64.f) + GN_EPS);
    const size_t off = gbase + (size_t)tt * D + c0;
    float o[8];
#pragma unroll
    for (int j = 0; j < 8; ++j) {
      const int chn = h * HS + c0 + j;
      o[j] = (yv[j] - mean) * rstd * s.lnx_g[chn] + s.lnx_b[chn] + bonus * vv8[j];
    }
    *(u32x4*)(s.r + off) = (u32x4){cvt_pk_bf16(o[0], o[1]), cvt_pk_bf16(o[2], o[3]), cvt_pk_bf16(o[4], o[5]), cvt_pk_bf16(o[6], o[7])};
  }
  __syncthreads();
}

DI void ln_phase(const bf16_t* __restrict__ z, const float* __restrict__ lg, const float* __restrict__ lb, bf16_t* __restrict__ xo, float* __restrict__ xo32,
                 const float* __restrict__ mod_l, int shift_idx, int scale_idx, bf16_t* __restrict__ ho, int bid, int nblk) {
  const int tq = opaque_v(threadIdx.x); const int lane = tq & 63, wv = tq >> 6;
  constexpr int RW = 4;
  for (int row0 = (bid * 4 + wv) * RW; row0 < T; row0 += nblk * 4 * RW) {
    float v[RW][16];
#pragma unroll
    for (int r = 0; r < RW; ++r) {
      const u32x4 a0 = *(const u32x4*)(z + (size_t)(row0 + r) * D + lane * 8), a1 = *(const u32x4*)(z + (size_t)(row0 + r) * D + 512 + lane * 8);
      const unsigned u[8] = {a0.x, a0.y, a0.z, a0.w, a1.x, a1.y, a1.z, a1.w};
#pragma unroll
      for (int q = 0; q < 8; ++q) { v[r][2 * q] = bf_lo(u[q]); v[r][2 * q + 1] = bf_hi(u[q]); }
    }
    const int b = row0 / SEQ;
#pragma unroll
    for (int r = 0; r < RW; ++r) {
      float s = 0.f;
#pragma unroll
      for (int i = 0; i < 16; ++i) s += v[r][i];
      const float mean = wave_sum(s) * (1.f / D);
      float q = 0.f;
#pragma unroll
      for (int i = 0; i < 16; ++i) { const float d = v[r][i] - mean; q += d * d; }
      const float rstd = rsqrtf(wave_sum(q) * (1.f / D) + LN_EPS);
      const int row = row0 + r;
#pragma unroll
      for (int hh = 0; hh < 2; ++hh) {
        const int d = hh * 512 + lane * 8;
        float o[8];
#pragma unroll
        for (int i = 0; i < 8; ++i) o[i] = (v[r][hh * 8 + i] - mean) * rstd * lg[d + i] + lb[d + i];
        if (xo32) { *(f32x4*)(xo32 + (size_t)row * D + d) = (f32x4){o[0], o[1], o[2], o[3]}; *(f32x4*)(xo32 + (size_t)row * D + d + 4) = (f32x4){o[4], o[5], o[6], o[7]}; }
        if (xo) *(u32x4*)(xo + (size_t)row * D + d) = (u32x4){cvt_pk_bf16(o[0], o[1]), cvt_pk_bf16(o[2], o[3]), cvt_pk_bf16(o[4], o[5]), cvt_pk_bf16(o[6], o[7])};
        if (ho) {
          float hq[8];
#pragma unroll
          for (int i = 0; i < 8; ++i) hq[i] = o[i] * (1.f + mod_l[(size_t)b * 6144 + scale_idx * D + d + i]) + mod_l[(size_t)b * 6144 + shift_idx * D + d + i];
          *(u32x4*)(ho + (size_t)row * D + d) = (u32x4){cvt_pk_bf16(hq[0], hq[1]), cvt_pk_bf16(hq[2], hq[3]), cvt_pk_bf16(hq[4], hq[5]), cvt_pk_bf16(hq[6], hq[7])};
        }
      }
    }
  }
}

DI void table_fp8_phase(const float* __restrict__ src, unsigned char* __restrict__ dst, float* __restrict__ inv, int rows, int bid, int nblk) {
  const int tq = opaque_v(threadIdx.x); const int lane = tq & 63, wv = tq >> 6;
  for (int r0 = (bid * 4 + wv) * 4; r0 < rows; r0 += nblk * 16) {
    f32x4 v[4][4];
#pragma unroll
    for (int rr = 0; rr < 4; ++rr)
#pragma unroll
      for (int i = 0; i < 4; ++i) v[rr][i] = __builtin_nontemporal_load((const f32x4*)(src + (size_t)(r0 + rr) * D + lane * 16 + i * 4));
#pragma unroll
    for (int rr = 0; rr < 4; ++rr) {
      float mx = 0.f;
#pragma unroll
      for (int i = 0; i < 4; ++i) mx = fmaxf(mx, fmaxf(fmaxf(fabsf(v[rr][i][0]), fabsf(v[rr][i][1])), fmaxf(fabsf(v[rr][i][2]), fabsf(v[rr][i][3]))));
#pragma unroll
      for (int o = 32; o >= 1; o >>= 1) mx = fmaxf(mx, __shfl_xor(mx, o));
      const float sc = mx > 0.f ? exp2f(floorf(log2f(384.f / mx))) : 1.f;
      unsigned w[4];
#pragma unroll
      for (int i = 0; i < 4; ++i) {
        int pk = 0;
        pk = __builtin_amdgcn_cvt_pk_fp8_f32(v[rr][i][0] * sc, v[rr][i][1] * sc, pk, false);
        pk = __builtin_amdgcn_cvt_pk_fp8_f32(v[rr][i][2] * sc, v[rr][i][3] * sc, pk, true);
        w[i] = (unsigned)pk;
      }
      *(u32x4*)(dst + (size_t)(r0 + rr) * D + lane * 16) = (u32x4){w[0], w[1], w[2], w[3]};
      if (lane == 0) inv[r0 + rr] = 1.f / sc;
    }
  }
}

struct PeerArgs {
  const bf16_t* h2;
  const unsigned char *u8, *v8;
  const float *uinv, *vinv;
  const unsigned short* epk; const float* gate;
  float* part;
  float* coef;
  const bf16_t* xres;
  const float* gate2;
  bf16_t* z;
  unsigned* ctr_u; unsigned* ctr_v;
};
constexpr int PCH = 64;
DI void cvt16_fp8(const u32x4& d, float (&f)[16]) {
  const unsigned w[4] = {d.x, d.y, d.z, d.w};
#pragma unroll
  for (int i = 0; i < 4; ++i) {
    const f32x2 lo = __builtin_amdgcn_cvt_pk_f32_fp8((int)w[i], false), hi = __builtin_amdgcn_cvt_pk_f32_fp8((int)w[i], true);
    f[i * 4] = lo.x; f[i * 4 + 1] = lo.y; f[i * 4 + 2] = hi.x; f[i * 4 + 3] = hi.y;
  }
}
template <bool VPHASE>
DI void peer_slice_phase(const PeerArgs& a, unsigned char* lds) {
  const int tq = opaque_v(threadIdx.x); const int lane = tq & 63, wv = tq >> 6, cc = lane & 7;
  volatile int* nxt = (volatile int*)lds;
  const unsigned xcc = xb_xcc_id() & 7u;
  unsigned* ctr = VPHASE ? a.ctr_v : a.ctr_u;
  for (int ks = 0; ks < 8; ++ks) {
    const int s = (int)((xcc + ks) & 7u);
    for (;;) {
      __syncthreads();
      if (tq == 0) *nxt = (int)atomicAdd(&ctr[s * 16], 1u);
      __syncthreads();
      const int chunk = *nxt;
      if (chunk >= T / PCH) break;
      for (int ti = 0; ti < PCH / 4; ++ti) {
        const int t = chunk * PCH + wv * (PCH / 4) + ti;
        const unsigned ep = (unsigned)a.epk[(size_t)t * 128 + lane] | ((unsigned)a.epk[(size_t)t * 128 + 64 + lane] << 16);
        const unsigned char* tab = (VPHASE ? a.v8 : a.u8) + s * 128 + cc * 16;
        u32x4 data[16];
        float cv[16];
        float c_lo = 0.f, c_hi = 0.f;
        if (VPHASE) { c_lo = a.coef[(size_t)t * 128 + lane]; c_hi = a.coef[(size_t)t * 128 + 64 + lane]; }
#pragma unroll
        for (int i = 0; i < 16; ++i) {
          const int src = (lane & ~7) | (i & 7);
          const unsigned ev = (unsigned)__shfl((int)ep, src);
          const unsigned e = (i < 8) ? (ev & 0xffffu) : (ev >> 16);
          if (VPHASE) cv[i] = __shfl(i < 8 ? c_lo : c_hi, src);
          data[i] = *(const u32x4*)(tab + (size_t)e * D);
        }
        if (!VPHASE) {
          const u32x4 h0 = *(const u32x4*)(a.h2 + (size_t)t * D + s * 128 + cc * 16), h1 = *(const u32x4*)(a.h2 + (size_t)t * D + s * 128 + cc * 16 + 8);
          float hf[16];
          { const unsigned u[8] = {h0.x, h0.y, h0.z, h0.w, h1.x, h1.y, h1.z, h1.w};
#pragma unroll
            for (int q = 0; q < 8; ++q) { hf[2 * q] = bf_lo(u[q]); hf[2 * q + 1] = bf_hi(u[q]); } }
          float r_lo = 0.f, r_hi = 0.f;
#pragma unroll
          for (int i = 0; i < 16; ++i) {
            float f[16]; cvt16_fp8(data[i], f);
            float d = 0.f;
#pragma unroll
            for (int q = 0; q < 16; ++q) d += f[q] * hf[q];
            d += __builtin_bit_cast(float, __builtin_amdgcn_update_dpp(0, __builtin_bit_cast(int, d), 0xB1, 0xF, 0xF, true));
            d += __builtin_bit_cast(float, __builtin_amdgcn_update_dpp(0, __builtin_bit_cast(int, d), 0x4E, 0xF, 0xF, true));
            d += __builtin_bit_cast(float, __builtin_amdgcn_update_dpp(0, __builtin_bit_cast(int, d), 0x141, 0xF, 0xF, true));
            if ((i & 7) == cc) { if (i < 8) r_lo = d; else r_hi = d; }
          }
          float* pp = a.part + ((size_t)s * T + t) * 128;
          pp[lane] = r_lo; pp[64 + lane] = r_hi;
        } else {
          float acc[16];
#pragma unroll
          for (int q = 0; q < 16; ++q) acc[q] = 0.f;
#pragma unroll
          for (int i = 0; i < 16; ++i) {
            float f[16]; cvt16_fp8(data[i], f);
#pragma unroll
            for (int q = 0; q < 16; ++q) acc[q] += cv[i] * f[q];
          }
          float r8[8], r4[4], r2[2];
          { const bool up = (lane & 8) != 0;
#pragma unroll
            for (int q = 0; q < 8; ++q) { const float keep = up ? acc[8 + q] : acc[q], send = up ? acc[q] : acc[8 + q]; r8[q] = keep + __shfl_xor(send, 8); } }
          { const bool up = (lane & 16) != 0;
#pragma unroll
            for (int q = 0; q < 4; ++q) { const float keep = up ? r8[4 + q] : r8[q], send = up ? r8[q] : r8[4 + q]; r4[q] = keep + __shfl_xor(send, 16); } }
          { const bool up = (lane & 32) != 0;
#pragma unroll
            for (int q = 0; q < 2; ++q) { const float keep = up ? r4[2 + q] : r4[q], send = up ? r4[q] : r4[2 + q]; r2[q] = keep + __shfl_xor(send, 32); } }
          const int col = s * 128 + cc * 16 + ((lane >> 3) & 1) * 8 + ((lane >> 4) & 1) * 4 + ((lane >> 5) & 1) * 2;
          const int b = t / SEQ;
          const unsigned xb = *(const unsigned*)(a.xres + (size_t)t * D + col); const f32x2 gt = *(const f32x2*)(a.gate2 + (size_t)b * 6144 + col);
          *(unsigned*)(a.z + (size_t)t * D + col) = cvt_pk_bf16(ALPHA * bf_lo(xb) + gt.x * r2[0], ALPHA * bf_hi(xb) + gt.y * r2[1]);
        }
      }
    }
  }
  __syncthreads();
}
DI void peer_coef_phase(const PeerArgs& a, int bid, int nblk) {
  const int tq = opaque_v(threadIdx.x);
  for (int g4 = bid * 256 + tq; g4 < T * 32; g4 += nblk * 256) {
    const int t = g4 >> 5, j = (g4 & 31) * 4;
    const u32x2 ep = *(const u32x2*)(a.epk + (size_t)t * 128 + j);
    const unsigned e[4] = {ep.x & 0xffffu, ep.x >> 16, ep.y & 0xffffu, ep.y >> 16};
    float ui[4], vi[4];
#pragma unroll
    for (int q = 0; q < 4; ++q) { ui[q] = a.uinv[e[q]]; vi[q] = a.vinv[e[q]]; }
    f32x4 sum = {0.f, 0.f, 0.f, 0.f};
#pragma unroll
    for (int s8 = 0; s8 < 8; ++s8) sum += *(const f32x4*)(a.part + ((size_t)s8 * T + t) * 128 + j);
    const f32x4 gt = *(const f32x4*)(a.gate + (size_t)t * 128 + j);
    f32x4 o;
#pragma unroll
    for (int q = 0; q < 4; ++q) o[q] = gt[q] * gelu_exact(sum[q] * ui[q]) * vi[q];
    *(f32x4*)(a.coef + (size_t)t * 128 + j) = o;
  }
}

DI void pool_phase(const bf16_t* __restrict__ zin, bf16_t* __restrict__ pout, int bid, int nblk) {
  const int tq = opaque_v(threadIdx.x);
  constexpr int SEG = 32;
  for (int it = bid * 256 + tq; it < (T / SEG) * (D / 8); it += nblk * 256) {
    const int ch = it & 127, seg = it >> 7;
    const int d = ch * 8, win = 2 << (d / 256);
    const int t0 = seg * SEG, tp0 = t0 % SEQ;
    float s[8];
#pragma unroll
    for (int j = 0; j < 8; ++j) s[j] = 0.f;
    for (int w = 1; w < win; ++w) {
      if (tp0 - w < 0) break;
      const u32x4 v = *(const u32x4*)(zin + (size_t)(t0 - w) * D + d);
      const unsigned u[4] = {v.x, v.y, v.z, v.w};
#pragma unroll
      for (int j = 0; j < 4; ++j) { s[2 * j] += bf_lo(u[j]); s[2 * j + 1] += bf_hi(u[j]); }
    }
#pragma unroll 4
    for (int i = 0; i < SEG; ++i) {
      const int t = t0 + i, tp = tp0 + i;
      const u32x4 v = *(const u32x4*)(zin + (size_t)t * D + d);
      const unsigned u[4] = {v.x, v.y, v.z, v.w};
      float z0[8];
#pragma unroll
      for (int j = 0; j < 4; ++j) { z0[2 * j] = bf_lo(u[j]); z0[2 * j + 1] = bf_hi(u[j]); }
#pragma unroll
      for (int j = 0; j < 8; ++j) s[j] += z0[j];
      const int cnt = min(tp + 1, win);
      const float ic = 1.f / (float)cnt;
      float o[8];
#pragma unroll
      for (int j = 0; j < 8; ++j) o[j] = s[j] * ic - z0[j];
      *(u32x4*)(pout + (size_t)t * D + d) = (u32x4){cvt_pk_bf16(o[0], o[1]), cvt_pk_bf16(o[2], o[3]), cvt_pk_bf16(o[4], o[5]), cvt_pk_bf16(o[6], o[7])};
      if (tp + 1 >= win) {
        const u32x4 vo = *(const u32x4*)(zin + (size_t)(t - win + 1) * D + d);
        const unsigned uo[4] = {vo.x, vo.y, vo.z, vo.w};
#pragma unroll
        for (int j = 0; j < 4; ++j) { s[2 * j] -= bf_lo(uo[j]); s[2 * j + 1] -= bf_hi(uo[j]); }
      }
    }
  }
}

#define GRID_SYNC() xcd_barrier(xb)

__global__ void __launch_bounds__(256, 2) mega(Params p) {
  __shared__ __attribute__((aligned(16))) unsigned char lds[LDS_BYTES + 16];
  cg::grid_group grid = cg::this_grid();
  const int bid = blockIdx.x, nblk = gridDim.x;
  if (threadIdx.x == 0) { *(volatile LAS unsigned*)(lds + LDS_BYTES) = 0u; *(volatile LAS unsigned*)(lds + LDS_BYTES + 4) = 0u; }
  __syncthreads();
  const XcdBarrier xb = xcd_barrier_post(p.bar, (volatile LAS unsigned*)(lds + LDS_BYTES));
  const float* mod0 = p.mod; const float* mod1 = p.mod + (size_t)NB * 6144;
  bf16_t* S[7];
#pragma unroll
  for (int i = 0; i < 7; ++i) S[i] = (bf16_t*)p.slot[i];

  prologue_phase(p, lds, bid, nblk);
  grid.sync();
  bf16_t *h = S[0], *r = S[1], *k = S[2], *v = S[3], *lw = S[4], *av = S[5];
  bf16_t* tw = p.lora_tmp; bf16_t* ta = tw + (size_t)T * 64; bf16_t* tg = ta + (size_t)T * 64;
  modulate_phase(p.x, mod0, p.rw_mu, h, S[4], S[5], S[6], bid, nblk);
  for (int it = bid; it < 4 * 8 * 2; it += nblk) {
    const int nt = it & 1, mt = (it >> 1) & 7, g4 = it >> 4;
    gemm_tile(mk(p.PoutT + g4 * 256, D, p.WgrpS + (size_t)g4 * 256 * 256, 256, 256, 256, EPI_BF16, p.WcT + g4 * 256, D), mt * 128, nt * 128, lds);
  }
  for (int it = bid; it < 2 * 16 * 8; it += nblk) {
    const int nt = it & 7, gl = it >> 3;
    gemm_tile(mk(p.KeysB + (size_t)gl * 128 * 128, 128, p.WqB + (size_t)(gl >> 4) * D * 2048 + (gl & 15) * 128, 2048, D, 128, EPI_BF16, p.WeffT + (size_t)gl * 128 * D, D), 0, nt * 128, lds);
  }
  GRID_SYNC();
  for (int it = 0, nit = sched_iters(4, nblk); it < nit; ++it) {
    int mt, nt; if (!sched_mn(it, bid, nblk, 4, mt, nt)) continue;
    GemmArgs g; int n0;
    if (nt == 0) { n0 = 0; g = mk(h, D, p.W1T, D, 64, D, EPI_TANH, tw, 64, p.rw_mu + 3 * D); }
    else if (nt == 1) { n0 = 0; g = mk(h, D, p.A1T, D, 64, D, EPI_BF16, ta, 64, p.rw_mu + 4 * D); }
    else { n0 = (nt - 2) * 128; g = mk(h, D, p.G1T, D, 192, D, EPI_SIGMOID, tg, 192, p.rw_mu + 5 * D); }
    gemm_tile(g, mt * 128, n0, lds);
  }
  for (int it = 0, nit = sched_iters(24, nblk, 128); it < nit; ++it) {
    int mt, nt; if (!sched_mn(it, bid, nblk, 24, mt, nt, 128)) continue;
    const int j = nt >> 3;
    gemm_tile256(mk(S[4 + j], D, p.WT_rkv + (size_t)j * D * D, D, D, D, EPI_BF16, j == 0 ? r : (j == 1 ? k : v), D), mt * 256, (nt & 7) * 128, lds);
  }
  GRID_SYNC();
  for (int it = 0, nit = sched_iters(16, nblk); it < nit; ++it) {
    int mt, nt; if (!sched_mn(it, bid, nblk, 16, mt, nt)) continue;
    const int j = nt >> 3, n0 = (nt & 7) * 128;
    GemmArgs g;
    if (j == 0) g = mk(tw, 64, p.W2T, 64, D, 64, EPI_LW, lw, D, nullptr, p.rw_w0);
    else g = mk(ta, 64, p.A2T, 64, D, 64, EPI_ASIG, av, D, nullptr, p.rw_a0);
    gemm_tile(g, mt * 128, n0, lds);
  }
  GRID_SYNC();
  {
    ScanArgs s; s.r = r; s.k = k; s.v = v; s.lw = lw; s.a = av; s.k_k = p.rw_k_k; s.k_a = p.rw_k_a; s.r_k = p.rw_r_k; s.lnx_g = p.rw_lnx_g; s.lnx_b = p.rw_lnx_b;
    s.Pg = (bf16_t*)p.out; s.Qz0 = S[0]; s.Qz1 = S[6]; s.Gg = p.Gg;
    { ScanIn cur, nxt; if (bid < NB * NH * NCH) scan_fetch<false>(s, bid, cur);
      for (int it = bid; it < NB * NH * NCH; it += nblk) { if (it + nblk < NB * NH * NCH) scan_fetch<false>(s, it + nblk, nxt); scan_phaseA_item(s, it, cur, lds); cur = nxt; } }
    GRID_SYNC();
    for (int it = bid; it < NB * NH; it += nblk) scan_chain_block(s, it, lds);
    GRID_SYNC();
    { ScanIn cur, nxt; if (bid < NB * NH * NCH) scan_fetch<true>(s, bid, cur);
      for (int it = bid; it < NB * NH * NCH; it += nblk) { if (it + nblk < NB * NH * NCH) scan_fetch<true>(s, it + nblk, nxt); scan_phaseC_item(s, it, cur, lds); cur = nxt; } }
    GRID_SYNC();
  }
  for (int it = 0, nit = sched_iters(8, nblk); it < nit; ++it) {
    int mt, nt; if (!sched_mn(it, bid, nblk, 8, mt, nt)) continue;
    gemm_tile(mk(tg, 192, p.G2T, 192, D, 192, EPI_GATE, r, D), mt * 128, nt * 128, lds);
  }
  GRID_SYNC();
  h = r;
  bf16_t* z = S[2];
  for (int it = 0, nit = sched_iters(8, nblk, 128); it < nit; ++it) {
    int mt, nt; if (!sched_mn(it, bid, nblk, 8, mt, nt, 128)) continue;
    gemm_tile256(mk(h, D, p.WoT, D, D, D, EPI_Z, z, D, nullptr, p.x, mod0 + 2 * D), mt * 256, nt * 128, lds);
  }
  table_fp8_phase(p.pe_u, p.slot[6], p.tinv, NEXP, bid, nblk);
  table_fp8_phase(p.pe_v, p.slot[6] + ((size_t)16 << 20), p.tinv + NEXP, NEXP, bid, nblk);
  table_fp8_phase(p.pe_u + (size_t)NEXP * D, p.slot[6] + ((size_t)32 << 20), p.tinv + 2 * NEXP, NEXP, bid, nblk);
  table_fp8_phase(p.pe_v + (size_t)NEXP * D, p.slot[6] + ((size_t)48 << 20), p.tinv + 3 * NEXP, NEXP, bid, nblk);
  GRID_SYNC();
  ln_phase(z, p.ln_g + 0 * D, p.ln_b + 0 * D, S[4], nullptr, mod0, 3, 4, S[0], bid, nblk);
  GRID_SYNC();

#pragma unroll
  for (int layer = 0; layer < 2; ++layer) {
    const float* modl = layer == 0 ? mod0 : mod1;
    const bf16_t* hp = S[0];
    unsigned char* lsl = p.slot[3];
    unsigned* epk = (unsigned*)(lsl + ((size_t)32 << 20));
    float* gate = (float*)(lsl + ((size_t)40 << 20));
    for (int it = 0, nit = sched_iters(8, nblk); it < nit; ++it) {
      int mt, hd; if (!sched_mn(it, bid, nblk, 8, mt, hd)) continue;
      gemm_tile(mk(hp, D, p.WeffT + (size_t)layer * 2048 * D, D, 2048, D, EPI_TOPK, epk, 0, nullptr, gate), mt * 128, (hd * 2 + 0) * 128, lds);
      gemm_tile(mk(hp, D, p.WeffT + (size_t)layer * 2048 * D, D, 2048, D, EPI_TOPK, epk, 0, nullptr, gate), mt * 128, (hd * 2 + 1) * 128, lds);
    }
    GRID_SYNC();
    PeerArgs a; a.h2 = hp;
    a.u8 = p.slot[6] + ((size_t)(layer * 32) << 20); a.v8 = a.u8 + ((size_t)16 << 20);
    a.uinv = p.tinv + (layer * 2) * NEXP; a.vinv = a.uinv + NEXP;
    a.epk = (const unsigned short*)epk; a.gate = gate; a.part = (float*)p.slot[1]; a.coef = (float*)lsl;
    a.xres = S[4]; a.gate2 = modl + 5 * D; a.z = S[1];
    a.ctr_u = p.bar + XCD_BAR_WORDS + (layer * 2) * 128; a.ctr_v = a.ctr_u + 128;
    peer_slice_phase<false>(a, lds);
    GRID_SYNC();
    peer_coef_phase(a, bid, nblk);
    GRID_SYNC();
    peer_slice_phase<true>(a, lds);
    GRID_SYNC();
    if (layer == 1) { ln_phase(a.z, p.ln_g + 3 * D, p.ln_b + 3 * D, nullptr, p.out, mod1, 0, 1, nullptr, bid, nblk); break; }
    ln_phase(a.z, p.ln_g + 1 * D, p.ln_b + 1 * D, S[4], nullptr, mod1, 0, 1, S[0], bid, nblk);
    GRID_SYNC();
    const bf16_t* x2 = S[4];
    bf16_t *hB = S[0], *zin = S[1], *pp = S[2];
    for (int it = 0, nit = sched_iters(8, nblk, 128); it < nit; ++it) {
      int mt, nt; if (!sched_mn(it, bid, nblk, 8, mt, nt, 128)) continue;
      gemm_tile256(mk(hB, D, p.PinT, D, D, D, EPI_BF16, zin, D), mt * 256, nt * 128, lds);
    }
    GRID_SYNC();
    pool_phase(zin, pp, bid, nblk);
    GRID_SYNC();
    bf16_t* z1 = S[3];
    for (int it = 0, nit = sched_iters(8, nblk, 128); it < nit; ++it) {
      int mt, nt; if (!sched_mn(it, bid, nblk, 8, mt, nt, 128)) continue;
      gemm_tile256(mk(pp, D, p.WcT, D, D, D, EPI_ZB, z1, D, nullptr, (const float*)x2, mod1 + 2 * D), mt * 256, nt * 128, lds);
    }
    GRID_SYNC();
    ln_phase(z1, p.ln_g + 2 * D, p.ln_b + 2 * D, S[4], nullptr, mod1, 3, 4, S[0], bid, nblk);
    GRID_SYNC();
  }
}

extern "C" void kernel_launch(void* const* d_in, const int* in_sizes, int n_in, void* d_out, int out_size, void* d_ws, size_t ws_size, hipStream_t stream) {
  Params p{};
  const float** ip = (const float**)&p.x;
  for (int i = 0; i < 30; ++i) ip[i] = (const float*)d_in[i];
  p.out = (float*)d_out;
  unsigned char* w = (unsigned char*)d_ws; size_t off = 0;
  auto take = [&](size_t bytes) { unsigned char* r = w + off; off += (bytes + 255) & ~(size_t)255; return r; };
  p.bar = (unsigned*)take(16384);
  p.mod = (float*)take((size_t)2 * NB * 6144 * 4);
  p.WT_rkv = (bf16_t*)take((size_t)3 * D * D * 2);
  p.W1T = (bf16_t*)take((size_t)128 * D * 2); p.A1T = (bf16_t*)take((size_t)128 * D * 2); p.G1T = (bf16_t*)take((size_t)256 * D * 2);
  p.W2T = (bf16_t*)take((size_t)D * 64 * 2); p.A2T = (bf16_t*)take((size_t)D * 64 * 2); p.G2T = (bf16_t*)take((size_t)D * 192 * 2);
  p.WoT = (bf16_t*)take((size_t)D * D * 2); p.PinT = (bf16_t*)take((size_t)D * D * 2); p.PoutT = (bf16_t*)take((size_t)D * D * 2);
  p.WgrpS = (bf16_t*)take((size_t)4 * 256 * 256 * 2); p.WcT = (bf16_t*)take((size_t)D * D * 2); p.WqB = (bf16_t*)take((size_t)2 * 2048 * D * 2); p.WeffT = (bf16_t*)take((size_t)2 * 2048 * D * 2); p.KeysB = (bf16_t*)take((size_t)2 * 16 * 128 * 128 * 2);
  p.tinv = (float*)take((size_t)4 * NEXP * 4);
  p.lora_tmp = (bf16_t*)take((size_t)T * 320 * 2);
  p.Gg = (float*)take((size_t)16384 * 64 * 4);
  for (int i = 0; i < 7; ++i) p.slot[i] = take((size_t)64 << 20);
  if (off > ws_size) return;

  static int grid_blocks = 0;
  if (!grid_blocks) {
    int dev = 0, cus = 0, per_cu = 0;
    hipGetDevice(&dev);
    hipDeviceGetAttribute(&cus, hipDeviceAttributeMultiprocessorCount, dev);
    hipOccupancyMaxActiveBlocksPerMultiprocessor(&per_cu, mega, 256, 0);
    if (per_cu > 2) per_cu = 2;
    if (per_cu < 1) per_cu = 1;
    grid_blocks = cus * per_cu;
  }
  hipMemsetAsync(p.bar, 0, 16384, stream);
  void* args[] = {&p};
  hipLaunchCooperativeKernel((void*)mega, dim3(grid_blocks), dim3(256), args, 0, stream);
}
```

```cpp
#include <hip/hip_runtime.h>
#include <hip/hip_cooperative_groups.h>
#include <stdint.h>
#include <stddef.h>
namespace cg = cooperative_groups;

typedef unsigned short bf16_t;
typedef short bf16x8 __attribute__((ext_vector_type(8)));
typedef float f32x4 __attribute__((ext_vector_type(4)));
typedef int i32x8 __attribute__((ext_vector_type(8)));
#define F8_FROM 1
typedef float f32x2 __attribute__((ext_vector_type(2)));
typedef unsigned u32x4 __attribute__((ext_vector_type(4)));
typedef unsigned u32x2 __attribute__((ext_vector_type(2)));
#define DI __device__ __forceinline__

constexpr int D = 1024, NB = 8, SEQ = 4096, T = NB * SEQ;
constexpr int NH = 16, HS = 64;
constexpr int NEXP = 16384;
constexpr float ALPHA = 1.4142135623730951f;
constexpr float LN_EPS = 1e-5f, GN_EPS = 64e-5f;
constexpr int LDS_BYTES = 76 * 1024;

typedef __bf16 bf16x2_t __attribute__((ext_vector_type(2)));
DI unsigned cvt_pk_bf16(float lo, float hi) { const f32x2 v = {lo, hi}; return __builtin_bit_cast(unsigned, __builtin_convertvector(v, bf16x2_t)); }
DI bf16_t f2bf(float f) { return (bf16_t)cvt_pk_bf16(f, 0.f); }
DI float bf_lo(unsigned u) { return __uint_as_float(u << 16); }
DI float bf_hi(unsigned u) { return __uint_as_float(u & 0xffff0000u); }

DI float sigmoidf_(float x) { return 1.f / (1.f + __expf(-x)); }
DI float wave_sum(float v) {
#pragma unroll
  for (int o = 32; o >= 1; o >>= 1) v += __shfl_xor(v, o);
  return v;
}
DI int opaque_v(int x) { asm volatile("" : "+v"(x)); return x; }
DI float gelu_exact(float v) {
  const float av = fabsf(v), t = __builtin_amdgcn_rcpf(av * 0.2316418882f + 1.0f);
  float q = t * 0.5307027145f + (-0.7265760135f); q = q * t + 0.7107068705f; q = q * t + (-0.142248368f); q = q * t + 0.127414796f; q = q * t;
  const float m = v * (q * __builtin_amdgcn_exp2f((v * v) * (-0.72134752044f)));
  return v < 0.f ? m : v - m;
}

#define XB_TMO      128
#define XB_XCNT(j)  (256  + 64 * (j))
#define XB_XSUB(j)  (1280 + 64 * (j))
#define XB_XGEN(j)  (2304 + 64 * (j))
#define XB_TOP      3328
#define XB_TOPGEN   3392
#define XCD_BAR_WORDS 3456
#define XB_SPIN_CAP (1u << 22)
#define LAS __attribute__((address_space(3)))
DI unsigned xb_ld(unsigned* p)              { return __hip_atomic_load(p, __ATOMIC_RELAXED, __HIP_MEMORY_SCOPE_AGENT); }
DI unsigned xb_add(unsigned* p, unsigned v) { return __hip_atomic_fetch_add(p, v, __ATOMIC_RELAXED, __HIP_MEMORY_SCOPE_AGENT); }
DI unsigned xb_xcc_id() { return (unsigned)__builtin_amdgcn_s_getreg((3 << 11) | 20) & 0xFu; }
#define XB_SPIN(cond, bar) do { unsigned _sp = 0; while (cond) { __builtin_amdgcn_s_sleep(1); \
    if ((++_sp & 255u) == 0u) { if (xb_ld(&(bar)[XB_TMO])) break; if (_sp > XB_SPIN_CAP) { atomicAdd(&(bar)[XB_TMO], 1u); break; } } } } while (0)
struct XcdBarrier { unsigned* bar; unsigned x; volatile LAS unsigned* st; };
DI XcdBarrier xcd_barrier_post(unsigned* bar, volatile LAS unsigned* st) {
  XcdBarrier b; b.bar = bar; b.x = xb_xcc_id(); b.st = st;
  if (threadIdx.x == 0) (void)xb_add(&bar[XB_XCNT(b.x)], 1u);
  return b;
}
DI void xcd_barrier_complete(unsigned* bar, unsigned x, unsigned& nloc, unsigned& nx) {
  const unsigned G = gridDim.x * gridDim.y * gridDim.z;
  unsigned sum, cnt, mine, sp = 0u;
  for (;;) {
    sum = 0u; cnt = 0u; mine = 0u;
#pragma unroll
    for (unsigned j = 0; j < 16; ++j) { const unsigned c = xb_ld(&bar[XB_XCNT(j)]); sum += c; cnt += (c > 0u) ? 1u : 0u; mine = (j == x) ? c : mine; }
    if (sum == G) break;
    __builtin_amdgcn_s_sleep(1);
    if ((++sp & 255u) == 0u) { if (xb_ld(&bar[XB_TMO])) break; if (sp > XB_SPIN_CAP) { atomicAdd(&bar[XB_TMO], 1u); break; } }
  }
  nloc = mine > 0u ? mine : 1u; nx = cnt > 0u ? cnt : 1u;
}
DI void xcd_barrier(const XcdBarrier& b0) {
  XcdBarrier b = b0; { unsigned xx = b0.x; asm volatile("" : "+s"(xx)); b.x = xx; }
  asm volatile("s_waitcnt vmcnt(0)" ::: "memory");
  __syncthreads();
  if (threadIdx.x == 0) {
    unsigned* bar = b.bar;
    __builtin_amdgcn_s_waitcnt(0);
    unsigned nloc = b.st[0], nx = b.st[1];
    if (nloc == 0u) { xcd_barrier_complete(bar, b.x, nloc, nx); b.st[0] = nloc; b.st[1] = nx; }
    const unsigned k = b.st[2]; b.st[2] = k + 1u;
    const unsigned old = xb_add(&bar[XB_XSUB(b.x)], 1u);
    if (old + 1u == (k + 1u) * nloc) {
      __builtin_amdgcn_fence(__ATOMIC_RELEASE, "agent");
      asm volatile("s_waitcnt vmcnt(0)" ::: "memory");
      (void)xb_add(&bar[XB_TOP], 1u);
    }
    const unsigned target = (k + 1u) * nx;
    XB_SPIN(xb_ld(&bar[XB_TOP]) < target, bar);
    __builtin_amdgcn_fence(__ATOMIC_ACQUIRE, "agent");
    asm volatile("s_waitcnt vmcnt(0)" ::: "memory");
  }
  __syncthreads();
}

struct Params {
  const float *x, *c, *ada_w, *ada_b, *ln_g, *ln_b, *rw_mu, *rw_w_rkv, *rw_w0, *rw_w1, *rw_w2, *rw_a0, *rw_a1, *rw_a2, *rw_g1, *rw_g2,
      *rw_k_k, *rw_k_a, *rw_r_k, *rw_lnx_g, *rw_lnx_b, *rw_w_o, *pl_w_in, *pl_w_grp, *pl_scale, *pl_w_out, *pe_w_q, *pe_keys, *pe_u, *pe_v;
  float* out;
  float* mod;
  bf16_t *WT_rkv, *W1T, *A1T, *G1T, *W2T, *A2T, *G2T, *WoT, *PinT, *PoutT, *WgrpS, *WcT, *WqB, *WeffT, *KeysB;
  unsigned char* slot[7];
  float* tinv;
  bf16_t* lora_tmp;
  float* Gg;
  unsigned* bar;
};

DI void mod_item(const Params& p, int item, unsigned char* lds) {
  float* cond = (float*)lds;
  float (*red)[NB][32] = (float (*)[NB][32])(lds + 32768);
  const int tid = opaque_v(threadIdx.x);
  for (int i = tid; i < NB * D; i += 256) { float v = p.c[i]; cond[i] = v / (1.f + __expf(-v)); }
  __syncthreads();
  const int l = item / 192, cb = item % 192;
  const int c4 = (tid & 7) * 4, kg = tid >> 3;
  const float* w = p.ada_w + (size_t)l * D * 6144 + cb * 32 + c4;
  f32x4 acc[NB];
#pragma unroll
  for (int b = 0; b < NB; ++b) acc[b] = (f32x4){0.f, 0.f, 0.f, 0.f};
#pragma unroll 1
  for (int i0 = 0; i0 < 32; i0 += 16) {
    f32x4 wv[16];
#pragma unroll
    for (int u = 0; u < 16; ++u) wv[u] = *(const f32x4*)(w + (size_t)(kg + 32 * (i0 + u)) * 6144);
#pragma unroll
    for (int u = 0; u < 16; ++u)
#pragma unroll
      for (int b = 0; b < NB; ++b) acc[b] += wv[u] * cond[b * D + kg + 32 * (i0 + u)];
  }
#pragma unroll
  for (int b = 0; b < NB; ++b) *(f32x4*)&red[kg][b][c4] = acc[b];
  __syncthreads();
  {
    const int b = tid >> 5, cc = tid & 31;
    float s = 0.f;
#pragma unroll
    for (int g = 0; g < 32; ++g) s += red[g][b][cc];
    const int n = cb * 32 + cc;
    p.mod[((size_t)l * NB + b) * 6144 + n] = s + p.ada_b[l * 6144 + n];
  }
  __syncthreads();
}

DI void transpose_item(const float* __restrict__ src, bf16_t* __restrict__ dst, int K, int N, int Kpad, int Npad, size_t sbs, size_t dbs, int item, unsigned char* lds) {
  float (*tile)[65] = (float (*)[65])lds;
  const int nb_n = Npad / 64, nb_k = Kpad / 64;
  const int per = nb_n * nb_k;
  const int bz = item / per, r = item % per;
  const int bk = r / nb_n, bn = r % nb_n;
  src += bz * sbs; dst += bz * dbs;
  const int tq = opaque_v(threadIdx.x);
  {
    const int rr = tq >> 4, c4 = (tq & 15) * 4, n = bn * 64 + c4;
    f32x4 v[4];
#pragma unroll
    for (int i = 0; i < 4; ++i) {
      const int k = bk * 64 + rr + i * 16;
      v[i] = (k < K && n < N) ? *(const f32x4*)(src + (size_t)k * N + n) : (f32x4){0.f, 0.f, 0.f, 0.f};
    }
#pragma unroll
    for (int i = 0; i < 4; ++i) { float* tr = &tile[rr + i * 16][c4]; tr[0] = v[i][0]; tr[1] = v[i][1]; tr[2] = v[i][2]; tr[3] = v[i][3]; }
  }
  __syncthreads();
  {
    const int nl = tq >> 2, kc = (tq & 3) * 16;
    unsigned o[8];
#pragma unroll
    for (int j = 0; j < 8; ++j) o[j] = cvt_pk_bf16(tile[kc + 2 * j][nl], tile[kc + 2 * j + 1][nl]);
    u32x4* dp = (u32x4*)(dst + (size_t)(bn * 64 + nl) * Kpad + bk * 64 + kc);
    dp[0] = (u32x4){o[0], o[1], o[2], o[3]}; dp[1] = (u32x4){o[4], o[5], o[6], o[7]};
  }
  __syncthreads();
}
DI void cvt_range(const float* __restrict__ src, bf16_t* __restrict__ dst, size_t n8, int bid, int nblk) {
  const int tq = opaque_v(threadIdx.x);
  for (size_t i = (size_t)bid * 256 + tq; i < n8; i += (size_t)nblk * 256) {
    const f32x4 a = *(const f32x4*)(src + i * 8), b = *(const f32x4*)(src + i * 8 + 4);
    u32x4 o; o.x = cvt_pk_bf16(a[0], a[1]); o.y = cvt_pk_bf16(a[2], a[3]); o.z = cvt_pk_bf16(b[0], b[1]); o.w = cvt_pk_bf16(b[2], b[3]);
    *(u32x4*)(dst + i * 8) = o;
  }
}
DI void prologue_phase(const Params& p, unsigned char* lds, int bid, int nblk) {
  constexpr int total = 768 + 32 + 32 + 64 + 16 + 16 + 48 + 256 + 256 + 256 + 384;
  for (int it = bid; it < total; it += nblk) {
    int r = it;
    if (r < 768) { transpose_item(p.rw_w_rkv, p.WT_rkv, D, D, D, D, (size_t)D * D, (size_t)D * D, r, lds); continue; } r -= 768;
    if (r < 32) { transpose_item(p.rw_w1, p.W1T, D, 64, D, 128, 0, 0, r, lds); continue; } r -= 32;
    if (r < 32) { transpose_item(p.rw_a1, p.A1T, D, 64, D, 128, 0, 0, r, lds); continue; } r -= 32;
    if (r < 64) { transpose_item(p.rw_g1, p.G1T, D, 160, D, 256, 0, 0, r, lds); continue; } r -= 64;
    if (r < 16) { transpose_item(p.rw_w2, p.W2T, 64, D, 64, D, 0, 0, r, lds); continue; } r -= 16;
    if (r < 16) { transpose_item(p.rw_a2, p.A2T, 64, D, 64, D, 0, 0, r, lds); continue; } r -= 16;
    if (r < 48) { transpose_item(p.rw_g2, p.G2T, 160, D, 192, D, 0, 0, r, lds); continue; } r -= 48;
    if (r < 256) { transpose_item(p.rw_w_o, p.WoT, D, D, D, D, 0, 0, r, lds); continue; } r -= 256;
    if (r < 256) { transpose_item(p.pl_w_in, p.PinT, D, D, D, D, 0, 0, r, lds); continue; } r -= 256;
    if (r < 256) { transpose_item(p.pl_w_out, p.PoutT, D, D, D, D, 0, 0, r, lds); continue; } r -= 256;
    mod_item(p, r, lds);
  }
  cvt_range(p.pe_keys, p.KeysB, (size_t)2 * 16 * 128 * 128 / 8, bid, nblk);
  cvt_range(p.pe_w_q, p.WqB, (size_t)2 * D * 2048 / 8, bid, nblk);
  {
    const int tq = opaque_v(threadIdx.x);
    for (int i = bid * 256 + tq; i < 4 * 256 * 256 / 8; i += nblk * 256) {
      const int e0 = (i * 8) & 255, g4 = (i * 8) >> 16;
      const f32x4 a0 = *(const f32x4*)(p.pl_w_grp + (size_t)i * 8), a1 = *(const f32x4*)(p.pl_w_grp + (size_t)i * 8 + 4);
      const f32x4 s0 = *(const f32x4*)(p.pl_scale + g4 * 256 + e0), s1 = *(const f32x4*)(p.pl_scale + g4 * 256 + e0 + 4);
      const f32x4 b0 = a0 * s0, b1 = a1 * s1;
      *(u32x4*)(p.WgrpS + (size_t)i * 8) = (u32x4){cvt_pk_bf16(b0[0], b0[1]), cvt_pk_bf16(b0[2], b0[3]), cvt_pk_bf16(b1[0], b1[1]), cvt_pk_bf16(b1[2], b1[3])};
    }
  }
}

DI void modulate_phase(const float* __restrict__ x, const float* __restrict__ mod_l, const float* __restrict__ mu, bf16_t* __restrict__ h, bf16_t* __restrict__ xr, bf16_t* __restrict__ xk,
                       bf16_t* __restrict__ xv, int bid, int nblk) {
  const size_t n8 = (size_t)T * D / 8; const int tq = opaque_v(threadIdx.x);
  for (size_t i = (size_t)bid * 256 + tq; i < n8; i += (size_t)nblk * 256) {
    const size_t e = i * 8; const int t = (int)(e / D), d = (int)(e % D), b = t / SEQ;
    const float* sh = mod_l + (size_t)b * 6144 + 0 * D + d; const float* sc = mod_l + (size_t)b * 6144 + 1 * D + d;
    float hv[8], pv[8];
    {
      const f32x4 a0 = *(const f32x4*)(x + e), a1 = *(const f32x4*)(x + e + 4);
      const f32x4 s0 = *(const f32x4*)sh, s1 = *(const f32x4*)(sh + 4), c0 = *(const f32x4*)sc, c1 = *(const f32x4*)(sc + 4);
      const f32x4 r0 = a0 * (c0 + 1.f) + s0, r1 = a1 * (c1 + 1.f) + s1;
      f32x4 q0 = {0.f, 0.f, 0.f, 0.f}, q1 = {0.f, 0.f, 0.f, 0.f};
      if ((t % SEQ) != 0) { const f32x4 b0 = *(const f32x4*)(x + e - D), b1 = *(const f32x4*)(x + e - D + 4); q0 = b0 * (c0 + 1.f) + s0; q1 = b1 * (c1 + 1.f) + s1; }
#pragma unroll
      for (int j = 0; j < 4; ++j) { hv[j] = r0[j]; hv[4 + j] = r1[j]; pv[j] = q0[j]; pv[4 + j] = q1[j]; }
    }
    u32x4 o; o.x = cvt_pk_bf16(hv[0], hv[1]); o.y = cvt_pk_bf16(hv[2], hv[3]); o.z = cvt_pk_bf16(hv[4], hv[5]); o.w = cvt_pk_bf16(hv[6], hv[7]);
    *(u32x4*)(h + e) = o;
#pragma unroll
    for (int n = 0; n < 3; ++n) {
      const f32x4 m0 = *(const f32x4*)(mu + n * D + d), m1 = *(const f32x4*)(mu + n * D + d + 4);
      float w[8];
#pragma unroll
      for (int j = 0; j < 8; ++j) { const float m = j < 4 ? m0[j] : m1[j - 4]; w[j] = hv[j] + (pv[j] - hv[j]) * m; }
      u32x4 q; q.x = cvt_pk_bf16(w[0], w[1]); q.y = cvt_pk_bf16(w[2], w[3]); q.z = cvt_pk_bf16(w[4], w[5]); q.w = cvt_pk_bf16(w[6], w[7]);
      *(u32x4*)((n == 0 ? xr : (n == 1 ? xk : xv)) + e) = q;
    }
  }
}

enum { EPI_BF16 = 0, EPI_TANH, EPI_SIGMOID, EPI_LW, EPI_ASIG, EPI_Z, EPI_SCALE, EPI_GATE, EPI_TOPK, EPI_ZB, EPI_F8 };
struct GemmArgs {
  const bf16_t* A; int lda;
  const bf16_t* Bt; int ldb;
  int N, K;
  const float* mu;
  int epi; void* out; int ldc;
  const float* v0; const float* v1;
};

DI int lds_off(int row, int chunk) { return row * 128 + ((chunk ^ (row & 7)) << 4); }

DI void gemm_load_a(const GemmArgs& g, int m0, int k0, int tid, u32x4 (&ra)[4]) {
#pragma unroll
  for (int i = 0; i < 4; ++i) {
    const int row = (tid >> 3) + i * 32, ch = tid & 7;
    const int m = m0 + row;
    const bf16_t* src = g.A + (size_t)m * g.lda + k0 + ch * 8;
    u32x4 v = *(const u32x4*)src;
    if (g.mu) {
      u32x4 pv = {0u, 0u, 0u, 0u};
      if ((m % SEQ) != 0) pv = *(const u32x4*)(src - g.lda);
      const f32x4 m0v = *(const f32x4*)(g.mu + k0 + ch * 8), m1v = *(const f32x4*)(g.mu + k0 + ch * 8 + 4);
      const unsigned hu[4] = {v.x, v.y, v.z, v.w}, pu[4] = {pv.x, pv.y, pv.z, pv.w};
      float o[8];
#pragma unroll
      for (int j = 0; j < 4; ++j) {
        const float h0 = bf_lo(hu[j]), h1 = bf_hi(hu[j]), p0 = bf_lo(pu[j]), p1 = bf_hi(pu[j]);
        const float mu0 = (2 * j < 4) ? m0v[(2 * j) & 3] : m1v[(2 * j) & 3], mu1 = (2 * j + 1 < 4) ? m0v[(2 * j + 1) & 3] : m1v[(2 * j + 1) & 3];
        o[2 * j] = h0 + (p0 - h0) * mu0; o[2 * j + 1] = h1 + (p1 - h1) * mu1;
      }
      v.x = cvt_pk_bf16(o[0], o[1]); v.y = cvt_pk_bf16(o[2], o[3]); v.z = cvt_pk_bf16(o[4], o[5]); v.w = cvt_pk_bf16(o[6], o[7]);
    }
    ra[i] = v;
  }
}
DI void gemm_load_b(const GemmArgs& g, int n0, int k0, int tid, u32x4 (&rb)[4]) {
#pragma unroll
  for (int i = 0; i < 4; ++i) {
    const int row = (tid >> 3) + i * 32, ch = tid & 7;
    rb[i] = *(const u32x4*)(g.Bt + (size_t)(n0 + row) * g.ldb + k0 + ch * 8);
  }
}
DI void gemm_store_lds(unsigned char* buf, int tid, const u32x4 (&r)[4]) {
#pragma unroll
  for (int i = 0; i < 4; ++i) {
    const int row = (tid >> 3) + i * 32, ch = tid & 7;
    *(u32x4*)(buf + lds_off(row, ch)) = r[i];
  }
}

DI unsigned f2key(float f) { unsigned u = __float_as_uint(f); return u ^ ((u >> 31) ? 0xffffffffu : 0x80000000u); }
DI float key2f(unsigned k) { unsigned u = (k >> 31) ? (k ^ 0x80000000u) : ~k; return __uint_as_float(u); }
#define CE_DESC(a, b) { const unsigned _mx = max(a, b), _mn = min(a, b); a = _mx; b = _mn; }
DI void sort16_desc(unsigned (&x)[16]) {
#pragma unroll
  for (int k = 2; k <= 16; k <<= 1) {
#pragma unroll
    for (int j = k >> 1; j > 0; j >>= 1) {
#pragma unroll
      for (int i = 0; i < 16; ++i) {
        const int l = i ^ j;
        if (l > i) {
          if ((i & k) == 0) { CE_DESC(x[i], x[l]); } else { CE_DESC(x[l], x[i]); }
        }
      }
    }
  }
}
DI void merge16_desc(unsigned (&x)[16]) {
#pragma unroll
  for (int j = 8; j > 0; j >>= 1) {
#pragma unroll
    for (int i = 0; i < 16; ++i) { const int l = i ^ j; if (l > i) { CE_DESC(x[i], x[l]); } }
  }
}

DI void peer_combine(const unsigned* row, int sw, unsigned* __restrict__ epk_row, float* __restrict__ gate_row) {
  float s1[16], s2[16];
#pragma unroll
  for (int i = 0; i < 4; ++i) {
    const u32x4 a = *(const u32x4*)(row + ((i ^ sw) << 2)), b = *(const u32x4*)(row + (((4 + i) ^ sw) << 2));
    s1[i * 4] = key2f(a.x & ~127u); s1[i * 4 + 1] = key2f(a.y & ~127u); s1[i * 4 + 2] = key2f(a.z & ~127u); s1[i * 4 + 3] = key2f(a.w & ~127u);
    s2[i * 4] = key2f(b.x & ~127u); s2[i * 4 + 1] = key2f(b.y & ~127u); s2[i * 4 + 2] = key2f(b.z & ~127u); s2[i * 4 + 3] = key2f(b.w & ~127u);
  }
  unsigned c[4][16];
  {
    int n = 0;
#pragma unroll
    for (int a = 0; a < 16; ++a)
#pragma unroll
      for (int b = 0; b < 16; ++b)
        if ((a + 1) * (b + 1) <= 16) { c[n >> 4][n & 15] = (f2key(s1[a] + s2[b]) & ~255u) | (unsigned)(255 - (a * 16 + b)); ++n; }
#pragma unroll
    for (int q = 50; q < 64; ++q) c[q >> 4][q & 15] = 0u;
  }
  sort16_desc(c[0]); sort16_desc(c[1]); sort16_desc(c[2]); sort16_desc(c[3]);
#pragma unroll
  for (int e = 0; e < 16; ++e) { c[0][e] = max(c[0][e], c[1][15 - e]); c[2][e] = max(c[2][e], c[3][15 - e]); }
  merge16_desc(c[0]); merge16_desc(c[2]);
#pragma unroll
  for (int e = 0; e < 16; ++e) c[0][e] = max(c[0][e], c[2][15 - e]);
  merge16_desc(c[0]);
  float best[16], den = 0.f;
  const float mx = key2f(c[0][0] & ~255u);
#pragma unroll
  for (int e = 0; e < 16; ++e) { best[e] = __expf(key2f(c[0][e] & ~255u) - mx); den += best[e]; }
  const float inv = 1.f / den;
  unsigned idw[8];
#pragma unroll
  for (int e = 0; e < 16; ++e) {
    const int pos = 255 - (int)(c[0][e] & 255u), a = pos >> 4, b = pos & 15;
    const unsigned i1 = 127u - (row[(((a >> 2) ^ sw) << 2) | (a & 3)] & 127u), i2 = 127u - (row[(((4 + (b >> 2)) ^ sw) << 2) | (b & 3)] & 127u);
    const unsigned id = i1 * 128u + i2;
    if (e & 1) idw[e >> 1] |= id << 16; else idw[e >> 1] = id;
    best[e] *= inv;
  }
  {
    unsigned pk[8];
#pragma unroll
    for (int k = 0; k < 8; ++k) {
      const unsigned lo = (idw[k >> 1] >> ((k & 1) * 16)) & 0xffffu, hi = (idw[4 + (k >> 1)] >> ((k & 1) * 16)) & 0xffffu;
      pk[k] = lo | (hi << 16);
    }
    ((u32x4*)epk_row)[0] = (u32x4){pk[0], pk[1], pk[2], pk[3]}; ((u32x4*)epk_row)[1] = (u32x4){pk[4], pk[5], pk[6], pk[7]};
    ((f32x4*)gate_row)[0] = (f32x4){best[0], best[1], best[2], best[3]}; ((f32x4*)gate_row)[1] = (f32x4){best[4], best[5], best[6], best[7]};
    ((f32x4*)(gate_row + 64))[0] = (f32x4){best[8], best[9], best[10], best[11]}; ((f32x4*)(gate_row + 64))[1] = (f32x4){best[12], best[13], best[14], best[15]};
  }
}

DI void gemm_glds(const bf16_t* __restrict__ base, int ld, int r0, int k0, unsigned char* buf, int wid, int lane) {
  const bf16_t* src = base + (size_t)(r0 + wid * 8 + (lane >> 3)) * ld + k0 + (((lane & 7) ^ (lane >> 3)) << 3);
#pragma unroll
  for (int j = 0; j < 4; ++j)
    __builtin_amdgcn_global_load_lds((const unsigned*)(src + (size_t)j * 32 * ld), (unsigned*)(buf + (j * 4 + wid) * 1024), 16, 0, 0);
}
DI void gemm_tile(const GemmArgs& g, int m0, int n0, unsigned char* lds) {
  constexpr int WM = 2, WN = 4 / WM, TM = 128 / WM, TN = 128 / WN, MI = TM / 16, NI = TN / 16;
  const int tid = opaque_v(threadIdx.x), lane = tid & 63, wid = tid >> 6;
  const int wm = wid / WN, wn = wid % WN;
  const int nk = g.K / 64;
  const bool lerp = g.mu != nullptr;
  f32x4 acc[MI][NI];
#pragma unroll
  for (int i = 0; i < MI; ++i)
#pragma unroll
    for (int j = 0; j < NI; ++j) acc[i][j] = (f32x4){0.f, 0.f, 0.f, 0.f};
  u32x4 ra[4];
  if (lerp) { gemm_load_a(g, m0, 0, tid, ra); gemm_store_lds(lds, tid, ra); } else gemm_glds(g.A, g.lda, m0, 0, lds, wid, lane);
  gemm_glds(g.Bt, g.ldb, n0, 0, lds + 16384, wid, lane);
  asm volatile("s_waitcnt vmcnt(0)" ::: "memory");
  __syncthreads();
  const int fr = lane & 15, fq = lane >> 4;
  for (int kt = 0; kt < nk; ++kt) {
    unsigned char* cur = lds + (kt & 1) * 32768;
    unsigned char* nxt = lds + ((kt + 1) & 1) * 32768;
    if (kt + 1 < nk) {
      if (lerp) gemm_load_a(g, m0, (kt + 1) * 64, tid, ra); else gemm_glds(g.A, g.lda, m0, (kt + 1) * 64, nxt, wid, lane);
      gemm_glds(g.Bt, g.ldb, n0, (kt + 1) * 64, nxt + 16384, wid, lane);
    }
    {
      bf16x8 af[2][MI], bfr[2][NI];
#pragma unroll
      for (int ks = 0; ks < 2; ++ks) {
#pragma unroll
        for (int i = 0; i < MI; ++i) af[ks][i] = *(const bf16x8*)(cur + lds_off(wm * TM + i * 16 + fr, ks * 4 + fq));
#pragma unroll
        for (int j = 0; j < NI; ++j) bfr[ks][j] = *(const bf16x8*)(cur + 16384 + lds_off(wn * TN + j * 16 + fr, ks * 4 + fq));
      }
      __builtin_amdgcn_sched_barrier(0);
#pragma unroll
      for (int ks = 0; ks < 2; ++ks)
#pragma unroll
        for (int i = 0; i < MI; ++i)
#pragma unroll
          for (int j = 0; j < NI; ++j) acc[i][j] = __builtin_amdgcn_mfma_f32_16x16x32_bf16(bfr[ks][j], af[ks][i], acc[i][j], 0, 0, 0);
      __builtin_amdgcn_sched_barrier(0);
    }
    if (lerp && kt + 1 < nk) gemm_store_lds(nxt, tid, ra);
    asm volatile("s_waitcnt vmcnt(0)" ::: "memory");
    __syncthreads();
  }
#pragma unroll
  for (int i = 0; i < MI; ++i) {
    const int m = m0 + wm * TM + i * 16 + fr;
#pragma unroll
    for (int j = 0; j < NI; ++j) {
      const int n = n0 + wn * TN + j * 16 + fq * 4;
      if (n >= g.N) continue;
      const f32x4 v = acc[i][j];
      bf16_t* ob = (bf16_t*)g.out + (size_t)m * g.ldc + n;
      switch (g.epi) {
        case EPI_BF16: *(u32x2*)ob = (u32x2){cvt_pk_bf16(v[0], v[1]), cvt_pk_bf16(v[2], v[3])}; break;
        case EPI_F8: {
          int pk = 0; pk = __builtin_amdgcn_cvt_pk_fp8_f32(v[0] * 64.f, v[1] * 64.f, pk, false); pk = __builtin_amdgcn_cvt_pk_fp8_f32(v[2] * 64.f, v[3] * 64.f, pk, true);
          *(int*)((unsigned char*)g.out + (size_t)m * g.ldc + n) = pk;
        } break;
        case EPI_TANH: *(u32x2*)ob = (u32x2){cvt_pk_bf16(tanhf(v[0]), tanhf(v[1])), cvt_pk_bf16(tanhf(v[2]), tanhf(v[3]))}; break;
        case EPI_SIGMOID: *(u32x2*)ob = (u32x2){cvt_pk_bf16(sigmoidf_(v[0]), sigmoidf_(v[1])), cvt_pk_bf16(sigmoidf_(v[2]), sigmoidf_(v[3]))}; break;
        case EPI_LW: {
          const f32x4 w0 = *(const f32x4*)(g.v0 + n); float o[4];
#pragma unroll
          for (int q = 0; q < 4; ++q) { const float xx = -(w0[q] + v[q]); const float sp = fmaxf(xx, 0.f) + __logf(1.f + __expf(-fabsf(xx))); o[q] = -__expf(-sp - 0.5f); }
          *(u32x2*)ob = (u32x2){cvt_pk_bf16(o[0], o[1]), cvt_pk_bf16(o[2], o[3])};
        } break;
        case EPI_ASIG: {
          const f32x4 a0 = *(const f32x4*)(g.v0 + n);
          *(u32x2*)ob = (u32x2){cvt_pk_bf16(sigmoidf_(a0[0] + v[0]), sigmoidf_(a0[1] + v[1])), cvt_pk_bf16(sigmoidf_(a0[2] + v[2]), sigmoidf_(a0[3] + v[3]))};
        } break;
        case EPI_Z: {
          const int b = m / SEQ;
          const f32x4 xv = *(const f32x4*)(g.v0 + (size_t)m * D + n), gt = *(const f32x4*)(g.v1 + (size_t)b * 6144 + n);
          const f32x4 zz = xv * ALPHA + gt * v;
          *(u32x2*)ob = (u32x2){cvt_pk_bf16(zz[0], zz[1]), cvt_pk_bf16(zz[2], zz[3])};
        } break;
        case EPI_GATE: {
          const u32x2 yv = *(const u32x2*)ob;
          *(u32x2*)ob = (u32x2){cvt_pk_bf16(bf_lo(yv.x) * v[0], bf_hi(yv.x) * v[1]), cvt_pk_bf16(bf_lo(yv.y) * v[2], bf_hi(yv.y) * v[3])};
        } break;
        default: {
          const f32x4 sc = *(const f32x4*)(g.v0 + n);
          *(u32x2*)ob = (u32x2){cvt_pk_bf16(v[0] * sc[0], v[1] * sc[1]), cvt_pk_bf16(v[2] * sc[2], v[3] * sc[3])};
        } break;
      }
    }
  }
}

DI int lds_off32(int row, int chunk) { return row * 64 + ((chunk ^ (((row >> 3) & 1) << 1)) << 4); }
DI void gemm256_issue(const GemmArgs& g, int m0, int n0, int k0, unsigned char* buf, int wid, int lane) {
  const int lr = lane >> 2, gc = ((lane & 3) ^ ((lane >> 5) << 1)) << 3;
  const bf16_t* sa = g.A + (size_t)(m0 + wid * 16 + lr) * g.lda + k0 + gc;
#pragma unroll
  for (int j = 0; j < 4; ++j) __builtin_amdgcn_global_load_lds((const unsigned*)(sa + (size_t)j * 64 * g.lda), (unsigned*)(buf + (j * 4 + wid) * 1024), 16, 0, 0);
  const bf16_t* sb = g.Bt + (size_t)(n0 + wid * 16 + lr) * g.ldb + k0 + gc;
#pragma unroll
  for (int j = 0; j < 2; ++j) __builtin_amdgcn_global_load_lds((const unsigned*)(sb + (size_t)j * 64 * g.ldb), (unsigned*)(buf + 16384 + (j * 4 + wid) * 1024), 16, 0, 0);
}
DI void gemm_tile256(const GemmArgs& g, int m0, int n0, unsigned char* lds) {
  constexpr int MI = 8, NI = 4, STG = 24576;
  const int tid = opaque_v(threadIdx.x), lane = tid & 63, wid = tid >> 6, wm = wid >> 1, wn = wid & 1, fr = lane & 15, fq = lane >> 4;
  const int nk = g.K / 32;
  f32x4 acc[MI][NI];
#pragma unroll
  for (int i = 0; i < MI; ++i)
#pragma unroll
    for (int j = 0; j < NI; ++j) acc[i][j] = (f32x4){0.f, 0.f, 0.f, 0.f};
  __syncthreads();
  gemm256_issue(g, m0, n0, 0, lds, wid, lane);
  if (nk > 1) gemm256_issue(g, m0, n0, 32, lds + STG, wid, lane);
  int sc = 0, sn = 2;
  for (int kt = 0; kt < nk; ++kt) {
    if (kt + 1 < nk) asm volatile("s_waitcnt vmcnt(6)" ::: "memory"); else asm volatile("s_waitcnt vmcnt(0)" ::: "memory");
    __builtin_amdgcn_s_barrier();
    if (kt + 2 < nk) gemm256_issue(g, m0, n0, (kt + 2) * 32, lds + sn * STG, wid, lane);
    const unsigned char* cur = lds + sc * STG;
    bf16x8 af[MI], bfr[NI];
#pragma unroll
    for (int i = 0; i < MI; ++i) af[i] = *(const bf16x8*)(cur + lds_off32(wm * 128 + i * 16 + fr, fq));
#pragma unroll
    for (int j = 0; j < NI; ++j) bfr[j] = *(const bf16x8*)(cur + 16384 + lds_off32(wn * 64 + j * 16 + fr, fq));
#pragma unroll
    for (int i = 0; i < MI; ++i)
#pragma unroll
      for (int j = 0; j < NI; ++j) acc[i][j] = __builtin_amdgcn_mfma_f32_16x16x32_bf16(bfr[j], af[i], acc[i][j], 0, 0, 0);
    sc = (sc == 2) ? 0 : sc + 1; sn = (sn == 2) ? 0 : sn + 1;
  }
  if (g.epi == EPI_TOPK) {
    const int grp = n0 >> 7;
    unsigned* lists = (unsigned*)g.out;
#pragma unroll 1
    for (int hb = 0; hb < 2; ++hb) {
      __syncthreads();
      if (wm == hb) {
#pragma unroll
        for (int i = 0; i < MI; ++i)
#pragma unroll
          for (int j = 0; j < NI; ++j) {
            const int ml = i * 16 + fr, c = wn * 16 + j * 4 + fq;
            u32x4 kv;
            kv.x = (f2key(acc[i][j][0]) & ~127u) | (unsigned)(127 - (c * 4 + 0)); kv.y = (f2key(acc[i][j][1]) & ~127u) | (unsigned)(127 - (c * 4 + 1));
            kv.z = (f2key(acc[i][j][2]) & ~127u) | (unsigned)(127 - (c * 4 + 2)); kv.w = (f2key(acc[i][j][3]) & ~127u) | (unsigned)(127 - (c * 4 + 3));
            *(u32x4*)(lds + ml * 512 + ((c ^ (ml & 31)) << 4)) = kv;
          }
      }
      __syncthreads();
      const int ml = wid * 32 + (lane & 31), hf = lane >> 5;
      unsigned a[16], b[16];
#pragma unroll 1
      for (int ch = 0; ch < 4; ++ch) {
#pragma unroll
        for (int cc = 0; cc < 4; ++cc) {
          const int c = hf * 16 + ch * 4 + cc;
          const u32x4 kv = *(const u32x4*)(lds + ml * 512 + ((c ^ (ml & 31)) << 4));
          b[cc * 4] = kv.x; b[cc * 4 + 1] = kv.y; b[cc * 4 + 2] = kv.z; b[cc * 4 + 3] = kv.w;
        }
        sort16_desc(b);
        if (ch == 0) {
#pragma unroll
          for (int e = 0; e < 16; ++e) a[e] = b[e];
        } else {
#pragma unroll
          for (int e = 0; e < 16; ++e) a[e] = max(a[e], b[15 - e]);
          merge16_desc(a);
        }
      }
#pragma unroll
      for (int e = 0; e < 16; ++e) b[e] = (unsigned)__shfl_xor((int)a[e], 32);
#pragma unroll
      for (int e = 0; e < 16; ++e) a[e] = max(a[e], b[15 - e]);
      merge16_desc(a);
      if (hf == 0) {
        u32x4* dst = (u32x4*)(lists + ((size_t)(m0 + hb * 128 + ml) * 16 + grp) * 16);
        dst[0] = (u32x4){a[0], a[1], a[2], a[3]}; dst[1] = (u32x4){a[4], a[5], a[6], a[7]};
        dst[2] = (u32x4){a[8], a[9], a[10], a[11]}; dst[3] = (u32x4){a[12], a[13], a[14], a[15]};
      }
    }
    __syncthreads();
    return;
  }
#pragma unroll
  for (int i = 0; i < MI; ++i) {
    const int m = m0 + wm * 128 + i * 16 + fr;
#pragma unroll
    for (int j = 0; j < NI; ++j) {
      const int n = n0 + wn * 64 + j * 16 + fq * 4;
      const f32x4 v = acc[i][j];
      if (g.epi == EPI_Z || g.epi == EPI_ZB) {
        const int b = m / SEQ;
        f32x4 xv;
        if (g.epi == EPI_Z) xv = *(const f32x4*)(g.v0 + (size_t)m * D + n);
        else { const u32x2 xb = *(const u32x2*)((const bf16_t*)g.v0 + (size_t)m * D + n); xv = (f32x4){bf_lo(xb.x), bf_hi(xb.x), bf_lo(xb.y), bf_hi(xb.y)}; }
        const f32x4 gt = *(const f32x4*)(g.v1 + (size_t)b * 6144 + n);
        const f32x4 zz = xv * ALPHA + gt * v;
        *(u32x2*)((bf16_t*)g.out + (size_t)m * g.ldc + n) = (u32x2){cvt_pk_bf16(zz[0], zz[1]), cvt_pk_bf16(zz[2], zz[3])};
      } else {
        *(u32x2*)((bf16_t*)g.out + (size_t)m * g.ldc + n) = (u32x2){cvt_pk_bf16(v[0], v[1]), cvt_pk_bf16(v[2], v[3])};
      }
    }
  }
}

DI int f8_swz(int row) { return ((row >> 1) & 1) | (((row >> 2) & 1) << 2); }
DI void f8_glds(const unsigned char* __restrict__ base, int r0, int k0, unsigned char* buf, int wid, int lane) {
  const int rl = lane >> 3;
  const unsigned char* src = base + (size_t)(r0 + wid * 8 + rl) * 1024 + k0 + (((lane & 7) ^ f8_swz(rl)) << 4);
#pragma unroll
  for (int j = 0; j < 4; ++j) __builtin_amdgcn_global_load_lds((const unsigned*)(src + (size_t)j * 32 * 1024), (unsigned*)(buf + (j * 4 + wid) * 1024), 16, 0, 0);
}
DI void gemm_tile_f8(const unsigned char* __restrict__ A8, const unsigned char* __restrict__ B8, int m0, int grp, unsigned* __restrict__ lists, unsigned char* lds) {
  const int tid = opaque_v(threadIdx.x), lane = tid & 63, wid = tid >> 6, wm = wid >> 1, wn = wid & 1, fr = lane & 15, fq = lane >> 4;
  const int n0 = grp * 128;
  f32x4 acc[4][4];
#pragma unroll
  for (int i = 0; i < 4; ++i)
#pragma unroll
    for (int j = 0; j < 4; ++j) acc[i][j] = (f32x4){0.f, 0.f, 0.f, 0.f};
  __syncthreads();
  f8_glds(A8, m0, 0, lds, wid, lane); f8_glds(B8, n0, 0, lds + 16384, wid, lane);
  asm volatile("s_waitcnt vmcnt(0)" ::: "memory");
  __syncthreads();
  const int sw = f8_swz(fr), c0 = ((2 * fq) ^ sw) << 4, c1 = ((2 * fq + 1) ^ sw) << 4;
  for (int kt = 0; kt < 8; ++kt) {
    const unsigned char* cur = lds + (kt & 1) * 32768;
    unsigned char* nxt = lds + ((kt + 1) & 1) * 32768;
    if (kt + 1 < 8) { f8_glds(A8, m0, (kt + 1) * 128, nxt, wid, lane); f8_glds(B8, n0, (kt + 1) * 128, nxt + 16384, wid, lane); }
    i32x8 af[4], bfr[4];
#pragma unroll
    for (int i = 0; i < 4; ++i) {
      const unsigned char* pr = cur + (wm * 64 + i * 16 + fr) * 128;
      const u32x4 lo = *(const u32x4*)(pr + c0), hi = *(const u32x4*)(pr + c1);
      af[i] = (i32x8){(int)lo.x, (int)lo.y, (int)lo.z, (int)lo.w, (int)hi.x, (int)hi.y, (int)hi.z, (int)hi.w};
    }
#pragma unroll
    for (int j = 0; j < 4; ++j) {
      const unsigned char* pr = cur + 16384 + (wn * 64 + j * 16 + fr) * 128;
      const u32x4 lo = *(const u32x4*)(pr + c0), hi = *(const u32x4*)(pr + c1);
      bfr[j] = (i32x8){(int)lo.x, (int)lo.y, (int)lo.z, (int)lo.w, (int)hi.x, (int)hi.y, (int)hi.z, (int)hi.w};
    }
    __builtin_amdgcn_sched_barrier(0);
#pragma unroll
    for (int i = 0; i < 4; ++i)
#pragma unroll
      for (int j = 0; j < 4; ++j) acc[i][j] = __builtin_amdgcn_mfma_scale_f32_16x16x128_f8f6f4(bfr[j], af[i], acc[i][j], 0, 0, 0, 0, 0, 0);
    __builtin_amdgcn_sched_barrier(0);
    asm volatile("s_waitcnt vmcnt(0)" ::: "memory");
    __syncthreads();
  }
#pragma unroll
  for (int i = 0; i < 4; ++i)
#pragma unroll
    for (int j = 0; j < 4; ++j) {
      const int ml = wm * 64 + i * 16 + fr, c = wn * 16 + j * 4 + fq;
      const f32x4 sv = acc[i][j] * 0.015625f;
      u32x4 kv;
      kv.x = (f2key(sv[0]) & ~127u) | (unsigned)(127 - (c * 4 + 0)); kv.y = (f2key(sv[1]) & ~127u) | (unsigned)(127 - (c * 4 + 1));
      kv.z = (f2key(sv[2]) & ~127u) | (unsigned)(127 - (c * 4 + 2)); kv.w = (f2key(sv[3]) & ~127u) | (unsigned)(127 - (c * 4 + 3));
      *(u32x4*)(lds + ml * 512 + ((c ^ (ml & 31)) << 4)) = kv;
    }
  __syncthreads();
  {
    const int ml = wid * 32 + (lane & 31), hf = lane >> 5;
    unsigned a[16], b[16];
#pragma unroll 1
    for (int ch = 0; ch < 4; ++ch) {
#pragma unroll
      for (int cc = 0; cc < 4; ++cc) {
        const int c = hf * 16 + ch * 4 + cc;
        const u32x4 kv = *(const u32x4*)(lds + ml * 512 + ((c ^ (ml & 31)) << 4));
        b[cc * 4] = kv.x; b[cc * 4 + 1] = kv.y; b[cc * 4 + 2] = kv.z; b[cc * 4 + 3] = kv.w;
      }
      sort16_desc(b);
      if (ch == 0) {
#pragma unroll
        for (int e = 0; e < 16; ++e) a[e] = b[e];
      } else {
#pragma unroll
        for (int e = 0; e < 16; ++e) a[e] = max(a[e], b[15 - e]);
        merge16_desc(a);
      }
    }
#pragma unroll
    for (int e = 0; e < 16; ++e) b[e] = (unsigned)__shfl_xor((int)a[e], 32);
#pragma unroll
    for (int e = 0; e < 16; ++e) a[e] = max(a[e], b[15 - e]);
    merge16_desc(a);
    if (hf == 0) {
      u32x4* dst = (u32x4*)(lists + ((size_t)(m0 + ml) * 16 + grp) * 16);
      dst[0] = (u32x4){a[0], a[1], a[2], a[3]}; dst[1] = (u32x4){a[4], a[5], a[6], a[7]};
      dst[2] = (u32x4){a[8], a[9], a[10], a[11]}; dst[3] = (u32x4){a[12], a[13], a[14], a[15]};
    }
  }
  __syncthreads();
}

DI GemmArgs mk(const bf16_t* A, int lda, const bf16_t* Bt, int ldb, int N, int K, int epi, void* out, int ldc,
               const float* mu = nullptr, const float* v0 = nullptr, const float* v1 = nullptr) {
  GemmArgs g; g.A = A; g.lda = lda; g.Bt = Bt; g.ldb = ldb; g.N = N; g.K = K; g.mu = mu; g.epi = epi; g.out = out; g.ldc = ldc; g.v0 = v0; g.v1 = v1; return g;
}
DI int sched_iters(int ntn, int nblk, int nmt = 256) {
  const int LB = nblk >> 3; int it = 0;
  for (int n0 = 0; n0 < ntn;) { int NT = min(8, ntn - n0); while (LB % NT) --NT; const int MT = LB / NT; it += (nmt + 8 * MT - 1) / (8 * MT); n0 += NT; }
  return it;
}
DI bool sched_mn(int i, int bid, int nblk, int ntn, int& mt, int& nt, int nmt = 256) {
  const int x = bid & 7, l = bid >> 3, LB = nblk >> 3; int base = 0;
  for (int n0 = 0; n0 < ntn;) {
    int NT = min(8, ntn - n0); while (LB % NT) --NT;
    const int MT = LB / NT, rounds = (nmt + 8 * MT - 1) / (8 * MT);
    if (i < base + rounds) { mt = (i - base) * 8 * MT + x * MT + (l % MT); nt = n0 + l / MT; return mt < nmt; }
    base += rounds; n0 += NT;
  }
  return false;
}

constexpr int CL = 32;
constexpr int NCH = SEQ / CL;
constexpr int SN = 144, ST = 80;
struct ScanArgs {
  bf16_t* r; const bf16_t *k, *v, *lw, *a;
  const float *k_k, *k_a, *r_k, *lnx_g, *lnx_b;
  bf16_t* Pg;
  bf16_t *Qz0, *Qz1;
  float* Gg;
  bf16_t* Tg;
};
DI int tr_off(int row, int tok) { return row * ST + ((((tok >> 3) ^ ((row >> 3) & 3)) << 4) | ((tok & 7) << 1)); }
template <bool PT, bool QT>
DI f32x4 tile_mm(const unsigned char* P, int ps, const unsigned char* Q, int qs, int i0, int j0, int nks, f32x4 acc, int lane) {
  const int fr = lane & 15, fq = lane >> 4;
  for (int ks = 0; ks < nks; ++ks) {
    const bf16x8 pa = *(const bf16x8*)(PT ? P + tr_off(i0 + fr, fq * 8) : P + (i0 + fr) * ps + ks * 64 + fq * 16);
    const bf16x8 qb = *(const bf16x8*)(QT ? Q + tr_off(j0 + fr, fq * 8) : Q + (j0 + fr) * qs + ks * 64 + fq * 16);
    acc = __builtin_amdgcn_mfma_f32_16x16x32_bf16(pa, qb, acc, 0, 0, 0);
  }
  return acc;
}
DI bf16_t* qz_ptr(const ScanArgs& s, int ch) { return ((ch >> 13) ? s.Qz1 : s.Qz0) + (size_t)(ch & 8191) * 4096; }
DI void st_bf16x4(unsigned char* p, const f32x4& v) { *(u32x2*)p = (u32x2){cvt_pk_bf16(v[0], v[1]), cvt_pk_bf16(v[2], v[3])}; }

struct ScanIn { u32x4 r, k, v, w, a, z0, z1, tb; f32x4 kk0, kk1, ka0, ka1, rk0, rk1; };
template <bool PHASE_C>
DI void scan_fetch(const ScanArgs& s, int item, ScanIn& in) {
  const int c = item & (NCH - 1), h = (item >> 7) & 15, b = item >> 11;
  const int tid = opaque_v(threadIdx.x), tt = tid >> 3, c0 = (tid & 7) * 8;
  const size_t off = ((size_t)b * SEQ + (size_t)c * CL + tt) * D + h * HS + c0;
  in.k = *(const u32x4*)(s.k + off); in.v = *(const u32x4*)(s.v + off); in.w = *(const u32x4*)(s.lw + off); in.a = *(const u32x4*)(s.a + off);
  { const int ch = h * HS + c0;
    in.kk0 = *(const f32x4*)(s.k_k + ch); in.kk1 = *(const f32x4*)(s.k_k + ch + 4); in.ka0 = *(const f32x4*)(s.k_a + ch); in.ka1 = *(const f32x4*)(s.k_a + ch + 4);
    if (PHASE_C) { in.rk0 = *(const f32x4*)(s.r_k + ch); in.rk1 = *(const f32x4*)(s.r_k + ch + 4); } }
  if (PHASE_C) {
    in.r = *(const u32x4*)(s.r + off);
    const bf16_t* Zg = qz_ptr(s, item);
    in.z0 = *(const u32x4*)(Zg + tid * 8); in.z1 = *(const u32x4*)(Zg + (tid + 256) * 8);
    if (tid < 96) in.tb = *(const u32x4*)(s.Tg + (size_t)item * 768 + tid * 8);
  }
}
template <bool PHASE_C>
DI void scan_load(const ScanArgs& s, const ScanIn& in, int h, float* lwbuf, unsigned char* At, unsigned char* Bt, unsigned char* Kt, unsigned char* Rt,
                  unsigned char* AtT, unsigned char* BhT, unsigned char* KhT, unsigned char* VT, float& bonus, float (&vout)[8], float* Gout) {
  const int tid = opaque_v(threadIdx.x), tt = tid >> 3, c0 = (tid & 7) * 8;
  const u32x4 vk = in.k, vv = in.v, vw = in.w, va = in.a;
  u32x4 vr = {0u, 0u, 0u, 0u};
  if (PHASE_C) vr = in.r;
  float fr_[8], fk[8], fv[8], fw[8], fa[8];
  { const unsigned ur[4] = {vr.x, vr.y, vr.z, vr.w}, uk[4] = {vk.x, vk.y, vk.z, vk.w}, uv[4] = {vv.x, vv.y, vv.z, vv.w}, uw[4] = {vw.x, vw.y, vw.z, vw.w}, ua[4] = {va.x, va.y, va.z, va.w};
#pragma unroll
    for (int j = 0; j < 4; ++j) {
      fr_[2 * j] = bf_lo(ur[j]); fr_[2 * j + 1] = bf_hi(ur[j]); fk[2 * j] = bf_lo(uk[j]); fk[2 * j + 1] = bf_hi(uk[j]);
      fv[2 * j] = bf_lo(uv[j]); fv[2 * j + 1] = bf_hi(uv[j]); fw[2 * j] = bf_lo(uw[j]); fw[2 * j + 1] = bf_hi(uw[j]);
      fa[2 * j] = bf_lo(ua[j]); fa[2 * j + 1] = bf_hi(ua[j]);
    } }
  *(f32x4*)(lwbuf + tt * 64 + c0) = (f32x4){fw[0], fw[1], fw[2], fw[3]}; *(f32x4*)(lwbuf + tt * 64 + c0 + 4) = (f32x4){fw[4], fw[5], fw[6], fw[7]};
  float kkr[8], nrm = 0.f, bon = 0.f, kp[8];
#pragma unroll
  for (int j = 0; j < 8; ++j) {
    const float pkk = j < 4 ? in.kk0[j & 3] : in.kk1[j & 3], pka = j < 4 ? in.ka0[j & 3] : in.ka1[j & 3];
    kkr[j] = fk[j] * pkk; nrm += kkr[j] * kkr[j];
    kp[j] = fk[j] * (1.f + (fa[j] - 1.f) * pka);
    if (PHASE_C) bon += fr_[j] * kp[j] * (j < 4 ? in.rk0[j & 3] : in.rk1[j & 3]);
  }
  nrm += __shfl_xor(nrm, 1); nrm += __shfl_xor(nrm, 2); nrm += __shfl_xor(nrm, 4);
  if (PHASE_C) { bon += __shfl_xor(bon, 1); bon += __shfl_xor(bon, 2); bon += __shfl_xor(bon, 4); }
  bonus = bon;
  const float inv = rsqrtf(fmaxf(nrm, 1e-24f));
  __syncthreads();
  {
    const int c = tid & 63, sg = tid >> 6;
    float w8[8];
#pragma unroll
    for (int i = 0; i < 8; ++i) w8[i] = lwbuf[(sg * 8 + i) * 64 + c];
    float run = 0.f;
#pragma unroll
    for (int i = 0; i < 8; ++i) { run += w8[i]; lwbuf[(sg * 8 + i) * 64 + c] = run; }
  }
  __syncthreads();
  float cum[8], cl[8];
  {
    const int sg = tt >> 3;
#pragma unroll
    for (int hh = 0; hh < 2; ++hh) {
      const f32x4 me = *(const f32x4*)(lwbuf + tt * 64 + c0 + hh * 4);
      const f32x4 s0 = *(const f32x4*)(lwbuf + 7 * 64 + c0 + hh * 4), s1 = *(const f32x4*)(lwbuf + 15 * 64 + c0 + hh * 4),
                  s2 = *(const f32x4*)(lwbuf + 23 * 64 + c0 + hh * 4), s3 = *(const f32x4*)(lwbuf + 31 * 64 + c0 + hh * 4);
#pragma unroll
      for (int q = 0; q < 4; ++q) {
        const float pre = (sg > 0 ? s0[q] : 0.f) + (sg > 1 ? s1[q] : 0.f) + (sg > 2 ? s2[q] : 0.f);
        cum[hh * 4 + q] = me[q] + pre; cl[hh * 4 + q] = (s0[q] + s1[q]) + (s2[q] + s3[q]);
      }
    }
  }
  float at[8], bt[8], kt[8], rt[8], bh[8], kh[8];
#pragma unroll
  for (int j = 0; j < 8; ++j) {
    const float kk = kkr[j] * inv, bb = kk * fa[j];
    const float ein = __expf(cum[j]), eneg = __expf(-cum[j]), eex = __expf(cum[j] - fw[j]), eend = __expf(cl[j] - cum[j]);
    at[j] = -kk * eex; bt[j] = bb * eneg; kt[j] = kp[j] * eneg; rt[j] = fr_[j] * ein; bh[j] = bb * eend; kh[j] = kp[j] * eend;
    vout[j] = fv[j];
  }
  *(u32x4*)(At + tt * SN + c0 * 2) = (u32x4){cvt_pk_bf16(at[0], at[1]), cvt_pk_bf16(at[2], at[3]), cvt_pk_bf16(at[4], at[5]), cvt_pk_bf16(at[6], at[7])};
  *(u32x4*)(Bt + tt * SN + c0 * 2) = (u32x4){cvt_pk_bf16(bt[0], bt[1]), cvt_pk_bf16(bt[2], bt[3]), cvt_pk_bf16(bt[4], bt[5]), cvt_pk_bf16(bt[6], bt[7])};
  *(u32x4*)(Kt + tt * SN + c0 * 2) = (u32x4){cvt_pk_bf16(kt[0], kt[1]), cvt_pk_bf16(kt[2], kt[3]), cvt_pk_bf16(kt[4], kt[5]), cvt_pk_bf16(kt[6], kt[7])};
  if (PHASE_C) *(u32x4*)(Rt + tt * SN + c0 * 2) = (u32x4){cvt_pk_bf16(rt[0], rt[1]), cvt_pk_bf16(rt[2], rt[3]), cvt_pk_bf16(rt[4], rt[5]), cvt_pk_bf16(rt[6], rt[7])};
#pragma unroll
  for (int j = 0; j < 8; ++j) {
    *(bf16_t*)(VT + tr_off(c0 + j, tt)) = f2bf(fv[j]);
    if (!PHASE_C) {
      *(bf16_t*)(AtT + tr_off(c0 + j, tt)) = f2bf(at[j]);
      *(bf16_t*)(BhT + tr_off(c0 + j, tt)) = f2bf(bh[j]);
      *(bf16_t*)(KhT + tr_off(c0 + j, tt)) = f2bf(kh[j]);
    }
  }
  if (!PHASE_C && tt == 0 && Gout) {
#pragma unroll
    for (int j = 0; j < 8; ++j) Gout[c0 + j] = __expf(cl[j]);
  }
}
DI void scan_tdiag(const float* A32, unsigned char* Tm, unsigned char* scr, int blk, int lane) {
  const int c = lane & 15, off = blk * 16;
  float av[120];
  {
    int n = 0;
#pragma unroll
    for (int i = 1; i < 16; ++i)
#pragma unroll
      for (int jj = 0; jj < i; ++jj) av[n++] = A32[(off + i) * 36 + off + jj];
  }
  float Tc[16];
  {
    int n = 0;
#pragma unroll
    for (int i = 0; i < 16; ++i) {
      float s0 = (i == c) ? 1.f : 0.f, s1 = 0.f, s2 = 0.f, s3 = 0.f;
#pragma unroll
      for (int jj = 0; jj < i; ++jj) {
        const float pr = av[n++] * Tc[jj];
        if ((jj & 3) == 0) s0 += pr; else if ((jj & 3) == 1) s1 += pr; else if ((jj & 3) == 2) s2 += pr; else s3 += pr;
      }
      Tc[i] = (s0 + s1) + (s2 + s3);
    }
  }
  if (lane < 32) {
    const bool real = lane < 16;
#pragma unroll
    for (int i = 0; i < 16; ++i) {
      if (real) *(bf16_t*)(Tm + (off + i) * ST + (off + c) * 2) = f2bf(Tc[i]);
      if (blk == 0) { if (real) *(bf16_t*)(Tm + i * ST + (16 + c) * 2) = 0; }
      else *(bf16_t*)(scr + 2560 + i * ST + lane * 2) = real ? f2bf(Tc[i]) : (bf16_t)0;
    }
    if (blk == 0 && real) {
      u32x4* d = (u32x4*)(scr + 1280 + c * ST);
      d[0] = (u32x4){cvt_pk_bf16(Tc[0], Tc[1]), cvt_pk_bf16(Tc[2], Tc[3]), cvt_pk_bf16(Tc[4], Tc[5]), cvt_pk_bf16(Tc[6], Tc[7])};
      d[1] = (u32x4){cvt_pk_bf16(Tc[8], Tc[9]), cvt_pk_bf16(Tc[10], Tc[11]), cvt_pk_bf16(Tc[12], Tc[13]), cvt_pk_bf16(Tc[14], Tc[15])};
      d[2] = (u32x4){0u, 0u, 0u, 0u}; d[3] = (u32x4){0u, 0u, 0u, 0u};
      u32x4* x = (u32x4*)(scr + 3840 + c * ST + 32); x[0] = (u32x4){0u, 0u, 0u, 0u}; x[1] = (u32x4){0u, 0u, 0u, 0u};
    }
  }
}
DI void scan_t21(unsigned char* Tm, unsigned char* scr, int lane) {
  const int fr = lane & 15, fq = lane >> 4;
  const f32x4 x = tile_mm<false, false>(scr, ST, scr + 1280, ST, 0, 0, 1, (f32x4){0.f, 0.f, 0.f, 0.f}, lane);
  st_bf16x4(scr + 3840 + fr * ST + (fq * 4) * 2, x);
  asm volatile("s_waitcnt lgkmcnt(0)" ::: "memory");
  const f32x4 y = tile_mm<false, false>(scr + 2560, ST, scr + 3840, ST, 0, 0, 1, (f32x4){0.f, 0.f, 0.f, 0.f}, lane);
#pragma unroll
  for (int q = 0; q < 4; ++q) *(bf16_t*)(Tm + (16 + fq * 4 + q) * ST + fr * 2) = f2bf(y[q]);
}

DI void scan_phaseA_item(const ScanArgs& s, int item, const ScanIn& in, unsigned char* lds) {
  const int c = item & (NCH - 1), h = (item >> 7) & 15, b = item >> 11;
  const int tid = opaque_v(threadIdx.x), lane = tid & 63, wv = tid >> 6, fr = lane & 15, fq = lane >> 4;
  unsigned char* At = lds; unsigned char* Bt = At + 32 * SN; unsigned char* Kt = Bt + 32 * SN;
  unsigned char* AtT = Kt + 32 * SN; unsigned char* BhT = AtT + 64 * ST; unsigned char* KhT = BhT + 64 * ST; unsigned char* VT = KhT + 64 * ST;
  unsigned char* Tm = VT + 64 * ST; unsigned char* Aak = Tm + 32 * ST;
  float* A32 = (float*)(Aak + 32 * ST);
  unsigned char* W1T = (unsigned char*)A32 + 4608; unsigned char* M2T = W1T + 64 * ST; unsigned char* UlT = M2T + 64 * ST;
  float* lwbuf = (float*)W1T;
  const size_t gbase = ((size_t)b * SEQ + (size_t)c * CL) * D + h * HS;
  float bonus; float vv8[8];
  scan_load<false>(s, in, h, lwbuf, At, Bt, Kt, nullptr, AtT, BhT, KhT, VT, bonus, vv8, s.Gg + (size_t)item * 64);
  __syncthreads();
  {
    const int mat = wv >> 1, ti = wv & 1;
#pragma unroll
    for (int tj = 0; tj < 2; ++tj) {
      const f32x4 x = tile_mm<false, false>(At, SN, mat ? Kt : Bt, SN, ti * 16, tj * 16, 2, (f32x4){0.f, 0.f, 0.f, 0.f}, lane);
#pragma unroll
      for (int q = 0; q < 4; ++q) {
        const int i = ti * 16 + fq * 4 + q, j = tj * 16 + fr;
        const float val = (j < i) ? x[q] : 0.f;
        if (mat == 0) { A32[i * 36 + j] = val; if (i >= 16) *(bf16_t*)(W1T + (i - 16) * ST + j * 2) = f2bf(val); }
        else *(bf16_t*)(Aak + i * ST + j * 2) = f2bf(val);
      }
    }
  }
  __syncthreads();
  if (wv < 2) scan_tdiag(A32, Tm, W1T, wv, lane);
  else {
#pragma unroll
    for (int u = 0; u < 4; ++u) {
      const int tile = (wv - 2) * 4 + u, ti = tile >> 2, tv = tile & 3;
      const f32x4 x = tile_mm<false, true>(Aak, ST, VT, ST, ti * 16, tv * 16, 1, (f32x4){0.f, 0.f, 0.f, 0.f}, lane);
      st_bf16x4(M2T + tr_off(tv * 16 + fr, ti * 16 + fq * 4), x);
    }
  }
  __syncthreads();
  if (wv == 0) scan_t21(Tm, W1T, lane);
  __syncthreads();
  if (tid < 96) {
    const int blk = tid >> 5, row = (tid & 31) >> 1, half = tid & 1;
    *(u32x4*)(s.Tg + (size_t)item * 768 + tid * 8) = *(const u32x4*)(Tm + ((blk == 0 ? 0 : 16) + row) * ST + (blk == 2 ? 32 : 0) + half * 16);
  }
#pragma unroll
  for (int u = 0; u < 4; ++u) {
    const int tile = wv * 4 + u, which = tile >> 3, ti = (tile >> 2) & 1, tn = tile & 3;
    const f32x4 x = tile_mm<false, true>(Tm, ST, which ? M2T : AtT, ST, ti * 16, tn * 16, 1, (f32x4){0.f, 0.f, 0.f, 0.f}, lane);
    st_bf16x4((which ? UlT : W1T) + tr_off(tn * 16 + fr, ti * 16 + fq * 4), x);
  }
  __syncthreads();
  bf16_t* Pg = s.Pg + (size_t)item * 4096; bf16_t* Qg = qz_ptr(s, item);
#pragma unroll
  for (int u = 0; u < 4; ++u) {
    const int tile = wv * 4 + u, tk = tile >> 2, tn = tile & 3;
    const f32x4 xp = tile_mm<true, true>(W1T, ST, BhT, ST, tk * 16, tn * 16, 1, (f32x4){0.f, 0.f, 0.f, 0.f}, lane);
    *(u32x2*)(Pg + (tn * 16 + fr) * 64 + tk * 16 + fq * 4) = (u32x2){cvt_pk_bf16(xp[0], xp[1]), cvt_pk_bf16(xp[2], xp[3])};
    f32x4 xq = tile_mm<true, true>(BhT, ST, UlT, ST, tk * 16, tn * 16, 1, (f32x4){0.f, 0.f, 0.f, 0.f}, lane);
    xq = tile_mm<true, true>(KhT, ST, VT, ST, tk * 16, tn * 16, 1, xq, lane);
    __hip_atomic_store((unsigned long long*)(Qg + ((tk * 4 + tn) * 64 + lane) * 4), (unsigned long long)cvt_pk_bf16(xq[0], xq[1]) | ((unsigned long long)cvt_pk_bf16(xq[2], xq[3]) << 32), __ATOMIC_RELAXED, __HIP_MEMORY_SCOPE_AGENT);
  }
  __syncthreads();
}

constexpr int RSLOT = 8192 + 8192 + 256;
constexpr int ZSTR = 144;
DI void scan_chain_block(const ScanArgs& s, int bh, unsigned char* lds) {
  const int tid = opaque_v(threadIdx.x), lane = tid & 63, tv = tid >> 6, fr = lane & 15, fq = lane >> 4;
  const int ch0 = bh * NCH;
  const bool loader = tv < 2;
  unsigned char* stg = lds + 4 * RSLOT;
  auto issue = [&](int c) {
    unsigned char* sl = lds + (c & 3) * RSLOT;
    const bf16_t* Pg = s.Pg + (size_t)(ch0 + c) * 4096; const bf16_t* Qg = qz_ptr(s, ch0 + c);
#pragma unroll
    for (int j = 0; j < 4; ++j) {
      const int pc = j * 2 + tv, row = pc * 8 + (lane >> 3);
      __builtin_amdgcn_global_load_lds((const unsigned*)(Pg + row * 64 + (((lane & 7) ^ ((row >> 1) & 7)) << 3)), (unsigned*)(sl + pc * 1024), 16, 0, 0);
    }
#pragma unroll
    for (int j = 0; j < 4; ++j) {
      const int qc = j * 2 + tv;
      __builtin_amdgcn_global_load_lds((const unsigned*)(Qg + (size_t)(qc * 64 + lane) * 8), (unsigned*)(sl + 8192 + qc * 1024), 16, 0, 0);
    }
    __builtin_amdgcn_global_load_lds((const unsigned*)(s.Gg + (size_t)(ch0 + c) * 64 + lane), (unsigned*)(sl + 16384), 4, 0, 0);
  };
  auto flush = [&](int c, int tl) {
    const unsigned char* sp = stg + (((c & 1) * 2 + tl) * 16 + (lane >> 2)) * ZSTR;
    bf16_t* Zo = qz_ptr(s, ch0 + c) + (tl * 16 + (lane >> 2)) * 64;
    const u32x4 a = *(const u32x4*)(sp + (lane & 3) * 16), b = *(const u32x4*)(sp + ((lane & 3) + 4) * 16);
    *(u32x4*)(Zo + (lane & 3) * 8) = a; *(u32x4*)(Zo + ((lane & 3) + 4) * 8) = b;
  };
  __syncthreads();
  if (loader) { issue(0); issue(1); issue(2); asm volatile("s_waitcnt vmcnt(18)" ::: "memory"); }
  __builtin_amdgcn_s_barrier();
  f32x4 Z[4];
#pragma unroll
  for (int t = 0; t < 4; ++t) Z[t] = (f32x4){0.f, 0.f, 0.f, 0.f};
  for (int c = 0; c < NCH; ++c) {
    if (loader && c + 3 < NCH) issue(c + 3);
    const unsigned char* sl = lds + (c & 3) * RSLOT;
    unsigned zp[4][2];
#pragma unroll
    for (int t = 0; t < 4; ++t) { zp[t][0] = cvt_pk_bf16(Z[t][0], Z[t][1]); zp[t][1] = cvt_pk_bf16(Z[t][2], Z[t][3]); }
    if (loader) {
      unsigned char* sp = stg + (((c & 1) * 2 + tv) * 16 + fr) * ZSTR + fq * 8;
#pragma unroll
      for (int t = 0; t < 4; ++t) *(u32x2*)(sp + t * 32) = (u32x2){zp[t][0], zp[t][1]};
    } else {
      bf16_t* Zo = qz_ptr(s, ch0 + c) + (tv * 16 + fr) * 64;
#pragma unroll
      for (int t = 0; t < 4; ++t) *(u32x2*)(Zo + t * 16 + fq * 4) = (u32x2){zp[t][0], zp[t][1]};
      if (c > 0) flush(c - 1, tv - 2);
    }
    bf16x8 zb[2];
#pragma unroll
    for (int ks = 0; ks < 2; ++ks) { const u32x4 w = {zp[2 * ks][0], zp[2 * ks][1], zp[2 * ks + 1][0], zp[2 * ks + 1][1]}; zb[ks] = __builtin_bit_cast(bf16x8, w); }
#pragma unroll
    for (int t = 0; t < 4; ++t) {
      const u32x2 qv = *(const u32x2*)(sl + 8192 + ((t * 4 + tv) * 64 + lane) * 8);
      const f32x4 g4 = *(const f32x4*)(sl + 16384 + (t * 16 + fq * 4) * 4);
      f32x4 acc = (f32x4){bf_lo(qv.x) + g4[0] * Z[t][0], bf_hi(qv.x) + g4[1] * Z[t][1], bf_lo(qv.y) + g4[2] * Z[t][2], bf_hi(qv.y) + g4[3] * Z[t][3]};
      const int rowp = t * 16 + fr, gs = (rowp >> 1) & 7;
#pragma unroll
      for (int ks = 0; ks < 2; ++ks) {
        const unsigned char* prow = sl + rowp * 128 + (fq & 1) * 8;
        const int qa = ks * 4 + (fq >> 1);
        const u32x2 p0 = *(const u32x2*)(prow + ((qa ^ gs) << 4)), p1 = *(const u32x2*)(prow + (((qa + 2) ^ gs) << 4));
        const u32x4 w = {p0.x, p0.y, p1.x, p1.y};
        acc = __builtin_amdgcn_mfma_f32_16x16x32_bf16(__builtin_bit_cast(bf16x8, w), zb[ks], acc, 0, 0, 0);
      }
      Z[t] = acc;
    }
    if (loader) { if (c + 3 < NCH) asm volatile("s_waitcnt vmcnt(18)" ::: "memory"); else asm volatile("s_waitcnt vmcnt(0)" ::: "memory"); }
    asm volatile("s_waitcnt lgkmcnt(0)" ::: "memory");
    __builtin_amdgcn_s_barrier();
  }
  if (!loader) flush(NCH - 1, tv - 2);
  __syncthreads();
}

DI void scan_phaseC_item(const ScanArgs& s, int item, const ScanIn& in, unsigned char* lds) {
  const int c = item & (NCH - 1), h = (item >> 7) & 15, b = item >> 11;
  const int tid = opaque_v(threadIdx.x), lane = tid & 63, wv = tid >> 6, fr = lane & 15, fq = lane >> 4;
  unsigned char* At = lds; unsigned char* Bt = At + 32 * SN; unsigned char* Kt = Bt + 32 * SN; unsigned char* Rt = Kt + 32 * SN;
  unsigned char* VT = Rt + 32 * SN;
  unsigned char* Tm = VT + 64 * ST; unsigned char* Aak = Tm + 32 * ST; unsigned char* Arb = Aak + 32 * ST; unsigned char* Ark = Arb + 32 * ST;
  float* A32 = (float*)(Ark + 32 * ST);
  unsigned char* S0 = (unsigned char*)A32 + 4608;
  unsigned char* X1T = S0 + 64 * SN; unsigned char* UT = X1T + 64 * ST;
  float* Yb = (float*)(UT + 64 * ST);
  float* lwbuf = Yb;
  const size_t gbase = ((size_t)b * SEQ + (size_t)c * CL) * D + h * HS;
  float bonus; float vv8[8];
  { const int e0 = tid * 8, e1 = (tid + 256) * 8;
    *(u32x4*)(S0 + (e0 >> 6) * SN + (e0 & 63) * 2) = in.z0; *(u32x4*)(S0 + (e1 >> 6) * SN + (e1 & 63) * 2) = in.z1; }
  scan_load<true>(s, in, h, lwbuf, At, Bt, Kt, Rt, nullptr, nullptr, nullptr, VT, bonus, vv8, nullptr);
  __syncthreads();
  if (tid < 96) {
    const int blk = tid >> 5, row = (tid & 31) >> 1, half = tid & 1;
    *(u32x4*)(Tm + ((blk == 0 ? 0 : 16) + row) * ST + (blk == 2 ? 32 : 0) + half * 16) = in.tb;
  } else if (tid < 128) {
    const int q = tid - 96;
    *(u32x4*)(Tm + (q >> 1) * ST + 32 + (q & 1) * 16) = (u32x4){0u, 0u, 0u, 0u};
  }
#pragma unroll
  for (int u = 0; u < 3; ++u) {
    const int tile = wv * 3 + u, mat = tile >> 2, ti = (tile >> 1) & 1, tj = tile & 1;
    const unsigned char* Pm = (mat == 0) ? At : Rt; const unsigned char* Qm = (mat == 1) ? Bt : Kt;
    unsigned char* dst = (mat == 0) ? Aak : (mat == 1 ? Arb : Ark);
    const f32x4 x = tile_mm<false, false>(Pm, SN, Qm, SN, ti * 16, tj * 16, 2, (f32x4){0.f, 0.f, 0.f, 0.f}, lane);
#pragma unroll
    for (int q = 0; q < 4; ++q) {
      const int i = ti * 16 + fq * 4 + q, j = tj * 16 + fr;
      const bool keep = (mat == 0) ? (j < i) : (j <= i);
      *(bf16_t*)(dst + i * ST + j * 2) = f2bf(keep ? x[q] : 0.f);
    }
  }
  __syncthreads();
#pragma unroll
  for (int u = 0; u < 2; ++u) {
    const int tile = wv * 2 + u, ti = tile >> 2, tv = tile & 3;
    f32x4 x = tile_mm<false, false>(At, SN, S0, SN, ti * 16, tv * 16, 2, (f32x4){0.f, 0.f, 0.f, 0.f}, lane);
    x = tile_mm<false, true>(Aak, ST, VT, ST, ti * 16, tv * 16, 1, x, lane);
    st_bf16x4(X1T + tr_off(tv * 16 + fr, ti * 16 + fq * 4), x);
  }
  __syncthreads();
#pragma unroll
  for (int u = 0; u < 2; ++u) {
    const int tile = wv * 2 + u, ti = tile >> 2, tv = tile & 3;
    const f32x4 x = tile_mm<false, true>(Tm, ST, X1T, ST, ti * 16, tv * 16, 1, (f32x4){0.f, 0.f, 0.f, 0.f}, lane);
    st_bf16x4(UT + tr_off(tv * 16 + fr, ti * 16 + fq * 4), x);
  }
  __syncthreads();
#pragma unroll
  for (int u = 0; u < 2; ++u) {
    const int tile = wv * 2 + u, ti = tile >> 2, tv = tile & 3;
    f32x4 x = tile_mm<false, false>(Rt, SN, S0, SN, ti * 16, tv * 16, 2, (f32x4){0.f, 0.f, 0.f, 0.f}, lane);
    x = tile_mm<false, true>(Arb, ST, UT, ST, ti * 16, tv * 16, 1, x, lane);
    x = tile_mm<false, true>(Ark, ST, VT, ST, ti * 16, tv * 16, 1, x, lane);
#pragma unroll
    for (int q = 0; q < 4; ++q) Yb[(ti * 16 + fq * 4 + q) * 68 + tv * 16 + fr] = x[q];
  }
  __syncthreads();
  {
    const int tt = tid >> 3, c0 = (tid & 7) * 8;
    float yv[8], sum = 0.f;
#pragma unroll
    for (int j = 0; j < 8; ++j) { yv[j] = Yb[tt * 68 + c0 + j]; sum += yv[j]; }
    sum += __shfl_xor(sum, 1); sum += __shfl_xor(sum, 2); sum += __shfl_xor(sum, 4);
    const float mean = sum * (1.f / 64.f);
    float var = 0.f;
#pragma unroll
    for (int j = 0; j < 8; ++j) { const float d = yv[j] - mean; var += d * d; }
    var += __shfl_xor(var, 1); var += __shfl_xor(var, 2); var += __shfl_xor(var, 4);
    const float rstd = rsqrtf(var * (1.f / 64.f) + GN_EPS);
    const size_t off = gbase + (size_t)tt * D + c0;
    float o[8];
#pragma unroll
    for (int j = 0; j < 8; ++j) {
      const int chn = h * HS + c0 + j;
      o[j] = (yv[j] - mean) * rstd * s.lnx_g[chn] + s.lnx_b[chn] + bonus * vv8[j];
    }
    *(u32x4*)(s.r + off) = (u32x4){cvt_pk_bf16(o[0], o[1]), cvt_pk_bf16(o[2], o[3]), cvt_pk_bf16(o[4], o[5]), cvt_pk_bf16(o[6], o[7])};
  }
  __syncthreads();
}

DI void ln_phase(const bf16_t* __restrict__ z, const float* __restrict__ lg, const float* __restrict__ lb, bf16_t* __restrict__ xo, float* __restrict__ xo32,
                 const float* __restrict__ mod_l, int shift_idx, int scale_idx, bf16_t* __restrict__ ho, unsigned char* __restrict__ ho8, int bid, int nblk) {
  const int tq = opaque_v(threadIdx.x); const int lane = tq & 63, wv = tq >> 6;
  constexpr int RW = 4;
  for (int row0 = (bid * 4 + wv) * RW; row0 < T; row0 += nblk * 4 * RW) {
    float v[RW][16];
#pragma unroll
    for (int r = 0; r < RW; ++r) {
      const u32x4 a0 = *(const u32x4*)(z + (size_t)(row0 + r) * D + lane * 8), a1 = *(const u32x4*)(z + (size_t)(row0 + r) * D + 512 + lane * 8);
      const unsigned u[8] = {a0.x, a0.y, a0.z, a0.w, a1.x, a1.y, a1.z, a1.w};
#pragma unroll
      for (int q = 0; q < 8; ++q) { v[r][2 * q] = bf_lo(u[q]); v[r][2 * q + 1] = bf_hi(u[q]); }
    }
    const int b = row0 / SEQ;
#pragma unroll
    for (int r = 0; r < RW; ++r) {
      float s = 0.f;
#pragma unroll
      for (int i = 0; i < 16; ++i) s += v[r][i];
      const float mean = wave_sum(s) * (1.f / D);
      float q = 0.f;
#pragma unroll
      for (int i = 0; i < 16; ++i) { const float d = v[r][i] - mean; q += d * d; }
      const float rstd = rsqrtf(wave_sum(q) * (1.f / D) + LN_EPS);
      const int row = row0 + r;
#pragma unroll
      for (int hh = 0; hh < 2; ++hh) {
        const int d = hh * 512 + lane * 8;
        float o[8];
#pragma unroll
        for (int i = 0; i < 8; ++i) o[i] = (v[r][hh * 8 + i] - mean) * rstd * lg[d + i] + lb[d + i];
        if (xo32) { *(f32x4*)(xo32 + (size_t)row * D + d) = (f32x4){o[0], o[1], o[2], o[3]}; *(f32x4*)(xo32 + (size_t)row * D + d + 4) = (f32x4){o[4], o[5], o[6], o[7]}; }
        if (xo) *(u32x4*)(xo + (size_t)row * D + d) = (u32x4){cvt_pk_bf16(o[0], o[1]), cvt_pk_bf16(o[2], o[3]), cvt_pk_bf16(o[4], o[5]), cvt_pk_bf16(o[6], o[7])};
        if (ho) {
          float hq[8];
#pragma unroll
          for (int i = 0; i < 8; ++i) hq[i] = o[i] * (1.f + mod_l[(size_t)b * 6144 + scale_idx * D + d + i]) + mod_l[(size_t)b * 6144 + shift_idx * D + d + i];
          *(u32x4*)(ho + (size_t)row * D + d) = (u32x4){cvt_pk_bf16(hq[0], hq[1]), cvt_pk_bf16(hq[2], hq[3]), cvt_pk_bf16(hq[4], hq[5]), cvt_pk_bf16(hq[6], hq[7])};
          if (ho8) {
            int p0 = 0, p1 = 0;
            p0 = __builtin_amdgcn_cvt_pk_fp8_f32(hq[0], hq[1], p0, false); p0 = __builtin_amdgcn_cvt_pk_fp8_f32(hq[2], hq[3], p0, true);
            p1 = __builtin_amdgcn_cvt_pk_fp8_f32(hq[4], hq[5], p1, false); p1 = __builtin_amdgcn_cvt_pk_fp8_f32(hq[6], hq[7], p1, true);
            *(u32x2*)(ho8 + (size_t)row * D + d) = (u32x2){(unsigned)p0, (unsigned)p1};
          }
        }
      }
    }
  }
}

DI void combine_phase(const unsigned* __restrict__ lists, unsigned* __restrict__ epk, float* __restrict__ gate, unsigned char* lds, int bid, int nblk) {
  const int tq = opaque_v(threadIdx.x);
  for (int g0 = bid * 256; g0 < T * 8; g0 += nblk * 256) {
    const u32x4* src = (const u32x4*)(lists + (size_t)g0 * 32);
    u32x4 v[8];
#pragma unroll
    for (int i = 0; i < 8; ++i) v[i] = src[i * 256 + tq];
    __syncthreads();
#pragma unroll
    for (int i = 0; i < 8; ++i) { const int ci = i * 256 + tq, t = ci >> 3, c = ci & 7; *(u32x4*)(lds + t * 128 + ((c ^ (t & 7)) << 4)) = v[i]; }
    __syncthreads();
    const int gid = g0 + tq, t = gid >> 3, head = gid & 7;
    peer_combine((const unsigned*)(lds + tq * 128), tq & 7, epk + (size_t)t * 64 + head * 8, gate + (size_t)t * 128 + head * 8);
  }
  __syncthreads();
}

DI void table_fp8_phase(const float* __restrict__ src, unsigned char* __restrict__ dst, float* __restrict__ inv, int rows, int bid, int nblk) {
  const int tq = opaque_v(threadIdx.x); const int lane = tq & 63, wv = tq >> 6;
  for (int r0 = (bid * 4 + wv) * 4; r0 < rows; r0 += nblk * 16) {
    f32x4 v[4][4];
#pragma unroll
    for (int rr = 0; rr < 4; ++rr)
#pragma unroll
      for (int i = 0; i < 4; ++i) v[rr][i] = __builtin_nontemporal_load((const f32x4*)(src + (size_t)(r0 + rr) * D + i * 256 + lane * 4));
#pragma unroll
    for (int rr = 0; rr < 4; ++rr) {
      float mx = 0.f;
#pragma unroll
      for (int i = 0; i < 4; ++i) mx = fmaxf(mx, fmaxf(fmaxf(fabsf(v[rr][i][0]), fabsf(v[rr][i][1])), fmaxf(fabsf(v[rr][i][2]), fabsf(v[rr][i][3]))));
#pragma unroll
      for (int o = 32; o >= 1; o >>= 1) mx = fmaxf(mx, __shfl_xor(mx, o));
      const float sc = mx > 0.f ? exp2f(floorf(log2f(384.f / mx))) : 1.f;
#pragma unroll
      for (int i = 0; i < 4; ++i) {
        int pk = 0;
        pk = __builtin_amdgcn_cvt_pk_fp8_f32(v[rr][i][0] * sc, v[rr][i][1] * sc, pk, false);
        pk = __builtin_amdgcn_cvt_pk_fp8_f32(v[rr][i][2] * sc, v[rr][i][3] * sc, pk, true);
        *(int*)(dst + (size_t)(r0 + rr) * D + i * 256 + lane * 4) = pk;
      }
      if (lane == 0) inv[r0 + rr] = 1.f / sc;
    }
  }
}

struct PeerArgs {
  const bf16_t* h2;
  const unsigned char *u8, *v8;
  const float *uinv, *vinv;
  const unsigned* epk; const float* gate;
  float* part;
  float* coef;
  const bf16_t* xres;
  const float* gate2;
  bf16_t* z;
  unsigned* ctr_u; unsigned* ctr_v;
};
constexpr int PCH = 64;
DI void cvt16_fp8(const u32x4& d, float (&f)[16]) {
  const unsigned w[4] = {d.x, d.y, d.z, d.w};
#pragma unroll
  for (int i = 0; i < 4; ++i) {
    const f32x2 lo = __builtin_amdgcn_cvt_pk_f32_fp8((int)w[i], false), hi = __builtin_amdgcn_cvt_pk_f32_fp8((int)w[i], true);
    f[i * 4] = lo.x; f[i * 4 + 1] = lo.y; f[i * 4 + 2] = hi.x; f[i * 4 + 3] = hi.y;
  }
}
template <bool VPHASE>
DI void peer_slice_phase(const PeerArgs& a, unsigned char* lds) {
  const int tq = opaque_v(threadIdx.x); const int lane = tq & 63, wv = tq >> 6, cc = lane & 7;
  volatile int* nxt = (volatile int*)lds;
  const unsigned xcc = xb_xcc_id() & 7u;
  unsigned* ctr = VPHASE ? a.ctr_v : a.ctr_u;
  for (int ks = 0; ks < 8; ++ks) {
    const int s = (int)((xcc + ks) & 7u);
    if (ks > 0) {
      __syncthreads();
      if (tq == 0) *nxt = (int)xb_ld(&ctr[s * 16]);
      __syncthreads();
      if (*nxt >= T / PCH) continue;
    }
    unsigned pend = 0u;
    if (tq == 0) pend = atomicAdd(&ctr[s * 16], 1u);
    for (;;) {
      __syncthreads();
      if (tq == 0) *nxt = (int)pend;
      __syncthreads();
      const int chunk = *nxt;
      if (chunk >= T / PCH) break;
      if (tq == 0) pend = atomicAdd(&ctr[s * 16], 1u);
      for (int ti = 0; ti < PCH / 4; ++ti) {
        const int t = chunk * PCH + wv * (PCH / 4) + ti;
        const unsigned ep = a.epk[(size_t)t * 64 + lane];
        const unsigned char* tab = (VPHASE ? a.v8 : a.u8) + s * 128 + cc * 16;
        u32x4 data[16];
        float cv[16];
        float c_lo = 0.f, c_hi = 0.f;
        if (VPHASE) { c_lo = a.coef[(size_t)t * 128 + lane]; c_hi = a.coef[(size_t)t * 128 + 64 + lane]; }
#pragma unroll
        for (int i = 0; i < 16; ++i) {
          const int src = (lane & ~7) | (i & 7);
          const unsigned ev = (unsigned)__shfl((int)ep, src);
          const unsigned e = (i < 8) ? (ev & 0xffffu) : (ev >> 16);
          if (VPHASE) cv[i] = __shfl(i < 8 ? c_lo : c_hi, src);
          data[i] = *(const u32x4*)(tab + (size_t)e * D);
        }
        if (!VPHASE) {
          const u32x4 h0 = *(const u32x4*)(a.h2 + (size_t)t * D + s * 128 + cc * 16), h1 = *(const u32x4*)(a.h2 + (size_t)t * D + s * 128 + cc * 16 + 8);
          float hf[16];
          { const unsigned u[8] = {h0.x, h0.y, h0.z, h0.w, h1.x, h1.y, h1.z, h1.w};
#pragma unroll
            for (int q = 0; q < 8; ++q) { hf[2 * q] = bf_lo(u[q]); hf[2 * q + 1] = bf_hi(u[q]); } }
          float r_lo = 0.f, r_hi = 0.f;
#pragma unroll
          for (int i = 0; i < 16; ++i) {
            float f[16]; cvt16_fp8(data[i], f);
            float d = 0.f;
#pragma unroll
            for (int q = 0; q < 16; ++q) d += f[q] * hf[q];
            d += __builtin_bit_cast(float, __builtin_amdgcn_update_dpp(0, __builtin_bit_cast(int, d), 0xB1, 0xF, 0xF, true));
            d += __builtin_bit_cast(float, __builtin_amdgcn_update_dpp(0, __builtin_bit_cast(int, d), 0x4E, 0xF, 0xF, true));
            d += __builtin_bit_cast(float, __builtin_amdgcn_update_dpp(0, __builtin_bit_cast(int, d), 0x141, 0xF, 0xF, true));
            if ((i & 7) == cc) { if (i < 8) r_lo = d; else r_hi = d; }
          }
          float* pp = a.part + ((size_t)s * T + t) * 128;
          pp[lane] = r_lo; pp[64 + lane] = r_hi;
        } else {
          float acc[16];
#pragma unroll
          for (int q = 0; q < 16; ++q) acc[q] = 0.f;
#pragma unroll
          for (int i = 0; i < 16; ++i) {
            float f[16]; cvt16_fp8(data[i], f);
#pragma unroll
            for (int q = 0; q < 16; ++q) acc[q] += cv[i] * f[q];
          }
          float r8[8], r4[4], r2[2];
          { const bool up = (lane & 8) != 0;
#pragma unroll
            for (int q = 0; q < 8; ++q) { const float keep = up ? acc[8 + q] : acc[q], send = up ? acc[q] : acc[8 + q]; r8[q] = keep + __shfl_xor(send, 8); } }
          { const bool up = (lane & 16) != 0;
#pragma unroll
            for (int q = 0; q < 4; ++q) { const float keep = up ? r8[4 + q] : r8[q], send = up ? r8[q] : r8[4 + q]; r4[q] = keep + __shfl_xor(send, 16); } }
          { const bool up = (lane & 32) != 0;
#pragma unroll
            for (int q = 0; q < 2; ++q) { const float keep = up ? r4[2 + q] : r4[q], send = up ? r4[q] : r4[2 + q]; r2[q] = keep + __shfl_xor(send, 32); } }
          const int col = s * 128 + cc * 16 + ((lane >> 3) & 1) * 8 + ((lane >> 4) & 1) * 4 + ((lane >> 5) & 1) * 2;
          const int b = t / SEQ;
          const unsigned xb = *(const unsigned*)(a.xres + (size_t)t * D + col); const f32x2 gt = *(const f32x2*)(a.gate2 + (size_t)b * 6144 + col);
          *(unsigned*)(a.z + (size_t)t * D + col) = cvt_pk_bf16(ALPHA * bf_lo(xb) + gt.x * r2[0], ALPHA * bf_hi(xb) + gt.y * r2[1]);
        }
      }
    }
  }
  __syncthreads();
}
DI void peer_coef_phase(const PeerArgs& a, int bid, int nblk) {
  const int tq = opaque_v(threadIdx.x);
  for (int g4 = bid * 256 + tq; g4 < T * 32; g4 += nblk * 256) {
    const int t = g4 >> 5, j = (g4 & 31) * 4;
    const u32x4 ep = *(const u32x4*)(a.epk + (size_t)t * 64 + (j & 63));
    const int sh = (j < 64) ? 0 : 16;
    const unsigned e[4] = {(ep.x >> sh) & 0xffffu, (ep.y >> sh) & 0xffffu, (ep.z >> sh) & 0xffffu, (ep.w >> sh) & 0xffffu};
    float ui[4], vi[4];
#pragma unroll
    for (int q = 0; q < 4; ++q) { ui[q] = a.uinv[e[q]]; vi[q] = a.vinv[e[q]]; }
    f32x4 sum = {0.f, 0.f, 0.f, 0.f};
#pragma unroll
    for (int s8 = 0; s8 < 8; ++s8) sum += *(const f32x4*)(a.part + ((size_t)s8 * T + t) * 128 + j);
    const f32x4 gt = *(const f32x4*)(a.gate + (size_t)t * 128 + j);
    f32x4 o;
#pragma unroll
    for (int q = 0; q < 4; ++q) o[q] = gt[q] * gelu_exact(sum[q] * ui[q]) * vi[q];
    *(f32x4*)(a.coef + (size_t)t * 128 + j) = o;
  }
}

DI void pool_phase(const bf16_t* __restrict__ zin, bf16_t* __restrict__ pout, int bid, int nblk) {
  const int tq = opaque_v(threadIdx.x);
  constexpr int SEG = 32;
  for (int it = bid * 256 + tq; it < (T / SEG) * (D / 8); it += nblk * 256) {
    const int ch = it & 127, seg = it >> 7;
    const int d = ch * 8, win = 2 << (d / 256);
    const int t0 = seg * SEG, tp0 = t0 % SEQ;
    float s[8];
#pragma unroll
    for (int j = 0; j < 8; ++j) s[j] = 0.f;
    for (int w = 1; w < win; ++w) {
      if (tp0 - w < 0) break;
      const u32x4 v = *(const u32x4*)(zin + (size_t)(t0 - w) * D + d);
      const unsigned u[4] = {v.x, v.y, v.z, v.w};
#pragma unroll
      for (int j = 0; j < 4; ++j) { s[2 * j] += bf_lo(u[j]); s[2 * j + 1] += bf_hi(u[j]); }
    }
#pragma unroll 4
    for (int i = 0; i < SEG; ++i) {
      const int t = t0 + i, tp = tp0 + i;
      const u32x4 v = *(const u32x4*)(zin + (size_t)t * D + d);
      const unsigned u[4] = {v.x, v.y, v.z, v.w};
      float z0[8];
#pragma unroll
      for (int j = 0; j < 4; ++j) { z0[2 * j] = bf_lo(u[j]); z0[2 * j + 1] = bf_hi(u[j]); }
#pragma unroll
      for (int j = 0; j < 8; ++j) s[j] += z0[j];
      const int cnt = min(tp + 1, win);
      const float ic = 1.f / (float)cnt;
      float o[8];
#pragma unroll
      for (int j = 0; j < 8; ++j) o[j] = s[j] * ic - z0[j];
      *(u32x4*)(pout + (size_t)t * D + d) = (u32x4){cvt_pk_bf16(o[0], o[1]), cvt_pk_bf16(o[2], o[3]), cvt_pk_bf16(o[4], o[5]), cvt_pk_bf16(o[6], o[7])};
      if (tp + 1 >= win) {
        const u32x4 vo = *(const u32x4*)(zin + (size_t)(t - win + 1) * D + d);
        const unsigned uo[4] = {vo.x, vo.y, vo.z, vo.w};
#pragma unroll
        for (int j = 0; j < 4; ++j) { s[2 * j] -= bf_lo(uo[j]); s[2 * j + 1] -= bf_hi(uo[j]); }
      }
    }
  }
}

#define GRID_SYNC() xcd_barrier(xb)

__global__ void __launch_bounds__(256, 2) mega(Params p) {
  __shared__ __attribute__((aligned(16))) unsigned char lds[LDS_BYTES + 16];
  cg::grid_group grid = cg::this_grid();
  const int bid = blockIdx.x, nblk = gridDim.x;
  if (threadIdx.x == 0) { *(volatile LAS unsigned*)(lds + LDS_BYTES) = 0u; *(volatile LAS unsigned*)(lds + LDS_BYTES + 4) = 0u; *(volatile LAS unsigned*)(lds + LDS_BYTES + 8) = 0u; }
  __syncthreads();
  const XcdBarrier xb = xcd_barrier_post(p.bar, (volatile LAS unsigned*)(lds + LDS_BYTES));
  const float* mod0 = p.mod; const float* mod1 = p.mod + (size_t)NB * 6144;
  bf16_t* S[7];
#pragma unroll
  for (int i = 0; i < 7; ++i) S[i] = (bf16_t*)p.slot[i];

  prologue_phase(p, lds, bid, nblk);
  grid.sync();
  bf16_t *h = S[0], *r = S[1], *k = S[2], *v = S[3], *lw = S[4], *av = S[5];
  bf16_t* tw = p.lora_tmp; bf16_t* ta = tw + (size_t)T * 64; bf16_t* tg = ta + (size_t)T * 64;
  modulate_phase(p.x, mod0, p.rw_mu, h, S[4], S[5], S[6], bid, nblk);
  for (int it = bid; it < 4 * 8 * 2; it += nblk) {
    const int nt = it & 1, mt = (it >> 1) & 7, g4 = it >> 4;
    gemm_tile(mk(p.PoutT + g4 * 256, D, p.WgrpS + (size_t)g4 * 256 * 256, 256, 256, 256, EPI_BF16, p.WcT + g4 * 256, D), mt * 128, nt * 128, lds);
  }
  for (int it = bid; it < 2 * 16 * 8; it += nblk) {
    const int nt = it & 7, gl = it >> 3;
    if (gl < F8_FROM * 16) gemm_tile(mk(p.KeysB + (size_t)gl * 128 * 128, 128, p.WqB + (size_t)(gl >> 4) * D * 2048 + (gl & 15) * 128, 2048, D, 128, EPI_BF16, p.WeffT + (size_t)gl * 128 * D, D), 0, nt * 128, lds);
    else gemm_tile(mk(p.KeysB + (size_t)gl * 128 * 128, 128, p.WqB + (size_t)(gl >> 4) * D * 2048 + (gl & 15) * 128, 2048, D, 128, EPI_F8, (unsigned char*)(p.WeffT + (size_t)(gl >> 4) * 2048 * D) + (size_t)(gl & 15) * 128 * D, D), 0, nt * 128, lds);
  }
  GRID_SYNC();
  for (int it = 0, nit = sched_iters(4, nblk); it < nit; ++it) {
    int mt, nt; if (!sched_mn(it, bid, nblk, 4, mt, nt)) continue;
    GemmArgs g; int n0;
    if (nt == 0) { n0 = 0; g = mk(h, D, p.W1T, D, 64, D, EPI_TANH, tw, 64, p.rw_mu + 3 * D); }
    else if (nt == 1) { n0 = 0; g = mk(h, D, p.A1T, D, 64, D, EPI_BF16, ta, 64, p.rw_mu + 4 * D); }
    else { n0 = (nt - 2) * 128; g = mk(h, D, p.G1T, D, 192, D, EPI_SIGMOID, tg, 192, p.rw_mu + 5 * D); }
    gemm_tile(g, mt * 128, n0, lds);
  }
  for (int it = 0, nit = sched_iters(24, nblk, 128); it < nit; ++it) {
    int mt, nt; if (!sched_mn(it, bid, nblk, 24, mt, nt, 128)) continue;
    const int j = nt >> 3;
    gemm_tile256(mk(S[4 + j], D, p.WT_rkv + (size_t)j * D * D, D, D, D, EPI_BF16, j == 0 ? r : (j == 1 ? k : v), D), mt * 256, (nt & 7) * 128, lds);
  }
  GRID_SYNC();
  for (int it = 0, nit = sched_iters(16, nblk); it < nit; ++it) {
    int mt, nt; if (!sched_mn(it, bid, nblk, 16, mt, nt)) continue;
    const int j = nt >> 3, n0 = (nt & 7) * 128;
    GemmArgs g;
    if (j == 0) g = mk(tw, 64, p.W2T, 64, D, 64, EPI_LW, lw, D, nullptr, p.rw_w0);
    else g = mk(ta, 64, p.A2T, 64, D, 64, EPI_ASIG, av, D, nullptr, p.rw_a0);
    gemm_tile(g, mt * 128, n0, lds);
  }
  GRID_SYNC();
  {
    ScanArgs s; s.r = r; s.k = k; s.v = v; s.lw = lw; s.a = av; s.k_k = p.rw_k_k; s.k_a = p.rw_k_a; s.r_k = p.rw_r_k; s.lnx_g = p.rw_lnx_g; s.lnx_b = p.rw_lnx_b;
    s.Pg = (bf16_t*)p.out; s.Qz0 = S[0]; s.Qz1 = S[6]; s.Gg = p.Gg; s.Tg = p.WT_rkv;
    { ScanIn cur, nxt; if (bid < NB * NH * NCH) scan_fetch<false>(s, bid, cur);
      for (int it = bid; it < NB * NH * NCH; it += nblk) { if (it + nblk < NB * NH * NCH) scan_fetch<false>(s, it + nblk, nxt); scan_phaseA_item(s, it, cur, lds); cur = nxt; } }
    GRID_SYNC();
    for (int it = bid; it < NB * NH; it += nblk) scan_chain_block(s, it, lds);
    GRID_SYNC();
    { ScanIn cur, nxt; if (bid < NB * NH * NCH) scan_fetch<true>(s, bid, cur);
      for (int it = bid; it < NB * NH * NCH; it += nblk) { if (it + nblk < NB * NH * NCH) scan_fetch<true>(s, it + nblk, nxt); scan_phaseC_item(s, it, cur, lds); cur = nxt; } }
    GRID_SYNC();
  }
  for (int it = 0, nit = sched_iters(8, nblk); it < nit; ++it) {
    int mt, nt; if (!sched_mn(it, bid, nblk, 8, mt, nt)) continue;
    gemm_tile(mk(tg, 192, p.G2T, 192, D, 192, EPI_GATE, r, D), mt * 128, nt * 128, lds);
  }
  GRID_SYNC();
  h = r;
  bf16_t* z = S[2];
  for (int it = 0, nit = sched_iters(8, nblk, 128); it < nit; ++it) {
    int mt, nt; if (!sched_mn(it, bid, nblk, 8, mt, nt, 128)) continue;
    gemm_tile256(mk(h, D, p.WoT, D, D, D, EPI_Z, z, D, nullptr, p.x, mod0 + 2 * D), mt * 256, nt * 128, lds);
  }
  table_fp8_phase(p.pe_u, p.slot[6], p.tinv, NEXP, bid, nblk);
  table_fp8_phase(p.pe_v, p.slot[6] + ((size_t)16 << 20), p.tinv + NEXP, NEXP, bid, nblk);
  table_fp8_phase(p.pe_u + (size_t)NEXP * D, p.slot[6] + ((size_t)32 << 20), p.tinv + 2 * NEXP, NEXP, bid, nblk);
  table_fp8_phase(p.pe_v + (size_t)NEXP * D, p.slot[6] + ((size_t)48 << 20), p.tinv + 3 * NEXP, NEXP, bid, nblk);
  GRID_SYNC();
  ln_phase(z, p.ln_g + 0 * D, p.ln_b + 0 * D, S[4], nullptr, mod0, 3, 4, S[0], F8_FROM <= 0 ? p.slot[5] : nullptr, bid, nblk);
  GRID_SYNC();

#pragma unroll
  for (int layer = 0; layer < 2; ++layer) {
    const float* modl = layer == 0 ? mod0 : mod1;
    const bf16_t* hp = S[0];
    unsigned char* lsl = p.slot[3];
    unsigned* epk = (unsigned*)(lsl + ((size_t)32 << 20));
    float* gate = (float*)(lsl + ((size_t)40 << 20));
    unsigned* lists = (unsigned*)p.slot[1];
    if (layer < F8_FROM) {
      for (int it = 0, nit = sched_iters(16, nblk, 128); it < nit; ++it) {
        int mt, grp; if (!sched_mn(it, bid, nblk, 16, mt, grp, 128)) continue;
        gemm_tile256(mk(hp, D, p.WeffT + (size_t)layer * 2048 * D, D, 2048, D, EPI_TOPK, lists, 0), mt * 256, grp * 128, lds);
      }
    } else {
      for (int it = 0, nit = sched_iters(16, nblk); it < nit; ++it) {
        int mt, grp; if (!sched_mn(it, bid, nblk, 16, mt, grp)) continue;
        gemm_tile_f8(p.slot[5], (const unsigned char*)(p.WeffT + (size_t)layer * 2048 * D), mt * 128, grp, lists, lds);
      }
    }
    GRID_SYNC();
    combine_phase(lists, epk, gate, lds, bid, nblk);
    GRID_SYNC();
    PeerArgs a; a.h2 = hp;
    a.u8 = p.slot[6] + ((size_t)(layer * 32) << 20); a.v8 = a.u8 + ((size_t)16 << 20);
    a.uinv = p.tinv + (layer * 2) * NEXP; a.vinv = a.uinv + NEXP;
    a.epk = epk; a.gate = gate; a.part = (float*)p.slot[1]; a.coef = (float*)lsl;
    a.xres = S[4]; a.gate2 = modl + 5 * D; a.z = S[1];
    a.ctr_u = p.bar + XCD_BAR_WORDS + (layer * 2) * 128; a.ctr_v = a.ctr_u + 128;
    peer_slice_phase<false>(a, lds);
    GRID_SYNC();
    peer_coef_phase(a, bid, nblk);
    GRID_SYNC();
    peer_slice_phase<true>(a, lds);
    GRID_SYNC();
    if (layer == 1) { ln_phase(a.z, p.ln_g + 3 * D, p.ln_b + 3 * D, nullptr, p.out, mod1, 0, 1, nullptr, nullptr, bid, nblk); break; }
    ln_phase(a.z, p.ln_g + 1 * D, p.ln_b + 1 * D, S[4], nullptr, mod1, 0, 1, S[0], nullptr, bid, nblk);
    GRID_SYNC();
    const bf16_t* x2 = S[4];
    bf16_t *hB = S[0], *zin = S[1], *pp = S[2];
    for (int it = 0, nit = sched_iters(8, nblk, 128); it < nit; ++it) {
      int mt, nt; if (!sched_mn(it, bid, nblk, 8, mt, nt, 128)) continue;
      gemm_tile256(mk(hB, D, p.PinT, D, D, D, EPI_BF16, zin, D), mt * 256, nt * 128, lds);
    }
    GRID_SYNC();
    pool_phase(zin, pp, bid, nblk);
    GRID_SYNC();
    bf16_t* z1 = S[3];
    for (int it = 0, nit = sched_iters(8, nblk, 128); it < nit; ++it) {
      int mt, nt; if (!sched_mn(it, bid, nblk, 8, mt, nt, 128)) continue;
      gemm_tile256(mk(pp, D, p.WcT, D, D, D, EPI_ZB, z1, D, nullptr, (const float*)x2, mod1 + 2 * D), mt * 256, nt * 128, lds);
    }
    GRID_SYNC();
    ln_phase(z1, p.ln_g + 2 * D, p.ln_b + 2 * D, S[4], nullptr, mod1, 3, 4, S[0], F8_FROM <= 1 ? p.slot[5] : nullptr, bid, nblk);
    GRID_SYNC();
  }
}

extern "C" void kernel_launch(void* const* d_in, const int* in_sizes, int n_in, void* d_out, int out_size, void* d_ws, size_t ws_size, hipStream_t stream) {
  Params p{};
  const float** ip = (const float**)&p.x;
  for (int i = 0; i < 30; ++i) ip[i] = (const float*)d_in[i];
  p.out = (float*)d_out;
  unsigned char* w = (unsigned char*)d_ws; size_t off = 0;
  auto take = [&](size_t bytes) { unsigned char* r = w + off; off += (bytes + 255) & ~(size_t)255; return r; };
  p.bar = (unsigned*)take(16384);
  p.mod = (float*)take((size_t)2 * NB * 6144 * 4);
  p.WT_rkv = (bf16_t*)take((size_t)3 * D * D * 2);
  p.W1T = (bf16_t*)take((size_t)128 * D * 2); p.A1T = (bf16_t*)take((size_t)128 * D * 2); p.G1T = (bf16_t*)take((size_t)256 * D * 2);
  p.W2T = (bf16_t*)take((size_t)D * 64 * 2); p.A2T = (bf16_t*)take((size_t)D * 64 * 2);
  p.WqB = (bf16_t*)take((size_t)2 * 2048 * D * 2); p.KeysB = (bf16_t*)take((size_t)2 * 16 * 128 * 128 * 2);
  p.lora_tmp = (bf16_t*)take((size_t)T * 320 * 2);
  p.G2T = (bf16_t*)take((size_t)D * 192 * 2);
  p.WoT = (bf16_t*)take((size_t)D * D * 2); p.PinT = (bf16_t*)take((size_t)D * D * 2); p.PoutT = (bf16_t*)take((size_t)D * D * 2);
  p.WgrpS = (bf16_t*)take((size_t)4 * 256 * 256 * 2); p.WcT = (bf16_t*)take((size_t)D * D * 2); p.WeffT = (bf16_t*)take((size_t)2 * 2048 * D * 2);
  p.tinv = (float*)take((size_t)4 * NEXP * 4);
  p.Gg = (float*)take((size_t)16384 * 64 * 4);
  for (int i = 0; i < 7; ++i) p.slot[i] = take((size_t)64 << 20);
  if (off > ws_size) return;

  static int grid_blocks = 0;
  if (!grid_blocks) {
    int dev = 0, cus = 0, per_cu = 0;
    hipGetDevice(&dev);
    hipDeviceGetAttribute(&cus, hipDeviceAttributeMultiprocessorCount, dev);
    hipOccupancyMaxActiveBlocksPerMultiprocessor(&per_cu, mega, 256, 0);
    if (per_cu > 2) per_cu = 2;
    if (per_cu < 1) per_cu = 1;
    grid_blocks = cus * per_cu;
  }
  hipMemsetAsync(p.bar, 0, 16384, stream);
  void* args[] = {&p};
  hipLaunchCooperativeKernel((void*)mega, dim3(grid_blocks), dim3(256), args, 0, stream);
}
```

```cpp
#include <hip/hip_runtime.h>
#include <hip/hip_cooperative_groups.h>
#include <stdint.h>
#include <stddef.h>
namespace cg = cooperative_groups;

typedef unsigned short bf16_t;
typedef short bf16x8 __attribute__((ext_vector_type(8)));
typedef float f32x4 __attribute__((ext_vector_type(4)));
typedef int i32x8 __attribute__((ext_vector_type(8)));
#define F8_FROM 1
typedef float f32x2 __attribute__((ext_vector_type(2)));
typedef unsigned u32x4 __attribute__((ext_vector_type(4)));
typedef unsigned u32x2 __attribute__((ext_vector_type(2)));
#define DI __device__ __forceinline__

constexpr int D = 1024, NB = 8, SEQ = 4096, T = NB * SEQ;
constexpr int NH = 16, HS = 64;
constexpr int NEXP = 16384;
constexpr float ALPHA = 1.4142135623730951f;
constexpr float LN_EPS = 1e-5f, GN_EPS = 64e-5f;
constexpr int LDS_BYTES = 76 * 1024;

typedef __bf16 bf16x2_t __attribute__((ext_vector_type(2)));
DI unsigned cvt_pk_bf16(float lo, float hi) { const f32x2 v = {lo, hi}; return __builtin_bit_cast(unsigned, __builtin_convertvector(v, bf16x2_t)); }
DI bf16_t f2bf(float f) { return (bf16_t)cvt_pk_bf16(f, 0.f); }
DI float bf_lo(unsigned u) { return __uint_as_float(u << 16); }
DI float bf_hi(unsigned u) { return __uint_as_float(u & 0xffff0000u); }

DI float sigmoidf_(float x) { return 1.f / (1.f + __expf(-x)); }
DI float wave_sum(float v) {
#pragma unroll
  for (int o = 32; o >= 1; o >>= 1) v += __shfl_xor(v, o);
  return v;
}
DI float sum8_dpp(float v) {
  v += __builtin_bit_cast(float, __builtin_amdgcn_update_dpp(0, __builtin_bit_cast(int, v), 0xB1, 0xF, 0xF, true));
  v += __builtin_bit_cast(float, __builtin_amdgcn_update_dpp(0, __builtin_bit_cast(int, v), 0x4E, 0xF, 0xF, true));
  v += __builtin_bit_cast(float, __builtin_amdgcn_update_dpp(0, __builtin_bit_cast(int, v), 0x141, 0xF, 0xF, true));
  return v;
}
DI int opaque_v(int x) { asm volatile("" : "+v"(x)); return x; }
DI float gelu_exact(float v) {
  const float av = fabsf(v), t = __builtin_amdgcn_rcpf(av * 0.2316418882f + 1.0f);
  float q = t * 0.5307027145f + (-0.7265760135f); q = q * t + 0.7107068705f; q = q * t + (-0.142248368f); q = q * t + 0.127414796f; q = q * t;
  const float m = v * (q * __builtin_amdgcn_exp2f((v * v) * (-0.72134752044f)));
  return v < 0.f ? m : v - m;
}

#define XB_TMO      128
#define XB_XCNT(j)  (256  + 64 * (j))
#define XB_XSUB(j)  (1280 + 64 * (j))
#define XB_XGEN(j)  (2304 + 64 * (j))
#define XB_TOP      3328
#define XB_TOPGEN   3392
#define XCD_BAR_WORDS 3456
#define XB_SPIN_CAP (1u << 22)
#define LAS __attribute__((address_space(3)))
DI unsigned xb_ld(unsigned* p)              { return __hip_atomic_load(p, __ATOMIC_RELAXED, __HIP_MEMORY_SCOPE_AGENT); }
DI unsigned xb_add(unsigned* p, unsigned v) { return __hip_atomic_fetch_add(p, v, __ATOMIC_RELAXED, __HIP_MEMORY_SCOPE_AGENT); }
DI unsigned xb_xcc_id() { return (unsigned)__builtin_amdgcn_s_getreg((3 << 11) | 20) & 0xFu; }
#define XB_SPIN(cond, bar) do { unsigned _sp = 0; while (cond) { __builtin_amdgcn_s_sleep(1); \
    if ((++_sp & 255u) == 0u) { if (xb_ld(&(bar)[XB_TMO])) break; if (_sp > XB_SPIN_CAP) { atomicAdd(&(bar)[XB_TMO], 1u); break; } } } } while (0)
struct XcdBarrier { unsigned* bar; unsigned x; volatile LAS unsigned* st; };
DI XcdBarrier xcd_barrier_post(unsigned* bar, volatile LAS unsigned* st) {
  XcdBarrier b; b.bar = bar; b.x = xb_xcc_id(); b.st = st;
  if (threadIdx.x == 0) (void)xb_add(&bar[XB_XCNT(b.x)], 1u);
  return b;
}
DI void xcd_barrier_complete(unsigned* bar, unsigned x, unsigned& nloc, unsigned& nx) {
  const unsigned G = gridDim.x * gridDim.y * gridDim.z;
  unsigned sum, cnt, mine, sp = 0u;
  for (;;) {
    sum = 0u; cnt = 0u; mine = 0u;
#pragma unroll
    for (unsigned j = 0; j < 16; ++j) { const unsigned c = xb_ld(&bar[XB_XCNT(j)]); sum += c; cnt += (c > 0u) ? 1u : 0u; mine = (j == x) ? c : mine; }
    if (sum == G) break;
    __builtin_amdgcn_s_sleep(1);
    if ((++sp & 255u) == 0u) { if (xb_ld(&bar[XB_TMO])) break; if (sp > XB_SPIN_CAP) { atomicAdd(&bar[XB_TMO], 1u); break; } }
  }
  nloc = mine > 0u ? mine : 1u; nx = cnt > 0u ? cnt : 1u;
}
DI void xcd_barrier(const XcdBarrier& b0) {
  XcdBarrier b = b0; { unsigned xx = b0.x; asm volatile("" : "+s"(xx)); b.x = xx; }
  asm volatile("s_waitcnt vmcnt(0)" ::: "memory");
  __syncthreads();
  if (threadIdx.x == 0) {
    unsigned* bar = b.bar;
    __builtin_amdgcn_s_waitcnt(0);
    unsigned nloc = b.st[0], nx = b.st[1];
    if (nloc == 0u) { xcd_barrier_complete(bar, b.x, nloc, nx); b.st[0] = nloc; b.st[1] = nx; }
    const unsigned k = b.st[2]; b.st[2] = k + 1u;
    const unsigned old = xb_add(&bar[XB_XSUB(b.x)], 1u);
    if (old + 1u == (k + 1u) * nloc) {
      __builtin_amdgcn_fence(__ATOMIC_RELEASE, "agent");
      asm volatile("s_waitcnt vmcnt(0)" ::: "memory");
      (void)xb_add(&bar[XB_TOP], 1u);
    }
    const unsigned target = (k + 1u) * nx;
    XB_SPIN(xb_ld(&bar[XB_TOP]) < target, bar);
    __builtin_amdgcn_fence(__ATOMIC_ACQUIRE, "agent");
    asm volatile("s_waitcnt vmcnt(0)" ::: "memory");
  }
  __syncthreads();
}

struct Params {
  const float *x, *c, *ada_w, *ada_b, *ln_g, *ln_b, *rw_mu, *rw_w_rkv, *rw_w0, *rw_w1, *rw_w2, *rw_a0, *rw_a1, *rw_a2, *rw_g1, *rw_g2,
      *rw_k_k, *rw_k_a, *rw_r_k, *rw_lnx_g, *rw_lnx_b, *rw_w_o, *pl_w_in, *pl_w_grp, *pl_scale, *pl_w_out, *pe_w_q, *pe_keys, *pe_u, *pe_v;
  float* out;
  float* mod;
  bf16_t *WT_rkv, *W1T, *A1T, *G1T, *W2T, *A2T, *G2T, *WoT, *PinT, *PoutT, *WgrpS, *WcT, *WqB, *WeffT, *KeysB;
  unsigned char* slot[7];
  float* tinv;
  bf16_t* lora_tmp;
  float* Gg;
  unsigned* bar;
};

DI void mod_stage1_item(const Params& p, float* __restrict__ partial, int item, unsigned char* lds) {
  float* cond = (float*)lds;
  const int tid = opaque_v(threadIdx.x);
  const int cc = item & 7, kc = (item >> 3) & 31, l = item >> 8;
  __syncthreads();
  { const int b = tid >> 5, kk = tid & 31; const float v = p.c[b * D + kc * 32 + kk]; cond[tid] = v / (1.f + __expf(-v)); }
  __syncthreads();
  if (tid < 192) {
    const int n = cc * 768 + tid * 4;
    const float* w = p.ada_w + ((size_t)l * D + kc * 32) * 6144 + n;
    f32x4 acc[NB];
#pragma unroll
    for (int b = 0; b < NB; ++b) acc[b] = (f32x4){0.f, 0.f, 0.f, 0.f};
#pragma unroll 1
    for (int k0 = 0; k0 < 32; k0 += 16) {
      f32x4 wv[16];
#pragma unroll
      for (int u = 0; u < 16; ++u) wv[u] = *(const f32x4*)(w + (size_t)(k0 + u) * 6144);
#pragma unroll
      for (int u = 0; u < 16; ++u)
#pragma unroll
        for (int b = 0; b < NB; ++b) acc[b] += wv[u] * cond[b * 32 + k0 + u];
    }
#pragma unroll
    for (int b = 0; b < NB; ++b) *(f32x4*)(partial + (((size_t)l * 32 + kc) * NB + b) * 6144 + n) = acc[b];
  }
  __syncthreads();
}
DI void mod_stage2_phase(const Params& p, const float* __restrict__ partial, int bid, int nblk) {
  const int tq = opaque_v(threadIdx.x);
  for (int i = bid * 256 + tq; i < 2 * NB * 6144 / 4; i += nblk * 256) {
    const int n = (i % 1536) * 4, b = (i / 1536) % NB, l = i / (1536 * NB);
    f32x4 s = *(const f32x4*)(p.ada_b + l * 6144 + n);
#pragma unroll
    for (int kc = 0; kc < 32; ++kc) s += *(const f32x4*)(partial + (((size_t)l * 32 + kc) * NB + b) * 6144 + n);
    *(f32x4*)(p.mod + ((size_t)l * NB + b) * 6144 + n) = s;
  }
}

DI void transpose_item(const float* __restrict__ src, bf16_t* __restrict__ dst, int K, int N, int Kpad, int Npad, size_t sbs, size_t dbs, int item, unsigned char* lds) {
  float (*tile)[65] = (float (*)[65])lds;
  const int nb_n = Npad / 64, nb_k = Kpad / 64;
  const int per = nb_n * nb_k;
  const int bz = item / per, r = item % per;
  const int bk = r / nb_n, bn = r % nb_n;
  src += bz * sbs; dst += bz * dbs;
  const int tq = opaque_v(threadIdx.x);
  {
    const int rr = tq >> 4, c4 = (tq & 15) * 4, n = bn * 64 + c4;
    f32x4 v[4];
#pragma unroll
    for (int i = 0; i < 4; ++i) {
      const int k = bk * 64 + rr + i * 16;
      v[i] = (k < K && n < N) ? *(const f32x4*)(src + (size_t)k * N + n) : (f32x4){0.f, 0.f, 0.f, 0.f};
    }
#pragma unroll
    for (int i = 0; i < 4; ++i) { float* tr = &tile[rr + i * 16][c4]; tr[0] = v[i][0]; tr[1] = v[i][1]; tr[2] = v[i][2]; tr[3] = v[i][3]; }
  }
  __syncthreads();
  {
    const int nl = tq >> 2, kc = (tq & 3) * 16;
    unsigned o[8];
#pragma unroll
    for (int j = 0; j < 8; ++j) o[j] = cvt_pk_bf16(tile[kc + 2 * j][nl], tile[kc + 2 * j + 1][nl]);
    u32x4* dp = (u32x4*)(dst + (size_t)(bn * 64 + nl) * Kpad + bk * 64 + kc);
    dp[0] = (u32x4){o[0], o[1], o[2], o[3]}; dp[1] = (u32x4){o[4], o[5], o[6], o[7]};
  }
  __syncthreads();
}
DI void cvt_range(const float* __restrict__ src, bf16_t* __restrict__ dst, size_t n8, int bid, int nblk) {
  const int tq = opaque_v(threadIdx.x);
  for (size_t i = (size_t)bid * 256 + tq; i < n8; i += (size_t)nblk * 256) {
    const f32x4 a = *(const f32x4*)(src + i * 8), b = *(const f32x4*)(src + i * 8 + 4);
    u32x4 o; o.x = cvt_pk_bf16(a[0], a[1]); o.y = cvt_pk_bf16(a[2], a[3]); o.z = cvt_pk_bf16(b[0], b[1]); o.w = cvt_pk_bf16(b[2], b[3]);
    *(u32x4*)(dst + i * 8) = o;
  }
}
DI void prologue_phase(const Params& p, unsigned char* lds, int bid, int nblk) {
  constexpr int total = 512 + 768 + 32 + 32 + 64 + 16 + 16 + 48 + 256 + 256 + 256;
  for (int it = bid; it < total; it += nblk) {
    int r = it;
    if (r < 512) { mod_stage1_item(p, (float*)p.slot[1], r, lds); continue; } r -= 512;
    if (r < 768) { transpose_item(p.rw_w_rkv, p.WT_rkv, D, D, D, D, (size_t)D * D, (size_t)D * D, r, lds); continue; } r -= 768;
    if (r < 32) { transpose_item(p.rw_w1, p.W1T, D, 64, D, 128, 0, 0, r, lds); continue; } r -= 32;
    if (r < 32) { transpose_item(p.rw_a1, p.A1T, D, 64, D, 128, 0, 0, r, lds); continue; } r -= 32;
    if (r < 64) { transpose_item(p.rw_g1, p.G1T, D, 160, D, 256, 0, 0, r, lds); continue; } r -= 64;
    if (r < 16) { transpose_item(p.rw_w2, p.W2T, 64, D, 64, D, 0, 0, r, lds); continue; } r -= 16;
    if (r < 16) { transpose_item(p.rw_a2, p.A2T, 64, D, 64, D, 0, 0, r, lds); continue; } r -= 16;
    if (r < 48) { transpose_item(p.rw_g2, p.G2T, 160, D, 192, D, 0, 0, r, lds); continue; } r -= 48;
    if (r < 256) { transpose_item(p.rw_w_o, p.WoT, D, D, D, D, 0, 0, r, lds); continue; } r -= 256;
    if (r < 256) { transpose_item(p.pl_w_in, p.PinT, D, D, D, D, 0, 0, r, lds); continue; } r -= 256;
    transpose_item(p.pl_w_out, p.PoutT, D, D, D, D, 0, 0, r, lds);
  }
  cvt_range(p.pe_keys, p.KeysB, (size_t)2 * 16 * 128 * 128 / 8, bid, nblk);
  cvt_range(p.pe_w_q, p.WqB, (size_t)2 * D * 2048 / 8, bid, nblk);
  {
    const int tq = opaque_v(threadIdx.x);
    for (int i = bid * 256 + tq; i < 4 * 256 * 256 / 8; i += nblk * 256) {
      const int e0 = (i * 8) & 255, g4 = (i * 8) >> 16;
      const f32x4 a0 = *(const f32x4*)(p.pl_w_grp + (size_t)i * 8), a1 = *(const f32x4*)(p.pl_w_grp + (size_t)i * 8 + 4);
      const f32x4 s0 = *(const f32x4*)(p.pl_scale + g4 * 256 + e0), s1 = *(const f32x4*)(p.pl_scale + g4 * 256 + e0 + 4);
      const f32x4 b0 = a0 * s0, b1 = a1 * s1;
      *(u32x4*)(p.WgrpS + (size_t)i * 8) = (u32x4){cvt_pk_bf16(b0[0], b0[1]), cvt_pk_bf16(b0[2], b0[3]), cvt_pk_bf16(b1[0], b1[1]), cvt_pk_bf16(b1[2], b1[3])};
    }
  }
}

DI void modulate_phase(const float* __restrict__ x, const float* __restrict__ mod_l, const float* __restrict__ mu, bf16_t* __restrict__ h, bf16_t* __restrict__ xr, bf16_t* __restrict__ xk,
                       bf16_t* __restrict__ xv, int bid, int nblk) {
  const size_t n8 = (size_t)T * D / 8; const int tq = opaque_v(threadIdx.x);
  const int dcol = (tq * 8) & (D - 1);
  f32x4 mv[3][2];
#pragma unroll
  for (int n = 0; n < 3; ++n) { mv[n][0] = *(const f32x4*)(mu + n * D + dcol); mv[n][1] = *(const f32x4*)(mu + n * D + dcol + 4); }
  int bcur = -1;
  f32x4 s0 = {0.f, 0.f, 0.f, 0.f}, s1 = s0, c0 = s0, c1 = s0;
  for (size_t i = (size_t)bid * 256 + tq; i < n8; i += (size_t)nblk * 256) {
    const size_t e = i * 8; const int t = (int)(e / D), d = dcol, b = t / SEQ;
    if (b != bcur) {
      const float* sh = mod_l + (size_t)b * 6144 + 0 * D + d; const float* sc = mod_l + (size_t)b * 6144 + 1 * D + d;
      s0 = *(const f32x4*)sh; s1 = *(const f32x4*)(sh + 4); c0 = *(const f32x4*)sc; c1 = *(const f32x4*)(sc + 4);
      bcur = b;
    }
    float hv[8], pv[8];
    {
      const f32x4 a0 = *(const f32x4*)(x + e), a1 = *(const f32x4*)(x + e + 4);
      const f32x4 r0 = a0 * (c0 + 1.f) + s0, r1 = a1 * (c1 + 1.f) + s1;
      f32x4 q0 = {0.f, 0.f, 0.f, 0.f}, q1 = {0.f, 0.f, 0.f, 0.f};
      if ((t % SEQ) != 0) { const f32x4 b0 = *(const f32x4*)(x + e - D), b1 = *(const f32x4*)(x + e - D + 4); q0 = b0 * (c0 + 1.f) + s0; q1 = b1 * (c1 + 1.f) + s1; }
#pragma unroll
      for (int j = 0; j < 4; ++j) { hv[j] = r0[j]; hv[4 + j] = r1[j]; pv[j] = q0[j]; pv[4 + j] = q1[j]; }
    }
    u32x4 o; o.x = cvt_pk_bf16(hv[0], hv[1]); o.y = cvt_pk_bf16(hv[2], hv[3]); o.z = cvt_pk_bf16(hv[4], hv[5]); o.w = cvt_pk_bf16(hv[6], hv[7]);
    *(u32x4*)(h + e) = o;
#pragma unroll
    for (int n = 0; n < 3; ++n) {
      const f32x4 m0 = mv[n][0], m1 = mv[n][1];
      float w[8];
#pragma unroll
      for (int j = 0; j < 8; ++j) { const float m = j < 4 ? m0[j] : m1[j - 4]; w[j] = hv[j] + (pv[j] - hv[j]) * m; }
      u32x4 q; q.x = cvt_pk_bf16(w[0], w[1]); q.y = cvt_pk_bf16(w[2], w[3]); q.z = cvt_pk_bf16(w[4], w[5]); q.w = cvt_pk_bf16(w[6], w[7]);
      *(u32x4*)((n == 0 ? xr : (n == 1 ? xk : xv)) + e) = q;
    }
  }
}

enum { EPI_BF16 = 0, EPI_TANH, EPI_SIGMOID, EPI_LW, EPI_ASIG, EPI_Z, EPI_SCALE, EPI_GATE, EPI_TOPK, EPI_ZB, EPI_F8 };
struct GemmArgs {
  const bf16_t* A; int lda;
  const bf16_t* Bt; int ldb;
  int N, K;
  const float* mu;
  int epi; void* out; int ldc;
  const float* v0; const float* v1;
};

DI int lds_off(int row, int chunk) { return row * 128 + ((chunk ^ (row & 7)) << 4); }

DI void gemm_load_a(const GemmArgs& g, int m0, int k0, int tid, u32x4 (&ra)[4]) {
#pragma unroll
  for (int i = 0; i < 4; ++i) {
    const int row = (tid >> 3) + i * 32, ch = tid & 7;
    const int m = m0 + row;
    const bf16_t* src = g.A + (size_t)m * g.lda + k0 + ch * 8;
    u32x4 v = *(const u32x4*)src;
    if (g.mu) {
      u32x4 pv = {0u, 0u, 0u, 0u};
      if ((m % SEQ) != 0) pv = *(const u32x4*)(src - g.lda);
      const f32x4 m0v = *(const f32x4*)(g.mu + k0 + ch * 8), m1v = *(const f32x4*)(g.mu + k0 + ch * 8 + 4);
      const unsigned hu[4] = {v.x, v.y, v.z, v.w}, pu[4] = {pv.x, pv.y, pv.z, pv.w};
      float o[8];
#pragma unroll
      for (int j = 0; j < 4; ++j) {
        const float h0 = bf_lo(hu[j]), h1 = bf_hi(hu[j]), p0 = bf_lo(pu[j]), p1 = bf_hi(pu[j]);
        const float mu0 = (2 * j < 4) ? m0v[(2 * j) & 3] : m1v[(2 * j) & 3], mu1 = (2 * j + 1 < 4) ? m0v[(2 * j + 1) & 3] : m1v[(2 * j + 1) & 3];
        o[2 * j] = h0 + (p0 - h0) * mu0; o[2 * j + 1] = h1 + (p1 - h1) * mu1;
      }
      v.x = cvt_pk_bf16(o[0], o[1]); v.y = cvt_pk_bf16(o[2], o[3]); v.z = cvt_pk_bf16(o[4], o[5]); v.w = cvt_pk_bf16(o[6], o[7]);
    }
    ra[i] = v;
  }
}
DI void gemm_load_b(const GemmArgs& g, int n0, int k0, int tid, u32x4 (&rb)[4]) {
#pragma unroll
  for (int i = 0; i < 4; ++i) {
    const int row = (tid >> 3) + i * 32, ch = tid & 7;
    rb[i] = *(const u32x4*)(g.Bt + (size_t)(n0 + row) * g.ldb + k0 + ch * 8);
  }
}
DI void gemm_store_lds(unsigned char* buf, int tid, const u32x4 (&r)[4]) {
#pragma unroll
  for (int i = 0; i < 4; ++i) {
    const int row = (tid >> 3) + i * 32, ch = tid & 7;
    *(u32x4*)(buf + lds_off(row, ch)) = r[i];
  }
}

DI unsigned f2key(float f) { unsigned u = __float_as_uint(f); return u ^ ((u >> 31) ? 0xffffffffu : 0x80000000u); }
DI float key2f(unsigned k) { unsigned u = (k >> 31) ? (k ^ 0x80000000u) : ~k; return __uint_as_float(u); }
#define CE_DESC(a, b) { const unsigned _mx = max(a, b), _mn = min(a, b); a = _mx; b = _mn; }
DI void sort16_desc(unsigned (&x)[16]) {
#pragma unroll
  for (int k = 2; k <= 16; k <<= 1) {
#pragma unroll
    for (int j = k >> 1; j > 0; j >>= 1) {
#pragma unroll
      for (int i = 0; i < 16; ++i) {
        const int l = i ^ j;
        if (l > i) {
          if ((i & k) == 0) { CE_DESC(x[i], x[l]); } else { CE_DESC(x[l], x[i]); }
        }
      }
    }
  }
}
DI void merge16_desc(unsigned (&x)[16]) {
#pragma unroll
  for (int j = 8; j > 0; j >>= 1) {
#pragma unroll
    for (int i = 0; i < 16; ++i) { const int l = i ^ j; if (l > i) { CE_DESC(x[i], x[l]); } }
  }
}

DI void peer_combine(const unsigned* row, int sw, unsigned* __restrict__ epk_row, float* __restrict__ gate_row) {
  float s1[16], s2[16];
#pragma unroll
  for (int i = 0; i < 4; ++i) {
    const u32x4 a = *(const u32x4*)(row + ((i ^ sw) << 2)), b = *(const u32x4*)(row + (((4 + i) ^ sw) << 2));
    s1[i * 4] = key2f(a.x & ~127u); s1[i * 4 + 1] = key2f(a.y & ~127u); s1[i * 4 + 2] = key2f(a.z & ~127u); s1[i * 4 + 3] = key2f(a.w & ~127u);
    s2[i * 4] = key2f(b.x & ~127u); s2[i * 4 + 1] = key2f(b.y & ~127u); s2[i * 4 + 2] = key2f(b.z & ~127u); s2[i * 4 + 3] = key2f(b.w & ~127u);
  }
  unsigned c[4][16];
  {
    int n = 0;
#pragma unroll
    for (int a = 0; a < 16; ++a)
#pragma unroll
      for (int b = 0; b < 16; ++b)
        if ((a + 1) * (b + 1) <= 16) { c[n >> 4][n & 15] = (f2key(s1[a] + s2[b]) & ~255u) | (unsigned)(255 - (a * 16 + b)); ++n; }
#pragma unroll
    for (int q = 50; q < 64; ++q) c[q >> 4][q & 15] = 0u;
  }
  sort16_desc(c[0]); sort16_desc(c[1]); sort16_desc(c[2]); sort16_desc(c[3]);
#pragma unroll
  for (int e = 0; e < 16; ++e) { c[0][e] = max(c[0][e], c[1][15 - e]); c[2][e] = max(c[2][e], c[3][15 - e]); }
  merge16_desc(c[0]); merge16_desc(c[2]);
#pragma unroll
  for (int e = 0; e < 16; ++e) c[0][e] = max(c[0][e], c[2][15 - e]);
  merge16_desc(c[0]);
  float best[16], den = 0.f;
  const float mx = key2f(c[0][0] & ~255u);
#pragma unroll
  for (int e = 0; e < 16; ++e) { best[e] = __expf(key2f(c[0][e] & ~255u) - mx); den += best[e]; }
  const float inv = 1.f / den;
  unsigned idw[8];
#pragma unroll
  for (int e = 0; e < 16; ++e) {
    const int pos = 255 - (int)(c[0][e] & 255u), a = pos >> 4, b = pos & 15;
    const unsigned i1 = 127u - (row[(((a >> 2) ^ sw) << 2) | (a & 3)] & 127u), i2 = 127u - (row[(((4 + (b >> 2)) ^ sw) << 2) | (b & 3)] & 127u);
    const unsigned id = i1 * 128u + i2;
    if (e & 1) idw[e >> 1] |= id << 16; else idw[e >> 1] = id;
    best[e] *= inv;
  }
  {
    unsigned pk[8];
#pragma unroll
    for (int k = 0; k < 8; ++k) {
      const unsigned lo = (idw[k >> 1] >> ((k & 1) * 16)) & 0xffffu, hi = (idw[4 + (k >> 1)] >> ((k & 1) * 16)) & 0xffffu;
      pk[k] = lo | (hi << 16);
    }
    ((u32x4*)epk_row)[0] = (u32x4){pk[0], pk[1], pk[2], pk[3]}; ((u32x4*)epk_row)[1] = (u32x4){pk[4], pk[5], pk[6], pk[7]};
    ((f32x4*)gate_row)[0] = (f32x4){best[0], best[1], best[2], best[3]}; ((f32x4*)gate_row)[1] = (f32x4){best[4], best[5], best[6], best[7]};
    ((f32x4*)(gate_row + 64))[0] = (f32x4){best[8], best[9], best[10], best[11]}; ((f32x4*)(gate_row + 64))[1] = (f32x4){best[12], best[13], best[14], best[15]};
  }
}

DI void gemm_glds(const bf16_t* __restrict__ base, int ld, int r0, int k0, unsigned char* buf, int wid, int lane) {
  const bf16_t* src = base + (size_t)(r0 + wid * 8 + (lane >> 3)) * ld + k0 + (((lane & 7) ^ (lane >> 3)) << 3);
#pragma unroll
  for (int j = 0; j < 4; ++j)
    __builtin_amdgcn_global_load_lds((const unsigned*)(src + (size_t)j * 32 * ld), (unsigned*)(buf + (j * 4 + wid) * 1024), 16, 0, 0);
}
DI void gemm_tile(const GemmArgs& g, int m0, int n0, unsigned char* lds) {
  constexpr int WM = 2, WN = 4 / WM, TM = 128 / WM, TN = 128 / WN, MI = TM / 16, NI = TN / 16;
  const int tid = opaque_v(threadIdx.x), lane = tid & 63, wid = tid >> 6;
  const int wm = wid / WN, wn = wid % WN;
  const int nk = g.K / 64;
  const bool lerp = g.mu != nullptr;
  f32x4 acc[MI][NI];
#pragma unroll
  for (int i = 0; i < MI; ++i)
#pragma unroll
    for (int j = 0; j < NI; ++j) acc[i][j] = (f32x4){0.f, 0.f, 0.f, 0.f};
  u32x2 ypre[MI][NI];
  if (g.epi == EPI_GATE) {
#pragma unroll
    for (int i = 0; i < MI; ++i)
#pragma unroll
      for (int j = 0; j < NI; ++j) ypre[i][j] = *(const u32x2*)((const bf16_t*)g.out + (size_t)(m0 + wm * TM + i * 16 + (lane & 15)) * g.ldc + n0 + wn * TN + j * 16 + (lane >> 4) * 4);
  } else {
#pragma unroll
    for (int i = 0; i < MI; ++i)
#pragma unroll
      for (int j = 0; j < NI; ++j) ypre[i][j] = (u32x2){0u, 0u};
  }
  u32x4 ra[4];
  if (lerp) { gemm_load_a(g, m0, 0, tid, ra); gemm_store_lds(lds, tid, ra); } else gemm_glds(g.A, g.lda, m0, 0, lds, wid, lane);
  gemm_glds(g.Bt, g.ldb, n0, 0, lds + 16384, wid, lane);
  asm volatile("s_waitcnt vmcnt(0)" ::: "memory");
  __syncthreads();
  const int fr = lane & 15, fq = lane >> 4;
  for (int kt = 0; kt < nk; ++kt) {
    unsigned char* cur = lds + (kt & 1) * 32768;
    unsigned char* nxt = lds + ((kt + 1) & 1) * 32768;
    if (kt + 1 < nk) {
      if (lerp) gemm_load_a(g, m0, (kt + 1) * 64, tid, ra); else gemm_glds(g.A, g.lda, m0, (kt + 1) * 64, nxt, wid, lane);
      gemm_glds(g.Bt, g.ldb, n0, (kt + 1) * 64, nxt + 16384, wid, lane);
    }
    {
      bf16x8 af[2][MI], bfr[2][NI];
#pragma unroll
      for (int ks = 0; ks < 2; ++ks) {
#pragma unroll
        for (int i = 0; i < MI; ++i) af[ks][i] = *(const bf16x8*)(cur + lds_off(wm * TM + i * 16 + fr, ks * 4 + fq));
#pragma unroll
        for (int j = 0; j < NI; ++j) bfr[ks][j] = *(const bf16x8*)(cur + 16384 + lds_off(wn * TN + j * 16 + fr, ks * 4 + fq));
      }
      __builtin_amdgcn_sched_barrier(0);
#pragma unroll
      for (int ks = 0; ks < 2; ++ks)
#pragma unroll
        for (int i = 0; i < MI; ++i)
#pragma unroll
          for (int j = 0; j < NI; ++j) acc[i][j] = __builtin_amdgcn_mfma_f32_16x16x32_bf16(bfr[ks][j], af[ks][i], acc[i][j], 0, 0, 0);
      __builtin_amdgcn_sched_barrier(0);
    }
    if (lerp && kt + 1 < nk) gemm_store_lds(nxt, tid, ra);
    asm volatile("s_waitcnt vmcnt(0)" ::: "memory");
    __syncthreads();
  }
#pragma unroll
  for (int i = 0; i < MI; ++i) {
    const int m = m0 + wm * TM + i * 16 + fr;
#pragma unroll
    for (int j = 0; j < NI; ++j) {
      const int n = n0 + wn * TN + j * 16 + fq * 4;
      if (n >= g.N) continue;
      const f32x4 v = acc[i][j];
      bf16_t* ob = (bf16_t*)g.out + (size_t)m * g.ldc + n;
      switch (g.epi) {
        case EPI_BF16: *(u32x2*)ob = (u32x2){cvt_pk_bf16(v[0], v[1]), cvt_pk_bf16(v[2], v[3])}; break;
        case EPI_F8: {
          int pk = 0; pk = __builtin_amdgcn_cvt_pk_fp8_f32(v[0] * 64.f, v[1] * 64.f, pk, false); pk = __builtin_amdgcn_cvt_pk_fp8_f32(v[2] * 64.f, v[3] * 64.f, pk, true);
          *(int*)((unsigned char*)g.out + (size_t)m * g.ldc + n) = pk;
        } break;
        case EPI_TANH: *(u32x2*)ob = (u32x2){cvt_pk_bf16(tanhf(v[0]), tanhf(v[1])), cvt_pk_bf16(tanhf(v[2]), tanhf(v[3]))}; break;
        case EPI_SIGMOID: *(u32x2*)ob = (u32x2){cvt_pk_bf16(sigmoidf_(v[0]), sigmoidf_(v[1])), cvt_pk_bf16(sigmoidf_(v[2]), sigmoidf_(v[3]))}; break;
        case EPI_LW: {
          const f32x4 w0 = *(const f32x4*)(g.v0 + n); float o[4];
#pragma unroll
          for (int q = 0; q < 4; ++q) o[q] = -0.60653065971f * sigmoidf_(w0[q] + v[q]);
          *(u32x2*)ob = (u32x2){cvt_pk_bf16(o[0], o[1]), cvt_pk_bf16(o[2], o[3])};
        } break;
        case EPI_ASIG: {
          const f32x4 a0 = *(const f32x4*)(g.v0 + n);
          *(u32x2*)ob = (u32x2){cvt_pk_bf16(sigmoidf_(a0[0] + v[0]), sigmoidf_(a0[1] + v[1])), cvt_pk_bf16(sigmoidf_(a0[2] + v[2]), sigmoidf_(a0[3] + v[3]))};
        } break;
        case EPI_Z: {
          const int b = m / SEQ;
          const f32x4 xv = *(const f32x4*)(g.v0 + (size_t)m * D + n), gt = *(const f32x4*)(g.v1 + (size_t)b * 6144 + n);
          const f32x4 zz = xv * ALPHA + gt * v;
          *(u32x2*)ob = (u32x2){cvt_pk_bf16(zz[0], zz[1]), cvt_pk_bf16(zz[2], zz[3])};
        } break;
        case EPI_GATE: {
          const u32x2 yv = ypre[i][j];
          *(u32x2*)ob = (u32x2){cvt_pk_bf16(bf_lo(yv.x) * v[0], bf_hi(yv.x) * v[1]), cvt_pk_bf16(bf_lo(yv.y) * v[2], bf_hi(yv.y) * v[3])};
        } break;
        default: {
          const f32x4 sc = *(const f32x4*)(g.v0 + n);
          *(u32x2*)ob = (u32x2){cvt_pk_bf16(v[0] * sc[0], v[1] * sc[1]), cvt_pk_bf16(v[2] * sc[2], v[3] * sc[3])};
        } break;
      }
    }
  }
}

DI int lds_off32(int row, int chunk) { return row * 64 + ((chunk ^ (((row >> 3) & 1) << 1)) << 4); }
DI void gemm256_issue(const GemmArgs& g, int m0, int n0, int k0, unsigned char* buf, int wid, int lane) {
  const int lr = lane >> 2, gc = ((lane & 3) ^ ((lane >> 5) << 1)) << 3;
  const bf16_t* sa = g.A + (size_t)(m0 + wid * 16 + lr) * g.lda + k0 + gc;
#pragma unroll
  for (int j = 0; j < 4; ++j) __builtin_amdgcn_global_load_lds((const unsigned*)(sa + (size_t)j * 64 * g.lda), (unsigned*)(buf + (j * 4 + wid) * 1024), 16, 0, 0);
  const bf16_t* sb = g.Bt + (size_t)(n0 + wid * 16 + lr) * g.ldb + k0 + gc;
#pragma unroll
  for (int j = 0; j < 2; ++j) __builtin_amdgcn_global_load_lds((const unsigned*)(sb + (size_t)j * 64 * g.ldb), (unsigned*)(buf + 16384 + (j * 4 + wid) * 1024), 16, 0, 0);
}
DI void gemm_tile256(const GemmArgs& g, int m0, int n0, unsigned char* lds) {
  constexpr int MI = 8, NI = 4, STG = 24576;
  const int tid = opaque_v(threadIdx.x), lane = tid & 63, wid = tid >> 6, wm = wid >> 1, wn = wid & 1, fr = lane & 15, fq = lane >> 4;
  const int nk = g.K / 32;
  f32x4 acc[MI][NI];
#pragma unroll
  for (int i = 0; i < MI; ++i)
#pragma unroll
    for (int j = 0; j < NI; ++j) acc[i][j] = (f32x4){0.f, 0.f, 0.f, 0.f};
  __syncthreads();
  gemm256_issue(g, m0, n0, 0, lds, wid, lane);
  if (nk > 1) gemm256_issue(g, m0, n0, 32, lds + STG, wid, lane);
  int sc = 0, sn = 2;
  for (int kt = 0; kt < nk; ++kt) {
    if (kt + 1 < nk) asm volatile("s_waitcnt vmcnt(6)" ::: "memory"); else asm volatile("s_waitcnt vmcnt(0)" ::: "memory");
    __builtin_amdgcn_s_barrier();
    if (kt + 2 < nk) gemm256_issue(g, m0, n0, (kt + 2) * 32, lds + sn * STG, wid, lane);
    const unsigned char* cur = lds + sc * STG;
    bf16x8 af[MI], bfr[NI];
#pragma unroll
    for (int i = 0; i < MI; ++i) af[i] = *(const bf16x8*)(cur + lds_off32(wm * 128 + i * 16 + fr, fq));
#pragma unroll
    for (int j = 0; j < NI; ++j) bfr[j] = *(const bf16x8*)(cur + 16384 + lds_off32(wn * 64 + j * 16 + fr, fq));
    __builtin_amdgcn_s_setprio(1);
#pragma unroll
    for (int i = 0; i < MI; ++i)
#pragma unroll
      for (int j = 0; j < NI; ++j) acc[i][j] = __builtin_amdgcn_mfma_f32_16x16x32_bf16(bfr[j], af[i], acc[i][j], 0, 0, 0);
    __builtin_amdgcn_s_setprio(0);
    sc = (sc == 2) ? 0 : sc + 1; sn = (sn == 2) ? 0 : sn + 1;
  }
  if (g.epi == EPI_TOPK) {
    const int grp = n0 >> 7;
    unsigned* lists = (unsigned*)g.out;
#pragma unroll 1
    for (int hb = 0; hb < 2; ++hb) {
      __syncthreads();
      if (wm == hb) {
#pragma unroll
        for (int i = 0; i < MI; ++i)
#pragma unroll
          for (int j = 0; j < NI; ++j) {
            const int ml = i * 16 + fr, c = wn * 16 + j * 4 + fq;
            u32x4 kv;
            kv.x = (f2key(acc[i][j][0]) & ~127u) | (unsigned)(127 - (c * 4 + 0)); kv.y = (f2key(acc[i][j][1]) & ~127u) | (unsigned)(127 - (c * 4 + 1));
            kv.z = (f2key(acc[i][j][2]) & ~127u) | (unsigned)(127 - (c * 4 + 2)); kv.w = (f2key(acc[i][j][3]) & ~127u) | (unsigned)(127 - (c * 4 + 3));
            *(u32x4*)(lds + ml * 512 + ((c ^ (ml & 31)) << 4)) = kv;
          }
      }
      __syncthreads();
      const int ml = wid * 32 + (lane & 31), hf = lane >> 5;
      unsigned a[16], b[16];
#pragma unroll 1
      for (int ch = 0; ch < 4; ++ch) {
#pragma unroll
        for (int cc = 0; cc < 4; ++cc) {
          const int c = hf * 16 + ch * 4 + cc;
          const u32x4 kv = *(const u32x4*)(lds + ml * 512 + ((c ^ (ml & 31)) << 4));
          b[cc * 4] = kv.x; b[cc * 4 + 1] = kv.y; b[cc * 4 + 2] = kv.z; b[cc * 4 + 3] = kv.w;
        }
        sort16_desc(b);
        if (ch == 0) {
#pragma unroll
          for (int e = 0; e < 16; ++e) a[e] = b[e];
        } else {
#pragma unroll
          for (int e = 0; e < 16; ++e) a[e] = max(a[e], b[15 - e]);
          merge16_desc(a);
        }
      }
#pragma unroll
      for (int e = 0; e < 16; ++e) b[e] = (unsigned)__shfl_xor((int)a[e], 32);
#pragma unroll
      for (int e = 0; e < 16; ++e) a[e] = max(a[e], b[15 - e]);
      merge16_desc(a);
      if (hf == 0) {
        u32x4* dst = (u32x4*)(lists + ((size_t)(m0 + hb * 128 + ml) * 16 + grp) * 16);
        dst[0] = (u32x4){a[0], a[1], a[2], a[3]}; dst[1] = (u32x4){a[4], a[5], a[6], a[7]};
        dst[2] = (u32x4){a[8], a[9], a[10], a[11]}; dst[3] = (u32x4){a[12], a[13], a[14], a[15]};
      }
    }
    __syncthreads();
    return;
  }
#pragma unroll
  for (int i = 0; i < MI; ++i) {
    const int m = m0 + wm * 128 + i * 16 + fr;
#pragma unroll
    for (int j = 0; j < NI; ++j) {
      const int n = n0 + wn * 64 + j * 16 + fq * 4;
      const f32x4 v = acc[i][j];
      if (g.epi == EPI_Z || g.epi == EPI_ZB) {
        const int b = m0 / SEQ;
        f32x4 xv;
        if (g.epi == EPI_Z) xv = *(const f32x4*)(g.v0 + (size_t)m * D + n);
        else { const u32x2 xb = *(const u32x2*)((const bf16_t*)g.v0 + (size_t)m * D + n); xv = (f32x4){bf_lo(xb.x), bf_hi(xb.x), bf_lo(xb.y), bf_hi(xb.y)}; }
        const f32x4 gt = *(const f32x4*)(g.v1 + (size_t)b * 6144 + n);
        const f32x4 zz = xv * ALPHA + gt * v;
        *(u32x2*)((bf16_t*)g.out + (size_t)m * g.ldc + n) = (u32x2){cvt_pk_bf16(zz[0], zz[1]), cvt_pk_bf16(zz[2], zz[3])};
      } else {
        *(u32x2*)((bf16_t*)g.out + (size_t)m * g.ldc + n) = (u32x2){cvt_pk_bf16(v[0], v[1]), cvt_pk_bf16(v[2], v[3])};
      }
    }
  }
}

DI int f8_swz(int row) { return ((row >> 1) & 1) | (((row >> 2) & 1) << 2); }
DI void f8_glds(const unsigned char* __restrict__ base, int r0, int k0, unsigned char* buf, int wid, int lane) {
  const int rl = lane >> 3;
  const unsigned char* src = base + (size_t)(r0 + wid * 8 + rl) * 1024 + k0 + (((lane & 7) ^ f8_swz(rl)) << 4);
#pragma unroll
  for (int j = 0; j < 4; ++j) __builtin_amdgcn_global_load_lds((const unsigned*)(src + (size_t)j * 32 * 1024), (unsigned*)(buf + (j * 4 + wid) * 1024), 16, 0, 0);
}
DI void gemm_tile_f8(const unsigned char* __restrict__ A8, const unsigned char* __restrict__ B8, int m0, int grp, unsigned* __restrict__ lists, unsigned char* lds) {
  const int tid = opaque_v(threadIdx.x), lane = tid & 63, wid = tid >> 6, wm = wid >> 1, wn = wid & 1, fr = lane & 15, fq = lane >> 4;
  const int n0 = grp * 128;
  f32x4 acc[4][4];
#pragma unroll
  for (int i = 0; i < 4; ++i)
#pragma unroll
    for (int j = 0; j < 4; ++j) acc[i][j] = (f32x4){0.f, 0.f, 0.f, 0.f};
  __syncthreads();
  f8_glds(A8, m0, 0, lds, wid, lane); f8_glds(B8, n0, 0, lds + 16384, wid, lane);
  asm volatile("s_waitcnt vmcnt(0)" ::: "memory");
  __syncthreads();
  const int sw = f8_swz(fr), c0 = ((2 * fq) ^ sw) << 4, c1 = ((2 * fq + 1) ^ sw) << 4;
  for (int kt = 0; kt < 8; ++kt) {
    const unsigned char* cur = lds + (kt & 1) * 32768;
    unsigned char* nxt = lds + ((kt + 1) & 1) * 32768;
    if (kt + 1 < 8) { f8_glds(A8, m0, (kt + 1) * 128, nxt, wid, lane); f8_glds(B8, n0, (kt + 1) * 128, nxt + 16384, wid, lane); }
    i32x8 af[4], bfr[4];
#pragma unroll
    for (int i = 0; i < 4; ++i) {
      const unsigned char* pr = cur + (wm * 64 + i * 16 + fr) * 128;
      const u32x4 lo = *(const u32x4*)(pr + c0), hi = *(const u32x4*)(pr + c1);
      af[i] = (i32x8){(int)lo.x, (int)lo.y, (int)lo.z, (int)lo.w, (int)hi.x, (int)hi.y, (int)hi.z, (int)hi.w};
    }
#pragma unroll
    for (int j = 0; j < 4; ++j) {
      const unsigned char* pr = cur + 16384 + (wn * 64 + j * 16 + fr) * 128;
      const u32x4 lo = *(const u32x4*)(pr + c0), hi = *(const u32x4*)(pr + c1);
      bfr[j] = (i32x8){(int)lo.x, (int)lo.y, (int)lo.z, (int)lo.w, (int)hi.x, (int)hi.y, (int)hi.z, (int)hi.w};
    }
    __builtin_amdgcn_sched_barrier(0);
#pragma unroll
    for (int i = 0; i < 4; ++i)
#pragma unroll
      for (int j = 0; j < 4; ++j) acc[i][j] = __builtin_amdgcn_mfma_scale_f32_16x16x128_f8f6f4(bfr[j], af[i], acc[i][j], 0, 0, 0, 0, 0, 0);
    __builtin_amdgcn_sched_barrier(0);
    asm volatile("s_waitcnt vmcnt(0)" ::: "memory");
    __syncthreads();
  }
#pragma unroll
  for (int i = 0; i < 4; ++i)
#pragma unroll
    for (int j = 0; j < 4; ++j) {
      const int ml = wm * 64 + i * 16 + fr, c = wn * 16 + j * 4 + fq;
      const f32x4 sv = acc[i][j] * 0.015625f;
      u32x4 kv;
      kv.x = (f2key(sv[0]) & ~127u) | (unsigned)(127 - (c * 4 + 0)); kv.y = (f2key(sv[1]) & ~127u) | (unsigned)(127 - (c * 4 + 1));
      kv.z = (f2key(sv[2]) & ~127u) | (unsigned)(127 - (c * 4 + 2)); kv.w = (f2key(sv[3]) & ~127u) | (unsigned)(127 - (c * 4 + 3));
      *(u32x4*)(lds + ml * 512 + ((c ^ (ml & 31)) << 4)) = kv;
    }
  __syncthreads();
  {
    const int ml = wid * 32 + (lane & 31), hf = lane >> 5;
    unsigned a[16], b[16];
#pragma unroll 1
    for (int ch = 0; ch < 4; ++ch) {
#pragma unroll
      for (int cc = 0; cc < 4; ++cc) {
        const int c = hf * 16 + ch * 4 + cc;
        const u32x4 kv = *(const u32x4*)(lds + ml * 512 + ((c ^ (ml & 31)) << 4));
        b[cc * 4] = kv.x; b[cc * 4 + 1] = kv.y; b[cc * 4 + 2] = kv.z; b[cc * 4 + 3] = kv.w;
      }
      sort16_desc(b);
      if (ch == 0) {
#pragma unroll
        for (int e = 0; e < 16; ++e) a[e] = b[e];
      } else {
#pragma unroll
        for (int e = 0; e < 16; ++e) a[e] = max(a[e], b[15 - e]);
        merge16_desc(a);
      }
    }
#pragma unroll
    for (int e = 0; e < 16; ++e) b[e] = (unsigned)__shfl_xor((int)a[e], 32);
#pragma unroll
    for (int e = 0; e < 16; ++e) a[e] = max(a[e], b[15 - e]);
    merge16_desc(a);
    if (hf == 0) {
      u32x4* dst = (u32x4*)(lists + ((size_t)(m0 + ml) * 16 + grp) * 16);
      dst[0] = (u32x4){a[0], a[1], a[2], a[3]}; dst[1] = (u32x4){a[4], a[5], a[6], a[7]};
      dst[2] = (u32x4){a[8], a[9], a[10], a[11]}; dst[3] = (u32x4){a[12], a[13], a[14], a[15]};
    }
  }
  __syncthreads();
}

DI GemmArgs mk(const bf16_t* A, int lda, const bf16_t* Bt, int ldb, int N, int K, int epi, void* out, int ldc,
               const float* mu = nullptr, const float* v0 = nullptr, const float* v1 = nullptr) {
  GemmArgs g; g.A = A; g.lda = lda; g.Bt = Bt; g.ldb = ldb; g.N = N; g.K = K; g.mu = mu; g.epi = epi; g.out = out; g.ldc = ldc; g.v0 = v0; g.v1 = v1; return g;
}
DI int sched_iters(int ntn, int nblk, int nmt = 256) {
  const int LB = nblk >> 3; int it = 0;
  for (int n0 = 0; n0 < ntn;) { int NT = min(8, ntn - n0); while (LB % NT) --NT; const int MT = LB / NT; it += (nmt + 8 * MT - 1) / (8 * MT); n0 += NT; }
  return it;
}
DI bool sched_mn(int i, int bid, int nblk, int ntn, int& mt, int& nt, int nmt = 256) {
  const int x = bid & 7, l = bid >> 3, LB = nblk >> 3; int base = 0;
  for (int n0 = 0; n0 < ntn;) {
    int NT = min(8, ntn - n0); while (LB % NT) --NT;
    const int MT = LB / NT, rounds = (nmt + 8 * MT - 1) / (8 * MT);
    if (i < base + rounds) { mt = (i - base) * 8 * MT + x * MT + (l % MT); nt = n0 + l / MT; return mt < nmt; }
    base += rounds; n0 += NT;
  }
  return false;
}

constexpr int CL = 32;
constexpr int NCH = SEQ / CL;
constexpr int SN = 144, ST = 80;
struct ScanArgs {
  bf16_t* r; const bf16_t *k, *v, *lw, *a;
  const float *k_k, *k_a, *r_k, *lnx_g, *lnx_b;
  bf16_t* Pg;
  bf16_t *Qz0, *Qz1;
  float* Gg;
  bf16_t* Tg;
};
DI int tr_off(int row, int tok) { return row * ST + ((((tok >> 3) ^ ((row >> 3) & 3)) << 4) | ((tok & 7) << 1)); }
template <bool PT, bool QT>
DI f32x4 tile_mm(const unsigned char* P, int ps, const unsigned char* Q, int qs, int i0, int j0, int nks, f32x4 acc, int lane) {
  const int fr = lane & 15, fq = lane >> 4;
  for (int ks = 0; ks < nks; ++ks) {
    const bf16x8 pa = *(const bf16x8*)(PT ? P + tr_off(i0 + fr, fq * 8) : P + (i0 + fr) * ps + ks * 64 + fq * 16);
    const bf16x8 qb = *(const bf16x8*)(QT ? Q + tr_off(j0 + fr, fq * 8) : Q + (j0 + fr) * qs + ks * 64 + fq * 16);
    acc = __builtin_amdgcn_mfma_f32_16x16x32_bf16(pa, qb, acc, 0, 0, 0);
  }
  return acc;
}
DI bf16_t* qz_ptr(const ScanArgs& s, int ch) { return ((ch >> 13) ? s.Qz1 : s.Qz0) + (size_t)(ch & 8191) * 4096; }
DI void st_bf16x4(unsigned char* p, const f32x4& v) { *(u32x2*)p = (u32x2){cvt_pk_bf16(v[0], v[1]), cvt_pk_bf16(v[2], v[3])}; }

struct ScanIn { u32x4 r, k, v, w, a, z0, z1, tb; f32x4 kk0, kk1, ka0, ka1, rk0, rk1; };
template <bool PHASE_C>
DI void scan_fetch(const ScanArgs& s, int item, ScanIn& in) {
  const int c = item & (NCH - 1), h = (item >> 7) & 15, b = item >> 11;
  const int tid = opaque_v(threadIdx.x), tt = tid >> 3, c0 = (tid & 7) * 8;
  const size_t off = ((size_t)b * SEQ + (size_t)c * CL + tt) * D + h * HS + c0;
  in.k = *(const u32x4*)(s.k + off); in.v = *(const u32x4*)(s.v + off); in.w = *(const u32x4*)(s.lw + off); in.a = *(const u32x4*)(s.a + off);
  { const int ch = h * HS + c0;
    in.kk0 = *(const f32x4*)(s.k_k + ch); in.kk1 = *(const f32x4*)(s.k_k + ch + 4); in.ka0 = *(const f32x4*)(s.k_a + ch); in.ka1 = *(const f32x4*)(s.k_a + ch + 4);
    if (PHASE_C) { in.rk0 = *(const f32x4*)(s.r_k + ch); in.rk1 = *(const f32x4*)(s.r_k + ch + 4); } }
  if (PHASE_C) {
    in.r = *(const u32x4*)(s.r + off);
    const bf16_t* Zg = qz_ptr(s, item);
    in.z0 = *(const u32x4*)(Zg + tid * 8); in.z1 = *(const u32x4*)(Zg + (tid + 256) * 8);
    if (tid < 96) in.tb = *(const u32x4*)(s.Tg + (size_t)item * 768 + tid * 8);
  }
}
template <bool PHASE_C>
DI void scan_load(const ScanArgs& s, const ScanIn& in, int h, float* lwbuf, unsigned char* At, unsigned char* Bt, unsigned char* Kt, unsigned char* Rt,
                  unsigned char* AtT, unsigned char* BhT, unsigned char* KhT, unsigned char* VT, float& bonus, float (&vout)[8], float* Gout) {
  const int tid = opaque_v(threadIdx.x), tt = tid >> 3, c0 = (tid & 7) * 8;
  const u32x4 vk = in.k, vv = in.v, vw = in.w, va = in.a;
  u32x4 vr = {0u, 0u, 0u, 0u};
  if (PHASE_C) vr = in.r;
  float fr_[8], fk[8], fv[8], fw[8], fa[8];
  { const unsigned ur[4] = {vr.x, vr.y, vr.z, vr.w}, uk[4] = {vk.x, vk.y, vk.z, vk.w}, uv[4] = {vv.x, vv.y, vv.z, vv.w}, uw[4] = {vw.x, vw.y, vw.z, vw.w}, ua[4] = {va.x, va.y, va.z, va.w};
#pragma unroll
    for (int j = 0; j < 4; ++j) {
      fr_[2 * j] = bf_lo(ur[j]); fr_[2 * j + 1] = bf_hi(ur[j]); fk[2 * j] = bf_lo(uk[j]); fk[2 * j + 1] = bf_hi(uk[j]);
      fv[2 * j] = bf_lo(uv[j]); fv[2 * j + 1] = bf_hi(uv[j]); fw[2 * j] = bf_lo(uw[j]); fw[2 * j + 1] = bf_hi(uw[j]);
      fa[2 * j] = bf_lo(ua[j]); fa[2 * j + 1] = bf_hi(ua[j]);
    } }
  *(f32x4*)(lwbuf + tt * 64 + c0) = (f32x4){fw[0], fw[1], fw[2], fw[3]}; *(f32x4*)(lwbuf + tt * 64 + c0 + 4) = (f32x4){fw[4], fw[5], fw[6], fw[7]};
  float kkr[8], nrm = 0.f, bon = 0.f, kp[8];
#pragma unroll
  for (int j = 0; j < 8; ++j) {
    const float pkk = j < 4 ? in.kk0[j & 3] : in.kk1[j & 3], pka = j < 4 ? in.ka0[j & 3] : in.ka1[j & 3];
    kkr[j] = fk[j] * pkk; nrm += kkr[j] * kkr[j];
    kp[j] = fk[j] * (1.f + (fa[j] - 1.f) * pka);
    if (PHASE_C) bon += fr_[j] * kp[j] * (j < 4 ? in.rk0[j & 3] : in.rk1[j & 3]);
  }
  nrm = sum8_dpp(nrm);
  if (PHASE_C) bon = sum8_dpp(bon);
  bonus = bon;
  const float inv = rsqrtf(fmaxf(nrm, 1e-24f));
  __syncthreads();
  {
    const int c = tid & 63, sg = tid >> 6;
    float w8[8];
#pragma unroll
    for (int i = 0; i < 8; ++i) w8[i] = lwbuf[(sg * 8 + i) * 64 + c];
    float run = 0.f;
#pragma unroll
    for (int i = 0; i < 8; ++i) { run += w8[i]; lwbuf[(sg * 8 + i) * 64 + c] = run; }
  }
  __syncthreads();
  float cum[8], cl[8];
  {
    const int sg = tt >> 3;
#pragma unroll
    for (int hh = 0; hh < 2; ++hh) {
      const f32x4 me = *(const f32x4*)(lwbuf + tt * 64 + c0 + hh * 4);
      const f32x4 s0 = *(const f32x4*)(lwbuf + 7 * 64 + c0 + hh * 4), s1 = *(const f32x4*)(lwbuf + 15 * 64 + c0 + hh * 4),
                  s2 = *(const f32x4*)(lwbuf + 23 * 64 + c0 + hh * 4), s3 = *(const f32x4*)(lwbuf + 31 * 64 + c0 + hh * 4);
#pragma unroll
      for (int q = 0; q < 4; ++q) {
        const float pre = (sg > 0 ? s0[q] : 0.f) + (sg > 1 ? s1[q] : 0.f) + (sg > 2 ? s2[q] : 0.f);
        cum[hh * 4 + q] = me[q] + pre; cl[hh * 4 + q] = (s0[q] + s1[q]) + (s2[q] + s3[q]);
      }
    }
  }
  float at[8], bt[8], kt[8], rt[8], bh[8], kh[8];
#pragma unroll
  for (int j = 0; j < 8; ++j) {
    const float kk = kkr[j] * inv, bb = kk * fa[j];
    const float ein = __expf(cum[j]), eneg = __expf(-cum[j]), eex = __expf(cum[j] - fw[j]), eend = __expf(cl[j] - cum[j]);
    at[j] = -kk * eex; bt[j] = bb * eneg; kt[j] = kp[j] * eneg; rt[j] = fr_[j] * ein; bh[j] = bb * eend; kh[j] = kp[j] * eend;
    vout[j] = fv[j];
  }
  *(u32x4*)(At + tt * SN + c0 * 2) = (u32x4){cvt_pk_bf16(at[0], at[1]), cvt_pk_bf16(at[2], at[3]), cvt_pk_bf16(at[4], at[5]), cvt_pk_bf16(at[6], at[7])};
  *(u32x4*)(Bt + tt * SN + c0 * 2) = (u32x4){cvt_pk_bf16(bt[0], bt[1]), cvt_pk_bf16(bt[2], bt[3]), cvt_pk_bf16(bt[4], bt[5]), cvt_pk_bf16(bt[6], bt[7])};
  *(u32x4*)(Kt + tt * SN + c0 * 2) = (u32x4){cvt_pk_bf16(kt[0], kt[1]), cvt_pk_bf16(kt[2], kt[3]), cvt_pk_bf16(kt[4], kt[5]), cvt_pk_bf16(kt[6], kt[7])};
  if (PHASE_C) *(u32x4*)(Rt + tt * SN + c0 * 2) = (u32x4){cvt_pk_bf16(rt[0], rt[1]), cvt_pk_bf16(rt[2], rt[3]), cvt_pk_bf16(rt[4], rt[5]), cvt_pk_bf16(rt[6], rt[7])};
#pragma unroll
  for (int j = 0; j < 8; ++j) {
    *(bf16_t*)(VT + tr_off(c0 + j, tt)) = f2bf(fv[j]);
    if (!PHASE_C) {
      *(bf16_t*)(AtT + tr_off(c0 + j, tt)) = f2bf(at[j]);
      *(bf16_t*)(BhT + tr_off(c0 + j, tt)) = f2bf(bh[j]);
      *(bf16_t*)(KhT + tr_off(c0 + j, tt)) = f2bf(kh[j]);
    }
  }
  if (!PHASE_C && tt == 0 && Gout) {
#pragma unroll
    for (int j = 0; j < 8; ++j) Gout[c0 + j] = __expf(cl[j]);
  }
}
DI void scan_tdiag(const float* A32, unsigned char* Tm, unsigned char* scr, int blk, int lane) {
  const int c = lane & 15, off = blk * 16;
  float av[120];
  {
    int n = 0;
#pragma unroll
    for (int i = 1; i < 16; ++i)
#pragma unroll
      for (int jj = 0; jj < i; ++jj) av[n++] = A32[(off + i) * 36 + off + jj];
  }
  float Tc[16];
  {
    int n = 0;
#pragma unroll
    for (int i = 0; i < 16; ++i) {
      float s0 = (i == c) ? 1.f : 0.f, s1 = 0.f, s2 = 0.f, s3 = 0.f;
#pragma unroll
      for (int jj = 0; jj < i; ++jj) {
        const float pr = av[n++] * Tc[jj];
        if ((jj & 3) == 0) s0 += pr; else if ((jj & 3) == 1) s1 += pr; else if ((jj & 3) == 2) s2 += pr; else s3 += pr;
      }
      Tc[i] = (s0 + s1) + (s2 + s3);
    }
  }
  if (lane < 32) {
    const bool real = lane < 16;
#pragma unroll
    for (int i = 0; i < 16; ++i) {
      if (real) *(bf16_t*)(Tm + (off + i) * ST + (off + c) * 2) = f2bf(Tc[i]);
      if (blk == 0) { if (real) *(bf16_t*)(Tm + i * ST + (16 + c) * 2) = 0; }
      else *(bf16_t*)(scr + 2560 + i * ST + lane * 2) = real ? f2bf(Tc[i]) : (bf16_t)0;
    }
    if (blk == 0 && real) {
      u32x4* d = (u32x4*)(scr + 1280 + c * ST);
      d[0] = (u32x4){cvt_pk_bf16(Tc[0], Tc[1]), cvt_pk_bf16(Tc[2], Tc[3]), cvt_pk_bf16(Tc[4], Tc[5]), cvt_pk_bf16(Tc[6], Tc[7])};
      d[1] = (u32x4){cvt_pk_bf16(Tc[8], Tc[9]), cvt_pk_bf16(Tc[10], Tc[11]), cvt_pk_bf16(Tc[12], Tc[13]), cvt_pk_bf16(Tc[14], Tc[15])};
      d[2] = (u32x4){0u, 0u, 0u, 0u}; d[3] = (u32x4){0u, 0u, 0u, 0u};
      u32x4* x = (u32x4*)(scr + 3840 + c * ST + 32); x[0] = (u32x4){0u, 0u, 0u, 0u}; x[1] = (u32x4){0u, 0u, 0u, 0u};
    }
  }
}
DI void scan_t21(unsigned char* Tm, unsigned char* scr, int lane) {
  const int fr = lane & 15, fq = lane >> 4;
  const f32x4 x = tile_mm<false, false>(scr, ST, scr + 1280, ST, 0, 0, 1, (f32x4){0.f, 0.f, 0.f, 0.f}, lane);
  st_bf16x4(scr + 3840 + fr * ST + (fq * 4) * 2, x);
  asm volatile("s_waitcnt lgkmcnt(0)" ::: "memory");
  const f32x4 y = tile_mm<false, false>(scr + 2560, ST, scr + 3840, ST, 0, 0, 1, (f32x4){0.f, 0.f, 0.f, 0.f}, lane);
#pragma unroll
  for (int q = 0; q < 4; ++q) *(bf16_t*)(Tm + (16 + fq * 4 + q) * ST + fr * 2) = f2bf(y[q]);
}

DI void scan_phaseA_item(const ScanArgs& s, int item, const ScanIn& in, unsigned char* lds) {
  const int c = item & (NCH - 1), h = (item >> 7) & 15, b = item >> 11;
  const int tid = opaque_v(threadIdx.x), lane = tid & 63, wv = tid >> 6, fr = lane & 15, fq = lane >> 4;
  unsigned char* At = lds; unsigned char* Bt = At + 32 * SN; unsigned char* Kt = Bt + 32 * SN;
  unsigned char* AtT = Kt + 32 * SN; unsigned char* BhT = AtT + 64 * ST; unsigned char* KhT = BhT + 64 * ST; unsigned char* VT = KhT + 64 * ST;
  unsigned char* Tm = VT + 64 * ST; unsigned char* Aak = Tm + 32 * ST;
  float* A32 = (float*)(Aak + 32 * ST);
  unsigned char* W1T = (unsigned char*)A32 + 4608; unsigned char* M2T = W1T + 64 * ST; unsigned char* UlT = M2T + 64 * ST;
  float* lwbuf = (float*)W1T;
  const size_t gbase = ((size_t)b * SEQ + (size_t)c * CL) * D + h * HS;
  float bonus; float vv8[8];
  scan_load<false>(s, in, h, lwbuf, At, Bt, Kt, nullptr, AtT, BhT, KhT, VT, bonus, vv8, s.Gg + (size_t)item * 64);
  __syncthreads();
  {
    const int mat = wv >> 1, ti = wv & 1;
#pragma unroll
    for (int tj = 0; tj < 2; ++tj) {
      const f32x4 x = tile_mm<false, false>(At, SN, mat ? Kt : Bt, SN, ti * 16, tj * 16, 2, (f32x4){0.f, 0.f, 0.f, 0.f}, lane);
#pragma unroll
      for (int q = 0; q < 4; ++q) {
        const int i = ti * 16 + fq * 4 + q, j = tj * 16 + fr;
        const float val = (j < i) ? x[q] : 0.f;
        if (mat == 0) { A32[i * 36 + j] = val; if (i >= 16) *(bf16_t*)(W1T + (i - 16) * ST + j * 2) = f2bf(val); }
        else *(bf16_t*)(Aak + i * ST + j * 2) = f2bf(val);
      }
    }
  }
  __syncthreads();
  if (wv < 2) scan_tdiag(A32, Tm, W1T, wv, lane);
  else {
#pragma unroll
    for (int u = 0; u < 4; ++u) {
      const int tile = (wv - 2) * 4 + u, ti = tile >> 2, tv = tile & 3;
      const f32x4 x = tile_mm<false, true>(Aak, ST, VT, ST, ti * 16, tv * 16, 1, (f32x4){0.f, 0.f, 0.f, 0.f}, lane);
      st_bf16x4(M2T + tr_off(tv * 16 + fr, ti * 16 + fq * 4), x);
    }
  }
  __syncthreads();
  if (wv == 0) scan_t21(Tm, W1T, lane);
  __syncthreads();
  if (tid < 96) {
    const int blk = tid >> 5, row = (tid & 31) >> 1, half = tid & 1;
    *(u32x4*)(s.Tg + (size_t)item * 768 + tid * 8) = *(const u32x4*)(Tm + ((blk == 0 ? 0 : 16) + row) * ST + (blk == 2 ? 32 : 0) + half * 16);
  }
#pragma unroll
  for (int u = 0; u < 4; ++u) {
    const int tile = wv * 4 + u, which = tile >> 3, ti = (tile >> 2) & 1, tn = tile & 3;
    const f32x4 x = tile_mm<false, true>(Tm, ST, which ? M2T : AtT, ST, ti * 16, tn * 16, 1, (f32x4){0.f, 0.f, 0.f, 0.f}, lane);
    st_bf16x4((which ? UlT : W1T) + tr_off(tn * 16 + fr, ti * 16 + fq * 4), x);
  }
  __syncthreads();
  bf16_t* Pg = s.Pg + (size_t)item * 4096; bf16_t* Qg = qz_ptr(s, item);
#pragma unroll
  for (int u = 0; u < 4; ++u) {
    const int tile = wv * 4 + u, tk = tile >> 2, tn = tile & 3;
    const f32x4 xp = tile_mm<true, true>(W1T, ST, BhT, ST, tk * 16, tn * 16, 1, (f32x4){0.f, 0.f, 0.f, 0.f}, lane);
    *(u32x2*)(Pg + (tn * 16 + fr) * 64 + tk * 16 + fq * 4) = (u32x2){cvt_pk_bf16(xp[0], xp[1]), cvt_pk_bf16(xp[2], xp[3])};
    f32x4 xq = tile_mm<true, true>(BhT, ST, UlT, ST, tk * 16, tn * 16, 1, (f32x4){0.f, 0.f, 0.f, 0.f}, lane);
    xq = tile_mm<true, true>(KhT, ST, VT, ST, tk * 16, tn * 16, 1, xq, lane);
    __hip_atomic_store((unsigned long long*)(Qg + ((tk * 4 + tn) * 64 + lane) * 4), (unsigned long long)cvt_pk_bf16(xq[0], xq[1]) | ((unsigned long long)cvt_pk_bf16(xq[2], xq[3]) << 32), __ATOMIC_RELAXED, __HIP_MEMORY_SCOPE_AGENT);
  }
  __syncthreads();
}

constexpr int RSLOT = 8192 + 8192 + 256;
constexpr int ZSTR = 144;
DI void scan_chain_block(const ScanArgs& s, int bh, unsigned char* lds) {
  const int tid = opaque_v(threadIdx.x), lane = tid & 63, tv = tid >> 6, fr = lane & 15, fq = lane >> 4;
  const int ch0 = bh * NCH;
  const bool loader = tv < 2;
  unsigned char* stg = lds + 4 * RSLOT;
  auto issue = [&](int c) {
    unsigned char* sl = lds + (c & 3) * RSLOT;
    const bf16_t* Pg = s.Pg + (size_t)(ch0 + c) * 4096; const bf16_t* Qg = qz_ptr(s, ch0 + c);
#pragma unroll
    for (int j = 0; j < 4; ++j) {
      const int pc = j * 2 + tv, row = pc * 8 + (lane >> 3);
      __builtin_amdgcn_global_load_lds((const unsigned*)(Pg + row * 64 + (((lane & 7) ^ ((row >> 1) & 7)) << 3)), (unsigned*)(sl + pc * 1024), 16, 0, 0);
    }
#pragma unroll
    for (int j = 0; j < 4; ++j) {
      const int qc = j * 2 + tv;
      __builtin_amdgcn_global_load_lds((const unsigned*)(Qg + (size_t)(qc * 64 + lane) * 8), (unsigned*)(sl + 8192 + qc * 1024), 16, 0, 0);
    }
    __builtin_amdgcn_global_load_lds((const unsigned*)(s.Gg + (size_t)(ch0 + c) * 64 + lane), (unsigned*)(sl + 16384), 4, 0, 0);
  };
  auto flush = [&](int c, int tl) {
    const unsigned char* sp = stg + (((c & 1) * 2 + tl) * 16 + (lane >> 2)) * ZSTR;
    bf16_t* Zo = qz_ptr(s, ch0 + c) + (tl * 16 + (lane >> 2)) * 64;
    const u32x4 a = *(const u32x4*)(sp + (lane & 3) * 16), b = *(const u32x4*)(sp + ((lane & 3) + 4) * 16);
    *(u32x4*)(Zo + (lane & 3) * 8) = a; *(u32x4*)(Zo + ((lane & 3) + 4) * 8) = b;
  };
  __syncthreads();
  if (loader) { issue(0); issue(1); issue(2); asm volatile("s_waitcnt vmcnt(18)" ::: "memory"); }
  __builtin_amdgcn_s_barrier();
  f32x4 Z[4];
#pragma unroll
  for (int t = 0; t < 4; ++t) Z[t] = (f32x4){0.f, 0.f, 0.f, 0.f};
  for (int c = 0; c < NCH; ++c) {
    if (loader && c + 3 < NCH) issue(c + 3);
    const unsigned char* sl = lds + (c & 3) * RSLOT;
    u32x2 qv[4], pf[4][2][2]; f32x4 g4[4];
#pragma unroll
    for (int t = 0; t < 4; ++t) {
      qv[t] = *(const u32x2*)(sl + 8192 + ((t * 4 + tv) * 64 + lane) * 8);
      g4[t] = *(const f32x4*)(sl + 16384 + (t * 16 + fq * 4) * 4);
      const int rowp = t * 16 + fr, gs = (rowp >> 1) & 7;
      const unsigned char* prow = sl + rowp * 128 + (fq & 1) * 8;
#pragma unroll
      for (int ks = 0; ks < 2; ++ks) {
        const int qa = ks * 4 + (fq >> 1);
        pf[t][ks][0] = *(const u32x2*)(prow + ((qa ^ gs) << 4)); pf[t][ks][1] = *(const u32x2*)(prow + (((qa + 2) ^ gs) << 4));
      }
    }
    __builtin_amdgcn_sched_barrier(0);
    unsigned zp[4][2];
#pragma unroll
    for (int t = 0; t < 4; ++t) { zp[t][0] = cvt_pk_bf16(Z[t][0], Z[t][1]); zp[t][1] = cvt_pk_bf16(Z[t][2], Z[t][3]); }
    if (loader) {
      unsigned char* sp = stg + (((c & 1) * 2 + tv) * 16 + fr) * ZSTR + fq * 8;
#pragma unroll
      for (int t = 0; t < 4; ++t) *(u32x2*)(sp + t * 32) = (u32x2){zp[t][0], zp[t][1]};
    } else {
      bf16_t* Zo = qz_ptr(s, ch0 + c) + (tv * 16 + fr) * 64;
#pragma unroll
      for (int t = 0; t < 4; ++t) *(u32x2*)(Zo + t * 16 + fq * 4) = (u32x2){zp[t][0], zp[t][1]};
      if (c > 0) flush(c - 1, tv - 2);
    }
    bf16x8 zb[2];
#pragma unroll
    for (int ks = 0; ks < 2; ++ks) { const u32x4 w = {zp[2 * ks][0], zp[2 * ks][1], zp[2 * ks + 1][0], zp[2 * ks + 1][1]}; zb[ks] = __builtin_bit_cast(bf16x8, w); }
    __builtin_amdgcn_sched_barrier(0);
#pragma unroll
    for (int t = 0; t < 4; ++t) {
      f32x4 acc = (f32x4){bf_lo(qv[t].x) + g4[t][0] * Z[t][0], bf_hi(qv[t].x) + g4[t][1] * Z[t][1], bf_lo(qv[t].y) + g4[t][2] * Z[t][2], bf_hi(qv[t].y) + g4[t][3] * Z[t][3]};
#pragma unroll
      for (int ks = 0; ks < 2; ++ks) {
        const u32x4 w = {pf[t][ks][0].x, pf[t][ks][0].y, pf[t][ks][1].x, pf[t][ks][1].y};
        acc = __builtin_amdgcn_mfma_f32_16x16x32_bf16(__builtin_bit_cast(bf16x8, w), zb[ks], acc, 0, 0, 0);
      }
      Z[t] = acc;
    }
    if (loader) { if (c + 3 < NCH) asm volatile("s_waitcnt vmcnt(18)" ::: "memory"); else asm volatile("s_waitcnt vmcnt(0)" ::: "memory"); }
    asm volatile("s_waitcnt lgkmcnt(0)" ::: "memory");
    __builtin_amdgcn_s_barrier();
  }
  if (!loader) flush(NCH - 1, tv - 2);
  __syncthreads();
}

DI void scan_phaseC_item(const ScanArgs& s, int item, const ScanIn& in, unsigned char* lds) {
  const int c = item & (NCH - 1), h = (item >> 7) & 15, b = item >> 11;
  const int tid = opaque_v(threadIdx.x), lane = tid & 63, wv = tid >> 6, fr = lane & 15, fq = lane >> 4;
  unsigned char* At = lds; unsigned char* Bt = At + 32 * SN; unsigned char* Kt = Bt + 32 * SN; unsigned char* Rt = Kt + 32 * SN;
  unsigned char* VT = Rt + 32 * SN;
  unsigned char* Tm = VT + 64 * ST; unsigned char* Aak = Tm + 32 * ST; unsigned char* Arb = Aak + 32 * ST; unsigned char* Ark = Arb + 32 * ST;
  float* A32 = (float*)(Ark + 32 * ST);
  unsigned char* S0 = (unsigned char*)A32 + 4608;
  unsigned char* X1T = S0 + 64 * SN; unsigned char* UT = X1T + 64 * ST;
  float* Yb = (float*)(UT + 64 * ST);
  float* lwbuf = Yb;
  const size_t gbase = ((size_t)b * SEQ + (size_t)c * CL) * D + h * HS;
  float bonus; float vv8[8];
  { const int e0 = tid * 8, e1 = (tid + 256) * 8;
    *(u32x4*)(S0 + (e0 >> 6) * SN + (e0 & 63) * 2) = in.z0; *(u32x4*)(S0 + (e1 >> 6) * SN + (e1 & 63) * 2) = in.z1; }
  scan_load<true>(s, in, h, lwbuf, At, Bt, Kt, Rt, nullptr, nullptr, nullptr, VT, bonus, vv8, nullptr);
  __syncthreads();
  if (tid < 96) {
    const int blk = tid >> 5, row = (tid & 31) >> 1, half = tid & 1;
    *(u32x4*)(Tm + ((blk == 0 ? 0 : 16) + row) * ST + (blk == 2 ? 32 : 0) + half * 16) = in.tb;
  } else if (tid < 128) {
    const int q = tid - 96;
    *(u32x4*)(Tm + (q >> 1) * ST + 32 + (q & 1) * 16) = (u32x4){0u, 0u, 0u, 0u};
  }
#pragma unroll
  for (int u = 0; u < 3; ++u) {
    const int tile = wv * 3 + u, mat = tile >> 2, ti = (tile >> 1) & 1, tj = tile & 1;
    const unsigned char* Pm = (mat == 0) ? At : Rt; const unsigned char* Qm = (mat == 1) ? Bt : Kt;
    unsigned char* dst = (mat == 0) ? Aak : (mat == 1 ? Arb : Ark);
    const f32x4 x = tile_mm<false, false>(Pm, SN, Qm, SN, ti * 16, tj * 16, 2, (f32x4){0.f, 0.f, 0.f, 0.f}, lane);
#pragma unroll
    for (int q = 0; q < 4; ++q) {
      const int i = ti * 16 + fq * 4 + q, j = tj * 16 + fr;
      const bool keep = (mat == 0) ? (j < i) : (j <= i);
      *(bf16_t*)(dst + i * ST + j * 2) = f2bf(keep ? x[q] : 0.f);
    }
  }
  __syncthreads();
#pragma unroll
  for (int u = 0; u < 2; ++u) {
    const int tile = wv * 2 + u, ti = tile >> 2, tv = tile & 3;
    f32x4 x = tile_mm<false, false>(At, SN, S0, SN, ti * 16, tv * 16, 2, (f32x4){0.f, 0.f, 0.f, 0.f}, lane);
    x = tile_mm<false, true>(Aak, ST, VT, ST, ti * 16, tv * 16, 1, x, lane);
    st_bf16x4(X1T + tr_off(tv * 16 + fr, ti * 16 + fq * 4), x);
  }
  __syncthreads();
#pragma unroll
  for (int u = 0; u < 2; ++u) {
    const int tile = wv * 2 + u, ti = tile >> 2, tv = tile & 3;
    const f32x4 x = tile_mm<false, true>(Tm, ST, X1T, ST, ti * 16, tv * 16, 1, (f32x4){0.f, 0.f, 0.f, 0.f}, lane);
    st_bf16x4(UT + tr_off(tv * 16 + fr, ti * 16 + fq * 4), x);
  }
  __syncthreads();
#pragma unroll
  for (int u = 0; u < 2; ++u) {
    const int tile = wv * 2 + u, ti = tile >> 2, tv = tile & 3;
    f32x4 x = tile_mm<false, false>(Rt, SN, S0, SN, ti * 16, tv * 16, 2, (f32x4){0.f, 0.f, 0.f, 0.f}, lane);
    x = tile_mm<false, true>(Arb, ST, UT, ST, ti * 16, tv * 16, 1, x, lane);
    x = tile_mm<false, true>(Ark, ST, VT, ST, ti * 16, tv * 16, 1, x, lane);
#pragma unroll
    for (int q = 0; q < 4; ++q) Yb[(ti * 16 + fq * 4 + q) * 68 + tv * 16 + fr] = x[q];
  }
  __syncthreads();
  {
    const int tt = tid >> 3, c0 = (tid & 7) * 8;
    float yv[8], sum = 0.f;
#pragma unroll
    for (int j = 0; j < 8; ++j) { yv[j] = Yb[tt * 68 + c0 + j]; sum += yv[j]; }
    sum = sum8_dpp(sum);
    const float mean = sum * (1.f / 64.f);
    float var = 0.f;
#pragma unroll
    for (int j = 0; j < 8; ++j) { const float d = yv[j] - mean; var += d * d; }
    var = sum8_dpp(var);
    const float rstd = rsqrtf(var * (1.f / 64.f) + GN_EPS);
    const size_t off = gbase + (size_t)tt * D + c0;
    float o[8];
#pragma unroll
    for (int j = 0; j < 8; ++j) {
      const int chn = h * HS + c0 + j;
      o[j] = (yv[j] - mean) * rstd * s.lnx_g[chn] + s.lnx_b[chn] + bonus * vv8[j];
    }
    *(u32x4*)(s.r + off) = (u32x4){cvt_pk_bf16(o[0], o[1]), cvt_pk_bf16(o[2], o[3]), cvt_pk_bf16(o[4], o[5]), cvt_pk_bf16(o[6], o[7])};
  }
  __syncthreads();
}

DI void ln_phase(const bf16_t* __restrict__ z, const float* __restrict__ lg, const float* __restrict__ lb, bf16_t* __restrict__ xo, float* __restrict__ xo32,
                 const float* __restrict__ mod_l, int shift_idx, int scale_idx, bf16_t* __restrict__ ho, unsigned char* __restrict__ ho8, int bid, int nblk) {
  const int tq = opaque_v(threadIdx.x); const int lane = tq & 63, wv = tq >> 6;
  constexpr int RW = 4;
  for (int row0 = (bid * 4 + wv) * RW; row0 < T; row0 += nblk * 4 * RW) {
    float v[RW][16];
#pragma unroll
    for (int r = 0; r < RW; ++r) {
      const u32x4 a0 = *(const u32x4*)(z + (size_t)(row0 + r) * D + lane * 8), a1 = *(const u32x4*)(z + (size_t)(row0 + r) * D + 512 + lane * 8);
      const unsigned u[8] = {a0.x, a0.y, a0.z, a0.w, a1.x, a1.y, a1.z, a1.w};
#pragma unroll
      for (int q = 0; q < 8; ++q) { v[r][2 * q] = bf_lo(u[q]); v[r][2 * q + 1] = bf_hi(u[q]); }
    }
    const int b = row0 / SEQ;
#pragma unroll
    for (int r = 0; r < RW; ++r) {
      float s = 0.f;
#pragma unroll
      for (int i = 0; i < 16; ++i) s += v[r][i];
      const float mean = wave_sum(s) * (1.f / D);
      float q = 0.f;
#pragma unroll
      for (int i = 0; i < 16; ++i) { const float d = v[r][i] - mean; q += d * d; }
      const float rstd = rsqrtf(wave_sum(q) * (1.f / D) + LN_EPS);
      const int row = row0 + r;
#pragma unroll
      for (int hh = 0; hh < 2; ++hh) {
        const int d = hh * 512 + lane * 8;
        float o[8];
#pragma unroll
        for (int i = 0; i < 8; ++i) o[i] = (v[r][hh * 8 + i] - mean) * rstd * lg[d + i] + lb[d + i];
        if (xo32) { *(f32x4*)(xo32 + (size_t)row * D + d) = (f32x4){o[0], o[1], o[2], o[3]}; *(f32x4*)(xo32 + (size_t)row * D + d + 4) = (f32x4){o[4], o[5], o[6], o[7]}; }
        if (xo) *(u32x4*)(xo + (size_t)row * D + d) = (u32x4){cvt_pk_bf16(o[0], o[1]), cvt_pk_bf16(o[2], o[3]), cvt_pk_bf16(o[4], o[5]), cvt_pk_bf16(o[6], o[7])};
        if (ho) {
          float hq[8];
#pragma unroll
          for (int i = 0; i < 8; ++i) hq[i] = o[i] * (1.f + mod_l[(size_t)b * 6144 + scale_idx * D + d + i]) + mod_l[(size_t)b * 6144 + shift_idx * D + d + i];
          *(u32x4*)(ho + (size_t)row * D + d) = (u32x4){cvt_pk_bf16(hq[0], hq[1]), cvt_pk_bf16(hq[2], hq[3]), cvt_pk_bf16(hq[4], hq[5]), cvt_pk_bf16(hq[6], hq[7])};
          if (ho8) {
            int p0 = 0, p1 = 0;
            p0 = __builtin_amdgcn_cvt_pk_fp8_f32(hq[0], hq[1], p0, false); p0 = __builtin_amdgcn_cvt_pk_fp8_f32(hq[2], hq[3], p0, true);
            p1 = __builtin_amdgcn_cvt_pk_fp8_f32(hq[4], hq[5], p1, false); p1 = __builtin_amdgcn_cvt_pk_fp8_f32(hq[6], hq[7], p1, true);
            *(u32x2*)(ho8 + (size_t)row * D + d) = (u32x2){(unsigned)p0, (unsigned)p1};
          }
        }
      }
    }
  }
}

DI void combine_phase(const unsigned* __restrict__ lists, unsigned* __restrict__ epk, float* __restrict__ gate, unsigned char* lds, int bid, int nblk) {
  const int tq = opaque_v(threadIdx.x);
  for (int g0 = bid * 256; g0 < T * 8; g0 += nblk * 256) {
    const u32x4* src = (const u32x4*)(lists + (size_t)g0 * 32);
    u32x4 v[8];
#pragma unroll
    for (int i = 0; i < 8; ++i) v[i] = src[i * 256 + tq];
    __syncthreads();
#pragma unroll
    for (int i = 0; i < 8; ++i) { const int ci = i * 256 + tq, t = ci >> 3, c = ci & 7; *(u32x4*)(lds + t * 128 + ((c ^ (t & 7)) << 4)) = v[i]; }
    __syncthreads();
    const int gid = g0 + tq, t = gid >> 3, head = gid & 7;
    peer_combine((const unsigned*)(lds + tq * 128), tq & 7, epk + (size_t)t * 64 + head * 8, gate + (size_t)t * 128 + head * 8);
  }
  __syncthreads();
}

template <bool INT8>
DI void table_fp8_phase(const float* __restrict__ src, unsigned char* __restrict__ dst, bf16_t* __restrict__ inv, int rows, int bid, int nblk) {
  const int tq = opaque_v(threadIdx.x); const int lane = tq & 63, wv = tq >> 6;
  for (int r0 = (bid * 4 + wv) * 4; r0 < rows; r0 += nblk * 16) {
    f32x4 v[4][4];
#pragma unroll
    for (int rr = 0; rr < 4; ++rr)
#pragma unroll
      for (int i = 0; i < 4; ++i) v[rr][i] = __builtin_nontemporal_load((const f32x4*)(src + (size_t)(r0 + rr) * D + i * 256 + lane * 4));
#pragma unroll
    for (int rr = 0; rr < 4; ++rr) {
      float mx = 0.f;
#pragma unroll
      for (int i = 0; i < 4; ++i) mx = fmaxf(mx, fmaxf(fmaxf(fabsf(v[rr][i][0]), fabsf(v[rr][i][1])), fmaxf(fabsf(v[rr][i][2]), fabsf(v[rr][i][3]))));
#pragma unroll
      for (int o = 32; o >= 1; o >>= 1) mx = fmaxf(mx, __shfl_xor(mx, o));
      const float sc = mx > 0.f ? exp2f(floorf(log2f((INT8 ? 127.f : 384.f) / mx))) : 1.f;
#pragma unroll
      for (int i = 0; i < 4; ++i) {
        int pk = 0;
        if (INT8) {
          const int q0 = (int)__builtin_rintf(v[rr][i][0] * sc), q1 = (int)__builtin_rintf(v[rr][i][1] * sc), q2 = (int)__builtin_rintf(v[rr][i][2] * sc), q3 = (int)__builtin_rintf(v[rr][i][3] * sc);
          pk = (q0 & 0xff) | ((q1 & 0xff) << 8) | ((q2 & 0xff) << 16) | (q3 << 24);
        } else {
          pk = __builtin_amdgcn_cvt_pk_fp8_f32(v[rr][i][0] * sc, v[rr][i][1] * sc, pk, false);
          pk = __builtin_amdgcn_cvt_pk_fp8_f32(v[rr][i][2] * sc, v[rr][i][3] * sc, pk, true);
        }
        *(int*)(dst + (size_t)(r0 + rr) * D + i * 256 + lane * 4) = pk;
      }
      if (lane == 0) inv[r0 + rr] = f2bf(1.f / sc);
    }
  }
}

struct PeerArgs {
  const bf16_t* h2;
  const unsigned char *u8, *v8;
  const bf16_t *uinv, *vinv;
  const unsigned* epk; const float* gate;
  float* part;
  float* coef;
  const bf16_t* xres;
  const float* gate2;
  bf16_t* z;
  unsigned* ctr_u; unsigned* ctr_v;
};
constexpr int PCH = 64;
DI void cvt16_fp8(const u32x4& d, float (&f)[16]) {
  const unsigned w[4] = {d.x, d.y, d.z, d.w};
#pragma unroll
  for (int i = 0; i < 4; ++i) {
    const f32x2 lo = __builtin_amdgcn_cvt_pk_f32_fp8((int)w[i], false), hi = __builtin_amdgcn_cvt_pk_f32_fp8((int)w[i], true);
    f[i * 4] = lo.x; f[i * 4 + 1] = lo.y; f[i * 4 + 2] = hi.x; f[i * 4 + 3] = hi.y;
  }
}
template <int I> DI int grp_bcast8(int v, int lane) {
  const int x = __builtin_amdgcn_update_dpp(0, v, (I & 3) * 85, 0xF, 0xF, true);
  const int y = __builtin_amdgcn_update_dpp(0, x, 0x141, 0xF, 0xF, true);
  return (((lane >> 2) & 1) == (I >> 2)) ? x : y;
}
struct PeerTok { u32x4 h0, h1; float c_lo, c_hi; };
template <bool VPHASE, int HALF>
DI void peer_issue_half(const PeerArgs& a, int s, int lane, int cc, unsigned ep, u32x4 (&data)[8]) {
  const unsigned char* tb = VPHASE ? a.v8 : a.u8;
  const unsigned off0 = (unsigned)(s * 128 + cc * 16);
#pragma unroll
  for (int i = 0; i < 8; ++i) {
    const unsigned ev = (unsigned)__shfl((int)ep, (lane & ~7) | i);
    const unsigned e = HALF ? (ev >> 16) : (ev & 0xffffu);
    data[i] = *(const u32x4*)(tb + (e * 1024u + off0));
  }
}
template <bool VPHASE>
DI void peer_side_loads(const PeerArgs& a, int t, int s, int lane, int cc, PeerTok& tk) {
  if (VPHASE) { tk.c_lo = a.coef[(size_t)t * 128 + lane]; tk.c_hi = a.coef[(size_t)t * 128 + 64 + lane]; }
  else { tk.h0 = *(const u32x4*)(a.h2 + (size_t)t * D + s * 128 + cc * 16); tk.h1 = *(const u32x4*)(a.h2 + (size_t)t * D + s * 128 + cc * 16 + 8); }
}
DI int peer_dot_half(const u32x4 (&data)[8], const int (&hq)[4], int cc) {
  int d[8];
#pragma unroll
  for (int i = 0; i < 8; ++i) {
    int a0 = __builtin_amdgcn_sdot4((int)data[i].x, hq[0], 0, false);
    int a1 = __builtin_amdgcn_sdot4((int)data[i].y, hq[1], 0, false);
    a0 = __builtin_amdgcn_sdot4((int)data[i].z, hq[2], a0, false);
    a1 = __builtin_amdgcn_sdot4((int)data[i].w, hq[3], a1, false);
    d[i] = a0 + a1;
  }
  const bool hi4 = (cc & 4) != 0, b0 = (cc & 1) != 0, b1 = (cc & 2) != 0;
  int e[4], g[2];
#pragma unroll
  for (int j = 0; j < 4; ++j) {
    const int keep = hi4 ? d[4 + j] : d[j], send = hi4 ? d[j] : d[4 + j];
    e[j] = keep + __builtin_amdgcn_update_dpp(0, send, 0x141, 0xF, 0xF, true);
  }
#pragma unroll
  for (int m = 0; m < 2; ++m) {
    const int keep = b0 ? e[2 * m + 1] : e[2 * m], send = b0 ? e[2 * m] : e[2 * m + 1];
    g[m] = keep + __builtin_amdgcn_update_dpp(0, send, 0xB1, 0xF, 0xF, true);
  }
  const int keep = b1 ? g[1] : g[0], send = b1 ? g[0] : g[1];
  return keep + __builtin_amdgcn_update_dpp(0, send, 0x4E, 0xF, 0xF, true);
}
DI void peer_axpy_half(const u32x4 (&data)[8], float c, int lane, float (&acc)[16]) {
#pragma unroll
  for (int i = 0; i < 8; ++i) {
    const float cvi = __shfl(c, (lane & ~7) | i);
    float f[16]; cvt16_fp8(data[i], f);
#pragma unroll
    for (int q = 0; q < 16; ++q) acc[q] += cvi * f[q];
  }
}
DI void peer_v_finish(const PeerArgs& a, int t, int s, int lane, int cc, const float (&acc)[16]) {
  float r8[8], r4[4], r2[2];
  { const bool up = (lane & 8) != 0;
#pragma unroll
    for (int q = 0; q < 8; ++q) { const float keep = up ? acc[8 + q] : acc[q], send = up ? acc[q] : acc[8 + q]; r8[q] = keep + __shfl_xor(send, 8); } }
  { const bool up = (lane & 16) != 0;
#pragma unroll
    for (int q = 0; q < 4; ++q) { const float keep = up ? r8[4 + q] : r8[q], send = up ? r8[q] : r8[4 + q]; r4[q] = keep + __shfl_xor(send, 16); } }
  { const bool up = (lane & 32) != 0;
#pragma unroll
    for (int q = 0; q < 2; ++q) { const float keep = up ? r4[2 + q] : r4[q], send = up ? r4[q] : r4[2 + q]; r2[q] = keep + __shfl_xor(send, 32); } }
  const int col = s * 128 + cc * 16 + ((lane >> 3) & 1) * 8 + ((lane >> 4) & 1) * 4 + ((lane >> 5) & 1) * 2;
  const int b = t / SEQ;
  const unsigned xb = *(const unsigned*)(a.xres + (size_t)t * D + col); const f32x2 gt = *(const f32x2*)(a.gate2 + (size_t)b * 6144 + col);
  *(unsigned*)(a.z + (size_t)t * D + col) = cvt_pk_bf16(ALPHA * bf_lo(xb) + gt.x * r2[0], ALPHA * bf_hi(xb) + gt.y * r2[1]);
}
template <bool VPHASE>
DI void peer_slice_phase(const PeerArgs& a, unsigned char* lds) {
  const int tq = opaque_v(threadIdx.x); const int lane = tq & 63, wv = tq >> 6, cc = lane & 7;
  volatile int* nxt = (volatile int*)lds;
  const unsigned xcc = xb_xcc_id() & 7u;
  unsigned* ctr = VPHASE ? a.ctr_v : a.ctr_u;
  for (int ks = 0; ks < 8; ++ks) {
    const int s = (int)((xcc + ks) & 7u);
    for (;;) {
      __syncthreads();
      if (tq == 0) *nxt = (int)atomicAdd(&ctr[s * 16], 1u);
      __syncthreads();
      const int chunk = *nxt;
      if (chunk >= T / PCH) break;
      if (VPHASE) {
      const int colc = s * 128 + cc * 16 + ((lane >> 3) & 1) * 8 + ((lane >> 4) & 1) * 4 + ((lane >> 5) & 1) * 2;
      const f32x2 gtc = *(const f32x2*)(a.gate2 + (size_t)((chunk * PCH) / SEQ) * 6144 + colc);
      for (int ti = 0; ti < PCH / 4; ++ti) {
        const int t = chunk * PCH + wv * (PCH / 4) + ti;
        const unsigned ep = a.epk[(size_t)t * 64 + lane];
        const unsigned char* tab = (VPHASE ? a.v8 : a.u8) + s * 128 + cc * 16;
        u32x4 data[16];
        float cv[16];
        float c_lo = 0.f, c_hi = 0.f;
        if (VPHASE) { c_lo = a.coef[(size_t)t * 128 + lane]; c_hi = a.coef[(size_t)t * 128 + 64 + lane]; }
        unsigned evs[8]; float cvl[8], cvh[8];
        evs[0] = (unsigned)grp_bcast8<0>((int)ep, lane); evs[1] = (unsigned)grp_bcast8<1>((int)ep, lane); evs[2] = (unsigned)grp_bcast8<2>((int)ep, lane); evs[3] = (unsigned)grp_bcast8<3>((int)ep, lane);
        evs[4] = (unsigned)grp_bcast8<4>((int)ep, lane); evs[5] = (unsigned)grp_bcast8<5>((int)ep, lane); evs[6] = (unsigned)grp_bcast8<6>((int)ep, lane); evs[7] = (unsigned)grp_bcast8<7>((int)ep, lane);
#pragma unroll
        for (int i8 = 0; i8 < 8; ++i8) { cvl[i8] = __shfl(c_lo, (lane & ~7) | i8); cvh[i8] = __shfl(c_hi, (lane & ~7) | i8); }
#pragma unroll
        for (int i = 0; i < 16; ++i) {
          const unsigned ev = evs[i & 7];
          const unsigned e = (i < 8) ? (ev & 0xffffu) : (ev >> 16);
          cv[i] = (i < 8) ? cvl[i & 7] : cvh[i & 7];
          data[i] = *(const u32x4*)(tab + (size_t)e * D);
        }
        if (!VPHASE) {
          const u32x4 h0 = *(const u32x4*)(a.h2 + (size_t)t * D + s * 128 + cc * 16), h1 = *(const u32x4*)(a.h2 + (size_t)t * D + s * 128 + cc * 16 + 8);
          float hf[16];
          { const unsigned u[8] = {h0.x, h0.y, h0.z, h0.w, h1.x, h1.y, h1.z, h1.w};
#pragma unroll
            for (int q = 0; q < 8; ++q) { hf[2 * q] = bf_lo(u[q]); hf[2 * q + 1] = bf_hi(u[q]); } }
          float r_lo = 0.f, r_hi = 0.f;
#pragma unroll
          for (int i = 0; i < 16; ++i) {
            float f[16]; cvt16_fp8(data[i], f);
            float d = 0.f;
#pragma unroll
            for (int q = 0; q < 16; ++q) d += f[q] * hf[q];
            d += __builtin_bit_cast(float, __builtin_amdgcn_update_dpp(0, __builtin_bit_cast(int, d), 0xB1, 0xF, 0xF, true));
            d += __builtin_bit_cast(float, __builtin_amdgcn_update_dpp(0, __builtin_bit_cast(int, d), 0x4E, 0xF, 0xF, true));
            d += __builtin_bit_cast(float, __builtin_amdgcn_update_dpp(0, __builtin_bit_cast(int, d), 0x141, 0xF, 0xF, true));
            if ((i & 7) == cc) { if (i < 8) r_lo = d; else r_hi = d; }
          }
          float* pp = a.part + ((size_t)t * 8 + s) * 128;
          pp[lane] = r_lo; pp[64 + lane] = r_hi;
        } else {
          float acc[16];
#pragma unroll
          for (int q = 0; q < 16; ++q) acc[q] = 0.f;
#pragma unroll
          for (int i = 0; i < 16; ++i) {
            float f[16]; cvt16_fp8(data[i], f);
#pragma unroll
            for (int q = 0; q < 16; ++q) acc[q] += cv[i] * f[q];
          }
          float r8[8], r4[4], r2[2];
          { const bool up = (lane & 8) != 0;
#pragma unroll
            for (int q = 0; q < 8; ++q) { const float keep = up ? acc[8 + q] : acc[q], send = up ? acc[q] : acc[8 + q]; r8[q] = keep + __builtin_bit_cast(float, __builtin_amdgcn_update_dpp(0, __builtin_bit_cast(int, send), 0x128, 0xF, 0xF, true)); } }
          { float* xr = (float*)(lds + 1024 + wv * 2048);
            *(f32x4*)(xr + lane * 8) = (f32x4){r8[0], r8[1], r8[2], r8[3]}; *(f32x4*)(xr + lane * 8 + 4) = (f32x4){r8[4], r8[5], r8[6], r8[7]};
            const int qs = ((lane >> 4) & 1) * 4 + ((lane >> 5) & 1) * 2;
            f32x2 t0 = *(const f32x2*)(xr + (0 * 16 + (lane & 15)) * 8 + qs), t1 = *(const f32x2*)(xr + (1 * 16 + (lane & 15)) * 8 + qs);
            const f32x2 t2 = *(const f32x2*)(xr + (2 * 16 + (lane & 15)) * 8 + qs), t3 = *(const f32x2*)(xr + (3 * 16 + (lane & 15)) * 8 + qs);
            t0 += t1; t0 += t2 + t3; r2[0] = t0.x; r2[1] = t0.y; (void)r4; }
          const int col = s * 128 + cc * 16 + ((lane >> 3) & 1) * 8 + ((lane >> 4) & 1) * 4 + ((lane >> 5) & 1) * 2;
          const int b = t / SEQ;
          const unsigned xb = *(const unsigned*)(a.xres + (size_t)t * D + col); const f32x2 gt = gtc; (void)b;
          *(unsigned*)(a.z + (size_t)t * D + col) = cvt_pk_bf16(ALPHA * bf_lo(xb) + gt.x * r2[0], ALPHA * bf_hi(xb) + gt.y * r2[1]);
        }
      }
        continue;
      }
      constexpr int NT = PCH / 4;
      const int t0 = chunk * PCH + wv * NT;
      const unsigned* epr = a.epk + (size_t)t0 * 64 + lane;
      u32x4 dL[8], dH[8]; PeerTok tk;
      unsigned ep = epr[0];
      peer_issue_half<VPHASE, 0>(a, s, lane, cc, ep, dL);
      peer_side_loads<VPHASE>(a, t0, s, lane, cc, tk);
      peer_issue_half<VPHASE, 1>(a, s, lane, cc, ep, dH);
#pragma unroll 1
      for (int ti = 0; ti < NT; ++ti) {
        const int t = t0 + ti;
        const bool more = ti + 1 < NT;
        const unsigned epn = more ? epr[(ti + 1) * 64] : 0u;
        if (!VPHASE) {
          float hf[16];
          { const unsigned u[8] = {tk.h0.x, tk.h0.y, tk.h0.z, tk.h0.w, tk.h1.x, tk.h1.y, tk.h1.z, tk.h1.w};
#pragma unroll
            for (int q = 0; q < 8; ++q) { hf[2 * q] = bf_lo(u[q]); hf[2 * q + 1] = bf_hi(u[q]); } }
          float hmx = 0.f;
#pragma unroll
          for (int q = 0; q < 16; ++q) hmx = fmaxf(hmx, fabsf(hf[q]));
          hmx = fmaxf(hmx, __builtin_bit_cast(float, __builtin_amdgcn_update_dpp(0, __builtin_bit_cast(int, hmx), 0xB1, 0xF, 0xF, true)));
          hmx = fmaxf(hmx, __builtin_bit_cast(float, __builtin_amdgcn_update_dpp(0, __builtin_bit_cast(int, hmx), 0x4E, 0xF, 0xF, true)));
          hmx = fmaxf(hmx, __builtin_bit_cast(float, __builtin_amdgcn_update_dpp(0, __builtin_bit_cast(int, hmx), 0x141, 0xF, 0xF, true)));
          const float sh = hmx > 0.f ? 127.f / hmx : 0.f, ish = hmx * (1.f / 127.f);
          int hq[4];
#pragma unroll
          for (int k4 = 0; k4 < 4; ++k4) {
            const int q0 = (int)__builtin_rintf(hf[4 * k4] * sh), q1 = (int)__builtin_rintf(hf[4 * k4 + 1] * sh), q2 = (int)__builtin_rintf(hf[4 * k4 + 2] * sh), q3 = (int)__builtin_rintf(hf[4 * k4 + 3] * sh);
            hq[k4] = (q0 & 0xff) | ((q1 & 0xff) << 8) | ((q2 & 0xff) << 16) | (q3 << 24);
          }
          const float r_lo = (float)peer_dot_half(dL, hq, cc) * ish;
          __builtin_amdgcn_sched_barrier(0);
          if (more) { peer_issue_half<VPHASE, 0>(a, s, lane, cc, epn, dL); peer_side_loads<VPHASE>(a, t + 1, s, lane, cc, tk); }
          __builtin_amdgcn_sched_barrier(0);
          const float r_hi = (float)peer_dot_half(dH, hq, cc) * ish;
          __builtin_amdgcn_sched_barrier(0);
          if (more) peer_issue_half<VPHASE, 1>(a, s, lane, cc, epn, dH);
          float* pp = a.part + ((size_t)t * 8 + s) * 128;
          pp[lane] = r_lo; pp[64 + lane] = r_hi;
        } else {
          float acc[16];
#pragma unroll
          for (int q = 0; q < 16; ++q) acc[q] = 0.f;
          const float c_lo = tk.c_lo, c_hi = tk.c_hi;
          peer_axpy_half(dL, c_lo, lane, acc);
          __builtin_amdgcn_sched_barrier(0);
          if (more) { peer_issue_half<VPHASE, 0>(a, s, lane, cc, epn, dL); peer_side_loads<VPHASE>(a, t + 1, s, lane, cc, tk); }
          __builtin_amdgcn_sched_barrier(0);
          peer_axpy_half(dH, c_hi, lane, acc);
          __builtin_amdgcn_sched_barrier(0);
          if (more) peer_issue_half<VPHASE, 1>(a, s, lane, cc, epn, dH);
          peer_v_finish(a, t, s, lane, cc, acc);
        }
      }
    }
  }
  __syncthreads();
}
DI void peer_coef_phase(const PeerArgs& a, unsigned char* lds, int bid, int nblk) {
  const int tq = opaque_v(threadIdx.x);
  __syncthreads();
  { const u32x4* su = (const u32x4*)a.uinv; const u32x4* sv = (const u32x4*)a.vinv;
#pragma unroll
    for (int i = 0; i < 8; ++i) { ((u32x4*)lds)[i * 256 + tq] = su[i * 256 + tq]; ((u32x4*)(lds + 32768))[i * 256 + tq] = sv[i * 256 + tq]; } }
  __syncthreads();
  const bf16_t* lu = (const bf16_t*)lds; const bf16_t* lv = (const bf16_t*)(lds + 32768);
  for (int g4 = bid * 256 + tq; g4 < T * 32; g4 += nblk * 256) {
    const int t = g4 >> 5, j = (g4 & 31) * 4;
    const u32x4 ep = *(const u32x4*)(a.epk + (size_t)t * 64 + (j & 63));
    const int sh = (j < 64) ? 0 : 16;
    const unsigned e[4] = {(ep.x >> sh) & 0xffffu, (ep.y >> sh) & 0xffffu, (ep.z >> sh) & 0xffffu, (ep.w >> sh) & 0xffffu};
    f32x4 sum = {0.f, 0.f, 0.f, 0.f};
#pragma unroll
    for (int s8 = 0; s8 < 8; ++s8) sum += *(const f32x4*)(a.part + ((size_t)t * 8 + s8) * 128 + j);
    const f32x4 gt = *(const f32x4*)(a.gate + (size_t)t * 128 + j);
    float ui[4], vi[4];
#pragma unroll
    for (int q = 0; q < 4; ++q) { ui[q] = __builtin_bit_cast(float, (unsigned)lu[e[q]] << 16); vi[q] = __builtin_bit_cast(float, (unsigned)lv[e[q]] << 16); }
    f32x4 o;
#pragma unroll
    for (int q = 0; q < 4; ++q) o[q] = gt[q] * gelu_exact(sum[q] * ui[q]) * vi[q];
    *(f32x4*)(a.coef + (size_t)t * 128 + j) = o;
  }
  __syncthreads();
}

DI void pool_phase(const bf16_t* __restrict__ zin, bf16_t* __restrict__ pout, int bid, int nblk) {
  const int tq = opaque_v(threadIdx.x);
  constexpr int SEG = 32;
  for (int it = bid * 256 + tq; it < (T / SEG) * (D / 8); it += nblk * 256) {
    const int ch = it & 127, seg = it >> 7;
    const int d = ch * 8, win = 2 << (d / 256);
    const int t0 = seg * SEG, tp0 = t0 % SEQ;
    float s[8];
#pragma unroll
    for (int j = 0; j < 8; ++j) s[j] = 0.f;
    for (int w = 1; w < win; ++w) {
      if (tp0 - w < 0) break;
      const u32x4 v = *(const u32x4*)(zin + (size_t)(t0 - w) * D + d);
      const unsigned u[4] = {v.x, v.y, v.z, v.w};
#pragma unroll
      for (int j = 0; j < 4; ++j) { s[2 * j] += bf_lo(u[j]); s[2 * j + 1] += bf_hi(u[j]); }
    }
#pragma unroll 4
    for (int i = 0; i < SEG; ++i) {
      const int t = t0 + i, tp = tp0 + i;
      const u32x4 v = *(const u32x4*)(zin + (size_t)t * D + d);
      const unsigned u[4] = {v.x, v.y, v.z, v.w};
      float z0[8];
#pragma unroll
      for (int j = 0; j < 4; ++j) { z0[2 * j] = bf_lo(u[j]); z0[2 * j + 1] = bf_hi(u[j]); }
#pragma unroll
      for (int j = 0; j < 8; ++j) s[j] += z0[j];
      const int cnt = min(tp + 1, win);
      const float ic = 1.f / (float)cnt;
      float o[8];
#pragma unroll
      for (int j = 0; j < 8; ++j) o[j] = s[j] * ic - z0[j];
      *(u32x4*)(pout + (size_t)t * D + d) = (u32x4){cvt_pk_bf16(o[0], o[1]), cvt_pk_bf16(o[2], o[3]), cvt_pk_bf16(o[4], o[5]), cvt_pk_bf16(o[6], o[7])};
      if (tp + 1 >= win) {
        const u32x4 vo = *(const u32x4*)(zin + (size_t)(t - win + 1) * D + d);
        const unsigned uo[4] = {vo.x, vo.y, vo.z, vo.w};
#pragma unroll
        for (int j = 0; j < 4; ++j) { s[2 * j] -= bf_lo(uo[j]); s[2 * j + 1] -= bf_hi(uo[j]); }
      }
    }
  }
}

#define GRID_SYNC() xcd_barrier(xb)

__global__ void __launch_bounds__(256, 2) mega(Params p) {
  __shared__ __attribute__((aligned(16))) unsigned char lds[LDS_BYTES + 16];
  const int bid = blockIdx.x, nblk = gridDim.x;
  if (threadIdx.x == 0) { *(volatile LAS unsigned*)(lds + LDS_BYTES) = 0u; *(volatile LAS unsigned*)(lds + LDS_BYTES + 4) = 0u; *(volatile LAS unsigned*)(lds + LDS_BYTES + 8) = 0u; }
  __syncthreads();
  const XcdBarrier xb = xcd_barrier_post(p.bar, (volatile LAS unsigned*)(lds + LDS_BYTES));
  const float* mod0 = p.mod; const float* mod1 = p.mod + (size_t)NB * 6144;
  bf16_t* S[7];
#pragma unroll
  for (int i = 0; i < 7; ++i) S[i] = (bf16_t*)p.slot[i];

  prologue_phase(p, lds, bid, nblk);
  GRID_SYNC();
  mod_stage2_phase(p, (const float*)p.slot[1], bid, nblk);
  for (int q = (bid + nblk - 128 % nblk) % nblk; q < 64 + 256; q += nblk) {
    if (q < 64) {
      const int it = q, nt = it & 1, mt = (it >> 1) & 7, g4 = it >> 4;
      gemm_tile(mk(p.PoutT + g4 * 256, D, p.WgrpS + (size_t)g4 * 256 * 256, 256, 256, 256, EPI_BF16, p.WcT + g4 * 256, D), mt * 128, nt * 128, lds);
    } else {
      const int it = q - 64, nt = it & 7, gl = it >> 3;
      if (gl < F8_FROM * 16) gemm_tile(mk(p.KeysB + (size_t)gl * 128 * 128, 128, p.WqB + (size_t)(gl >> 4) * D * 2048 + (gl & 15) * 128, 2048, D, 128, EPI_BF16, p.WeffT + (size_t)gl * 128 * D, D), 0, nt * 128, lds);
      else gemm_tile(mk(p.KeysB + (size_t)gl * 128 * 128, 128, p.WqB + (size_t)(gl >> 4) * D * 2048 + (gl & 15) * 128, 2048, D, 128, EPI_F8, (unsigned char*)(p.WeffT + (size_t)(gl >> 4) * 2048 * D) + (size_t)(gl & 15) * 128 * D, D), 0, nt * 128, lds);
    }
  }
  GRID_SYNC();
  bf16_t *h = S[0], *r = S[1], *k = S[2], *v = S[3], *lw = S[4], *av = S[5];
  bf16_t* tw = p.lora_tmp; bf16_t* ta = tw + (size_t)T * 64; bf16_t* tg = ta + (size_t)T * 64;
  modulate_phase(p.x, mod0, p.rw_mu, h, S[4], S[5], S[6], bid, nblk);
  GRID_SYNC();
  for (int it = 0, nit = sched_iters(4, nblk); it < nit; ++it) {
    int mt, nt; if (!sched_mn(it, bid, nblk, 4, mt, nt)) continue;
    GemmArgs g; int n0;
    if (nt == 0) { n0 = 0; g = mk(h, D, p.W1T, D, 64, D, EPI_TANH, tw, 64, p.rw_mu + 3 * D); }
    else if (nt == 1) { n0 = 0; g = mk(h, D, p.A1T, D, 64, D, EPI_BF16, ta, 64, p.rw_mu + 4 * D); }
    else { n0 = (nt - 2) * 128; g = mk(h, D, p.G1T, D, 192, D, EPI_SIGMOID, tg, 192, p.rw_mu + 5 * D); }
    gemm_tile(g, mt * 128, n0, lds);
  }
  for (int it = 0, nit = sched_iters(24, nblk, 128); it < nit; ++it) {
    int mt, nt; if (!sched_mn(it, bid, nblk, 24, mt, nt, 128)) continue;
    const int j = nt >> 3;
    gemm_tile256(mk(S[4 + j], D, p.WT_rkv + (size_t)j * D * D, D, D, D, EPI_BF16, j == 0 ? r : (j == 1 ? k : v), D), mt * 256, (nt & 7) * 128, lds);
  }
  GRID_SYNC();
  for (int it = 0, nit = sched_iters(16, nblk); it < nit; ++it) {
    int mt, nt; if (!sched_mn(it, bid, nblk, 16, mt, nt)) continue;
    const int j = nt >> 3, n0 = (nt & 7) * 128;
    GemmArgs g;
    if (j == 0) g = mk(tw, 64, p.W2T, 64, D, 64, EPI_LW, lw, D, nullptr, p.rw_w0);
    else g = mk(ta, 64, p.A2T, 64, D, 64, EPI_ASIG, av, D, nullptr, p.rw_a0);
    gemm_tile(g, mt * 128, n0, lds);
  }
  GRID_SYNC();
  {
    ScanArgs s; s.r = r; s.k = k; s.v = v; s.lw = lw; s.a = av; s.k_k = p.rw_k_k; s.k_a = p.rw_k_a; s.r_k = p.rw_r_k; s.lnx_g = p.rw_lnx_g; s.lnx_b = p.rw_lnx_b;
    s.Pg = (bf16_t*)p.out; s.Qz0 = S[0]; s.Qz1 = S[6]; s.Gg = p.Gg; s.Tg = p.WT_rkv;
    { ScanIn cur, nxt; if (bid < NB * NH * NCH) scan_fetch<false>(s, bid, cur);
      for (int it = bid; it < NB * NH * NCH; it += nblk) { if (it + nblk < NB * NH * NCH) scan_fetch<false>(s, it + nblk, nxt); scan_phaseA_item(s, it, cur, lds); cur = nxt; } }
    GRID_SYNC();
    for (int it = bid; it < NB * NH; it += nblk) scan_chain_block(s, it, lds);
    GRID_SYNC();
    { ScanIn cur, nxt; if (bid < NB * NH * NCH) scan_fetch<true>(s, bid, cur);
      for (int it = bid; it < NB * NH * NCH; it += nblk) { if (it + nblk < NB * NH * NCH) scan_fetch<true>(s, it + nblk, nxt); scan_phaseC_item(s, it, cur, lds); cur = nxt; } }
    GRID_SYNC();
  }
  for (int it = 0, nit = sched_iters(8, nblk); it < nit; ++it) {
    int mt, nt; if (!sched_mn(it, bid, nblk, 8, mt, nt)) continue;
    gemm_tile(mk(tg, 192, p.G2T, 192, D, 192, EPI_GATE, r, D), mt * 128, nt * 128, lds);
  }
  GRID_SYNC();
  h = r;
  bf16_t* z = S[2];
  const bool tables_first = bid >= (nblk >> 1);
  if (tables_first) {
  table_fp8_phase<true>(p.pe_u, p.slot[6], (bf16_t*)p.tinv, NEXP, bid, nblk);
  table_fp8_phase<false>(p.pe_v, p.slot[6] + ((size_t)16 << 20), (bf16_t*)p.tinv + NEXP, NEXP, bid, nblk);
  table_fp8_phase<true>(p.pe_u + (size_t)NEXP * D, p.slot[6] + ((size_t)32 << 20), (bf16_t*)p.tinv + 2 * NEXP, NEXP, bid, nblk);
  table_fp8_phase<false>(p.pe_v + (size_t)NEXP * D, p.slot[6] + ((size_t)48 << 20), (bf16_t*)p.tinv + 3 * NEXP, NEXP, bid, nblk);
  }
  for (int it = 0, nit = sched_iters(8, nblk, 128); it < nit; ++it) {
    int mt, nt; if (!sched_mn(it, bid, nblk, 8, mt, nt, 128)) continue;
    gemm_tile256(mk(h, D, p.WoT, D, D, D, EPI_Z, z, D, nullptr, p.x, mod0 + 2 * D), mt * 256, nt * 128, lds);
  }
  if (!tables_first) {
  table_fp8_phase<true>(p.pe_u, p.slot[6], (bf16_t*)p.tinv, NEXP, bid, nblk);
  table_fp8_phase<false>(p.pe_v, p.slot[6] + ((size_t)16 << 20), (bf16_t*)p.tinv + NEXP, NEXP, bid, nblk);
  table_fp8_phase<true>(p.pe_u + (size_t)NEXP * D, p.slot[6] + ((size_t)32 << 20), (bf16_t*)p.tinv + 2 * NEXP, NEXP, bid, nblk);
  table_fp8_phase<false>(p.pe_v + (size_t)NEXP * D, p.slot[6] + ((size_t)48 << 20), (bf16_t*)p.tinv + 3 * NEXP, NEXP, bid, nblk);
  }
  GRID_SYNC();
  ln_phase(z, p.ln_g + 0 * D, p.ln_b + 0 * D, S[4], nullptr, mod0, 3, 4, S[0], F8_FROM <= 0 ? p.slot[5] : nullptr, bid, nblk);
  GRID_SYNC();

#pragma unroll
  for (int layer = 0; layer < 2; ++layer) {
    const float* modl = layer == 0 ? mod0 : mod1;
    const bf16_t* hp = S[0];
    unsigned char* lsl = p.slot[3];
    unsigned* epk = (unsigned*)(lsl + ((size_t)32 << 20));
    float* gate = (float*)(lsl + ((size_t)40 << 20));
    unsigned* lists = (unsigned*)p.slot[1];
    if (layer < F8_FROM) {
      for (int it = 0, nit = sched_iters(16, nblk, 128); it < nit; ++it) {
        int mt, grp; if (!sched_mn(it, bid, nblk, 16, mt, grp, 128)) continue;
        gemm_tile256(mk(hp, D, p.WeffT + (size_t)layer * 2048 * D, D, 2048, D, EPI_TOPK, lists, 0), mt * 256, grp * 128, lds);
      }
    } else {
      for (int it = 0, nit = sched_iters(16, nblk); it < nit; ++it) {
        int mt, grp; if (!sched_mn(it, bid, nblk, 16, mt, grp)) continue;
        gemm_tile_f8(p.slot[5], (const unsigned char*)(p.WeffT + (size_t)layer * 2048 * D), mt * 128, grp, lists, lds);
      }
    }
    GRID_SYNC();
    combine_phase(lists, epk, gate, lds, bid, nblk);
    GRID_SYNC();
    PeerArgs a; a.h2 = hp;
    a.u8 = p.slot[6] + ((size_t)(layer * 32) << 20); a.v8 = a.u8 + ((size_t)16 << 20);
    a.uinv = (const bf16_t*)p.tinv + (layer * 2) * NEXP; a.vinv = a.uinv + NEXP;
    a.epk = epk; a.gate = gate; a.part = (float*)p.slot[1]; a.coef = (float*)lsl;
    a.xres = S[4]; a.gate2 = modl + 5 * D; a.z = S[1];
    a.ctr_u = p.bar + XCD_BAR_WORDS + (layer * 2) * 128; a.ctr_v = a.ctr_u + 128;
    peer_slice_phase<false>(a, lds);
    GRID_SYNC();
    peer_coef_phase(a, lds, bid, nblk);
    GRID_SYNC();
    peer_slice_phase<true>(a, lds);
    GRID_SYNC();
    if (layer == 1) { ln_phase(a.z, p.ln_g + 3 * D, p.ln_b + 3 * D, nullptr, p.out, mod1, 0, 1, nullptr, nullptr, bid, nblk); break; }
    ln_phase(a.z, p.ln_g + 1 * D, p.ln_b + 1 * D, S[4], nullptr, mod1, 0, 1, S[0], nullptr, bid, nblk);
    GRID_SYNC();
    const bf16_t* x2 = S[4];
    bf16_t *hB = S[0], *zin = S[1], *pp = S[2];
    for (int it = 0, nit = sched_iters(8, nblk, 128); it < nit; ++it) {
      int mt, nt; if (!sched_mn(it, bid, nblk, 8, mt, nt, 128)) continue;
      gemm_tile256(mk(hB, D, p.PinT, D, D, D, EPI_BF16, zin, D), mt * 256, nt * 128, lds);
    }
    GRID_SYNC();
    pool_phase(zin, pp, bid, nblk);
    GRID_SYNC();
    bf16_t* z1 = S[3];
    for (int it = 0, nit = sched_iters(8, nblk, 128); it < nit; ++it) {
      int mt, nt; if (!sched_mn(it, bid, nblk, 8, mt, nt, 128)) continue;
      gemm_tile256(mk(pp, D, p.WcT, D, D, D, EPI_ZB, z1, D, nullptr, (const float*)x2, mod1 + 2 * D), mt * 256, nt * 128, lds);
    }
    GRID_SYNC();
    ln_phase(z1, p.ln_g + 2 * D, p.ln_b + 2 * D, S[4], nullptr, mod1, 3, 4, S[0], F8_FROM <= 1 ? p.slot[5] : nullptr, bid, nblk);
    GRID_SYNC();
  }
}

extern "C" void kernel_launch(void* const* d_in, const int* in_sizes, int n_in, void* d_out, int out_size, void* d_ws, size_t ws_size, hipStream_t stream) {
  Params p{};
  const float** ip = (const float**)&p.x;
  for (int i = 0; i < 30; ++i) ip[i] = (const float*)d_in[i];
  p.out = (float*)d_out;
  unsigned char* w = (unsigned char*)d_ws; size_t off = 0;
  auto take = [&](size_t bytes) { unsigned char* r = w + off; off += (bytes + 255) & ~(size_t)255; return r; };
  p.bar = (unsigned*)take(16384);
  p.mod = (float*)take((size_t)2 * NB * 6144 * 4);
  p.WT_rkv = (bf16_t*)take((size_t)3 * D * D * 2);
  p.W1T = (bf16_t*)take((size_t)128 * D * 2); p.A1T = (bf16_t*)take((size_t)128 * D * 2); p.G1T = (bf16_t*)take((size_t)256 * D * 2);
  p.W2T = (bf16_t*)take((size_t)D * 64 * 2); p.A2T = (bf16_t*)take((size_t)D * 64 * 2);
  p.WqB = (bf16_t*)take((size_t)2 * 2048 * D * 2); p.KeysB = (bf16_t*)take((size_t)2 * 16 * 128 * 128 * 2);
  p.lora_tmp = (bf16_t*)take((size_t)T * 320 * 2);
  p.G2T = (bf16_t*)take((size_t)D * 192 * 2);
  p.WoT = (bf16_t*)take((size_t)D * D * 2); p.PinT = (bf16_t*)take((size_t)D * D * 2); p.PoutT = (bf16_t*)take((size_t)D * D * 2);
  p.WgrpS = (bf16_t*)take((size_t)4 * 256 * 256 * 2); p.WcT = (bf16_t*)take((size_t)D * D * 2); p.WeffT = (bf16_t*)take((size_t)2 * 2048 * D * 2);
  p.tinv = (float*)take((size_t)4 * NEXP * 4);
  p.Gg = (float*)take((size_t)16384 * 64 * 4);
  for (int i = 0; i < 7; ++i) p.slot[i] = take((size_t)64 << 20);
  if (off > ws_size) return;

  static int grid_blocks = 0;
  if (!grid_blocks) {
    int dev = 0, cus = 0, per_cu = 0;
    hipGetDevice(&dev);
    hipDeviceGetAttribute(&cus, hipDeviceAttributeMultiprocessorCount, dev);
    hipOccupancyMaxActiveBlocksPerMultiprocessor(&per_cu, mega, 256, 0);
    if (per_cu > 2) per_cu = 2;
    if (per_cu < 1) per_cu = 1;
    grid_blocks = cus * per_cu;
  }
  hipMemsetAsync(p.bar, 0, 16384, stream);
  void* args[] = {&p};
  hipLaunchCooperativeKernel((void*)mega, dim3(grid_blocks), dim3(256), args, 0, stream);
}
```
